# Optimizing an MI355X kernel written in HIP

```python
import math
import jax, jax.numpy as jnp
from jax import lax
import numpy as np

D_MODEL = 1024
BATCH = 8
SEQ = 4096
DEPTH = 2

F32 = jnp.float32
EPS = 1e-6
Q_BLOCK = 128
ROPE_THETA = 500000.0
ROT_FRACTION = 4

SSD_HEADS = 4
SSD_HEAD_DIM = 64
SSD_D_INNER = SSD_HEADS * SSD_HEAD_DIM
SSD_GROUPS = 2
SSD_STATE = 128
SSD_CONV = 4
SSD_CONV_DIM = SSD_D_INNER + 2 * SSD_GROUPS * SSD_STATE
SSD_CHUNK = 128

DSA_HEADS = 4
DSA_HEAD_DIM = 64
IDX_HEADS = 8
IDX_DIM = 64
IDX_TOPK_MAX = 256

MLA_HEADS = 4
MLA_Q_RANK = 256
MLA_KV_RANK = 128
MLA_NOPE = 64
MLA_ROPE = 32
MLA_V = 64

FOX_HEADS = 4
FOX_HEAD_DIM = 64
FOX_FORGET_BIAS_INIT = 2.0

MIX_WIDTH = SSD_D_INNER + DSA_HEADS * DSA_HEAD_DIM + MLA_HEADS * MLA_V + FOX_HEADS * FOX_HEAD_DIM

IN_SPLITS = (SSD_D_INNER, SSD_CONV_DIM, SSD_HEADS,
             DSA_HEADS * DSA_HEAD_DIM, DSA_HEAD_DIM, DSA_HEAD_DIM, IDX_HEADS * IDX_DIM, IDX_DIM, IDX_HEADS,
             MLA_Q_RANK, MLA_KV_RANK, MLA_ROPE,
             FOX_HEADS * FOX_HEAD_DIM, FOX_HEADS * FOX_HEAD_DIM, FOX_HEADS * FOX_HEAD_DIM, FOX_HEADS)
IN_COLS = sum(IN_SPLITS)

MOE_GROUPS = 4
MOE_EXPERTS_PER_GROUP = 8
MOE_EXPERTS = MOE_GROUPS * MOE_EXPERTS_PER_GROUP
MOE_TOPK = 2
MOE_FF = 256
MOE_BLOCK = 128

kernel_name = 'hybrid_ssd_dsa_mla_fox_hmoe'


def rmsnorm(x, g):
    xf = x.astype(F32)
    y = xf * lax.rsqrt(jnp.mean(xf * xf, axis=-1, keepdims=True) + EPS) * g.astype(F32)
    return y.astype(x.dtype)


def rope(x, positions, rot_dim):
    half = rot_dim // 2
    inv = ROPE_THETA ** (-jnp.arange(half, dtype=F32) / half)
    ang = positions.astype(F32)[..., None] * inv
    cos = jnp.cos(ang)[:, :, None, :]
    sin = jnp.sin(ang)[:, :, None, :]
    xr = x[..., :rot_dim].astype(F32)
    x1, x2 = xr[..., :half], xr[..., half:]
    rot = jnp.concatenate([x1 * cos - x2 * sin, x2 * cos + x1 * sin], axis=-1).astype(x.dtype)
    return jnp.concatenate([rot, x[..., rot_dim:]], axis=-1)


def split_points():
    pts, acc = [], 0
    for w in IN_SPLITS[:-1]:
        acc += w
        pts.append(acc)
    return pts


def ssd_scan(xh, dt, a, bh, ch):
    b, s, h, p = xh.shape
    n = bh.shape[-1]
    c = s // SSD_CHUNK
    xh = xh.astype(F32).reshape(b, c, SSD_CHUNK, h, p)
    bh = bh.astype(F32).reshape(b, c, SSD_CHUNK, h, n)
    ch = ch.astype(F32).reshape(b, c, SSD_CHUNK, h, n)
    dt = dt.reshape(b, c, SSD_CHUNK, h)
    a_cs = jnp.cumsum(jnp.moveaxis(dt * a, -1, 1), axis=-1)
    tri = jnp.tril(jnp.ones((SSD_CHUNK, SSD_CHUNK), dtype=bool))
    seg = jnp.exp(jnp.where(tri, a_cs[..., :, None] - a_cs[..., None, :], -jnp.inf))
    xdt = xh * dt[..., None]
    y_diag = jnp.einsum('bcqhn,bckhn,bhcqk,bckhp->bcqhp', ch, bh, seg, xdt)
    decay_to_end = jnp.exp(a_cs[..., -1:] - a_cs)
    chunk_states = jnp.einsum('bckhn,bhck,bckhp->cbhpn', bh, decay_to_end, xdt)
    chunk_decay = jnp.moveaxis(jnp.exp(a_cs[..., -1]), -1, 0)

    def step(state, inp):
        st, dec = inp
        return state * dec[..., None, None] + st, state

    _, prev = lax.scan(step, jnp.zeros((b, h, p, n), F32), (chunk_states, chunk_decay))
    y_off = jnp.einsum('bcqhn,cbhpn,bhcq->bcqhp', ch, prev, jnp.exp(a_cs))
    return (y_diag + y_off).reshape(b, s, h, p)


def ssd_mixer(z, xbc, dt_raw, conv_w, conv_b, dt_bias, a_log, d_skip, norm_w):
    b, s, _ = z.shape
    xbc = lax.conv_general_dilated(xbc, conv_w[:, None, :].astype(xbc.dtype), window_strides=(1,),
                                   padding=[(SSD_CONV - 1, 0)], dimension_numbers=('NWC', 'WIO', 'NWC'),
                                   feature_group_count=SSD_CONV_DIM) + conv_b
    xbc = jax.nn.silu(xbc)
    xs = xbc[..., :SSD_D_INNER]
    bm = xbc[..., SSD_D_INNER:SSD_D_INNER + SSD_GROUPS * SSD_STATE]
    cm = xbc[..., SSD_D_INNER + SSD_GROUPS * SSD_STATE:]
    rep = SSD_HEADS // SSD_GROUPS
    xh = xs.reshape(b, s, SSD_HEADS, SSD_HEAD_DIM)
    bh = jnp.repeat(bm.reshape(b, s, SSD_GROUPS, SSD_STATE), rep, axis=2)
    ch = jnp.repeat(cm.reshape(b, s, SSD_GROUPS, SSD_STATE), rep, axis=2)
    dt = jax.nn.softplus(dt_raw.astype(F32) + dt_bias.astype(F32))
    a = -jnp.exp(a_log.astype(F32))
    y = ssd_scan(xh, dt, a, bh, ch) + d_skip.astype(F32)[:, None] * xh.astype(F32)
    y = y.reshape(b, s, SSD_D_INNER)
    return rmsnorm(y * jax.nn.silu(z.astype(F32)), norm_w)


def blocked_causal_attention(q, k, v, fcum=None):
    b, s, h, dq = q.shape
    dv = v.shape[-1]
    scale = dq ** -0.5
    k_pos = jnp.arange(s)
    f_t = None if fcum is None else jnp.moveaxis(fcum, 1, 2)

    def one(i):
        start = i * Q_BLOCK
        q_blk = lax.dynamic_slice_in_dim(q, start, Q_BLOCK, axis=1)
        logits = jnp.einsum('bqhd,bkhd->bhqk', q_blk, k).astype(F32) * scale
        if f_t is not None:
            f_q = lax.dynamic_slice_in_dim(f_t, start, Q_BLOCK, axis=2)
            logits = logits + f_q[..., :, None] - f_t[:, :, None, :]
        q_pos = start + jnp.arange(Q_BLOCK)
        mask = k_pos[None, :] <= q_pos[:, None]
        p = jax.nn.softmax(jnp.where(mask, logits, -jnp.inf), axis=-1)
        return jnp.einsum('bhqk,bkhd->bqhd', p.astype(v.dtype), v)

    out = lax.map(one, jnp.arange(s // Q_BLOCK))
    return jnp.moveaxis(out, 0, 1).reshape(b, s, h * dv)


def dsa_mixer(q, k, v, q_idx, k_idx, w_idx, positions, n_sel):
    b, s, _ = q.shape
    q = rope(q.reshape(b, s, DSA_HEADS, DSA_HEAD_DIM), positions, DSA_HEAD_DIM // ROT_FRACTION)
    k = rope(k[:, :, None, :], positions, DSA_HEAD_DIM // ROT_FRACTION)[:, :, 0]
    q_idx = rope(q_idx.reshape(b, s, IDX_HEADS, IDX_DIM), positions, IDX_DIM // ROT_FRACTION)
    k_idx = rope(k_idx[:, :, None, :], positions, IDX_DIM // ROT_FRACTION)[:, :, 0]
    w_idx = w_idx.astype(F32) * (IDX_HEADS * IDX_DIM) ** -0.5
    scale = DSA_HEAD_DIM ** -0.5
    k_pos = jnp.arange(s)
    bidx = jnp.arange(b)[:, None, None]

    def one(i):
        start = i * Q_BLOCK
        q_blk = lax.dynamic_slice_in_dim(q, start, Q_BLOCK, axis=1)
        qi_blk = lax.dynamic_slice_in_dim(q_idx, start, Q_BLOCK, axis=1)
        wi_blk = lax.dynamic_slice_in_dim(w_idx, start, Q_BLOCK, axis=1)
        q_pos = start + jnp.arange(Q_BLOCK)
        rel = jax.nn.relu(jnp.einsum('bqjd,bkd->bqjk', qi_blk, k_idx).astype(F32))
        score = jnp.einsum('bqjk,bqj->bqk', rel, wi_blk)
        score = jnp.where((k_pos[None, :] <= q_pos[:, None])[None], score, -jnp.inf)
        _, sel = lax.top_k(score, n_sel)
        k_sel = k[bidx, sel]
        v_sel = v[bidx, sel]
        logits = jnp.einsum('bqhd,bqnd->bhqn', q_blk, k_sel).astype(F32) * scale
        valid = (sel <= q_pos[None, :, None])[:, None]
        p = jax.nn.softmax(jnp.where(valid, logits, -jnp.inf), axis=-1)
        return jnp.einsum('bhqn,bqnd->bqhd', p.astype(v.dtype), v_sel)

    out = lax.map(one, jnp.arange(s // Q_BLOCK))
    return jnp.moveaxis(out, 0, 1).reshape(b, s, DSA_HEADS * DSA_HEAD_DIM)


def mla_mixer(c_q, c_kv, k_rope, positions, q_norm, w_uq, kv_norm, w_ukv):
    b, s, _ = c_q.shape
    qf = (rmsnorm(c_q, q_norm) @ w_uq).reshape(b, s, MLA_HEADS, MLA_NOPE + MLA_ROPE)
    kvf = (rmsnorm(c_kv, kv_norm) @ w_ukv).reshape(b, s, MLA_HEADS, MLA_NOPE + MLA_V)
    q_pe = rope(qf[..., MLA_NOPE:], positions, MLA_ROPE)
    k_pe = rope(k_rope[:, :, None, :], positions, MLA_ROPE)
    q = jnp.concatenate([qf[..., :MLA_NOPE], q_pe], axis=-1)
    k = jnp.concatenate([kvf[..., :MLA_NOPE], jnp.broadcast_to(k_pe, (b, s, MLA_HEADS, MLA_ROPE))], axis=-1)
    v = kvf[..., MLA_NOPE:]
    return blocked_causal_attention(q, k, v)


def fox_mixer(q, k, v, f_raw, f_bias):
    b, s, _ = q.shape
    shp = (b, s, FOX_HEADS, FOX_HEAD_DIM)
    log_f = jax.nn.log_sigmoid(f_raw.astype(F32) + f_bias.astype(F32))
    fcum = jnp.cumsum(log_f, axis=1)
    return blocked_causal_attention(q.reshape(shp), k.reshape(shp), v.reshape(shp), fcum)


def hier_moe(h, w_rg, b_rg, w_re, b_re, w_gate, w_up, w_down):
    t, d = h.shape
    g_prob = jax.nn.softmax((h @ w_rg + b_rg).astype(F32), axis=-1)
    g_p, g_idx = lax.top_k(g_prob, 1)
    e_logits = (h @ w_re + b_re).astype(F32).reshape(t, MOE_GROUPS, MOE_EXPERTS_PER_GROUP)
    e_in = jnp.take_along_axis(e_logits, g_idx[:, :, None], axis=1)[:, 0]
    e_top, e_loc = lax.top_k(e_in, MOE_TOPK)
    e_w = jax.nn.softmax(e_top, axis=-1) * g_p
    e_id = g_idx * MOE_EXPERTS_PER_GROUP + e_loc
    n_assign = t * MOE_TOPK
    flat_e = e_id.reshape(-1)
    flat_tok = jnp.repeat(jnp.arange(t, dtype=jnp.int32), MOE_TOPK)
    flat_w = e_w.reshape(-1)
    order = jnp.argsort(flat_e)
    se, stok, sw = flat_e[order], flat_tok[order], flat_w[order]
    counts = jnp.bincount(flat_e, length=MOE_EXPERTS)
    starts = jnp.cumsum(counts) - counts
    pcounts = ((counts + MOE_BLOCK - 1) // MOE_BLOCK) * MOE_BLOCK
    pends = jnp.cumsum(pcounts)
    pstarts = pends - pcounts
    dest = pstarts[se] + (jnp.arange(n_assign) - starts[se])
    n_slots = n_assign + MOE_EXPERTS * MOE_BLOCK
    n_slots = ((n_slots + MOE_BLOCK - 1) // MOE_BLOCK) * MOE_BLOCK
    slot_tok = jnp.zeros((n_slots,), jnp.int32).at[dest].set(stok)
    slot_w = jnp.zeros((n_slots,), F32).at[dest].set(sw)
    n_blocks = n_slots // MOE_BLOCK
    block_e = jnp.minimum(jnp.searchsorted(pends, jnp.arange(n_blocks) * MOE_BLOCK, side='right'), MOE_EXPERTS - 1)
    xs = h[slot_tok].reshape(n_blocks, MOE_BLOCK, d)

    def expert_block(args):
        xb, e = args
        return (jax.nn.silu(xb @ w_gate[e]) * (xb @ w_up[e])) @ w_down[e]

    ys = lax.map(expert_block, (xs, block_e)).reshape(n_slots, d)
    return jax.ops.segment_sum(ys * slot_w[:, None].astype(ys.dtype), slot_tok, num_segments=t)


def setup_inputs(seed: int = 0) -> dict:
    key = jax.random.key(seed)
    ks = jax.random.split(key, 28)
    L, D = DEPTH, D_MODEL

    def nrm(k, shape, scale):
        return jax.random.normal(k, shape, F32) * scale

    x = jax.random.normal(ks[0], (BATCH, SEQ, D), F32)
    positions = jnp.broadcast_to(jnp.arange(SEQ, dtype=jnp.int32), (BATCH, SEQ))
    norm_mix = 1.0 + nrm(ks[1], (L, D), 0.02)
    w_in = nrm(ks[2], (L, D, IN_COLS), D ** -0.5)
    ssd_conv_w = nrm(ks[3], (L, SSD_CONV, SSD_CONV_DIM), SSD_CONV ** -0.5)
    ssd_conv_b = nrm(ks[4], (L, SSD_CONV_DIM), 0.02)
    dt0 = jnp.exp(jax.random.uniform(ks[5], (L, SSD_HEADS), F32, math.log(1e-3), math.log(1e-1)))
    ssd_dt_bias = dt0 + jnp.log(-jnp.expm1(-dt0))
    ssd_a_log = jnp.log(jax.random.uniform(ks[6], (L, SSD_HEADS), F32, 1.0, 16.0))
    ssd_d = 1.0 + nrm(ks[7], (L, SSD_HEADS), 0.1)
    ssd_norm = 1.0 + nrm(ks[8], (L, SSD_D_INNER), 0.02)
    mla_q_norm = 1.0 + nrm(ks[9], (L, MLA_Q_RANK), 0.02)
    mla_w_uq = nrm(ks[10], (L, MLA_Q_RANK, MLA_HEADS * (MLA_NOPE + MLA_ROPE)), MLA_Q_RANK ** -0.5)
    mla_kv_norm = 1.0 + nrm(ks[11], (L, MLA_KV_RANK), 0.02)
    mla_w_ukv = nrm(ks[12], (L, MLA_KV_RANK, MLA_HEADS * (MLA_NOPE + MLA_V)), MLA_KV_RANK ** -0.5)
    fox_f_bias = FOX_FORGET_BIAS_INIT + nrm(ks[13], (L, FOX_HEADS), 0.1)
    w_out = nrm(ks[14], (L, MIX_WIDTH, D), 0.5 * MIX_WIDTH ** -0.5)
    norm_ffn = 1.0 + nrm(ks[15], (L, D), 0.02)
    router_group_w = nrm(ks[16], (L, D, MOE_GROUPS), D ** -0.5)
    router_group_b = nrm(ks[17], (L, MOE_GROUPS), 0.01)
    router_expert_w = nrm(ks[18], (L, D, MOE_EXPERTS), D ** -0.5)
    router_expert_b = nrm(ks[19], (L, MOE_EXPERTS), 0.01)
    expert_w_gate = nrm(ks[20], (L, MOE_EXPERTS, D, MOE_FF), D ** -0.5)
    expert_w_up = nrm(ks[21], (L, MOE_EXPERTS, D, MOE_FF), D ** -0.5)
    expert_w_down = nrm(ks[22], (L, MOE_EXPERTS, MOE_FF, D), MOE_FF ** -0.5)
    final_norm = 1.0 + nrm(ks[23], (D,), 0.02)
    return {'x': x, 'positions': positions, 'norm_mix': norm_mix, 'w_in': w_in,
            'ssd_conv_w': ssd_conv_w, 'ssd_conv_b': ssd_conv_b, 'ssd_dt_bias': ssd_dt_bias,
            'ssd_a_log': ssd_a_log, 'ssd_d': ssd_d, 'ssd_norm': ssd_norm,
            'mla_q_norm': mla_q_norm, 'mla_w_uq': mla_w_uq, 'mla_kv_norm': mla_kv_norm, 'mla_w_ukv': mla_w_ukv,
            'fox_f_bias': fox_f_bias, 'w_out': w_out, 'norm_ffn': norm_ffn,
            'router_group_w': router_group_w, 'router_group_b': router_group_b,
            'router_expert_w': router_expert_w, 'router_expert_b': router_expert_b,
            'expert_w_gate': expert_w_gate, 'expert_w_up': expert_w_up, 'expert_w_down': expert_w_down,
            'final_norm': final_norm}


def reference(x, positions, norm_mix, w_in, ssd_conv_w, ssd_conv_b, ssd_dt_bias, ssd_a_log, ssd_d, ssd_norm,
              mla_q_norm, mla_w_uq, mla_kv_norm, mla_w_ukv, fox_f_bias, w_out, norm_ffn,
              router_group_w, router_group_b, router_expert_w, router_expert_b,
              expert_w_gate, expert_w_up, expert_w_down, final_norm):
    b, s, _ = x.shape
    n_sel = min(IDX_TOPK_MAX, s // 4)
    pts = split_points()
    for l in range(DEPTH):
        h = rmsnorm(x, norm_mix[l])
        proj = h @ w_in[l]
        (ssd_z, ssd_xbc, ssd_dt, dsa_q, dsa_k, dsa_v, idx_q, idx_k, idx_w,
         mla_cq, mla_ckv, mla_kr, fox_q, fox_k, fox_v, fox_f) = jnp.split(proj, pts, axis=-1)
        y_ssd = ssd_mixer(ssd_z, ssd_xbc, ssd_dt, ssd_conv_w[l], ssd_conv_b[l], ssd_dt_bias[l],
                          ssd_a_log[l], ssd_d[l], ssd_norm[l])
        y_dsa = dsa_mixer(dsa_q, dsa_k, dsa_v, idx_q, idx_k, idx_w, positions, n_sel)
        y_mla = mla_mixer(mla_cq, mla_ckv, mla_kr, positions, mla_q_norm[l], mla_w_uq[l], mla_kv_norm[l], mla_w_ukv[l])
        y_fox = fox_mixer(fox_q, fox_k, fox_v, fox_f, fox_f_bias[l])
        heads = jnp.concatenate([y_ssd.astype(x.dtype), y_dsa.astype(x.dtype),
                                 y_mla.astype(x.dtype), y_fox.astype(x.dtype)], axis=-1)
        x = x + heads @ w_out[l]
        h2 = rmsnorm(x, norm_ffn[l]).reshape(b * s, D_MODEL)
        y_ffn = hier_moe(h2, router_group_w[l], router_group_b[l], router_expert_w[l], router_expert_b[l],
                         expert_w_gate[l], expert_w_up[l], expert_w_down[l])
        x = x + y_ffn.reshape(b, s, D_MODEL).astype(x.dtype)
    return rmsnorm(x, final_norm)
```

```cpp
#include <hip/hip_runtime.h>
#include <hip/hip_cooperative_groups.h>
#include <cstdio>
#include <cmath>
#include <cstdint>


namespace cg = cooperative_groups;

typedef __attribute__((ext_vector_type(8))) short bf16x8;
typedef __attribute__((ext_vector_type(4))) short bf16x4;
typedef __attribute__((ext_vector_type(16))) float f32x16;
typedef unsigned short u16;
typedef unsigned long long u64;

#define DI __device__ __forceinline__
#define MFMA32(a, b, c) __builtin_amdgcn_mfma_f32_32x32x16_bf16((a), (b), (c), 0, 0, 0)

constexpr int T_TOK = 32768, SEQ = 4096, NB = 8, DM = 1024, DEPTH = 2;
constexpr int NREF = 3184;
constexpr int NPAD = 3200;
constexpr int LDP = 2848;
constexpr int PC_Z = 0, PC_XBC = 256, PC_DSAQ = 1024, PC_DSAK = 1280, PC_IDXQ = 1344, PC_IDXK = 1856,
              PC_CQ = 1920, PC_CKV = 2176, PC_KR = 2304, PC_FOXQ = 2336, PC_FOXK = 2592;
constexpr int NC_DSAV = 2848, NC_FOXV = 2912, NC_SMALL = 3168;
constexpr float EPS = 1e-6f;
constexpr float LOG2E = 1.4426950408889634f;
constexpr int NTHR = 512;
constexpr int LDS_BYTES = 147456;

constexpr size_t al256(size_t x) { return (x + 255) & ~(size_t)255; }
constexpr size_t WS_CTL   = 0;
constexpr size_t WS_WIN   = 4096;
constexpr size_t WS_WUQ   = WS_WIN  + (size_t)2 * NPAD * 1024 * 2;
constexpr size_t WS_WUKV  = WS_WUQ  + (size_t)2 * 384 * 256 * 2;
constexpr size_t WS_WOUT  = WS_WUKV + (size_t)2 * 512 * 128 * 2;
constexpr size_t WS_WG    = WS_WOUT + (size_t)2 * 1024 * 1024 * 2;
constexpr size_t WS_WU    = WS_WG   + (size_t)32 * 256 * 1024 * 2;
constexpr size_t WS_WD    = WS_WU   + (size_t)32 * 256 * 1024 * 2;
constexpr size_t WS_TRIG  = WS_WD   + (size_t)32 * 256 * 1024 * 2;
constexpr size_t WS_ACT   = WS_TRIG + (size_t)T_TOK * 48 * 4;
constexpr size_t WS_PROJ  = WS_ACT  + (size_t)T_TOK * 1024 * 2;
constexpr size_t WS_SMALL = WS_PROJ + (size_t)T_TOK * LDP * 2;
constexpr size_t WS_MLAQ  = WS_SMALL + (size_t)T_TOK * 16 * 4;
constexpr size_t WS_MLAK  = WS_MLAQ + (size_t)T_TOK * 384 * 2;
constexpr size_t WS_MLAVT = WS_MLAK + (size_t)T_TOK * 384 * 2;
constexpr size_t WS_DSAVT = WS_MLAVT + (size_t)T_TOK * 256 * 2;
constexpr size_t WS_FOXVT = WS_DSAVT + (size_t)T_TOK * 64 * 2;
constexpr size_t WS_FLOG  = WS_FOXVT + (size_t)T_TOK * 256 * 2;
constexpr size_t WS_CS    = WS_FLOG + (size_t)T_TOK * 4 * 4;
constexpr size_t WS_CDEC  = WS_CS   + (size_t)8 * 32 * 4 * 64 * 128 * 4;
constexpr size_t WS_MASK  = WS_CDEC + 4096;
constexpr size_t WS_TOKW  = WS_MASK + (size_t)T_TOK * 64 * 8;
constexpr size_t WS_END   = WS_TOKW + (size_t)T_TOK * 2 * 4;
constexpr size_t WS_LIST  = WS_PROJ;
constexpr size_t WS_HMID  = WS_PROJ + (size_t)64 * 32768 * 4;
static_assert(WS_HMID + (size_t)T_TOK * 512 * 2 <= WS_SMALL, "aliases must fit in PROJ");
static_assert(WS_END <= (size_t)512 * 1024 * 1024, "workspace budget");

struct Args {
    const float* in[25];
    float* out;
    unsigned char* ws;
    float inv16[8];
    float inv32[16];
    int ph_lo, ph_hi;
};

typedef const __attribute__((address_space(4))) Args KArgs;
struct Ctx { int tid, lane, wave; unsigned char* lds; };
__device__ __forceinline__ Ctx fresh_ctx(unsigned char* lds) {
    int t = threadIdx.x; asm volatile("" : "+v"(t));
    Ctx c; c.tid = t; c.lane = t & 63; c.wave = __builtin_amdgcn_readfirstlane(t >> 6); c.lds = lds; return c;
}

DI u16 f2bf(float x) { unsigned u = __float_as_uint(x); u += 0x7fffu + ((u >> 16) & 1u); return (u16)(u >> 16); }
DI float bf2f(u16 h) { return __uint_as_float(((unsigned)h) << 16); }
DI unsigned pack2(float a, float b) { return (unsigned)f2bf(a) | ((unsigned)f2bf(b) << 16); }
DI float wsum(float v) { for (int o = 32; o >= 1; o >>= 1) v += __shfl_xor(v, o); return v; }
DI float wmaxf(float v) { for (int o = 32; o >= 1; o >>= 1) v = fmaxf(v, __shfl_xor(v, o)); return v; }
DI float wminf(float v) { for (int o = 32; o >= 1; o >>= 1) v = fminf(v, __shfl_xor(v, o)); return v; }
DI float siluf(float x) { return x / (1.f + __expf(-x)); }
DI float softplusf(float x) { return fmaxf(x, 0.f) + log1pf(__expf(-fabsf(x))); }
DI int crow(int reg, int h) { return (reg & 3) + 8 * (reg >> 2) + 4 * h; }
DI bf16x8 pack8(const f32x16& x, int s) {
    uint4 p;
    p.x = pack2(x[8 * s + 0], x[8 * s + 1]); p.y = pack2(x[8 * s + 2], x[8 * s + 3]);
    p.z = pack2(x[8 * s + 4], x[8 * s + 5]); p.w = pack2(x[8 * s + 6], x[8 * s + 7]);
    return __builtin_bit_cast(bf16x8, p);
}
DI f32x16 zero16() { f32x16 z; for (int i = 0; i < 16; ++i) z[i] = 0.f; return z; }

DI int ref_col(int n) {
    if (n < 1024) return n;
    if (n < 1280) return n - 1024 + 1028;
    if (n < 1344) return n - 1280 + 1284;
    if (n < 1856) return n - 1344 + 1412;
    if (n < 1920) return n - 1856 + 1924;
    if (n < 2176) return n - 1920 + 1996;
    if (n < 2304) return n - 2176 + 2252;
    if (n < 2336) return n - 2304 + 2380;
    if (n < 2592) return n - 2336 + 2412;
    if (n < 2848) return n - 2592 + 2668;
    if (n < 2912) return n - 2848 + 1348;
    if (n < 3168) return n - 2912 + 2924;
    if (n < 3172) return n - 3168 + 1024;
    if (n < 3180) return n - 3172 + 1988;
    if (n < 3184) return n - 3180 + 3180;
    return -1;
}

constexpr int G_LDT = 72;
constexpr int G_AEL = 256 * G_LDT, G_BEL = 128 * G_LDT, G_STEL = G_AEL + G_BEL;
constexpr int G_LDS_BYTES = 2 * G_STEL * 2;

struct GP { const u16 *a0, *a1, *a2, *a3, *b0, *b1; };

template <bool PAIRED>
DI void gemm_core(const Ctx& c, int K, const GP& gp, f32x16 (&acc)[2][2]) {
    u16* S = (u16*)c.lds;
    const int r8 = c.tid >> 3, kc = c.tid & 7;
    const int wm = c.wave & 3, wn = c.wave >> 2, l31 = c.lane & 31, h = c.lane >> 5;
    const int nb0 = PAIRED ? wn * 32 : wn * 64, nb1 = PAIRED ? 64 + wn * 32 : wn * 64 + 32;
    uint4 ra0, ra1, ra2, ra3, rb0, rb1;
    const int nk = K >> 6;
#define G_LOAD(KOFF) do { \
        ra0 = *(const uint4*)(gp.a0 + (KOFF) + kc * 8); ra1 = *(const uint4*)(gp.a1 + (KOFF) + kc * 8); \
        ra2 = *(const uint4*)(gp.a2 + (KOFF) + kc * 8); ra3 = *(const uint4*)(gp.a3 + (KOFF) + kc * 8); \
        rb0 = *(const uint4*)(gp.b0 + (KOFF) + kc * 8); rb1 = *(const uint4*)(gp.b1 + (KOFF) + kc * 8); } while (0)
#define G_STORE(SP) do { u16* sp_ = (SP); \
        *(uint4*)(sp_ + (r8) * G_LDT + kc * 8) = ra0; *(uint4*)(sp_ + (r8 + 64) * G_LDT + kc * 8) = ra1; \
        *(uint4*)(sp_ + (r8 + 128) * G_LDT + kc * 8) = ra2; *(uint4*)(sp_ + (r8 + 192) * G_LDT + kc * 8) = ra3; \
        *(uint4*)(sp_ + G_AEL + (r8) * G_LDT + kc * 8) = rb0; *(uint4*)(sp_ + G_AEL + (r8 + 64) * G_LDT + kc * 8) = rb1; } while (0)
    G_LOAD(0);
    G_STORE(S);
    __syncthreads();
    for (int kt = 0; kt < nk; ++kt) {
        const bool more = (kt + 1 < nk);
        if (more) G_LOAD((kt + 1) * 64);
        const u16* As = S + (kt & 1) * G_STEL;
        const u16* Bs = As + G_AEL;
#pragma unroll
        for (int ks = 0; ks < 4; ++ks) {
            const bf16x8 a0 = *(const bf16x8*)(As + (wm * 64 + l31) * G_LDT + ks * 16 + h * 8);
            const bf16x8 a1 = *(const bf16x8*)(As + (wm * 64 + 32 + l31) * G_LDT + ks * 16 + h * 8);
            const bf16x8 b0 = *(const bf16x8*)(Bs + (nb0 + l31) * G_LDT + ks * 16 + h * 8);
            const bf16x8 b1 = *(const bf16x8*)(Bs + (nb1 + l31) * G_LDT + ks * 16 + h * 8);
            acc[0][0] = MFMA32(a0, b0, acc[0][0]);
            acc[0][1] = MFMA32(a0, b1, acc[0][1]);
            acc[1][0] = MFMA32(a1, b0, acc[1][0]);
            acc[1][1] = MFMA32(a1, b1, acc[1][1]);
        }
        if (more) G_STORE(S + ((kt + 1) & 1) * G_STEL);
        __syncthreads();
    }
}

DI void xpose_tile(const Ctx& c, const float* in, int ld_in, int k0, int n0, int colmode, const float* kscale, u16* out, int ld_out) {
    float* tile = (float*)c.lds;
    const int j = c.tid & 63, r0 = c.tid >> 6;
    const int n = n0 + j;
    const int rc = colmode ? ref_col(n) : n;
#pragma unroll
    for (int rr = 0; rr < 8; ++rr) {
        const int kk = r0 + 8 * rr;
        float v = 0.f;
        if (rc >= 0) { v = in[(size_t)(k0 + kk) * ld_in + rc]; if (kscale) v *= kscale[k0 + kk]; }
        tile[kk * 65 + j] = v;
    }
    __syncthreads();
#pragma unroll
    for (int rr = 0; rr < 8; ++rr) {
        const int jj = r0 + 8 * rr;
        out[(size_t)(n0 + jj) * ld_out + k0 + j] = f2bf(tile[j * 65 + jj]);
    }
    __syncthreads();
}

DI void phase_prep(const Ctx& c_in, KArgs& a) {
    const Ctx c = fresh_ctx(c_in.lds);
    unsigned char* ws = a.ws;
    const int n_win = 2 * 50 * 16;
    const int n_wuq = 2 * 6 * 4;
    const int n_wukv = 2 * 8 * 2;
    const int n_wout = 2 * 16 * 16;
    const int n_trig = T_TOK * 24 / NTHR;
    const int total = n_win + n_wuq + n_wukv + n_wout + n_trig;
    for (int it = blockIdx.x; it < total; it += gridDim.x) {
        int i = it;
        if (i < n_win) {
            const int l = i / 800, r = i % 800, nt = r / 16, kt = r % 16;
            xpose_tile(c, a.in[3] + (size_t)l * 1024 * NREF, NREF, kt * 64, nt * 64, 1, nullptr, (u16*)(ws + WS_WIN) + (size_t)l * NPAD * 1024, 1024);
            continue;
        }
        i -= n_win;
        if (i < n_wuq) {
            const int l = i / 24, r = i % 24, nt = r / 4, kt = r % 4;
            xpose_tile(c, a.in[11] + (size_t)l * 256 * 384, 384, kt * 64, nt * 64, 0, a.in[10] + l * 256, (u16*)(ws + WS_WUQ) + (size_t)l * 384 * 256, 256);
            continue;
        }
        i -= n_wuq;
        if (i < n_wukv) {
            const int l = i / 16, r = i % 16, nt = r / 2, kt = r % 2;
            xpose_tile(c, a.in[13] + (size_t)l * 128 * 512, 512, kt * 64, nt * 64, 0, a.in[12] + l * 128, (u16*)(ws + WS_WUKV) + (size_t)l * 512 * 128, 128);
            continue;
        }
        i -= n_wukv;
        if (i < n_wout) {
            const int l = i / 256, r = i % 256, nt = r / 16, kt = r % 16;
            xpose_tile(c, a.in[15] + (size_t)l * 1024 * 1024, 1024, kt * 64, nt * 64, 0, nullptr, (u16*)(ws + WS_WOUT) + (size_t)l * 1024 * 1024, 1024);
            continue;
        }
        i -= n_wout;
        {
            const int e = i * NTHR + c.tid;
            const int t = e / 24, j = e % 24;
            const int pos = ((const int*)a.in[1])[t];
            const float inv = (j < 8) ? a.inv16[j] : a.inv32[j - 8];
            const float ang = (float)pos * inv;
            const double ad = (double)ang;
            const double r = ad - 6.283185307179586476925 * rint(ad * 0.15915494309189533577);
            const float rf = (float)r;
            const float cs = cosf(rf), sn = sinf(rf);
            float* trig = (float*)(ws + WS_TRIG) + (size_t)t * 48;
            if (j < 8) { trig[j] = cs; trig[8 + j] = sn; } else { trig[16 + (j - 8)] = cs; trig[32 + (j - 8)] = sn; }
        }
    }
}

DI void phase_norm_in(const Ctx& c_in, KArgs& a, int l) {
    const Ctx c = fresh_ctx(c_in.lds);
    unsigned char* ws = a.ws;
    const float* x = (l == 0) ? a.in[0] : a.out;
    const float* g = a.in[2] + l * 1024;
    u16* act = (u16*)(ws + WS_ACT);
    const int n_norm = T_TOK / 8;
    const int n_exp = 3 * 32 * 64;
    if (blockIdx.x == 0 && c.tid < 64) ((int*)(ws + WS_CTL))[c.tid] = 0;
    for (int it = blockIdx.x; it < n_norm + n_exp; it += gridDim.x) {
        if (it < n_exp) {
            const int which = it / 2048, r = it % 2048, e = r / 64, tt = r % 64;
            if (which < 2) {
                const float* src = a.in[21 + which] + ((size_t)l * 32 + e) * 1024 * 256;
                u16* dst = (u16*)(ws + (which == 0 ? WS_WG : WS_WU)) + (size_t)e * 256 * 1024;
                const int nt = tt / 16, kt = tt % 16;
                xpose_tile(c, src, 256, kt * 64, nt * 64, 0, nullptr, dst, 1024);
            } else {
                const float* src = a.in[23] + ((size_t)l * 32 + e) * 256 * 1024;
                u16* dst = (u16*)(ws + WS_WD) + (size_t)e * 1024 * 256;
                const int nt = tt / 4, kt = tt % 4;
                xpose_tile(c, src, 1024, kt * 64, nt * 64, 0, nullptr, dst, 256);
            }
        } else {
            const int t = (it - n_exp) * 8 + c.wave;
            const float* xr = x + (size_t)t * 1024;
            float v[16]; float ss = 0.f;
#pragma unroll
            for (int j = 0; j < 16; ++j) { v[j] = xr[c.lane + 64 * j]; ss += v[j] * v[j]; }
            ss = wsum(ss);
            const float rs = rsqrtf(ss * (1.f / 1024.f) + EPS);
#pragma unroll
            for (int j = 0; j < 16; ++j) act[(size_t)t * 1024 + c.lane + 64 * j] = f2bf(v[j] * rs * g[c.lane + 64 * j]);
        }
    }
}

DI void phase_inproj(const Ctx& c_in, KArgs& a, int l) {
    const Ctx c = fresh_ctx(c_in.lds);
    unsigned char* ws = a.ws;
    const u16* act = (const u16*)(ws + WS_ACT);
    const u16* w = (const u16*)(ws + WS_WIN) + (size_t)l * NPAD * 1024;
    u16* proj = (u16*)(ws + WS_PROJ);
    u16* dsavt = (u16*)(ws + WS_DSAVT);
    u16* foxvt = (u16*)(ws + WS_FOXVT);
    float* small = (float*)(ws + WS_SMALL);
    const int r8 = c.tid >> 3;
    const int wm = c.wave & 3, wn = c.wave >> 2, l31 = c.lane & 31, h = c.lane >> 5;
    const int ntiles = (T_TOK / 256) * (NPAD / 128);
    for (int tile = blockIdx.x; tile < ntiles; tile += gridDim.x) {
        const int mt = tile / 25, nt = tile % 25;
        GP gp;
        gp.a0 = act + (size_t)(mt * 256 + r8) * 1024; gp.a1 = gp.a0 + 64 * 1024; gp.a2 = gp.a0 + 128 * 1024; gp.a3 = gp.a0 + 192 * 1024;
        gp.b0 = w + (size_t)(nt * 128 + r8) * 1024; gp.b1 = gp.b0 + 64 * 1024;
        f32x16 acc[2][2];
        acc[0][0] = zero16(); acc[0][1] = zero16(); acc[1][0] = zero16(); acc[1][1] = zero16();
        gemm_core<false>(c, 1024, gp, acc);
#pragma unroll
        for (int i = 0; i < 2; ++i)
#pragma unroll
            for (int j = 0; j < 2; ++j) {
                const int m0 = mt * 256 + wm * 64 + i * 32, n0 = nt * 128 + wn * 64 + j * 32;
                const int n = n0 + l31;
                if (n0 < LDP) {
#pragma unroll
                    for (int r = 0; r < 16; ++r) proj[(size_t)(m0 + crow(r, h)) * LDP + n] = f2bf(acc[i][j][r]);
                } else if (n0 < NC_SMALL) {
                    const int b = m0 >> 12, s0 = m0 & 4095;
                    u16* base = (n0 < NC_FOXV) ? dsavt + ((size_t)b * 64 + (n - NC_DSAV)) * 4096 : foxvt + ((size_t)b * 256 + (n - NC_FOXV)) * 4096;
#pragma unroll
                    for (int q = 0; q < 4; ++q) {
                        uint2 pk; pk.x = pack2(acc[i][j][4 * q], acc[i][j][4 * q + 1]); pk.y = pack2(acc[i][j][4 * q + 2], acc[i][j][4 * q + 3]);
                        *(uint2*)(base + s0 + 8 * q + 4 * h) = pk;
                    }
                } else {
                    const int cc = n - NC_SMALL;
                    if (cc < 16) {
#pragma unroll
                        for (int r = 0; r < 16; ++r) small[(size_t)(m0 + crow(r, h)) * 16 + cc] = acc[i][j][r];
                    }
                }
            }
    }
}

constexpr int SSD_LD = 136;
constexpr int SSD_TILE_B = 128 * SSD_LD * 2;
constexpr int SSD_OFF_DT = 3 * SSD_TILE_B;
constexpr int SSD_OFF_ACS = SSD_OFF_DT + 2048;
constexpr int SSD_OFF_SSQ = SSD_OFF_ACS + 2048;

DI void ssd_dt_acs(const Ctx& c, KArgs& a, int l, int tok0, float* dt_s, float* acs_s) {
    const float* small = (const float*)(a.ws + WS_SMALL);
    {
        const int t = c.tid >> 2, hd = c.tid & 3;
        const float raw = small[(size_t)(tok0 + t) * 16 + hd] + a.in[6][l * 4 + hd];
        dt_s[hd * 128 + t] = softplusf(raw);
    }
    __syncthreads();
    if (c.wave < 4) {
        const int hd = c.wave;
        const float av = -__expf(a.in[7][l * 4 + hd]);
        const float v0 = dt_s[hd * 128 + 2 * c.lane] * av, v1 = dt_s[hd * 128 + 2 * c.lane + 1] * av;
        const float s = v0 + v1;
        float inc = s;
#pragma unroll
        for (int o = 1; o < 64; o <<= 1) { const float tv = __shfl_up(inc, o); if (c.lane >= o) inc += tv; }
        const float ex = inc - s;
        acs_s[hd * 128 + 2 * c.lane] = ex + v0;
        acs_s[hd * 128 + 2 * c.lane + 1] = ex + v0 + v1;
    }
    __syncthreads();
}

DI float ssd_conv(const u16* proj, const float* cw, const float* cb, int b, int s, int xc) {
    float acc = cb[xc];
#pragma unroll
    for (int j = 0; j < 4; ++j) {
        const int sp = s - 3 + j;
        if (sp >= 0) acc += cw[j * 768 + xc] * bf2f(proj[(size_t)(b * 4096 + sp) * LDP + PC_XBC + xc]);
    }
    return siluf(acc);
}

DI void ssd_state_item(const Ctx& c_in, KArgs& a, int l, int item) {
    const Ctx c = fresh_ctx(c_in.lds);
    unsigned char* ws = a.ws;
    const u16* proj = (const u16*)(ws + WS_PROJ);
    const float* cw = a.in[4] + (size_t)l * 4 * 768;
    const float* cb = a.in[5] + (size_t)l * 768;
    float* cs = (float*)(ws + WS_CS);
    float* cdec = (float*)(ws + WS_CDEC);
    const int b = item >> 5, ch = item & 31, tok0 = b * 4096 + ch * 128, s0 = ch * 128;
    u16* XT = (u16*)c.lds;
    u16* BT = (u16*)(c.lds + SSD_TILE_B);
    float* dt_s = (float*)(c.lds + SSD_OFF_DT);
    float* acs_s = (float*)(c.lds + SSD_OFF_ACS);
    const int l31 = c.lane & 31, h = c.lane >> 5;
    ssd_dt_acs(c, a, l, tok0, dt_s, acs_s);
    if (c.tid < 4) cdec[(b * 32 + ch) * 4 + c.tid] = __expf(acs_s[c.tid * 128 + 127]);
    for (int g = 0; g < 2; ++g) {
        for (int i = 0; i < 64; ++i) {
            const int e = c.tid + NTHR * i;
            const int chl = e & 255, t = e >> 8;
            if (chl < 128) {
                const int head = 2 * g + (chl >> 6);
                const float v = ssd_conv(proj, cw, cb, b, s0 + t, 128 * g + chl);
                const float sc = dt_s[head * 128 + t] * __expf(acs_s[head * 128 + 127] - acs_s[head * 128 + t]);
                XT[chl * SSD_LD + t] = f2bf(v * sc);
            } else {
                const int n = chl - 128;
                const float v = ssd_conv(proj, cw, cb, b, s0 + t, 256 + 128 * g + n);
                BT[n * SSD_LD + t] = f2bf(v);
            }
        }
        __syncthreads();
        {
            const int hh = c.wave >> 2, pt = (c.wave >> 1) & 1, nh = c.wave & 1;
            f32x16 acc0 = zero16(), acc1 = zero16();
#pragma unroll
            for (int ks = 0; ks < 8; ++ks) {
                const bf16x8 af = *(const bf16x8*)(XT + (hh * 64 + pt * 32 + l31) * SSD_LD + ks * 16 + h * 8);
                const bf16x8 b0 = *(const bf16x8*)(BT + (nh * 64 + l31) * SSD_LD + ks * 16 + h * 8);
                const bf16x8 b1 = *(const bf16x8*)(BT + (nh * 64 + 32 + l31) * SSD_LD + ks * 16 + h * 8);
                acc0 = MFMA32(af, b0, acc0);
                acc1 = MFMA32(af, b1, acc1);
            }
            const int head = 2 * g + hh;
            float* dst = cs + ((size_t)((b * 32 + ch) * 4 + head) * 64) * 128;
#pragma unroll
            for (int r = 0; r < 16; ++r) {
                const int p = pt * 32 + crow(r, h);
                dst[p * 128 + nh * 64 + l31] = acc0[r];
                dst[p * 128 + nh * 64 + 32 + l31] = acc1[r];
            }
        }
        __syncthreads();
    }
}

DI void ssd_scan_item(const Ctx& c_in, KArgs& a, int item) {
    const Ctx c = fresh_ctx(c_in.lds);
    float* cs = (float*)(a.ws + WS_CS);
    const float* cdec = (const float*)(a.ws + WS_CDEC);
    const int idx = item * NTHR + c.tid;
    const int bh = idx >> 13, pn = idx & 8191, b = bh >> 2, hd = bh & 3;
    float s = 0.f;
    for (int ch = 0; ch < 32; ++ch) {
        const size_t off = ((size_t)((b * 32 + ch) * 4 + hd)) * 8192 + pn;
        const float v = cs[off];
        cs[off] = s;
        s = s * cdec[(b * 32 + ch) * 4 + hd] + v;
    }
}

DI void ssd_out_item(const Ctx& c_in, KArgs& a, int l, int item) {
    const Ctx c = fresh_ctx(c_in.lds);
    unsigned char* ws = a.ws;
    const u16* proj = (const u16*)(ws + WS_PROJ);
    const float* cw = a.in[4] + (size_t)l * 4 * 768;
    const float* cb = a.in[5] + (size_t)l * 768;
    const float* prev = (const float*)(ws + WS_CS);
    u16* act = (u16*)(ws + WS_ACT);
    const int b = item >> 5, ch = item & 31, tok0 = b * 4096 + ch * 128, s0 = ch * 128;
    u16* XT = (u16*)c.lds;
    u16* BM = (u16*)(c.lds + SSD_TILE_B);
    u16* CM = (u16*)(c.lds + 2 * SSD_TILE_B);
    float* dt_s = (float*)(c.lds + SSD_OFF_DT);
    float* acs_s = (float*)(c.lds + SSD_OFF_ACS);
    float* ssq = (float*)(c.lds + SSD_OFF_SSQ);
    const int l31 = c.lane & 31, h = c.lane >> 5;
    if (c.tid < 128) ssq[c.tid] = 0.f;
    ssd_dt_acs(c, a, l, tok0, dt_s, acs_s);
    f32x16 yreg[2][2];
    const int hh = c.wave >> 2, qt = c.wave & 3;
    const int q = qt * 32 + l31;
#pragma unroll
    for (int g = 0; g < 2; ++g) {
        for (int part = 0; part < 3; ++part) {
            for (int i = 0; i < 32; ++i) {
                const int e = c.tid + NTHR * i;
                const int chl = e & 127, t = e >> 7;
                const float v = ssd_conv(proj, cw, cb, b, s0 + t, 256 * part + 128 * g + chl);
                if (part == 0) XT[chl * SSD_LD + t] = f2bf(v);
                else if (part == 1) BM[t * SSD_LD + chl] = f2bf(v);
                else CM[t * SSD_LD + chl] = f2bf(v);
            }
        }
        __syncthreads();
        {
            const int head = 2 * g + hh;
            const float acs_q = acs_s[head * 128 + q];
            bf16x8 cf[8];
#pragma unroll
            for (int ks = 0; ks < 8; ++ks) cf[ks] = *(const bf16x8*)(CM + q * SSD_LD + ks * 16 + h * 8);
            f32x16 yo0 = zero16(), yo1 = zero16();
            for (int kt = 0; kt <= qt; ++kt) {
                f32x16 gt = zero16();
#pragma unroll
                for (int ks = 0; ks < 8; ++ks) {
                    const bf16x8 bf = *(const bf16x8*)(BM + (kt * 32 + l31) * SSD_LD + ks * 16 + h * 8);
                    gt = MFMA32(bf, cf[ks], gt);
                }
#pragma unroll
                for (int r = 0; r < 16; ++r) {
                    const int k = kt * 32 + crow(r, h);
                    const float dec = __expf(fminf(acs_q - acs_s[head * 128 + k], 0.f)) * dt_s[head * 128 + k];
                    gt[r] = (k <= q) ? gt[r] * dec : 0.f;
                }
#pragma unroll
                for (int s2 = 0; s2 < 2; ++s2) {
                    const bf16x8 pb = pack8(gt, s2);
                    const int koff = kt * 32 + 16 * s2 + 4 * h;
                    {
                        const u16* xr = XT + (hh * 64 + l31) * SSD_LD + koff;
                        const uint2 lo = *(const uint2*)xr, hi = *(const uint2*)(xr + 8);
                        const bf16x8 xa = __builtin_bit_cast(bf16x8, make_uint4(lo.x, lo.y, hi.x, hi.y));
                        yo0 = MFMA32(xa, pb, yo0);
                    }
                    {
                        const u16* xr = XT + (hh * 64 + 32 + l31) * SSD_LD + koff;
                        const uint2 lo = *(const uint2*)xr, hi = *(const uint2*)(xr + 8);
                        const bf16x8 xa = __builtin_bit_cast(bf16x8, make_uint4(lo.x, lo.y, hi.x, hi.y));
                        yo1 = MFMA32(xa, pb, yo1);
                    }
                }
            }
            f32x16 yf0 = zero16(), yf1 = zero16();
            const float* pv = prev + ((size_t)((b * 32 + ch) * 4 + head) * 64) * 128;
#pragma unroll
            for (int ks = 0; ks < 8; ++ks) {
                {
                    const float* pr = pv + (size_t)l31 * 128 + ks * 16 + h * 8;
                    const float4 f0 = *(const float4*)pr, f1 = *(const float4*)(pr + 4);
                    const bf16x8 pa = __builtin_bit_cast(bf16x8, make_uint4(pack2(f0.x, f0.y), pack2(f0.z, f0.w), pack2(f1.x, f1.y), pack2(f1.z, f1.w)));
                    yf0 = MFMA32(pa, cf[ks], yf0);
                }
                {
                    const float* pr = pv + (size_t)(32 + l31) * 128 + ks * 16 + h * 8;
                    const float4 f0 = *(const float4*)pr, f1 = *(const float4*)(pr + 4);
                    const bf16x8 pa = __builtin_bit_cast(bf16x8, make_uint4(pack2(f0.x, f0.y), pack2(f0.z, f0.w), pack2(f1.x, f1.y), pack2(f1.z, f1.w)));
                    yf1 = MFMA32(pa, cf[ks], yf1);
                }
            }
            const float eq = __expf(acs_q);
            const float dsk = a.in[8][l * 4 + head];
            float part = 0.f;
#pragma unroll
            for (int pt = 0; pt < 2; ++pt) {
#pragma unroll
                for (int qd = 0; qd < 4; ++qd) {
                    const int p0 = pt * 32 + 8 * qd + 4 * h;
                    const uint2 zz = *(const uint2*)(proj + (size_t)(tok0 + q) * LDP + PC_Z + head * 64 + p0);
                    const float zf[4] = { bf2f((u16)(zz.x & 0xffff)), bf2f((u16)(zz.x >> 16)), bf2f((u16)(zz.y & 0xffff)), bf2f((u16)(zz.y >> 16)) };
#pragma unroll
                    for (int r3 = 0; r3 < 4; ++r3) {
                        const int r = 4 * qd + r3;
                        const float yo = pt ? yo1[r] : yo0[r];
                        const float yf = pt ? yf1[r] : yf0[r];
                        const float xv = bf2f(XT[(hh * 64 + p0 + r3) * SSD_LD + q]);
                        const float y = (yo + yf * eq + dsk * xv) * siluf(zf[r3]);
                        yreg[g][pt][r] = y;
                        part += y * y;
                    }
                }
            }
            part += __shfl_xor(part, 32);
            if (h == 0) atomicAdd(&ssq[q], part);
        }
        __syncthreads();
    }
    {
        const float rs = rsqrtf(ssq[q] * (1.f / 256.f) + EPS);
        const float* nw = a.in[9] + l * 256;
#pragma unroll
        for (int g = 0; g < 2; ++g) {
            const int head = 2 * g + hh;
#pragma unroll
            for (int pt = 0; pt < 2; ++pt)
#pragma unroll
                for (int qd = 0; qd < 4; ++qd) {
                    const int p0 = pt * 32 + 8 * qd + 4 * h;
                    const float* w4 = nw + head * 64 + p0;
                    uint2 pk;
                    pk.x = pack2(yreg[g][pt][4 * qd] * rs * w4[0], yreg[g][pt][4 * qd + 1] * rs * w4[1]);
                    pk.y = pack2(yreg[g][pt][4 * qd + 2] * rs * w4[2], yreg[g][pt][4 * qd + 3] * rs * w4[3]);
                    *(uint2*)(act + (size_t)(tok0 + q) * 1024 + head * 64 + p0) = pk;
                }
        }
    }
    __syncthreads();
}

DI void token_post_item(const Ctx& c_in, KArgs& a, int l, int item) {
    const Ctx c = fresh_ctx(c_in.lds);
    unsigned char* ws = a.ws;
    u16* proj = (u16*)(ws + WS_PROJ);
    u16* mlak = (u16*)(ws + WS_MLAK);
    const float* trig = (const float*)(ws + WS_TRIG);
    const float* small = (const float*)(ws + WS_SMALL);
    float* flog = (float*)(ws + WS_FLOG);
    const int t = item * 8 + c.wave;
    u16* pr = proj + (size_t)t * LDP;
    const float* tg = trig + (size_t)t * 48;
#pragma unroll
    for (int r = 0; r < 2; ++r) {
        const int pid = c.lane + 64 * r;
        if (pid < 112) {
            int col, i;
            if (pid < 32)       { col = PC_DSAQ + (pid >> 3) * 64; i = pid & 7; }
            else if (pid < 40)  { col = PC_DSAK; i = pid - 32; }
            else if (pid < 104) { const int p = pid - 40; col = PC_IDXQ + (p >> 3) * 64; i = p & 7; }
            else                { col = PC_IDXK; i = pid - 104; }
            const float x1 = bf2f(pr[col + i]), x2 = bf2f(pr[col + 8 + i]);
            const float cs = tg[i], sn = tg[8 + i];
            pr[col + i] = f2bf(x1 * cs - x2 * sn);
            pr[col + 8 + i] = f2bf(x2 * cs + x1 * sn);
        } else {
            const int i = pid - 112;
            const float x1 = bf2f(pr[PC_KR + i]), x2 = bf2f(pr[PC_KR + 16 + i]);
            const float cs = tg[16 + i], sn = tg[32 + i];
            const u16 o1 = f2bf(x1 * cs - x2 * sn), o2 = f2bf(x2 * cs + x1 * sn);
#pragma unroll
            for (int hd = 0; hd < 4; ++hd) { mlak[(size_t)t * 384 + hd * 96 + 64 + i] = o1; mlak[(size_t)t * 384 + hd * 96 + 80 + i] = o2; }
        }
    }
    if (c.lane < 4) {
        const float f = small[(size_t)t * 16 + 12 + c.lane] + a.in[14][l * 4 + c.lane];
        const float ls = fminf(f, 0.f) - log1pf(__expf(-fabsf(f)));
        const int b = t >> 12, s = t & 4095;
        flog[(size_t)(b * 4 + c.lane) * 4096 + s] = ls;
    }
}

DI void mla_up_item(const Ctx& c_in, KArgs& a, int l, int which, int item) {
    const Ctx c = fresh_ctx(c_in.lds);
    unsigned char* ws = a.ws;
    const u16* proj = (const u16*)(ws + WS_PROJ);
    const float* trig = (const float*)(ws + WS_TRIG);
    float* rs_s = (float*)(c.lds + G_LDS_BYTES);
    const int r8 = c.tid >> 3;
    const int wm = c.wave & 3, wn = c.wave >> 2, l31 = c.lane & 31, h = c.lane >> 5;
    const int K = which == 0 ? 256 : 128;
    const int pc = which == 0 ? PC_CQ : PC_CKV;
    const int ntn = which == 0 ? 3 : 4;
    const int mt = item / ntn, nt = item % ntn;
    const u16* w = which == 0 ? (const u16*)(ws + WS_WUQ) + (size_t)l * 384 * 256 : (const u16*)(ws + WS_WUKV) + (size_t)l * 512 * 128;
    {
        const int row = c.tid >> 1, half = c.tid & 1;
        const u16* p = proj + (size_t)(mt * 256 + row) * LDP + pc + half * (K / 2);
        float ss = 0.f;
        for (int i = 0; i < K / 2; i += 8) {
            const uint4 v = *(const uint4*)(p + i);
            const unsigned w4[4] = { v.x, v.y, v.z, v.w };
#pragma unroll
            for (int j = 0; j < 4; ++j) { const float f0 = bf2f((u16)(w4[j] & 0xffff)), f1 = bf2f((u16)(w4[j] >> 16)); ss += f0 * f0 + f1 * f1; }
        }
        ss += __shfl_xor(ss, 1);
        if (half == 0) rs_s[row] = rsqrtf(ss / (float)K + EPS);
    }
    __syncthreads();
    GP gp;
    gp.a0 = proj + (size_t)(mt * 256 + r8) * LDP + pc; gp.a1 = gp.a0 + 64 * LDP; gp.a2 = gp.a0 + 128 * LDP; gp.a3 = gp.a0 + 192 * LDP;
    gp.b0 = w + (size_t)(nt * 128 + r8) * K; gp.b1 = gp.b0 + 64 * K;
    f32x16 acc[2][2];
    acc[0][0] = zero16(); acc[0][1] = zero16(); acc[1][0] = zero16(); acc[1][1] = zero16();
    gemm_core<false>(c, K, gp, acc);
    u16* mlaq = (u16*)(ws + WS_MLAQ);
    u16* mlak = (u16*)(ws + WS_MLAK);
    u16* mlavt = (u16*)(ws + WS_MLAVT);
#pragma unroll
    for (int i = 0; i < 2; ++i)
#pragma unroll
        for (int j = 0; j < 2; ++j) {
            const int ml0 = wm * 64 + i * 32, m0 = mt * 256 + ml0, n0 = nt * 128 + wn * 64 + j * 32;
            const int n = n0 + l31;
            if (which == 0) {
                const bool rope = ((n0 >> 5) % 3) == 2;
#pragma unroll
                for (int r = 0; r < 16; ++r) {
                    const int ml = ml0 + crow(r, h), m = mt * 256 + ml;
                    float v = acc[i][j][r] * rs_s[ml];
                    if (rope) {
                        const float pv = __shfl_xor(v, 16);
                        const int ii = l31 & 15;
                        const float cs = trig[(size_t)m * 48 + 16 + ii], sn = trig[(size_t)m * 48 + 32 + ii];
                        v = (l31 < 16) ? (v * cs - pv * sn) : (v * cs + pv * sn);
                    }
                    mlaq[(size_t)m * 384 + n] = f2bf(v);
                }
            } else {
                const int head = n0 >> 7, wi = n0 & 127;
                if (wi < 64) {
#pragma unroll
                    for (int r = 0; r < 16; ++r) {
                        const int ml = ml0 + crow(r, h), m = mt * 256 + ml;
                        mlak[(size_t)m * 384 + head * 96 + wi + l31] = f2bf(acc[i][j][r] * rs_s[ml]);
                    }
                } else {
                    const int b = m0 >> 12, s0 = m0 & 4095, d = wi - 64 + l31;
                    u16* base = mlavt + ((size_t)(b * 4 + head) * 64 + d) * 4096 + s0;
#pragma unroll
                    for (int q = 0; q < 4; ++q) {
                        const int mlq = ml0 + 8 * q + 4 * h;
                        uint2 pk;
                        pk.x = pack2(acc[i][j][4 * q] * rs_s[mlq], acc[i][j][4 * q + 1] * rs_s[mlq + 1]);
                        pk.y = pack2(acc[i][j][4 * q + 2] * rs_s[mlq + 2], acc[i][j][4 * q + 3] * rs_s[mlq + 3]);
                        *(uint2*)(base + 8 * q + 4 * h) = pk;
                    }
                }
            }
        }
    __syncthreads();
}

constexpr int AT_LDV = 68;
template <int DQ, int MODE>
DI void attn_item(const Ctx& c_in, KArgs& a, int item) {
    const Ctx c = fresh_ctx(c_in.lds);
    unsigned char* ws = a.ws;
    constexpr int LDK = DQ + 8;
    constexpr int K_EL = 64 * LDK, V_EL = 64 * AT_LDV, ST_EL = K_EL + V_EL;
    constexpr int NKS = DQ / 16;
    constexpr int KCH = DQ / 8;
    u16* S = (u16*)c.lds;
    float* fc_s = (float*)(c.lds + 2 * ST_EL * 2 + 64);
    const int l31 = c.lane & 31, h = c.lane >> 5;
    int b, hd, wq0, nkt;
    const u16 *Qp, *Kp, *Vp; int ldq, ldk, ocol;
    float scale;
    if (MODE == 0) {
        const int qb = 15 - (item >> 5), rem = item & 31; b = rem >> 2; hd = rem & 3;
        wq0 = qb * 256 + c.wave * 32; nkt = qb * 4 + 4;
        Qp = (const u16*)(ws + WS_MLAQ) + (size_t)b * 4096 * 384 + hd * 96; ldq = 384;
        Kp = (const u16*)(ws + WS_MLAK) + (size_t)b * 4096 * 384 + hd * 96; ldk = 384;
        Vp = (const u16*)(ws + WS_MLAVT) + (size_t)(b * 4 + hd) * 64 * 4096;
        ocol = 512 + hd * 64; scale = 0.10206207261596575f;
    } else if (MODE == 1) {
        const int qb = 15 - (item >> 5), rem = item & 31; b = rem >> 2; hd = rem & 3;
        wq0 = qb * 256 + c.wave * 32; nkt = qb * 4 + 4;
        Qp = (const u16*)(ws + WS_PROJ) + (size_t)b * 4096 * LDP + PC_FOXQ + hd * 64; ldq = LDP;
        Kp = (const u16*)(ws + WS_PROJ) + (size_t)b * 4096 * LDP + PC_FOXK + hd * 64; ldk = LDP;
        Vp = (const u16*)(ws + WS_FOXVT) + (size_t)(b * 4 + hd) * 64 * 4096;
        ocol = 768 + hd * 64; scale = 0.125f;
    } else {
        const int qb = 63 - (item >> 3); b = item & 7; hd = c.wave & 3;
        wq0 = qb * 64 + (c.wave >> 2) * 32; nkt = qb + 1;
        Qp = (const u16*)(ws + WS_PROJ) + (size_t)b * 4096 * LDP + PC_DSAQ + hd * 64; ldq = LDP;
        Kp = (const u16*)(ws + WS_PROJ) + (size_t)b * 4096 * LDP + PC_DSAK; ldk = LDP;
        Vp = (const u16*)(ws + WS_DSAVT) + (size_t)b * 64 * 4096;
        ocol = 256 + hd * 64; scale = 0.125f;
    }
    const float sc2 = scale * LOG2E;
    const int q = wq0 + l31;
    bf16x8 qf[NKS];
#pragma unroll
    for (int ks = 0; ks < NKS; ++ks) qf[ks] = *(const bf16x8*)(Qp + (size_t)q * ldq + ks * 16 + h * 8);
    float fq = 0.f;
    if (MODE == 1) {
        const float* fl = (const float*)(ws + WS_FLOG) + (size_t)(b * 4 + hd) * 4096;
        float* wtot = (float*)(c.lds + 2 * ST_EL * 2);
        const int nk = nkt * 64;
        float v[8]; float s = 0.f;
#pragma unroll
        for (int j = 0; j < 8; ++j) { const int idx = c.tid * 8 + j; v[j] = (idx < nk) ? fl[idx] : 0.f; s += v[j]; v[j] = s; }
        float inc = s;
#pragma unroll
        for (int o = 1; o < 64; o <<= 1) { const float tv = __shfl_up(inc, o); if (c.lane >= o) inc += tv; }
        if (c.lane == 63) wtot[c.wave] = inc;
        __syncthreads();
        float base = inc - s;
        for (int w2 = 0; w2 < c.wave; ++w2) base += wtot[w2];
#pragma unroll
        for (int j = 0; j < 8; ++j) fc_s[c.tid * 8 + j] = base + v[j];
        __syncthreads();
        fq = fc_s[q];
    }
    const int krow0 = c.tid / KCH, kch0 = c.tid % KCH;
    const int c1 = c.tid + NTHR; const int krow1 = c1 / KCH, kch1 = c1 % KCH; const bool has1 = (KCH * 64 > NTHR) && (c1 < KCH * 64);
    const int vrow = c.tid >> 3, vch = c.tid & 7;
    uint4 rk0, rk1, rv; rk1 = make_uint4(0, 0, 0, 0);
    auto gload = [&](int kt) {
        rk0 = *(const uint4*)(Kp + (size_t)(kt * 64 + krow0) * ldk + kch0 * 8);
        if (has1) rk1 = *(const uint4*)(Kp + (size_t)(kt * 64 + krow1) * ldk + kch1 * 8);
        rv = *(const uint4*)(Vp + (size_t)vrow * 4096 + kt * 64 + vch * 8);
    };
    auto sstore = [&](int st) {
        u16* Ks = S + st * ST_EL; u16* Vs = Ks + K_EL;
        *(uint4*)(Ks + krow0 * LDK + kch0 * 8) = rk0;
        if (has1) *(uint4*)(Ks + krow1 * LDK + kch1 * 8) = rk1;
        *(uint2*)(Vs + vrow * AT_LDV + vch * 8) = make_uint2(rv.x, rv.y);
        *(uint2*)(Vs + vrow * AT_LDV + vch * 8 + 4) = make_uint2(rv.z, rv.w);
    };
    f32x16 o0 = zero16(), o1 = zero16();
    float m_run = -1e30f, l_run = 0.f;
    gload(0); sstore(0);
    __syncthreads();
    for (int kt = 0; kt < nkt; ++kt) {
        const bool more = (kt + 1 < nkt);
        if (more) gload(kt + 1);
        if (kt * 64 <= wq0 + 31) {
            const u16* Ks = S + (kt & 1) * ST_EL; const u16* Vs = Ks + K_EL;
            f32x16 s0 = zero16(), s1 = zero16();
#pragma unroll
            for (int ks = 0; ks < NKS; ++ks) {
                const bf16x8 k0 = *(const bf16x8*)(Ks + l31 * LDK + ks * 16 + h * 8);
                const bf16x8 k1 = *(const bf16x8*)(Ks + (32 + l31) * LDK + ks * 16 + h * 8);
                s0 = MFMA32(k0, qf[ks], s0);
                s1 = MFMA32(k1, qf[ks], s1);
            }
            u64 mw = 0;
            if (MODE == 2) mw = ((const u64*)(ws + WS_MASK))[(size_t)(b * 4096 + q) * 64 + kt];
            const bool diag = (kt * 64 + 63 > wq0);
            float mx = -1e30f;
            unsigned vmask0 = 0, vmask1 = 0;
#pragma unroll
            for (int r = 0; r < 16; ++r) {
                const int kr = crow(r, h);
                const int k0i = kt * 64 + kr, k1i = k0i + 32;
                bool v0, v1;
                if (MODE == 2) { v0 = (mw >> kr) & 1ull; v1 = (mw >> (32 + kr)) & 1ull; }
                else { v0 = !diag || (k0i <= q); v1 = !diag || (k1i <= q); }
                float x0 = s0[r] * sc2, x1 = s1[r] * sc2;
                if (MODE == 1) { x0 += (fq - fc_s[k0i]) * LOG2E; x1 += (fq - fc_s[k1i]) * LOG2E; }
                x0 = v0 ? x0 : -1e30f; x1 = v1 ? x1 : -1e30f;
                s0[r] = x0; s1[r] = x1;
                mx = fmaxf(mx, fmaxf(x0, x1));
                vmask0 |= (v0 ? 1u : 0u) << r; vmask1 |= (v1 ? 1u : 0u) << r;
            }
            mx = fmaxf(mx, __shfl_xor(mx, 32));
            const float m_new = fmaxf(m_run, mx);
            const float alpha = exp2f(m_run - m_new);
            float rsum = 0.f;
#pragma unroll
            for (int r = 0; r < 16; ++r) {
                const float p0 = ((vmask0 >> r) & 1u) ? exp2f(s0[r] - m_new) : 0.f;
                const float p1 = ((vmask1 >> r) & 1u) ? exp2f(s1[r] - m_new) : 0.f;
                s0[r] = p0; s1[r] = p1; rsum += p0 + p1;
            }
            rsum += __shfl_xor(rsum, 32);
            l_run = l_run * alpha + rsum; m_run = m_new;
#pragma unroll
            for (int r = 0; r < 16; ++r) { o0[r] *= alpha; o1[r] *= alpha; }
#pragma unroll
            for (int sub = 0; sub < 2; ++sub)
#pragma unroll
                for (int s2 = 0; s2 < 2; ++s2) {
                    const bf16x8 pb = pack8(sub ? s1 : s0, s2);
                    const int koff = sub * 32 + 16 * s2 + 4 * h;
                    {
                        const u16* vr = Vs + l31 * AT_LDV + koff;
                        const uint2 lo = *(const uint2*)vr, hi = *(const uint2*)(vr + 8);
                        o0 = MFMA32(__builtin_bit_cast(bf16x8, make_uint4(lo.x, lo.y, hi.x, hi.y)), pb, o0);
                    }
                    {
                        const u16* vr = Vs + (32 + l31) * AT_LDV + koff;
                        const uint2 lo = *(const uint2*)vr, hi = *(const uint2*)(vr + 8);
                        o1 = MFMA32(__builtin_bit_cast(bf16x8, make_uint4(lo.x, lo.y, hi.x, hi.y)), pb, o1);
                    }
                }
        }
        if (more) sstore((kt + 1) & 1);
        __syncthreads();
    }
    {
        const float inv = 1.f / l_run;
        u16* act = (u16*)(ws + WS_ACT) + (size_t)(b * 4096 + q) * 1024 + ocol;
#pragma unroll
        for (int qd = 0; qd < 4; ++qd) {
            uint2 pk;
            pk.x = pack2(o0[4 * qd] * inv, o0[4 * qd + 1] * inv); pk.y = pack2(o0[4 * qd + 2] * inv, o0[4 * qd + 3] * inv);
            *(uint2*)(act + 8 * qd + 4 * h) = pk;
            pk.x = pack2(o1[4 * qd] * inv, o1[4 * qd + 1] * inv); pk.y = pack2(o1[4 * qd + 2] * inv, o1[4 * qd + 3] * inv);
            *(uint2*)(act + 32 + 8 * qd + 4 * h) = pk;
        }
    }
}

constexpr int SC_LD = 4100;
DI void dsa_index_item(const Ctx& c_in, KArgs& a, int item) {
    const Ctx c = fresh_ctx(c_in.lds);
    unsigned char* ws = a.ws;
    const u16* proj = (const u16*)(ws + WS_PROJ);
    const float* small = (const float*)(ws + WS_SMALL);
    u64* mask = (u64*)(ws + WS_MASK);
    float* SC = (float*)c.lds;
    unsigned* HIST = (unsigned*)(c.lds + 8 * SC_LD * 4);
    const int l31 = c.lane & 31, h = c.lane >> 5;
    const int sg = 511 - (item >> 3), b = item & 7, s0 = sg * 8;
    const int tok0 = b * 4096 + s0;
    const int ntile = ((s0 + 7) >> 5) + 1;
    bf16x8 qa[2][4];
    float wv[2][16];
#pragma unroll
    for (int rt = 0; rt < 2; ++rt) {
        const int r = rt * 32 + l31, ql = r >> 3, j = r & 7;
        const u16* p = proj + (size_t)(tok0 + ql) * LDP + PC_IDXQ + j * 64 + h * 8;
#pragma unroll
        for (int ks = 0; ks < 4; ++ks) qa[rt][ks] = *(const bf16x8*)(p + ks * 16);
#pragma unroll
        for (int r2 = 0; r2 < 16; ++r2) {
            const int qq = (r2 >> 2) + 4 * rt, jj = (r2 & 3) + 4 * h;
            wv[rt][r2] = small[(size_t)(tok0 + qq) * 16 + 4 + jj] * 0.044194173824159216f;
        }
    }
    for (int kt = c.wave; kt < ntile; kt += 8) {
        const int key = kt * 32 + l31;
        const u16* kp = proj + (size_t)(b * 4096 + key) * LDP + PC_IDXK + h * 8;
        bf16x8 kb[4];
#pragma unroll
        for (int ks = 0; ks < 4; ++ks) kb[ks] = *(const bf16x8*)(kp + ks * 16);
        f32x16 a0 = zero16(), a1 = zero16();
#pragma unroll
        for (int ks = 0; ks < 4; ++ks) { a0 = MFMA32(qa[0][ks], kb[ks], a0); a1 = MFMA32(qa[1][ks], kb[ks], a1); }
#pragma unroll
        for (int g = 0; g < 4; ++g) {
            float p0 = 0.f, p1 = 0.f;
#pragma unroll
            for (int r3 = 0; r3 < 4; ++r3) {
                p0 += wv[0][4 * g + r3] * fmaxf(a0[4 * g + r3], 0.f);
                p1 += wv[1][4 * g + r3] * fmaxf(a1[4 * g + r3], 0.f);
            }
            const float t0 = p0 + __shfl_xor(p0, 32);
            const float t1 = p1 + __shfl_xor(p1, 32);
            SC[(4 * h + g) * SC_LD + key] = h ? t1 : t0;
        }
    }
    __syncthreads();
    {
        const int qi = s0 + c.wave, n = qi + 1;
        const float* sc = SC + c.wave * SC_LD;
        unsigned* hist = HIST + c.wave * 256;
        const int nit = (n + 63) >> 6;
        float thr = -INFINITY; int cut = 0x7fffffff;
        if (n > 256) {
            float lo = INFINITY, hi = -INFINITY;
            for (int it = 0; it < nit; ++it) { const int i = it * 64 + c.lane; if (i < n) { const float x = sc[i]; lo = fminf(lo, x); hi = fmaxf(hi, x); } }
            lo = wminf(lo); hi = wmaxf(hi);
            int kk = 256;
            for (int iter = 0; iter < 48; ++iter) {
                if (lo == hi) {
                    thr = lo;
                    int cnt = 0;
                    for (int it = 0; it < nit; ++it) { const int i = it * 64 + c.lane; const bool e = (i < n) && (sc[i] == thr); cnt += __popcll(__ballot(e)); }
                    if (kk < cnt) {
                        int need = kk;
                        for (int it = 0; it < nit; ++it) {
                            const int i = it * 64 + c.lane; const bool e = (i < n) && (sc[i] == thr);
                            const u64 mk = __ballot(e); const int cn = __popcll(mk);
                            if (need <= cn) {
                                const u64 sel = __ballot(e && (__popcll(mk & ((1ull << c.lane) - 1ull)) == need - 1));
                                cut = it * 64 + (__ffsll((long long)sel) - 1);
                                break;
                            }
                            need -= cn;
                        }
                    }
                    break;
                }
                float scl = 256.0f / (hi - lo);
                if (!(scl < 1e30f)) scl = 1e30f;
#pragma unroll
                for (int j = 0; j < 4; ++j) hist[c.lane + 64 * j] = 0u;
                for (int it = 0; it < nit; ++it) {
                    const int i = it * 64 + c.lane;
                    if (i < n) { const float x = sc[i]; if (x >= lo && x <= hi) { int bn = (int)((x - lo) * scl); bn = bn > 255 ? 255 : bn; atomicAdd(&hist[bn], 1u); } }
                }
                const unsigned c0 = hist[4 * c.lane], c1 = hist[4 * c.lane + 1], c2 = hist[4 * c.lane + 2], c3 = hist[4 * c.lane + 3];
                const unsigned ls = c0 + c1 + c2 + c3;
                unsigned suf = ls;
#pragma unroll
                for (int o = 1; o < 64; o <<= 1) { const unsigned tv = __shfl_down(suf, o); if (c.lane + o < 64) suf += tv; }
                const unsigned above_lane = suf - ls;
                const bool mine = (suf >= (unsigned)kk) && (above_lane < (unsigned)kk);
                int bstar = 0; unsigned above = 0, cntb = 0;
                if (mine) {
                    unsigned run = above_lane;
                    if (run + c3 >= (unsigned)kk) { bstar = 4 * c.lane + 3; above = run; cntb = c3; }
                    else { run += c3;
                        if (run + c2 >= (unsigned)kk) { bstar = 4 * c.lane + 2; above = run; cntb = c2; }
                        else { run += c2;
                            if (run + c1 >= (unsigned)kk) { bstar = 4 * c.lane + 1; above = run; cntb = c1; }
                            else { run += c1; bstar = 4 * c.lane; above = run; cntb = c0; } } }
                }
                const u64 mm = __ballot(mine);
                const int src = __ffsll((long long)mm) - 1;
                bstar = __shfl(bstar, src); above = __shfl(above, src); cntb = __shfl(cntb, src);
                kk -= (int)above;
                float nlo = INFINITY, nhi = -INFINITY;
                for (int it = 0; it < nit; ++it) {
                    const int i = it * 64 + c.lane;
                    if (i < n) { const float x = sc[i]; if (x >= lo && x <= hi) { int bn = (int)((x - lo) * scl); bn = bn > 255 ? 255 : bn; if (bn == bstar) { nlo = fminf(nlo, x); nhi = fmaxf(nhi, x); } } }
                }
                lo = wminf(nlo); hi = wmaxf(nhi);
                thr = lo;
                if ((int)cntb == kk) break;
            }
        }
        u64* mrow = mask + (size_t)(b * 4096 + qi) * 64;
        for (int it = 0; it < 64; ++it) {
            const int i = it * 64 + c.lane;
            bool sel = false;
            if (i < n) { const float x = sc[i]; sel = (x > thr) || (x == thr && i <= cut); }
            const u64 wd = __ballot(sel);
            if (c.lane == 0) mrow[it] = wd;
        }
    }
    __syncthreads();
}

DI void phase_outproj(const Ctx& c_in, KArgs& a, int l) {
    const Ctx c = fresh_ctx(c_in.lds);
    unsigned char* ws = a.ws;
    const u16* act = (const u16*)(ws + WS_ACT);
    const u16* w = (const u16*)(ws + WS_WOUT) + (size_t)l * 1024 * 1024;
    const float* xin = (l == 0) ? a.in[0] : a.out;
    float* out = a.out;
    const int r8 = c.tid >> 3;
    const int wm = c.wave & 3, wn = c.wave >> 2, l31 = c.lane & 31, h = c.lane >> 5;
    const int ntiles = (T_TOK / 256) * 8;
    for (int tile = blockIdx.x; tile < ntiles; tile += gridDim.x) {
        const int mt = tile >> 3, nt = tile & 7;
        GP gp;
        gp.a0 = act + (size_t)(mt * 256 + r8) * 1024; gp.a1 = gp.a0 + 64 * 1024; gp.a2 = gp.a0 + 128 * 1024; gp.a3 = gp.a0 + 192 * 1024;
        gp.b0 = w + (size_t)(nt * 128 + r8) * 1024; gp.b1 = gp.b0 + 64 * 1024;
        f32x16 acc[2][2];
        acc[0][0] = zero16(); acc[0][1] = zero16(); acc[1][0] = zero16(); acc[1][1] = zero16();
        gemm_core<false>(c, 1024, gp, acc);
#pragma unroll
        for (int i = 0; i < 2; ++i)
#pragma unroll
            for (int j = 0; j < 2; ++j) {
                const int m0 = mt * 256 + wm * 64 + i * 32, n = nt * 128 + wn * 64 + j * 32 + l31;
#pragma unroll
                for (int r = 0; r < 16; ++r) {
                    const size_t off = (size_t)(m0 + crow(r, h)) * 1024 + n;
                    out[off] = xin[off] + acc[i][j][r];
                }
            }
    }
}

DI void phase_router(const Ctx& c_in, KArgs& a, int l) {
    const Ctx c = fresh_ctx(c_in.lds);
    unsigned char* ws = a.ws;
    const float* x = a.out;
    const float* g = a.in[16] + l * 1024;
    const float* wrg = a.in[17] + (size_t)l * 1024 * 4;
    const float* brg = a.in[18] + l * 4;
    const float* wre = a.in[19] + (size_t)l * 1024 * 32;
    const float* bre = a.in[20] + l * 32;
    u16* act = (u16*)(ws + WS_ACT);
    int* cnt = (int*)(ws + WS_CTL);
    int* list = (int*)(ws + WS_LIST);
    float* tokw = (float*)(ws + WS_TOKW);
    const int nitems = T_TOK / 8;
    for (int it = blockIdx.x; it < nitems; it += gridDim.x) {
        const int t = it * 8 + c.wave;
        float hv[16];
        {
            const float* xr = x + (size_t)t * 1024;
            float ss = 0.f;
#pragma unroll
            for (int j = 0; j < 16; ++j) { hv[j] = xr[c.lane + 64 * j]; ss += hv[j] * hv[j]; }
            ss = wsum(ss);
            const float rs = rsqrtf(ss * (1.f / 1024.f) + EPS);
#pragma unroll
            for (int j = 0; j < 16; ++j) {
                hv[j] = hv[j] * rs * g[c.lane + 64 * j];
                act[(size_t)t * 1024 + c.lane + 64 * j] = f2bf(hv[j]);
            }
        }
        float lg[36];
#pragma unroll
        for (int e = 0; e < 36; ++e) lg[e] = 0.f;
#pragma unroll
        for (int j = 0; j < 16; ++j) {
            const int i = c.lane + 64 * j;
            const float4 wg4 = *(const float4*)(wrg + (size_t)i * 4);
            lg[0] += hv[j] * wg4.x; lg[1] += hv[j] * wg4.y; lg[2] += hv[j] * wg4.z; lg[3] += hv[j] * wg4.w;
#pragma unroll
            for (int e4 = 0; e4 < 8; ++e4) {
                const float4 we = *(const float4*)(wre + (size_t)i * 32 + e4 * 4);
                lg[4 + e4 * 4 + 0] += hv[j] * we.x; lg[4 + e4 * 4 + 1] += hv[j] * we.y; lg[4 + e4 * 4 + 2] += hv[j] * we.z; lg[4 + e4 * 4 + 3] += hv[j] * we.w;
            }
        }
#pragma unroll
        for (int e = 0; e < 36; ++e) lg[e] = wsum(lg[e]);
        {
            float gl[4];
#pragma unroll
            for (int e = 0; e < 4; ++e) gl[e] = lg[e] + brg[e];
            int gi = 0; float gm = gl[0];
#pragma unroll
            for (int e = 1; e < 4; ++e) if (gl[e] > gm) { gm = gl[e]; gi = e; }
            float den = 0.f;
#pragma unroll
            for (int e = 0; e < 4; ++e) den += __expf(gl[e] - gm);
            const float gp = 1.f / den;
            float el[8];
#pragma unroll
            for (int e = 0; e < 8; ++e) {
                const float v0 = lg[4 + e], v1 = lg[12 + e], v2 = lg[20 + e], v3 = lg[28 + e];
                el[e] = (gi == 0 ? v0 : gi == 1 ? v1 : gi == 2 ? v2 : v3) + bre[gi * 8 + e];
            }
            int i1 = 0; float v1 = el[0];
#pragma unroll
            for (int e = 1; e < 8; ++e) if (el[e] > v1) { v1 = el[e]; i1 = e; }
            int i2 = 0; float v2 = -INFINITY;
#pragma unroll
            for (int e = 0; e < 8; ++e) if (e != i1 && el[e] > v2) { v2 = el[e]; i2 = e; }
            const float ex = __expf(v2 - v1);
            const float w1 = gp / (1.f + ex), w2 = gp * ex / (1.f + ex);
            if (c.lane == 0) {
                const int e1 = gi * 8 + i1, e2 = gi * 8 + i2;
                const int s1 = atomicAdd(&cnt[e1 * 2 + 0], 1);
                list[(size_t)(e1 * 2 + 0) * 32768 + s1] = t;
                const int s2 = atomicAdd(&cnt[e2 * 2 + 1], 1);
                list[(size_t)(e2 * 2 + 1) * 32768 + s2] = t;
                tokw[t * 2] = w1; tokw[t * 2 + 1] = w2;
            }
        }
    }
}

DI int moe_setup(const Ctx& c, KArgs& a, int ntn, int kfilter, int* tstart  ) {
    const int* cnt = (const int*)(a.ws + WS_CTL);
    if (c.tid == 0) {
        int run = 0;
        for (int L = 0; L < 64; ++L) {
            tstart[L] = run;
            const int n = __hip_atomic_load(&cnt[L], __ATOMIC_RELAXED, __HIP_MEMORY_SCOPE_AGENT);
            if (kfilter < 0 || (L & 1) == kfilter) run += ((n + 255) >> 8) * ntn;
        }
        tstart[64] = run;
    }
    __syncthreads();
    return tstart[64];
}

DI void phase_moe_up(const Ctx& c_in, KArgs& a) {
    const Ctx c = fresh_ctx(c_in.lds);
    unsigned char* ws = a.ws;
    const u16* act = (const u16*)(ws + WS_ACT);
    const int* cnt = (const int*)(ws + WS_CTL);
    const int* list = (const int*)(ws + WS_LIST);
    const float* tokw = (const float*)(ws + WS_TOKW);
    u16* hmid = (u16*)(ws + WS_HMID);
    int* tstart = (int*)(c.lds + G_LDS_BYTES);
    int* tok_s = (int*)(c.lds + G_LDS_BYTES + 512);
    const int r8 = c.tid >> 3;
    const int wm = c.wave & 3, wn = c.wave >> 2, l31 = c.lane & 31, h = c.lane >> 5;
    const int total = moe_setup(c, a, 4, -1, tstart);
    for (int tile = blockIdx.x; tile < total; tile += gridDim.x) {
        int L = 0;
        for (int j = 0; j < 64; ++j) if (tstart[j + 1] <= tile) L = j + 1;
        const int rel = tile - tstart[L], mi = rel >> 2, nt = rel & 3;
        const int e = L >> 1, kr = L & 1;
        const int n = __hip_atomic_load(&cnt[L], __ATOMIC_RELAXED, __HIP_MEMORY_SCOPE_AGENT);
        __syncthreads();
        if (c.tid < 256) { const int r = mi * 256 + c.tid; tok_s[c.tid] = (r < n) ? list[(size_t)L * 32768 + r] : -1; }
        __syncthreads();
        GP gp;
        { const int t0 = tok_s[r8], t1 = tok_s[r8 + 64], t2 = tok_s[r8 + 128], t3 = tok_s[r8 + 192];
          gp.a0 = act + (size_t)(t0 < 0 ? 0 : t0) * 1024; gp.a1 = act + (size_t)(t1 < 0 ? 0 : t1) * 1024;
          gp.a2 = act + (size_t)(t2 < 0 ? 0 : t2) * 1024; gp.a3 = act + (size_t)(t3 < 0 ? 0 : t3) * 1024; }
        gp.b0 = (const u16*)(ws + WS_WG) + ((size_t)e * 256 + nt * 64 + r8) * 1024;
        gp.b1 = (const u16*)(ws + WS_WU) + ((size_t)e * 256 + nt * 64 + r8) * 1024;
        f32x16 acc[2][2];
        acc[0][0] = zero16(); acc[0][1] = zero16(); acc[1][0] = zero16(); acc[1][1] = zero16();
        gemm_core<true>(c, 1024, gp, acc);
#pragma unroll
        for (int i = 0; i < 2; ++i) {
            const int nn = nt * 64 + wn * 32 + l31;
#pragma unroll
            for (int r = 0; r < 16; ++r) {
                const int ml = wm * 64 + i * 32 + crow(r, h);
                const int tk = tok_s[ml];
                if (tk >= 0) {
                    const float gv = acc[i][0][r], uv = acc[i][1][r];
                    hmid[((size_t)tk * 2 + kr) * 256 + nn] = f2bf(siluf(gv) * uv * tokw[tk * 2 + kr]);
                }
            }
        }
    }
}

DI void phase_moe_down(const Ctx& c_in, KArgs& a, int kpass) {
    const Ctx c = fresh_ctx(c_in.lds);
    unsigned char* ws = a.ws;
    const int* cnt = (const int*)(ws + WS_CTL);
    const int* list = (const int*)(ws + WS_LIST);
    const u16* hmid = (const u16*)(ws + WS_HMID);
    float* out = a.out;
    int* tstart = (int*)(c.lds + G_LDS_BYTES);
    int* tok_s = (int*)(c.lds + G_LDS_BYTES + 512);
    const int r8 = c.tid >> 3;
    const int wm = c.wave & 3, wn = c.wave >> 2, l31 = c.lane & 31, h = c.lane >> 5;
    const int total = moe_setup(c, a, 8, kpass, tstart);
    for (int tile = blockIdx.x; tile < total; tile += gridDim.x) {
        int L = 0;
        for (int j = 0; j < 64; ++j) if (tstart[j + 1] <= tile) L = j + 1;
        const int rel = tile - tstart[L], mi = rel >> 3, nt = rel & 7;
        const int e = L >> 1;
        const int n = __hip_atomic_load(&cnt[L], __ATOMIC_RELAXED, __HIP_MEMORY_SCOPE_AGENT);
        __syncthreads();
        if (c.tid < 256) { const int r = mi * 256 + c.tid; tok_s[c.tid] = (r < n) ? list[(size_t)L * 32768 + r] : -1; }
        __syncthreads();
        GP gp;
        { const int t0 = tok_s[r8], t1 = tok_s[r8 + 64], t2 = tok_s[r8 + 128], t3 = tok_s[r8 + 192];
          gp.a0 = hmid + ((size_t)(t0 < 0 ? 0 : t0) * 2 + kpass) * 256; gp.a1 = hmid + ((size_t)(t1 < 0 ? 0 : t1) * 2 + kpass) * 256;
          gp.a2 = hmid + ((size_t)(t2 < 0 ? 0 : t2) * 2 + kpass) * 256; gp.a3 = hmid + ((size_t)(t3 < 0 ? 0 : t3) * 2 + kpass) * 256; }
        gp.b0 = (const u16*)(ws + WS_WD) + ((size_t)e * 1024 + nt * 128 + r8) * 256; gp.b1 = gp.b0 + 64 * 256;
        f32x16 acc[2][2];
        acc[0][0] = zero16(); acc[0][1] = zero16(); acc[1][0] = zero16(); acc[1][1] = zero16();
        gemm_core<false>(c, 256, gp, acc);
#pragma unroll
        for (int i = 0; i < 2; ++i)
#pragma unroll
            for (int j = 0; j < 2; ++j) {
                const int nn = nt * 128 + wn * 64 + j * 32 + l31;
#pragma unroll
                for (int r = 0; r < 16; ++r) {
                    const int tk = tok_s[wm * 64 + i * 32 + crow(r, h)];
                    if (tk >= 0) { const size_t off = (size_t)tk * 1024 + nn; out[off] = out[off] + acc[i][j][r]; }
                }
            }
    }
}

DI void phase_final(const Ctx& c_in, KArgs& a) {
    const Ctx c = fresh_ctx(c_in.lds);
    float* x = a.out;
    const float* g = a.in[24];
    for (int it = blockIdx.x; it < T_TOK / 8; it += gridDim.x) {
        const int t = it * 8 + c.wave;
        float* xr = x + (size_t)t * 1024;
        float v[16]; float ss = 0.f;
#pragma unroll
        for (int j = 0; j < 16; ++j) { v[j] = xr[c.lane + 64 * j]; ss += v[j] * v[j]; }
        ss = wsum(ss);
        const float rs = rsqrtf(ss * (1.f / 1024.f) + EPS);
#pragma unroll
        for (int j = 0; j < 16; ++j) xr[c.lane + 64 * j] = v[j] * rs * g[c.lane + 64 * j];
    }
}

template <int SP>
DI void run_phase(const Ctx& c, KArgs& a, int l) {
    if constexpr (SP == 11) phase_prep(c, a);
    else if constexpr (SP == 12) phase_final(c, a);
    else if constexpr (SP == 0) phase_norm_in(c, a, l);
    else if constexpr (SP == 1) phase_inproj(c, a, l);
    else if constexpr (SP == 2) {
        const int n_ssd = 256, n_q = 128 * 3, n_kv = 128 * 4, n_tok = T_TOK / 8;
        for (int it = blockIdx.x; it < n_ssd + n_q + n_kv + n_tok; it += gridDim.x) {
            if (it < n_ssd) ssd_state_item(c, a, l, it);
            else if (it < n_ssd + n_q) mla_up_item(c, a, l, 0, it - n_ssd);
            else if (it < n_ssd + n_q + n_kv) mla_up_item(c, a, l, 1, it - n_ssd - n_q);
            else token_post_item(c, a, l, it - n_ssd - n_q - n_kv);
        }
    }
    else if constexpr (SP == 3) { for (int it = blockIdx.x; it < 512; it += gridDim.x) ssd_scan_item(c, a, it); }
    else if constexpr (SP == 4) {
        const int n_at = 512, n_ssd = 256, n_idx = 4096;
        for (int it = blockIdx.x; it < 2 * n_at + n_ssd + n_idx; it += gridDim.x) {
            if (it < 2 * n_at) { if (it & 1) attn_item<64, 1>(c, a, it >> 1); else attn_item<96, 0>(c, a, it >> 1); }
            else if (it < 2 * n_at + n_ssd) ssd_out_item(c, a, l, it - 2 * n_at);
            else dsa_index_item(c, a, it - 2 * n_at - n_ssd);
            __syncthreads();
        }
    }
    else if constexpr (SP == 5) { for (int it = blockIdx.x; it < 512; it += gridDim.x) { attn_item<64, 2>(c, a, it); __syncthreads(); } }
    else if constexpr (SP == 6) phase_outproj(c, a, l);
    else if constexpr (SP == 7) phase_router(c, a, l);
    else if constexpr (SP == 8) phase_moe_up(c, a);
    else if constexpr (SP == 9) phase_moe_down(c, a, 0);
    else if constexpr (SP == 10) phase_moe_down(c, a, 1);
}

#ifndef ONE_LAUNCH
#define ONE_LAUNCH 1
#endif

#if ONE_LAUNCH
__global__ void __launch_bounds__(NTHR) mega(Args a_unused) {
    extern __shared__ __attribute__((aligned(16))) unsigned char lds[];
    cg::grid_group grid = cg::this_grid();
    Ctx c; c.tid = threadIdx.x; c.lane = c.tid & 63; c.wave = 0; c.lds = lds;
    for (int ph = 0; ph < 24; ++ph) {
        if (ph > 0) grid.sync();
        KArgs* kp = (KArgs*)__builtin_amdgcn_kernarg_segment_ptr();
        asm volatile("" : "+s"(kp));
        KArgs& a = *kp;
        const int l = (ph - 1) / 11;
        const int sp = (ph == 0) ? 11 : (ph == 23) ? 12 : (ph - 1) % 11;
        switch (sp) {
        case 0: run_phase<0>(c, a, l); break;
        case 1: run_phase<1>(c, a, l); break;
        case 2: run_phase<2>(c, a, l); break;
        case 3: run_phase<3>(c, a, l); break;
        case 4: run_phase<4>(c, a, l); break;
        case 5: run_phase<5>(c, a, l); break;
        case 6: run_phase<6>(c, a, l); break;
        case 7: run_phase<7>(c, a, l); break;
        case 8: run_phase<8>(c, a, l); break;
        case 9: run_phase<9>(c, a, l); break;
        case 10: run_phase<10>(c, a, l); break;
        case 11: run_phase<11>(c, a, l); break;
        default: run_phase<12>(c, a, l); break;
        }
    }
}
#else
template <int SP>
__global__ void __launch_bounds__(NTHR) kphase(Args a, int l) {
    extern __shared__ __attribute__((aligned(16))) unsigned char lds[];
    Ctx c; c.tid = threadIdx.x; c.lane = c.tid & 63; c.wave = __builtin_amdgcn_readfirstlane(c.tid >> 6); c.lds = lds;
    KArgs* kp = (KArgs*)__builtin_amdgcn_kernarg_segment_ptr();
    run_phase<SP>(c, *kp, l);
}
template <int SP>
static void launch_phase(const Args& a, int l, int grid, hipStream_t stream) {
    static bool attr_set = false;
    if (!attr_set) { (void)hipFuncSetAttribute((const void*)kphase<SP>, hipFuncAttributeMaxDynamicSharedMemorySize, LDS_BYTES); attr_set = true; }
    hipLaunchKernelGGL(kphase<SP>, dim3(grid), dim3(NTHR), LDS_BYTES, stream, a, l);
}
#endif

extern "C" void kernel_launch(void* const* d_in, const int* in_sizes, int n_in, void* d_out, int out_size, void* d_ws, size_t ws_size, hipStream_t stream) {
    static int grid = 0;
    if (grid == 0) {
        if (n_in != 25 || ws_size < WS_END) { fprintf(stderr, "kernel_launch: unexpected inputs (n_in %d, ws %zu, need %zu)\n", n_in, ws_size, (size_t)WS_END); grid = -1; return; }
        int dev = 0, cus = 0;
        (void)hipGetDevice(&dev);
        (void)hipDeviceGetAttribute(&cus, hipDeviceAttributeMultiprocessorCount, dev);
        if (cus <= 0) cus = 256;
#if ONE_LAUNCH
        int per_cu = 0;
        if (hipFuncSetAttribute((const void*)mega, hipFuncAttributeMaxDynamicSharedMemorySize, LDS_BYTES) != hipSuccess) { fprintf(stderr, "kernel_launch: hipFuncSetAttribute failed\n"); grid = -1; return; }
        if (hipOccupancyMaxActiveBlocksPerMultiprocessor(&per_cu, (const void*)mega, NTHR, LDS_BYTES) != hipSuccess || per_cu < 1) { fprintf(stderr, "kernel_launch: occupancy query says %d blocks per CU\n", per_cu); (void)hipGetLastError(); grid = -1; return; }
        grid = cus;
#else
        grid = cus;
#endif
    }
    if (grid < 0) return;
    Args a{};
    for (int i = 0; i < 25; ++i) a.in[i] = (const float*)d_in[i];
    a.out = (float*)d_out; a.ws = (unsigned char*)d_ws;
    for (int i = 0; i < 8; ++i) a.inv16[i] = (float)pow(500000.0, -(double)i / 8.0);
    for (int i = 0; i < 16; ++i) a.inv32[i] = (float)pow(500000.0, -(double)i / 16.0);
    a.ph_lo = 0; a.ph_hi = 0;
#if ONE_LAUNCH
    void* kargs[] = { &a };
    hipError_t e = hipLaunchCooperativeKernel((const void*)mega, dim3(grid), dim3(NTHR), kargs, LDS_BYTES, stream);
    if (e != hipSuccess) fprintf(stderr, "kernel_launch: cooperative launch failed: %s (grid %d)\n", hipGetErrorString(e), grid);
#else
    launch_phase<11>(a, 0, grid, stream);
    for (int l = 0; l < DEPTH; ++l) {
        launch_phase<0>(a, l, grid, stream);
        launch_phase<1>(a, l, grid, stream);
        launch_phase<2>(a, l, grid, stream);
        launch_phase<3>(a, l, grid, stream);
        launch_phase<4>(a, l, grid, stream);
        launch_phase<5>(a, l, grid, stream);
        launch_phase<6>(a, l, grid, stream);
        launch_phase<7>(a, l, grid, stream);
        launch_phase<8>(a, l, grid, stream);
        launch_phase<9>(a, l, grid, stream);
        launch_phase<10>(a, l, grid, stream);
    }
    launch_phase<12>(a, 0, grid, stream);
#endif
}
```

```cpp
#include <hip/hip_runtime.h>
#include <hip/hip_cooperative_groups.h>
#include <cstdio>
#include <cmath>
#include <cstdint>


namespace cg = cooperative_groups;

typedef __attribute__((ext_vector_type(8))) short bf16x8;
typedef __attribute__((ext_vector_type(4))) short bf16x4;
typedef __attribute__((ext_vector_type(16))) float f32x16;
typedef unsigned short u16;
typedef unsigned long long u64;

#define DI __device__ __forceinline__
#define MFMA32(a, b, c) __builtin_amdgcn_mfma_f32_32x32x16_bf16((a), (b), (c), 0, 0, 0)

constexpr int T_TOK = 32768, SEQ = 4096, NB = 8, DM = 1024, DEPTH = 2;
constexpr int NREF = 3184;
constexpr int NPAD = 3200;
constexpr int LDP = 2848;
constexpr int PC_Z = 0, PC_XBC = 256, PC_DSAQ = 1024, PC_DSAK = 1280, PC_IDXQ = 1344, PC_IDXK = 1856,
              PC_CQ = 1920, PC_CKV = 2176, PC_KR = 2304, PC_FOXQ = 2336, PC_FOXK = 2592;
constexpr int NC_DSAV = 2848, NC_FOXV = 2912, NC_SMALL = 3168;
constexpr float EPS = 1e-6f;
constexpr float LOG2E = 1.4426950408889634f;
constexpr int NTHR = 512;
constexpr int LDS_BYTES = 147456;

constexpr size_t al256(size_t x) { return (x + 255) & ~(size_t)255; }
constexpr size_t WS_CTL   = 0;
constexpr size_t WS_BAR   = 4096;
constexpr size_t WS_CTL_BYTES = 32768;
constexpr size_t WS_WIN   = 32768;
constexpr size_t WS_WUQ   = WS_WIN  + (size_t)2 * NPAD * 1024 * 2;
constexpr size_t WS_WUKV  = WS_WUQ  + (size_t)2 * 384 * 256 * 2;
constexpr size_t WS_WOUT  = WS_WUKV + (size_t)2 * 512 * 128 * 2;
constexpr size_t WS_WG    = WS_WOUT + (size_t)2 * 1024 * 1024 * 2;
constexpr size_t WS_WU    = WS_WG   + (size_t)32 * 256 * 1024 * 2;
constexpr size_t WS_WD    = WS_WU   + (size_t)32 * 256 * 1024 * 2;
constexpr size_t WS_TRIG  = WS_WD   + (size_t)32 * 256 * 1024 * 2;
constexpr size_t WS_ACT   = WS_TRIG + (size_t)T_TOK * 48 * 4;
constexpr size_t WS_PROJ  = WS_ACT  + (size_t)T_TOK * 1024 * 2;
constexpr size_t WS_SMALL = WS_PROJ + (size_t)T_TOK * LDP * 2;
constexpr size_t WS_MLAQ  = WS_SMALL + (size_t)T_TOK * 16 * 4;
constexpr size_t WS_MLAK  = WS_MLAQ + (size_t)T_TOK * 384 * 2;
constexpr size_t WS_MLAVT = WS_MLAK + (size_t)T_TOK * 384 * 2;
constexpr size_t WS_DSAVT = WS_MLAVT + (size_t)T_TOK * 256 * 2;
constexpr size_t WS_FOXVT = WS_DSAVT + (size_t)T_TOK * 64 * 2;
constexpr size_t WS_FLOG  = WS_FOXVT + (size_t)T_TOK * 256 * 2;
constexpr size_t WS_CS    = WS_FLOG + (size_t)T_TOK * 4 * 4;
constexpr size_t WS_CDEC  = WS_CS   + (size_t)8 * 32 * 4 * 64 * 128 * 4;
constexpr size_t WS_MASK  = WS_CDEC + 4096;
constexpr size_t WS_TOKW  = WS_MASK + (size_t)T_TOK * 64 * 8;
constexpr size_t WS_WRH   = WS_TOKW + (size_t)T_TOK * 2 * 4;
constexpr size_t WS_WRL   = WS_WRH + (size_t)2 * 64 * 1024 * 2;
constexpr size_t WS_END   = WS_WRL + (size_t)2 * 64 * 1024 * 2;
constexpr size_t WS_LIST  = WS_PROJ;
constexpr size_t WS_HMID  = WS_PROJ + (size_t)64 * 32768 * 4;
static_assert(WS_HMID + (size_t)T_TOK * 512 * 2 <= WS_SMALL, "aliases must fit in PROJ");
static_assert(WS_END <= (size_t)512 * 1024 * 1024, "workspace budget");

struct Args {
    const float* in[25];
    float* out;
    unsigned char* ws;
    float inv16[8];
    float inv32[16];
    int ph_lo, ph_hi;
};

typedef const __attribute__((address_space(4))) Args KArgs;
struct Ctx { int tid, lane, wave; unsigned char* lds; };
__device__ __forceinline__ Ctx fresh_ctx(unsigned char* lds) {
    int t = threadIdx.x; asm volatile("" : "+v"(t));
    Ctx c; c.tid = t; c.lane = t & 63; c.wave = __builtin_amdgcn_readfirstlane(t >> 6); c.lds = lds; return c;
}

DI u16 f2bf(float x) { unsigned u = __float_as_uint(x); u += 0x7fffu + ((u >> 16) & 1u); return (u16)(u >> 16); }
DI float bf2f(u16 h) { return __uint_as_float(((unsigned)h) << 16); }
DI unsigned pack2(float a, float b) { return (unsigned)f2bf(a) | ((unsigned)f2bf(b) << 16); }
DI float wsum(float v) { for (int o = 32; o >= 1; o >>= 1) v += __shfl_xor(v, o); return v; }
DI float wmaxf(float v) { for (int o = 32; o >= 1; o >>= 1) v = fmaxf(v, __shfl_xor(v, o)); return v; }
DI float wminf(float v) { for (int o = 32; o >= 1; o >>= 1) v = fminf(v, __shfl_xor(v, o)); return v; }
DI float siluf(float x) { return x / (1.f + __expf(-x)); }
DI float softplusf(float x) { return fmaxf(x, 0.f) + log1pf(__expf(-fabsf(x))); }
DI int crow(int reg, int h) { return (reg & 3) + 8 * (reg >> 2) + 4 * h; }
DI bf16x8 pack8(const f32x16& x, int s) {
    uint4 p;
    p.x = pack2(x[8 * s + 0], x[8 * s + 1]); p.y = pack2(x[8 * s + 2], x[8 * s + 3]);
    p.z = pack2(x[8 * s + 4], x[8 * s + 5]); p.w = pack2(x[8 * s + 6], x[8 * s + 7]);
    return __builtin_bit_cast(bf16x8, p);
}
DI f32x16 zero16() { f32x16 z; for (int i = 0; i < 16; ++i) z[i] = 0.f; return z; }

DI int ref_col(int n) {
    if (n < 1024) return n;
    if (n < 1280) return n - 1024 + 1028;
    if (n < 1344) return n - 1280 + 1284;
    if (n < 1856) return n - 1344 + 1412;
    if (n < 1920) return n - 1856 + 1924;
    if (n < 2176) return n - 1920 + 1996;
    if (n < 2304) return n - 2176 + 2252;
    if (n < 2336) return n - 2304 + 2380;
    if (n < 2592) return n - 2336 + 2412;
    if (n < 2848) return n - 2592 + 2668;
    if (n < 2912) return n - 2848 + 1348;
    if (n < 3168) return n - 2912 + 2924;
    if (n < 3172) return n - 3168 + 1024;
    if (n < 3180) return n - 3172 + 1988;
    if (n < 3184) return n - 3180 + 3180;
    return -1;
}

constexpr int G_LDT = 72;
constexpr int G_AEL = 256 * G_LDT, G_BEL = 128 * G_LDT, G_STEL = G_AEL + G_BEL;
constexpr int G_LDS_BYTES = 2 * G_STEL * 2;

struct GP { const u16 *a0, *a1, *a2, *a3, *b0, *b1; };

template <bool PAIRED>
DI void gemm_core(const Ctx& c, int K, const GP& gp, f32x16 (&acc)[2][2]) {
    u16* S = (u16*)c.lds;
    const int r8 = c.tid >> 3, kc = c.tid & 7;
    const int wm = c.wave & 3, wn = c.wave >> 2, l31 = c.lane & 31, h = c.lane >> 5;
    const int nb0 = PAIRED ? wn * 32 : wn * 64, nb1 = PAIRED ? 64 + wn * 32 : wn * 64 + 32;
    uint4 ra0, ra1, ra2, ra3, rb0, rb1;
    const int nk = K >> 6;
#define G_LOAD(KOFF) do { \
        ra0 = *(const uint4*)(gp.a0 + (KOFF) + kc * 8); ra1 = *(const uint4*)(gp.a1 + (KOFF) + kc * 8); \
        ra2 = *(const uint4*)(gp.a2 + (KOFF) + kc * 8); ra3 = *(const uint4*)(gp.a3 + (KOFF) + kc * 8); \
        rb0 = *(const uint4*)(gp.b0 + (KOFF) + kc * 8); rb1 = *(const uint4*)(gp.b1 + (KOFF) + kc * 8); } while (0)
#define G_STORE(SP) do { u16* sp_ = (SP); \
        *(uint4*)(sp_ + (r8) * G_LDT + kc * 8) = ra0; *(uint4*)(sp_ + (r8 + 64) * G_LDT + kc * 8) = ra1; \
        *(uint4*)(sp_ + (r8 + 128) * G_LDT + kc * 8) = ra2; *(uint4*)(sp_ + (r8 + 192) * G_LDT + kc * 8) = ra3; \
        *(uint4*)(sp_ + G_AEL + (r8) * G_LDT + kc * 8) = rb0; *(uint4*)(sp_ + G_AEL + (r8 + 64) * G_LDT + kc * 8) = rb1; } while (0)
    G_LOAD(0);
    G_STORE(S);
    __syncthreads();
    for (int kt = 0; kt < nk; ++kt) {
        const bool more = (kt + 1 < nk);
        if (more) G_LOAD((kt + 1) * 64);
        const u16* As = S + (kt & 1) * G_STEL;
        const u16* Bs = As + G_AEL;
#pragma unroll
        for (int ks = 0; ks < 4; ++ks) {
            const bf16x8 a0 = *(const bf16x8*)(As + (wm * 64 + l31) * G_LDT + ks * 16 + h * 8);
            const bf16x8 a1 = *(const bf16x8*)(As + (wm * 64 + 32 + l31) * G_LDT + ks * 16 + h * 8);
            const bf16x8 b0 = *(const bf16x8*)(Bs + (nb0 + l31) * G_LDT + ks * 16 + h * 8);
            const bf16x8 b1 = *(const bf16x8*)(Bs + (nb1 + l31) * G_LDT + ks * 16 + h * 8);
            acc[0][0] = MFMA32(a0, b0, acc[0][0]);
            acc[0][1] = MFMA32(a0, b1, acc[0][1]);
            acc[1][0] = MFMA32(a1, b0, acc[1][0]);
            acc[1][1] = MFMA32(a1, b1, acc[1][1]);
        }
        if (more) G_STORE(S + ((kt + 1) & 1) * G_STEL);
        __syncthreads();
    }
}

DI void xpose_tile(const Ctx& c, const float* in, int ld_in, int k0, int n0, int colmode, const float* kscale, u16* out, int ld_out) {
    float* tile = (float*)c.lds;
    const int j = c.tid & 63, r0 = c.tid >> 6;
    const int n = n0 + j;
    const int rc = colmode ? ref_col(n) : n;
#pragma unroll
    for (int rr = 0; rr < 8; ++rr) {
        const int kk = r0 + 8 * rr;
        float v = 0.f;
        if (rc >= 0) { v = in[(size_t)(k0 + kk) * ld_in + rc]; if (kscale) v *= kscale[k0 + kk]; }
        tile[kk * 65 + j] = v;
    }
    __syncthreads();
#pragma unroll
    for (int rr = 0; rr < 8; ++rr) {
        const int jj = r0 + 8 * rr;
        out[(size_t)(n0 + jj) * ld_out + k0 + j] = f2bf(tile[j * 65 + jj]);
    }
    __syncthreads();
}

DI void phase_prep(const Ctx& c_in, KArgs& a) {
    const Ctx c = fresh_ctx(c_in.lds);
    unsigned char* ws = a.ws;
    const int n_win = 2 * 50 * 16;
    const int n_wuq = 2 * 6 * 4;
    const int n_wukv = 2 * 8 * 2;
    const int n_wout = 2 * 16 * 16;
    const int n_trig = T_TOK * 24 / NTHR;
    const int n_wr = 2 * 64 * 1024 / NTHR;
    const int total = n_win + n_wuq + n_wukv + n_wout + n_trig + n_wr;
    for (int it = blockIdx.x; it < total; it += gridDim.x) {
        int i = it;
        if (i < n_win) {
            const int l = i / 800, r = i % 800, nt = r / 16, kt = r % 16;
            xpose_tile(c, a.in[3] + (size_t)l * 1024 * NREF, NREF, kt * 64, nt * 64, 1, nullptr, (u16*)(ws + WS_WIN) + (size_t)l * NPAD * 1024, 1024);
            continue;
        }
        i -= n_win;
        if (i < n_wuq) {
            const int l = i / 24, r = i % 24, nt = r / 4, kt = r % 4;
            xpose_tile(c, a.in[11] + (size_t)l * 256 * 384, 384, kt * 64, nt * 64, 0, a.in[10] + l * 256, (u16*)(ws + WS_WUQ) + (size_t)l * 384 * 256, 256);
            continue;
        }
        i -= n_wuq;
        if (i < n_wukv) {
            const int l = i / 16, r = i % 16, nt = r / 2, kt = r % 2;
            xpose_tile(c, a.in[13] + (size_t)l * 128 * 512, 512, kt * 64, nt * 64, 0, a.in[12] + l * 128, (u16*)(ws + WS_WUKV) + (size_t)l * 512 * 128, 128);
            continue;
        }
        i -= n_wukv;
        if (i < n_wout) {
            const int l = i / 256, r = i % 256, nt = r / 16, kt = r % 16;
            xpose_tile(c, a.in[15] + (size_t)l * 1024 * 1024, 1024, kt * 64, nt * 64, 0, nullptr, (u16*)(ws + WS_WOUT) + (size_t)l * 1024 * 1024, 1024);
            continue;
        }
        i -= n_wout;
        if (i >= n_trig) {
            const int e = (i - n_trig) * NTHR + c.tid;
            const int l = e >> 16, n = (e >> 10) & 63, k = e & 1023;
            float v = 0.f;
            if (n < 4) v = a.in[17][((size_t)l * 1024 + k) * 4 + n];
            else if (n < 36) v = a.in[19][((size_t)l * 1024 + k) * 32 + (n - 4)];
            const u16 hi = f2bf(v);
            ((u16*)(ws + WS_WRH))[e] = hi;
            ((u16*)(ws + WS_WRL))[e] = f2bf(v - bf2f(hi));
            continue;
        }
        {
            const int e = i * NTHR + c.tid;
            const int t = e / 24, j = e % 24;
            const int pos = ((const int*)a.in[1])[t];
            const float inv = (j < 8) ? a.inv16[j] : a.inv32[j - 8];
            const float ang = (float)pos * inv;
            const double ad = (double)ang;
            const double r = ad - 6.283185307179586476925 * rint(ad * 0.15915494309189533577);
            const float rf = (float)r;
            const float cs = cosf(rf), sn = sinf(rf);
            float* trig = (float*)(ws + WS_TRIG) + (size_t)t * 48;
            if (j < 8) { trig[j] = cs; trig[8 + j] = sn; } else { trig[16 + (j - 8)] = cs; trig[32 + (j - 8)] = sn; }
        }
    }
}

DI void phase_norm_in(const Ctx& c_in, KArgs& a, int l) {
    const Ctx c = fresh_ctx(c_in.lds);
    unsigned char* ws = a.ws;
    const float* x = (l == 0) ? a.in[0] : a.out;
    const float* g = a.in[2] + l * 1024;
    u16* act = (u16*)(ws + WS_ACT);
    const int n_norm = T_TOK / 8;
    const int n_exp = 3 * 32 * 64;
    if (blockIdx.x == 0 && c.tid < 64) ((int*)(ws + WS_CTL))[c.tid] = 0;
    for (int it = blockIdx.x; it < n_norm + n_exp; it += gridDim.x) {
        if (it < n_exp) {
            const int which = it / 2048, r = it % 2048, e = r / 64, tt = r % 64;
            if (which < 2) {
                const float* src = a.in[21 + which] + ((size_t)l * 32 + e) * 1024 * 256;
                u16* dst = (u16*)(ws + (which == 0 ? WS_WG : WS_WU)) + (size_t)e * 256 * 1024;
                const int nt = tt / 16, kt = tt % 16;
                xpose_tile(c, src, 256, kt * 64, nt * 64, 0, nullptr, dst, 1024);
            } else {
                const float* src = a.in[23] + ((size_t)l * 32 + e) * 256 * 1024;
                u16* dst = (u16*)(ws + WS_WD) + (size_t)e * 1024 * 256;
                const int nt = tt / 4, kt = tt % 4;
                xpose_tile(c, src, 1024, kt * 64, nt * 64, 0, nullptr, dst, 256);
            }
        } else {
            const int t = (it - n_exp) * 8 + c.wave;
            const float* xr = x + (size_t)t * 1024;
            float v[16]; float ss = 0.f;
#pragma unroll
            for (int j = 0; j < 16; ++j) { v[j] = xr[c.lane + 64 * j]; ss += v[j] * v[j]; }
            ss = wsum(ss);
            const float rs = rsqrtf(ss * (1.f / 1024.f) + EPS);
#pragma unroll
            for (int j = 0; j < 16; ++j) act[(size_t)t * 1024 + c.lane + 64 * j] = f2bf(v[j] * rs * g[c.lane + 64 * j]);
        }
    }
}

DI void phase_inproj(const Ctx& c_in, KArgs& a, int l) {
    const Ctx c = fresh_ctx(c_in.lds);
    unsigned char* ws = a.ws;
    const u16* act = (const u16*)(ws + WS_ACT);
    const u16* w = (const u16*)(ws + WS_WIN) + (size_t)l * NPAD * 1024;
    u16* proj = (u16*)(ws + WS_PROJ);
    u16* dsavt = (u16*)(ws + WS_DSAVT);
    u16* foxvt = (u16*)(ws + WS_FOXVT);
    float* small = (float*)(ws + WS_SMALL);
    const int r8 = c.tid >> 3;
    const int wm = c.wave & 3, wn = c.wave >> 2, l31 = c.lane & 31, h = c.lane >> 5;
    const int ntiles = (T_TOK / 256) * (NPAD / 128);
    for (int tile = blockIdx.x; tile < ntiles; tile += gridDim.x) {
        const int mt = tile / 25, nt = tile % 25;
        GP gp;
        gp.a0 = act + (size_t)(mt * 256 + r8) * 1024; gp.a1 = gp.a0 + 64 * 1024; gp.a2 = gp.a0 + 128 * 1024; gp.a3 = gp.a0 + 192 * 1024;
        gp.b0 = w + (size_t)(nt * 128 + r8) * 1024; gp.b1 = gp.b0 + 64 * 1024;
        f32x16 acc[2][2];
        acc[0][0] = zero16(); acc[0][1] = zero16(); acc[1][0] = zero16(); acc[1][1] = zero16();
        gemm_core<false>(c, 1024, gp, acc);
#pragma unroll
        for (int i = 0; i < 2; ++i)
#pragma unroll
            for (int j = 0; j < 2; ++j) {
                const int m0 = mt * 256 + wm * 64 + i * 32, n0 = nt * 128 + wn * 64 + j * 32;
                const int n = n0 + l31;
                if (n0 < LDP) {
#pragma unroll
                    for (int r = 0; r < 16; ++r) proj[(size_t)(m0 + crow(r, h)) * LDP + n] = f2bf(acc[i][j][r]);
                } else if (n0 < NC_SMALL) {
                    const int b = m0 >> 12, s0 = m0 & 4095;
                    u16* base = (n0 < NC_FOXV) ? dsavt + ((size_t)b * 64 + (n - NC_DSAV)) * 4096 : foxvt + ((size_t)b * 256 + (n - NC_FOXV)) * 4096;
#pragma unroll
                    for (int q = 0; q < 4; ++q) {
                        uint2 pk; pk.x = pack2(acc[i][j][4 * q], acc[i][j][4 * q + 1]); pk.y = pack2(acc[i][j][4 * q + 2], acc[i][j][4 * q + 3]);
                        *(uint2*)(base + s0 + 8 * q + 4 * h) = pk;
                    }
                } else {
                    const int cc = n - NC_SMALL;
                    if (cc < 16) {
#pragma unroll
                        for (int r = 0; r < 16; ++r) small[(size_t)(m0 + crow(r, h)) * 16 + cc] = acc[i][j][r];
                    }
                }
            }
    }
}

constexpr int SSD_LD = 136;
constexpr int SSD_TILE_B = 128 * SSD_LD * 2;
constexpr int SSD_OFF_DT = 3 * SSD_TILE_B;
constexpr int SSD_OFF_ACS = SSD_OFF_DT + 2048;
constexpr int SSD_OFF_SSQ = SSD_OFF_ACS + 2048;

DI void ssd_dt_acs(const Ctx& c, KArgs& a, int l, int tok0, float* dt_s, float* acs_s) {
    const float* small = (const float*)(a.ws + WS_SMALL);
    {
        const int t = c.tid >> 2, hd = c.tid & 3;
        const float raw = small[(size_t)(tok0 + t) * 16 + hd] + a.in[6][l * 4 + hd];
        dt_s[hd * 128 + t] = softplusf(raw);
    }
    __syncthreads();
    if (c.wave < 4) {
        const int hd = c.wave;
        const float av = -__expf(a.in[7][l * 4 + hd]);
        const float v0 = dt_s[hd * 128 + 2 * c.lane] * av, v1 = dt_s[hd * 128 + 2 * c.lane + 1] * av;
        const float s = v0 + v1;
        float inc = s;
#pragma unroll
        for (int o = 1; o < 64; o <<= 1) { const float tv = __shfl_up(inc, o); if (c.lane >= o) inc += tv; }
        const float ex = inc - s;
        acs_s[hd * 128 + 2 * c.lane] = ex + v0;
        acs_s[hd * 128 + 2 * c.lane + 1] = ex + v0 + v1;
    }
    __syncthreads();
}

DI float ssd_conv(const u16* proj, const float* cw, const float* cb, int b, int s, int xc) {
    float acc = cb[xc];
#pragma unroll
    for (int j = 0; j < 4; ++j) {
        const int sp = s - 3 + j;
        if (sp >= 0) acc += cw[j * 768 + xc] * bf2f(proj[(size_t)(b * 4096 + sp) * LDP + PC_XBC + xc]);
    }
    return siluf(acc);
}

template <bool TRANSPOSED>
DI void conv_stage_unit(const Ctx& c, const u16* proj, const float* cw, const float* cb, int b, int s0, int tseg, int xc0, u16* dst,
                        const float* dt_s, const float* acs_s, int head0) {
    const int ch = 2 * c.lane, xc = xc0 + ch;
    float w0[4], w1[4];
#pragma unroll
    for (int j = 0; j < 4; ++j) { w0[j] = cw[j * 768 + xc]; w1[j] = cw[j * 768 + xc + 1]; }
    const float bias0 = cb[xc], bias1 = cb[xc + 1];
    const int sb = s0 + tseg * 32 - 3;
    const u16* src = proj + (size_t)(b * 4096) * LDP + PC_XBC + xc;
    unsigned raw[35];
#pragma unroll
    for (int i = 0; i < 35; ++i) { const int sp = sb + i; raw[i] = (sp >= 0) ? *(const unsigned*)(src + (size_t)sp * LDP) : 0u; }
    const int head = head0 + (ch >> 6);
#pragma unroll
    for (int t = 0; t < 32; ++t) {
        float x0 = bias0, x1 = bias1;
#pragma unroll
        for (int j = 0; j < 4; ++j) { x0 += w0[j] * bf2f((u16)(raw[t + j] & 0xffff)); x1 += w1[j] * bf2f((u16)(raw[t + j] >> 16)); }
        x0 = siluf(x0); x1 = siluf(x1);
        const int tt = tseg * 32 + t;
        if (dt_s) { const float sc = dt_s[head * 128 + tt] * __expf(acs_s[head * 128 + 127] - acs_s[head * 128 + tt]); x0 *= sc; x1 *= sc; }
        if (TRANSPOSED) { dst[ch * SSD_LD + tt] = f2bf(x0); dst[(ch + 1) * SSD_LD + tt] = f2bf(x1); }
        else *(unsigned*)(dst + tt * SSD_LD + ch) = pack2(x0, x1);
    }
}

DI void ssd_state_item(const Ctx& c_in, KArgs& a, int l, int item) {
    const Ctx c = fresh_ctx(c_in.lds);
    unsigned char* ws = a.ws;
    const u16* proj = (const u16*)(ws + WS_PROJ);
    const float* cw = a.in[4] + (size_t)l * 4 * 768;
    const float* cb = a.in[5] + (size_t)l * 768;
    float* cs = (float*)(ws + WS_CS);
    float* cdec = (float*)(ws + WS_CDEC);
    const int b = item >> 5, ch = item & 31, tok0 = b * 4096 + ch * 128, s0 = ch * 128;
    u16* XT = (u16*)c.lds;
    u16* BT = (u16*)(c.lds + SSD_TILE_B);
    float* dt_s = (float*)(c.lds + SSD_OFF_DT);
    float* acs_s = (float*)(c.lds + SSD_OFF_ACS);
    const int l31 = c.lane & 31, h = c.lane >> 5;
    ssd_dt_acs(c, a, l, tok0, dt_s, acs_s);
    if (c.tid < 4) cdec[(b * 32 + ch) * 4 + c.tid] = __expf(acs_s[c.tid * 128 + 127]);
    for (int g = 0; g < 2; ++g) {
        if (c.wave < 4) conv_stage_unit<true>(c, proj, cw, cb, b, s0, c.wave, 128 * g, XT, dt_s, acs_s, 2 * g);
        else conv_stage_unit<true>(c, proj, cw, cb, b, s0, c.wave - 4, 256 + 128 * g, BT, nullptr, nullptr, 0);
        __syncthreads();
        {
            const int hh = c.wave >> 2, pt = (c.wave >> 1) & 1, nh = c.wave & 1;
            f32x16 acc0 = zero16(), acc1 = zero16();
#pragma unroll
            for (int ks = 0; ks < 8; ++ks) {
                const bf16x8 af = *(const bf16x8*)(XT + (hh * 64 + pt * 32 + l31) * SSD_LD + ks * 16 + h * 8);
                const bf16x8 b0 = *(const bf16x8*)(BT + (nh * 64 + l31) * SSD_LD + ks * 16 + h * 8);
                const bf16x8 b1 = *(const bf16x8*)(BT + (nh * 64 + 32 + l31) * SSD_LD + ks * 16 + h * 8);
                acc0 = MFMA32(af, b0, acc0);
                acc1 = MFMA32(af, b1, acc1);
            }
            const int head = 2 * g + hh;
            float* dst = cs + ((size_t)((b * 32 + ch) * 4 + head) * 64) * 128;
#pragma unroll
            for (int r = 0; r < 16; ++r) {
                const int p = pt * 32 + crow(r, h);
                dst[p * 128 + nh * 64 + l31] = acc0[r];
                dst[p * 128 + nh * 64 + 32 + l31] = acc1[r];
            }
        }
        __syncthreads();
    }
}

DI void ssd_scan_item(const Ctx& c_in, KArgs& a, int item) {
    const Ctx c = fresh_ctx(c_in.lds);
    float* cs = (float*)(a.ws + WS_CS);
    const float* cdec = (const float*)(a.ws + WS_CDEC);
    const int idx = item * NTHR + c.tid;
    const int bh = idx >> 13, pn = idx & 8191, b = bh >> 2, hd = bh & 3;
    float s = 0.f;
    for (int ch = 0; ch < 32; ++ch) {
        const size_t off = ((size_t)((b * 32 + ch) * 4 + hd)) * 8192 + pn;
        const float v = cs[off];
        cs[off] = s;
        s = s * cdec[(b * 32 + ch) * 4 + hd] + v;
    }
}

DI void ssd_out_item(const Ctx& c_in, KArgs& a, int l, int item) {
    const Ctx c = fresh_ctx(c_in.lds);
    unsigned char* ws = a.ws;
    const u16* proj = (const u16*)(ws + WS_PROJ);
    const float* cw = a.in[4] + (size_t)l * 4 * 768;
    const float* cb = a.in[5] + (size_t)l * 768;
    const float* prev = (const float*)(ws + WS_CS);
    u16* act = (u16*)(ws + WS_ACT);
    const int b = item >> 5, ch = item & 31, tok0 = b * 4096 + ch * 128, s0 = ch * 128;
    u16* XT = (u16*)c.lds;
    u16* BM = (u16*)(c.lds + SSD_TILE_B);
    u16* CM = (u16*)(c.lds + 2 * SSD_TILE_B);
    float* dt_s = (float*)(c.lds + SSD_OFF_DT);
    float* acs_s = (float*)(c.lds + SSD_OFF_ACS);
    float* ssq = (float*)(c.lds + SSD_OFF_SSQ);
    const int l31 = c.lane & 31, h = c.lane >> 5;
    ssd_dt_acs(c, a, l, tok0, dt_s, acs_s);
    f32x16 yreg[2][2];
    const int hh = c.wave >> 2, qt = c.wave & 3;
    const int q = qt * 32 + l31;
#pragma unroll
    for (int g = 0; g < 2; ++g) {
        for (int u = c.wave; u < 12; u += 8) {
            const int part = u >> 2, tseg = u & 3;
            if (part == 0) conv_stage_unit<true>(c, proj, cw, cb, b, s0, tseg, 128 * g, XT, nullptr, nullptr, 0);
            else if (part == 1) conv_stage_unit<false>(c, proj, cw, cb, b, s0, tseg, 256 + 128 * g, BM, nullptr, nullptr, 0);
            else conv_stage_unit<false>(c, proj, cw, cb, b, s0, tseg, 512 + 128 * g, CM, nullptr, nullptr, 0);
        }
        __syncthreads();
        {
            const int head = 2 * g + hh;
            const float acs_q = acs_s[head * 128 + q];
            bf16x8 cf[8];
#pragma unroll
            for (int ks = 0; ks < 8; ++ks) cf[ks] = *(const bf16x8*)(CM + q * SSD_LD + ks * 16 + h * 8);
            f32x16 yo0 = zero16(), yo1 = zero16();
            for (int kt = 0; kt <= qt; ++kt) {
                f32x16 gt = zero16();
#pragma unroll
                for (int ks = 0; ks < 8; ++ks) {
                    const bf16x8 bf = *(const bf16x8*)(BM + (kt * 32 + l31) * SSD_LD + ks * 16 + h * 8);
                    gt = MFMA32(bf, cf[ks], gt);
                }
#pragma unroll
                for (int r = 0; r < 16; ++r) {
                    const int k = kt * 32 + crow(r, h);
                    const float dec = __expf(fminf(acs_q - acs_s[head * 128 + k], 0.f)) * dt_s[head * 128 + k];
                    gt[r] = (k <= q) ? gt[r] * dec : 0.f;
                }
#pragma unroll
                for (int s2 = 0; s2 < 2; ++s2) {
                    const bf16x8 pb = pack8(gt, s2);
                    const int koff = kt * 32 + 16 * s2 + 4 * h;
                    {
                        const u16* xr = XT + (hh * 64 + l31) * SSD_LD + koff;
                        const uint2 lo = *(const uint2*)xr, hi = *(const uint2*)(xr + 8);
                        const bf16x8 xa = __builtin_bit_cast(bf16x8, make_uint4(lo.x, lo.y, hi.x, hi.y));
                        yo0 = MFMA32(xa, pb, yo0);
                    }
                    {
                        const u16* xr = XT + (hh * 64 + 32 + l31) * SSD_LD + koff;
                        const uint2 lo = *(const uint2*)xr, hi = *(const uint2*)(xr + 8);
                        const bf16x8 xa = __builtin_bit_cast(bf16x8, make_uint4(lo.x, lo.y, hi.x, hi.y));
                        yo1 = MFMA32(xa, pb, yo1);
                    }
                }
            }
            f32x16 yf0 = zero16(), yf1 = zero16();
            const float* pv = prev + ((size_t)((b * 32 + ch) * 4 + head) * 64) * 128;
#pragma unroll
            for (int ks = 0; ks < 8; ++ks) {
                {
                    const float* pr = pv + (size_t)l31 * 128 + ks * 16 + h * 8;
                    const float4 f0 = *(const float4*)pr, f1 = *(const float4*)(pr + 4);
                    const bf16x8 pa = __builtin_bit_cast(bf16x8, make_uint4(pack2(f0.x, f0.y), pack2(f0.z, f0.w), pack2(f1.x, f1.y), pack2(f1.z, f1.w)));
                    yf0 = MFMA32(pa, cf[ks], yf0);
                }
                {
                    const float* pr = pv + (size_t)(32 + l31) * 128 + ks * 16 + h * 8;
                    const float4 f0 = *(const float4*)pr, f1 = *(const float4*)(pr + 4);
                    const bf16x8 pa = __builtin_bit_cast(bf16x8, make_uint4(pack2(f0.x, f0.y), pack2(f0.z, f0.w), pack2(f1.x, f1.y), pack2(f1.z, f1.w)));
                    yf1 = MFMA32(pa, cf[ks], yf1);
                }
            }
            const float eq = __expf(acs_q);
            const float dsk = a.in[8][l * 4 + head];
            float part = 0.f;
#pragma unroll
            for (int pt = 0; pt < 2; ++pt) {
#pragma unroll
                for (int qd = 0; qd < 4; ++qd) {
                    const int p0 = pt * 32 + 8 * qd + 4 * h;
                    const uint2 zz = *(const uint2*)(proj + (size_t)(tok0 + q) * LDP + PC_Z + head * 64 + p0);
                    const float zf[4] = { bf2f((u16)(zz.x & 0xffff)), bf2f((u16)(zz.x >> 16)), bf2f((u16)(zz.y & 0xffff)), bf2f((u16)(zz.y >> 16)) };
#pragma unroll
                    for (int r3 = 0; r3 < 4; ++r3) {
                        const int r = 4 * qd + r3;
                        const float yo = pt ? yo1[r] : yo0[r];
                        const float yf = pt ? yf1[r] : yf0[r];
                        const float xv = bf2f(XT[(hh * 64 + p0 + r3) * SSD_LD + q]);
                        const float y = (yo + yf * eq + dsk * xv) * siluf(zf[r3]);
                        yreg[g][pt][r] = y;
                        part += y * y;
                    }
                }
            }
            part += __shfl_xor(part, 32);
            if (h == 0) ssq[head * 128 + q] = part;
        }
        __syncthreads();
    }
    {
        const float rs = rsqrtf((ssq[q] + ssq[128 + q] + ssq[256 + q] + ssq[384 + q]) * (1.f / 256.f) + EPS);
        const float* nw = a.in[9] + l * 256;
#pragma unroll
        for (int g = 0; g < 2; ++g) {
            const int head = 2 * g + hh;
#pragma unroll
            for (int pt = 0; pt < 2; ++pt)
#pragma unroll
                for (int qd = 0; qd < 4; ++qd) {
                    const int p0 = pt * 32 + 8 * qd + 4 * h;
                    const float* w4 = nw + head * 64 + p0;
                    uint2 pk;
                    pk.x = pack2(yreg[g][pt][4 * qd] * rs * w4[0], yreg[g][pt][4 * qd + 1] * rs * w4[1]);
                    pk.y = pack2(yreg[g][pt][4 * qd + 2] * rs * w4[2], yreg[g][pt][4 * qd + 3] * rs * w4[3]);
                    *(uint2*)(act + (size_t)(tok0 + q) * 1024 + head * 64 + p0) = pk;
                }
        }
    }
    __syncthreads();
}

DI void token_post_item(const Ctx& c_in, KArgs& a, int l, int item) {
    const Ctx c = fresh_ctx(c_in.lds);
    unsigned char* ws = a.ws;
    u16* proj = (u16*)(ws + WS_PROJ);
    u16* mlak = (u16*)(ws + WS_MLAK);
    const float* trig = (const float*)(ws + WS_TRIG);
    const float* small = (const float*)(ws + WS_SMALL);
    float* flog = (float*)(ws + WS_FLOG);
    const int t = item * 8 + c.wave;
    u16* pr = proj + (size_t)t * LDP;
    const float* tg = trig + (size_t)t * 48;
#pragma unroll
    for (int r = 0; r < 2; ++r) {
        const int pid = c.lane + 64 * r;
        if (pid < 112) {
            int col, i;
            if (pid < 32)       { col = PC_DSAQ + (pid >> 3) * 64; i = pid & 7; }
            else if (pid < 40)  { col = PC_DSAK; i = pid - 32; }
            else if (pid < 104) { const int p = pid - 40; col = PC_IDXQ + (p >> 3) * 64; i = p & 7; }
            else                { col = PC_IDXK; i = pid - 104; }
            const float x1 = bf2f(pr[col + i]), x2 = bf2f(pr[col + 8 + i]);
            const float cs = tg[i], sn = tg[8 + i];
            pr[col + i] = f2bf(x1 * cs - x2 * sn);
            pr[col + 8 + i] = f2bf(x2 * cs + x1 * sn);
        } else {
            const int i = pid - 112;
            const float x1 = bf2f(pr[PC_KR + i]), x2 = bf2f(pr[PC_KR + 16 + i]);
            const float cs = tg[16 + i], sn = tg[32 + i];
            const u16 o1 = f2bf(x1 * cs - x2 * sn), o2 = f2bf(x2 * cs + x1 * sn);
#pragma unroll
            for (int hd = 0; hd < 4; ++hd) { mlak[(size_t)t * 384 + hd * 96 + 64 + i] = o1; mlak[(size_t)t * 384 + hd * 96 + 80 + i] = o2; }
        }
    }
    if (c.lane < 4) {
        const float f = small[(size_t)t * 16 + 12 + c.lane] + a.in[14][l * 4 + c.lane];
        const float ls = fminf(f, 0.f) - log1pf(__expf(-fabsf(f)));
        const int b = t >> 12, s = t & 4095;
        flog[(size_t)(b * 4 + c.lane) * 4096 + s] = ls;
    }
}

DI void mla_up_item(const Ctx& c_in, KArgs& a, int l, int which, int item) {
    const Ctx c = fresh_ctx(c_in.lds);
    unsigned char* ws = a.ws;
    const u16* proj = (const u16*)(ws + WS_PROJ);
    const float* trig = (const float*)(ws + WS_TRIG);
    float* rs_s = (float*)(c.lds + G_LDS_BYTES);
    const int r8 = c.tid >> 3;
    const int wm = c.wave & 3, wn = c.wave >> 2, l31 = c.lane & 31, h = c.lane >> 5;
    const int K = which == 0 ? 256 : 128;
    const int pc = which == 0 ? PC_CQ : PC_CKV;
    const int ntn = which == 0 ? 3 : 4;
    const int mt = item / ntn, nt = item % ntn;
    const u16* w = which == 0 ? (const u16*)(ws + WS_WUQ) + (size_t)l * 384 * 256 : (const u16*)(ws + WS_WUKV) + (size_t)l * 512 * 128;
    {
        const int row = c.tid >> 1, half = c.tid & 1;
        const u16* p = proj + (size_t)(mt * 256 + row) * LDP + pc + half * (K / 2);
        float ss = 0.f;
        for (int i = 0; i < K / 2; i += 8) {
            const uint4 v = *(const uint4*)(p + i);
            const unsigned w4[4] = { v.x, v.y, v.z, v.w };
#pragma unroll
            for (int j = 0; j < 4; ++j) { const float f0 = bf2f((u16)(w4[j] & 0xffff)), f1 = bf2f((u16)(w4[j] >> 16)); ss += f0 * f0 + f1 * f1; }
        }
        ss += __shfl_xor(ss, 1);
        if (half == 0) rs_s[row] = rsqrtf(ss / (float)K + EPS);
    }
    __syncthreads();
    GP gp;
    gp.a0 = proj + (size_t)(mt * 256 + r8) * LDP + pc; gp.a1 = gp.a0 + 64 * LDP; gp.a2 = gp.a0 + 128 * LDP; gp.a3 = gp.a0 + 192 * LDP;
    gp.b0 = w + (size_t)(nt * 128 + r8) * K; gp.b1 = gp.b0 + 64 * K;
    f32x16 acc[2][2];
    acc[0][0] = zero16(); acc[0][1] = zero16(); acc[1][0] = zero16(); acc[1][1] = zero16();
    gemm_core<false>(c, K, gp, acc);
    u16* mlaq = (u16*)(ws + WS_MLAQ);
    u16* mlak = (u16*)(ws + WS_MLAK);
    u16* mlavt = (u16*)(ws + WS_MLAVT);
#pragma unroll
    for (int i = 0; i < 2; ++i)
#pragma unroll
        for (int j = 0; j < 2; ++j) {
            const int ml0 = wm * 64 + i * 32, m0 = mt * 256 + ml0, n0 = nt * 128 + wn * 64 + j * 32;
            const int n = n0 + l31;
            if (which == 0) {
                const bool rope = ((n0 >> 5) % 3) == 2;
#pragma unroll
                for (int r = 0; r < 16; ++r) {
                    const int ml = ml0 + crow(r, h), m = mt * 256 + ml;
                    float v = acc[i][j][r] * rs_s[ml];
                    if (rope) {
                        const float pv = __shfl_xor(v, 16);
                        const int ii = l31 & 15;
                        const float cs = trig[(size_t)m * 48 + 16 + ii], sn = trig[(size_t)m * 48 + 32 + ii];
                        v = (l31 < 16) ? (v * cs - pv * sn) : (v * cs + pv * sn);
                    }
                    mlaq[(size_t)m * 384 + n] = f2bf(v);
                }
            } else {
                const int head = n0 >> 7, wi = n0 & 127;
                if (wi < 64) {
#pragma unroll
                    for (int r = 0; r < 16; ++r) {
                        const int ml = ml0 + crow(r, h), m = mt * 256 + ml;
                        mlak[(size_t)m * 384 + head * 96 + wi + l31] = f2bf(acc[i][j][r] * rs_s[ml]);
                    }
                } else {
                    const int b = m0 >> 12, s0 = m0 & 4095, d = wi - 64 + l31;
                    u16* base = mlavt + ((size_t)(b * 4 + head) * 64 + d) * 4096 + s0;
#pragma unroll
                    for (int q = 0; q < 4; ++q) {
                        const int mlq = ml0 + 8 * q + 4 * h;
                        uint2 pk;
                        pk.x = pack2(acc[i][j][4 * q] * rs_s[mlq], acc[i][j][4 * q + 1] * rs_s[mlq + 1]);
                        pk.y = pack2(acc[i][j][4 * q + 2] * rs_s[mlq + 2], acc[i][j][4 * q + 3] * rs_s[mlq + 3]);
                        *(uint2*)(base + 8 * q + 4 * h) = pk;
                    }
                }
            }
        }
    __syncthreads();
}

constexpr int AT_LDV = 68;
template <int DQ, int MODE>
DI void attn_item(const Ctx& c_in, KArgs& a, int item) {
    const Ctx c = fresh_ctx(c_in.lds);
    unsigned char* ws = a.ws;
    constexpr int LDK = DQ + 8;
    constexpr int K_EL = 64 * LDK, V_EL = 64 * AT_LDV, ST_EL = K_EL + V_EL;
    constexpr int NKS = DQ / 16;
    constexpr int KCH = DQ / 8;
    u16* S = (u16*)c.lds;
    float* fc_s = (float*)(c.lds + 2 * ST_EL * 2 + 64);
    const int l31 = c.lane & 31, h = c.lane >> 5;
    int b, hd, wq0, nkt;
    const u16 *Qp, *Kp, *Vp; int ldq, ldk, ocol;
    float scale;
    if (MODE == 0) {
        const int qb = 15 - (item >> 5), rem = item & 31; b = rem >> 2; hd = rem & 3;
        wq0 = qb * 256 + c.wave * 32; nkt = qb * 4 + 4;
        Qp = (const u16*)(ws + WS_MLAQ) + (size_t)b * 4096 * 384 + hd * 96; ldq = 384;
        Kp = (const u16*)(ws + WS_MLAK) + (size_t)b * 4096 * 384 + hd * 96; ldk = 384;
        Vp = (const u16*)(ws + WS_MLAVT) + (size_t)(b * 4 + hd) * 64 * 4096;
        ocol = 512 + hd * 64; scale = 0.10206207261596575f;
    } else if (MODE == 1) {
        const int qb = 15 - (item >> 5), rem = item & 31; b = rem >> 2; hd = rem & 3;
        wq0 = qb * 256 + c.wave * 32; nkt = qb * 4 + 4;
        Qp = (const u16*)(ws + WS_PROJ) + (size_t)b * 4096 * LDP + PC_FOXQ + hd * 64; ldq = LDP;
        Kp = (const u16*)(ws + WS_PROJ) + (size_t)b * 4096 * LDP + PC_FOXK + hd * 64; ldk = LDP;
        Vp = (const u16*)(ws + WS_FOXVT) + (size_t)(b * 4 + hd) * 64 * 4096;
        ocol = 768 + hd * 64; scale = 0.125f;
    } else {
        const int qb = 63 - (item >> 3); b = item & 7; hd = c.wave & 3;
        wq0 = qb * 64 + (c.wave >> 2) * 32; nkt = qb + 1;
        Qp = (const u16*)(ws + WS_PROJ) + (size_t)b * 4096 * LDP + PC_DSAQ + hd * 64; ldq = LDP;
        Kp = (const u16*)(ws + WS_PROJ) + (size_t)b * 4096 * LDP + PC_DSAK; ldk = LDP;
        Vp = (const u16*)(ws + WS_DSAVT) + (size_t)b * 64 * 4096;
        ocol = 256 + hd * 64; scale = 0.125f;
    }
    const float sc2 = scale * LOG2E;
    const int q = wq0 + l31;
    bf16x8 qf[NKS];
#pragma unroll
    for (int ks = 0; ks < NKS; ++ks) qf[ks] = *(const bf16x8*)(Qp + (size_t)q * ldq + ks * 16 + h * 8);
    float fq = 0.f;
    if (MODE == 1) {
        const float* fl = (const float*)(ws + WS_FLOG) + (size_t)(b * 4 + hd) * 4096;
        float* wtot = (float*)(c.lds + 2 * ST_EL * 2);
        const int nk = nkt * 64;
        float v[8]; float s = 0.f;
#pragma unroll
        for (int j = 0; j < 8; ++j) { const int idx = c.tid * 8 + j; v[j] = (idx < nk) ? fl[idx] : 0.f; s += v[j]; v[j] = s; }
        float inc = s;
#pragma unroll
        for (int o = 1; o < 64; o <<= 1) { const float tv = __shfl_up(inc, o); if (c.lane >= o) inc += tv; }
        if (c.lane == 63) wtot[c.wave] = inc;
        __syncthreads();
        float base = inc - s;
        for (int w2 = 0; w2 < c.wave; ++w2) base += wtot[w2];
#pragma unroll
        for (int j = 0; j < 8; ++j) fc_s[c.tid * 8 + j] = base + v[j];
        __syncthreads();
        fq = fc_s[q];
    }
    const int krow0 = c.tid / KCH, kch0 = c.tid % KCH;
    const int c1 = c.tid + NTHR; const int krow1 = c1 / KCH, kch1 = c1 % KCH; const bool has1 = (KCH * 64 > NTHR) && (c1 < KCH * 64);
    const int vrow = c.tid >> 3, vch = c.tid & 7;
    uint4 rk0, rk1, rv; rk1 = make_uint4(0, 0, 0, 0);
    auto gload = [&](int kt) {
        rk0 = *(const uint4*)(Kp + (size_t)(kt * 64 + krow0) * ldk + kch0 * 8);
        if (has1) rk1 = *(const uint4*)(Kp + (size_t)(kt * 64 + krow1) * ldk + kch1 * 8);
        rv = *(const uint4*)(Vp + (size_t)vrow * 4096 + kt * 64 + vch * 8);
    };
    auto sstore = [&](int st) {
        u16* Ks = S + st * ST_EL; u16* Vs = Ks + K_EL;
        *(uint4*)(Ks + krow0 * LDK + kch0 * 8) = rk0;
        if (has1) *(uint4*)(Ks + krow1 * LDK + kch1 * 8) = rk1;
        *(uint2*)(Vs + vrow * AT_LDV + vch * 8) = make_uint2(rv.x, rv.y);
        *(uint2*)(Vs + vrow * AT_LDV + vch * 8 + 4) = make_uint2(rv.z, rv.w);
    };
    f32x16 o0 = zero16(), o1 = zero16();
    float m_run = -1e30f, l_run = 0.f;
    gload(0); sstore(0);
    __syncthreads();
    for (int kt = 0; kt < nkt; ++kt) {
        const bool more = (kt + 1 < nkt);
        if (more) gload(kt + 1);
        if (kt * 64 <= wq0 + 31) {
            const u16* Ks = S + (kt & 1) * ST_EL; const u16* Vs = Ks + K_EL;
            f32x16 s0 = zero16(), s1 = zero16();
#pragma unroll
            for (int ks = 0; ks < NKS; ++ks) {
                const bf16x8 k0 = *(const bf16x8*)(Ks + l31 * LDK + ks * 16 + h * 8);
                const bf16x8 k1 = *(const bf16x8*)(Ks + (32 + l31) * LDK + ks * 16 + h * 8);
                s0 = MFMA32(k0, qf[ks], s0);
                s1 = MFMA32(k1, qf[ks], s1);
            }
            u64 mw = 0;
            if (MODE == 2) mw = ((const u64*)(ws + WS_MASK))[(size_t)(b * 4096 + q) * 64 + kt];
            const bool diag = (kt * 64 + 63 > wq0);
            float mx = -1e30f;
            unsigned vmask0 = 0, vmask1 = 0;
#pragma unroll
            for (int r = 0; r < 16; ++r) {
                const int kr = crow(r, h);
                const int k0i = kt * 64 + kr, k1i = k0i + 32;
                bool v0, v1;
                if (MODE == 2) { v0 = (mw >> kr) & 1ull; v1 = (mw >> (32 + kr)) & 1ull; }
                else { v0 = !diag || (k0i <= q); v1 = !diag || (k1i <= q); }
                float x0 = s0[r] * sc2, x1 = s1[r] * sc2;
                if (MODE == 1) { x0 += (fq - fc_s[k0i]) * LOG2E; x1 += (fq - fc_s[k1i]) * LOG2E; }
                x0 = v0 ? x0 : -1e30f; x1 = v1 ? x1 : -1e30f;
                s0[r] = x0; s1[r] = x1;
                mx = fmaxf(mx, fmaxf(x0, x1));
                vmask0 |= (v0 ? 1u : 0u) << r; vmask1 |= (v1 ? 1u : 0u) << r;
            }
            mx = fmaxf(mx, __shfl_xor(mx, 32));
            const float m_new = fmaxf(m_run, mx);
            const float alpha = exp2f(m_run - m_new);
            float rsum = 0.f;
#pragma unroll
            for (int r = 0; r < 16; ++r) {
                const float p0 = ((vmask0 >> r) & 1u) ? exp2f(s0[r] - m_new) : 0.f;
                const float p1 = ((vmask1 >> r) & 1u) ? exp2f(s1[r] - m_new) : 0.f;
                s0[r] = p0; s1[r] = p1; rsum += p0 + p1;
            }
            rsum += __shfl_xor(rsum, 32);
            l_run = l_run * alpha + rsum; m_run = m_new;
#pragma unroll
            for (int r = 0; r < 16; ++r) { o0[r] *= alpha; o1[r] *= alpha; }
#pragma unroll
            for (int sub = 0; sub < 2; ++sub)
#pragma unroll
                for (int s2 = 0; s2 < 2; ++s2) {
                    const bf16x8 pb = pack8(sub ? s1 : s0, s2);
                    const int koff = sub * 32 + 16 * s2 + 4 * h;
                    {
                        const u16* vr = Vs + l31 * AT_LDV + koff;
                        const uint2 lo = *(const uint2*)vr, hi = *(const uint2*)(vr + 8);
                        o0 = MFMA32(__builtin_bit_cast(bf16x8, make_uint4(lo.x, lo.y, hi.x, hi.y)), pb, o0);
                    }
                    {
                        const u16* vr = Vs + (32 + l31) * AT_LDV + koff;
                        const uint2 lo = *(const uint2*)vr, hi = *(const uint2*)(vr + 8);
                        o1 = MFMA32(__builtin_bit_cast(bf16x8, make_uint4(lo.x, lo.y, hi.x, hi.y)), pb, o1);
                    }
                }
        }
        if (more) sstore((kt + 1) & 1);
        __syncthreads();
    }
    {
        const float inv = 1.f / l_run;
        u16* act = (u16*)(ws + WS_ACT) + (size_t)(b * 4096 + q) * 1024 + ocol;
#pragma unroll
        for (int qd = 0; qd < 4; ++qd) {
            uint2 pk;
            pk.x = pack2(o0[4 * qd] * inv, o0[4 * qd + 1] * inv); pk.y = pack2(o0[4 * qd + 2] * inv, o0[4 * qd + 3] * inv);
            *(uint2*)(act + 8 * qd + 4 * h) = pk;
            pk.x = pack2(o1[4 * qd] * inv, o1[4 * qd + 1] * inv); pk.y = pack2(o1[4 * qd + 2] * inv, o1[4 * qd + 3] * inv);
            *(uint2*)(act + 32 + 8 * qd + 4 * h) = pk;
        }
    }
}

constexpr int SC_LD = 4100;
DI void dsa_index_item(const Ctx& c_in, KArgs& a, int item) {
    const Ctx c = fresh_ctx(c_in.lds);
    unsigned char* ws = a.ws;
    const u16* proj = (const u16*)(ws + WS_PROJ);
    const float* small = (const float*)(ws + WS_SMALL);
    u64* mask = (u64*)(ws + WS_MASK);
    float* SC = (float*)c.lds;
    unsigned* HIST = (unsigned*)(c.lds + 8 * SC_LD * 4);
    const int l31 = c.lane & 31, h = c.lane >> 5;
    const int sg = 511 - (item >> 3), b = item & 7, s0 = sg * 8;
    const int tok0 = b * 4096 + s0;
    const int ntile = ((s0 + 7) >> 5) + 1;
    bf16x8 qa[2][4];
    float wv[2][16];
#pragma unroll
    for (int rt = 0; rt < 2; ++rt) {
        const int r = rt * 32 + l31, ql = r >> 3, j = r & 7;
        const u16* p = proj + (size_t)(tok0 + ql) * LDP + PC_IDXQ + j * 64 + h * 8;
#pragma unroll
        for (int ks = 0; ks < 4; ++ks) qa[rt][ks] = *(const bf16x8*)(p + ks * 16);
#pragma unroll
        for (int r2 = 0; r2 < 16; ++r2) {
            const int qq = (r2 >> 2) + 4 * rt, jj = (r2 & 3) + 4 * h;
            wv[rt][r2] = small[(size_t)(tok0 + qq) * 16 + 4 + jj] * 0.044194173824159216f;
        }
    }
    for (int kt = c.wave; kt < ntile; kt += 8) {
        const int key = kt * 32 + l31;
        const u16* kp = proj + (size_t)(b * 4096 + key) * LDP + PC_IDXK + h * 8;
        bf16x8 kb[4];
#pragma unroll
        for (int ks = 0; ks < 4; ++ks) kb[ks] = *(const bf16x8*)(kp + ks * 16);
        f32x16 a0 = zero16(), a1 = zero16();
#pragma unroll
        for (int ks = 0; ks < 4; ++ks) { a0 = MFMA32(qa[0][ks], kb[ks], a0); a1 = MFMA32(qa[1][ks], kb[ks], a1); }
#pragma unroll
        for (int g = 0; g < 4; ++g) {
            float p0 = 0.f, p1 = 0.f;
#pragma unroll
            for (int r3 = 0; r3 < 4; ++r3) {
                p0 += wv[0][4 * g + r3] * fmaxf(a0[4 * g + r3], 0.f);
                p1 += wv[1][4 * g + r3] * fmaxf(a1[4 * g + r3], 0.f);
            }
            const float t0 = p0 + __shfl_xor(p0, 32);
            const float t1 = p1 + __shfl_xor(p1, 32);
            SC[(4 * h + g) * SC_LD + key] = h ? t1 : t0;
        }
    }
    __syncthreads();
    {
        const int qi = s0 + c.wave, n = qi + 1;
        const float* sc = SC + c.wave * SC_LD;
        unsigned* hist = HIST + c.wave * 256;
        const int nit = (n + 63) >> 6;
        float thr = -INFINITY; int cut = 0x7fffffff;
        if (n > 256) {
            float lo = INFINITY, hi = -INFINITY;
            for (int it = 0; it < nit; ++it) { const int i = it * 64 + c.lane; if (i < n) { const float x = sc[i]; lo = fminf(lo, x); hi = fmaxf(hi, x); } }
            lo = wminf(lo); hi = wmaxf(hi);
            int kk = 256;
            for (int iter = 0; iter < 48; ++iter) {
                if (lo == hi) {
                    thr = lo;
                    int cnt = 0;
                    for (int it = 0; it < nit; ++it) { const int i = it * 64 + c.lane; const bool e = (i < n) && (sc[i] == thr); cnt += __popcll(__ballot(e)); }
                    if (kk < cnt) {
                        int need = kk;
                        for (int it = 0; it < nit; ++it) {
                            const int i = it * 64 + c.lane; const bool e = (i < n) && (sc[i] == thr);
                            const u64 mk = __ballot(e); const int cn = __popcll(mk);
                            if (need <= cn) {
                                const u64 sel = __ballot(e && (__popcll(mk & ((1ull << c.lane) - 1ull)) == need - 1));
                                cut = it * 64 + (__ffsll((long long)sel) - 1);
                                break;
                            }
                            need -= cn;
                        }
                    }
                    break;
                }
                float scl = 256.0f / (hi - lo);
                if (!(scl < 1e30f)) scl = 1e30f;
#pragma unroll
                for (int j = 0; j < 4; ++j) hist[c.lane + 64 * j] = 0u;
                for (int it = 0; it < nit; ++it) {
                    const int i = it * 64 + c.lane;
                    if (i < n) { const float x = sc[i]; if (x >= lo && x <= hi) { int bn = (int)((x - lo) * scl); bn = bn > 255 ? 255 : bn; atomicAdd(&hist[bn], 1u); } }
                }
                const unsigned c0 = hist[4 * c.lane], c1 = hist[4 * c.lane + 1], c2 = hist[4 * c.lane + 2], c3 = hist[4 * c.lane + 3];
                const unsigned ls = c0 + c1 + c2 + c3;
                unsigned suf = ls;
#pragma unroll
                for (int o = 1; o < 64; o <<= 1) { const unsigned tv = __shfl_down(suf, o); if (c.lane + o < 64) suf += tv; }
                const unsigned above_lane = suf - ls;
                const bool mine = (suf >= (unsigned)kk) && (above_lane < (unsigned)kk);
                int bstar = 0; unsigned above = 0, cntb = 0;
                if (mine) {
                    unsigned run = above_lane;
                    if (run + c3 >= (unsigned)kk) { bstar = 4 * c.lane + 3; above = run; cntb = c3; }
                    else { run += c3;
                        if (run + c2 >= (unsigned)kk) { bstar = 4 * c.lane + 2; above = run; cntb = c2; }
                        else { run += c2;
                            if (run + c1 >= (unsigned)kk) { bstar = 4 * c.lane + 1; above = run; cntb = c1; }
                            else { run += c1; bstar = 4 * c.lane; above = run; cntb = c0; } } }
                }
                const u64 mm = __ballot(mine);
                const int src = __ffsll((long long)mm) - 1;
                bstar = __shfl(bstar, src); above = __shfl(above, src); cntb = __shfl(cntb, src);
                kk -= (int)above;
                float nlo = INFINITY, nhi = -INFINITY;
                for (int it = 0; it < nit; ++it) {
                    const int i = it * 64 + c.lane;
                    if (i < n) { const float x = sc[i]; if (x >= lo && x <= hi) { int bn = (int)((x - lo) * scl); bn = bn > 255 ? 255 : bn; if (bn == bstar) { nlo = fminf(nlo, x); nhi = fmaxf(nhi, x); } } }
                }
                lo = wminf(nlo); hi = wmaxf(nhi);
                thr = lo;
                if ((int)cntb == kk) break;
            }
        }
        u64* mrow = mask + (size_t)(b * 4096 + qi) * 64;
        for (int it = 0; it < 64; ++it) {
            const int i = it * 64 + c.lane;
            bool sel = false;
            if (i < n) { const float x = sc[i]; sel = (x > thr) || (x == thr && i <= cut); }
            const u64 wd = __ballot(sel);
            if (c.lane == 0) mrow[it] = wd;
        }
    }
    __syncthreads();
}

DI void phase_outproj(const Ctx& c_in, KArgs& a, int l) {
    const Ctx c = fresh_ctx(c_in.lds);
    unsigned char* ws = a.ws;
    const u16* act = (const u16*)(ws + WS_ACT);
    const u16* w = (const u16*)(ws + WS_WOUT) + (size_t)l * 1024 * 1024;
    const float* xin = (l == 0) ? a.in[0] : a.out;
    float* out = a.out;
    const int r8 = c.tid >> 3;
    const int wm = c.wave & 3, wn = c.wave >> 2, l31 = c.lane & 31, h = c.lane >> 5;
    const int ntiles = (T_TOK / 256) * 8;
    for (int tile = blockIdx.x; tile < ntiles; tile += gridDim.x) {
        const int mt = tile >> 3, nt = tile & 7;
        GP gp;
        gp.a0 = act + (size_t)(mt * 256 + r8) * 1024; gp.a1 = gp.a0 + 64 * 1024; gp.a2 = gp.a0 + 128 * 1024; gp.a3 = gp.a0 + 192 * 1024;
        gp.b0 = w + (size_t)(nt * 128 + r8) * 1024; gp.b1 = gp.b0 + 64 * 1024;
        f32x16 acc[2][2];
        acc[0][0] = zero16(); acc[0][1] = zero16(); acc[1][0] = zero16(); acc[1][1] = zero16();
        gemm_core<false>(c, 1024, gp, acc);
#pragma unroll
        for (int i = 0; i < 2; ++i)
#pragma unroll
            for (int j = 0; j < 2; ++j) {
                const int m0 = mt * 256 + wm * 64 + i * 32, n = nt * 128 + wn * 64 + j * 32 + l31;
#pragma unroll
                for (int r = 0; r < 16; ++r) {
                    const size_t off = (size_t)(m0 + crow(r, h)) * 1024 + n;
                    out[off] = xin[off] + acc[i][j][r];
                }
            }
    }
}

constexpr int RT_LD = 1032;
DI void phase_router(const Ctx& c_in, KArgs& a, int l) {
    const Ctx c = fresh_ctx(c_in.lds);
    unsigned char* ws = a.ws;
    const float* x = a.out;
    const float* g = a.in[16] + l * 1024;
    const float* brg = a.in[18] + l * 4;
    const float* bre = a.in[20] + l * 32;
    const u16* wrh = (const u16*)(ws + WS_WRH) + (size_t)l * 64 * 1024;
    const u16* wrl = (const u16*)(ws + WS_WRL) + (size_t)l * 64 * 1024;
    u16* act = (u16*)(ws + WS_ACT);
    int* cnt = (int*)(ws + WS_CTL);
    int* list = (int*)(ws + WS_LIST);
    float* tokw = (float*)(ws + WS_TOKW);
    u16* HI = (u16*)c.lds;
    u16* LO = HI + 32 * RT_LD;
    float* LG = (float*)(c.lds + 2 * 32 * RT_LD * 2);
    const int l31 = c.lane & 31, h = c.lane >> 5;
    for (int it = blockIdx.x; it < T_TOK / 32; it += gridDim.x) {
        const int t0 = it * 32;
#pragma unroll
        for (int tt = 0; tt < 4; ++tt) {
            const int tl = c.wave * 4 + tt, t = t0 + tl;
            const float* xr = x + (size_t)t * 1024 + c.lane * 4;
            float4 v[4]; float ss = 0.f;
#pragma unroll
            for (int j = 0; j < 4; ++j) { v[j] = *(const float4*)(xr + 256 * j); ss += v[j].x * v[j].x + v[j].y * v[j].y + v[j].z * v[j].z + v[j].w * v[j].w; }
            ss = wsum(ss);
            const float rs = rsqrtf(ss * (1.f / 1024.f) + EPS);
#pragma unroll
            for (int j = 0; j < 4; ++j) {
                const float4 gg = *(const float4*)(g + c.lane * 4 + 256 * j);
                const float h0 = v[j].x * rs * gg.x, h1 = v[j].y * rs * gg.y, h2 = v[j].z * rs * gg.z, h3 = v[j].w * rs * gg.w;
                const u16 b0 = f2bf(h0), b1 = f2bf(h1), b2 = f2bf(h2), b3 = f2bf(h3);
                const uint2 hp = make_uint2((unsigned)b0 | ((unsigned)b1 << 16), (unsigned)b2 | ((unsigned)b3 << 16));
                const uint2 lp = make_uint2(pack2(h0 - bf2f(b0), h1 - bf2f(b1)), pack2(h2 - bf2f(b2), h3 - bf2f(b3)));
                *(uint2*)(act + (size_t)t * 1024 + c.lane * 4 + 256 * j) = hp;
                *(uint2*)(HI + tl * RT_LD + c.lane * 4 + 256 * j) = hp;
                *(uint2*)(LO + tl * RT_LD + c.lane * 4 + 256 * j) = lp;
            }
        }
        __syncthreads();
        {
            const int k0 = c.wave * 128 + h * 8;
            f32x16 acc0 = zero16(), acc1 = zero16();
#pragma unroll
            for (int ks = 0; ks < 8; ++ks) {
                const int k = k0 + ks * 16;
                const bf16x8 ah = *(const bf16x8*)(HI + l31 * RT_LD + k);
                const bf16x8 al = *(const bf16x8*)(LO + l31 * RT_LD + k);
                const bf16x8 bh0 = *(const bf16x8*)(wrh + (size_t)l31 * 1024 + k);
                const bf16x8 bh1 = *(const bf16x8*)(wrh + (size_t)(32 + l31) * 1024 + k);
                const bf16x8 bl0 = *(const bf16x8*)(wrl + (size_t)l31 * 1024 + k);
                const bf16x8 bl1 = *(const bf16x8*)(wrl + (size_t)(32 + l31) * 1024 + k);
                acc0 = MFMA32(ah, bh0, acc0); acc0 = MFMA32(ah, bl0, acc0); acc0 = MFMA32(al, bh0, acc0);
                acc1 = MFMA32(ah, bh1, acc1); acc1 = MFMA32(ah, bl1, acc1); acc1 = MFMA32(al, bh1, acc1);
            }
            __syncthreads();
            float* PART = (float*)c.lds + c.wave * (32 * 37);
#pragma unroll
            for (int r = 0; r < 16; ++r) {
                PART[crow(r, h) * 37 + l31] = acc0[r];
                if (l31 < 4) PART[crow(r, h) * 37 + 32 + l31] = acc1[r];
            }
        }
        __syncthreads();
        for (int i = c.tid; i < 32 * 36; i += NTHR) {
            const int tk = i / 36, e = i % 36;
            float s = 0.f;
#pragma unroll
            for (int w2 = 0; w2 < 8; ++w2) s += ((const float*)c.lds)[w2 * (32 * 37) + tk * 37 + e];
            LG[tk * 65 + e] = s;
        }
        __syncthreads();
        if (c.tid < 32) {
            const int t = t0 + c.tid;
            const float* lg = LG + c.tid * 65;
            float gl[4];
#pragma unroll
            for (int e = 0; e < 4; ++e) gl[e] = lg[e] + brg[e];
            int gi = 0; float gm = gl[0];
#pragma unroll
            for (int e = 1; e < 4; ++e) if (gl[e] > gm) { gm = gl[e]; gi = e; }
            float den = 0.f;
#pragma unroll
            for (int e = 0; e < 4; ++e) den += __expf(gl[e] - gm);
            const float gp = 1.f / den;
            float el[8];
#pragma unroll
            for (int e = 0; e < 8; ++e) el[e] = lg[4 + gi * 8 + e] + bre[gi * 8 + e];
            int i1 = 0; float v1 = el[0];
#pragma unroll
            for (int e = 1; e < 8; ++e) if (el[e] > v1) { v1 = el[e]; i1 = e; }
            int i2 = 0; float v2 = -INFINITY;
#pragma unroll
            for (int e = 0; e < 8; ++e) if (e != i1 && el[e] > v2) { v2 = el[e]; i2 = e; }
            const float ex = __expf(v2 - v1);
            const float w1 = gp / (1.f + ex), w2 = gp * ex / (1.f + ex);
            const int e1 = gi * 8 + i1, e2 = gi * 8 + i2;
            const int s1 = atomicAdd(&cnt[e1 * 2 + 0], 1);
            list[(size_t)(e1 * 2 + 0) * 32768 + s1] = t;
            const int s2 = atomicAdd(&cnt[e2 * 2 + 1], 1);
            list[(size_t)(e2 * 2 + 1) * 32768 + s2] = t;
            tokw[t * 2] = w1; tokw[t * 2 + 1] = w2;
        }
        __syncthreads();
    }
}

DI int moe_setup(const Ctx& c, KArgs& a, int ntn, int kfilter, int* tstart  ) {
    const int* cnt = (const int*)(a.ws + WS_CTL);
    if (c.tid == 0) {
        int run = 0;
        for (int L = 0; L < 64; ++L) {
            tstart[L] = run;
            const int n = __hip_atomic_load(&cnt[L], __ATOMIC_RELAXED, __HIP_MEMORY_SCOPE_AGENT);
            if (kfilter < 0 || (L & 1) == kfilter) run += ((n + 255) >> 8) * ntn;
        }
        tstart[64] = run;
    }
    __syncthreads();
    return tstart[64];
}

DI void phase_moe_up(const Ctx& c_in, KArgs& a) {
    const Ctx c = fresh_ctx(c_in.lds);
    unsigned char* ws = a.ws;
    const u16* act = (const u16*)(ws + WS_ACT);
    const int* cnt = (const int*)(ws + WS_CTL);
    const int* list = (const int*)(ws + WS_LIST);
    const float* tokw = (const float*)(ws + WS_TOKW);
    u16* hmid = (u16*)(ws + WS_HMID);
    int* tstart = (int*)(c.lds + G_LDS_BYTES);
    int* tok_s = (int*)(c.lds + G_LDS_BYTES + 512);
    const int r8 = c.tid >> 3;
    const int wm = c.wave & 3, wn = c.wave >> 2, l31 = c.lane & 31, h = c.lane >> 5;
    const int total = moe_setup(c, a, 4, -1, tstart);
    for (int tile = blockIdx.x; tile < total; tile += gridDim.x) {
        int L = 0;
        for (int j = 0; j < 64; ++j) if (tstart[j + 1] <= tile) L = j + 1;
        const int rel = tile - tstart[L], mi = rel >> 2, nt = rel & 3;
        const int e = L >> 1, kr = L & 1;
        const int n = __hip_atomic_load(&cnt[L], __ATOMIC_RELAXED, __HIP_MEMORY_SCOPE_AGENT);
        __syncthreads();
        if (c.tid < 256) { const int r = mi * 256 + c.tid; tok_s[c.tid] = (r < n) ? list[(size_t)L * 32768 + r] : -1; }
        __syncthreads();
        GP gp;
        { const int t0 = tok_s[r8], t1 = tok_s[r8 + 64], t2 = tok_s[r8 + 128], t3 = tok_s[r8 + 192];
          gp.a0 = act + (size_t)(t0 < 0 ? 0 : t0) * 1024; gp.a1 = act + (size_t)(t1 < 0 ? 0 : t1) * 1024;
          gp.a2 = act + (size_t)(t2 < 0 ? 0 : t2) * 1024; gp.a3 = act + (size_t)(t3 < 0 ? 0 : t3) * 1024; }
        gp.b0 = (const u16*)(ws + WS_WG) + ((size_t)e * 256 + nt * 64 + r8) * 1024;
        gp.b1 = (const u16*)(ws + WS_WU) + ((size_t)e * 256 + nt * 64 + r8) * 1024;
        f32x16 acc[2][2];
        acc[0][0] = zero16(); acc[0][1] = zero16(); acc[1][0] = zero16(); acc[1][1] = zero16();
        gemm_core<true>(c, 1024, gp, acc);
#pragma unroll
        for (int i = 0; i < 2; ++i) {
            const int nn = nt * 64 + wn * 32 + l31;
#pragma unroll
            for (int r = 0; r < 16; ++r) {
                const int ml = wm * 64 + i * 32 + crow(r, h);
                const int tk = tok_s[ml];
                if (tk >= 0) {
                    const float gv = acc[i][0][r], uv = acc[i][1][r];
                    hmid[((size_t)tk * 2 + kr) * 256 + nn] = f2bf(siluf(gv) * uv * tokw[tk * 2 + kr]);
                }
            }
        }
    }
}

DI void phase_moe_down(const Ctx& c_in, KArgs& a, int kpass) {
    const Ctx c = fresh_ctx(c_in.lds);
    unsigned char* ws = a.ws;
    const int* cnt = (const int*)(ws + WS_CTL);
    const int* list = (const int*)(ws + WS_LIST);
    const u16* hmid = (const u16*)(ws + WS_HMID);
    float* out = a.out;
    int* tstart = (int*)(c.lds + G_LDS_BYTES);
    int* tok_s = (int*)(c.lds + G_LDS_BYTES + 512);
    const int r8 = c.tid >> 3;
    const int wm = c.wave & 3, wn = c.wave >> 2, l31 = c.lane & 31, h = c.lane >> 5;
    const int total = moe_setup(c, a, 8, kpass, tstart);
    for (int tile = blockIdx.x; tile < total; tile += gridDim.x) {
        int L = 0;
        for (int j = 0; j < 64; ++j) if (tstart[j + 1] <= tile) L = j + 1;
        const int rel = tile - tstart[L], mi = rel >> 3, nt = rel & 7;
        const int e = L >> 1;
        const int n = __hip_atomic_load(&cnt[L], __ATOMIC_RELAXED, __HIP_MEMORY_SCOPE_AGENT);
        __syncthreads();
        if (c.tid < 256) { const int r = mi * 256 + c.tid; tok_s[c.tid] = (r < n) ? list[(size_t)L * 32768 + r] : -1; }
        __syncthreads();
        GP gp;
        { const int t0 = tok_s[r8], t1 = tok_s[r8 + 64], t2 = tok_s[r8 + 128], t3 = tok_s[r8 + 192];
          gp.a0 = hmid + ((size_t)(t0 < 0 ? 0 : t0) * 2 + kpass) * 256; gp.a1 = hmid + ((size_t)(t1 < 0 ? 0 : t1) * 2 + kpass) * 256;
          gp.a2 = hmid + ((size_t)(t2 < 0 ? 0 : t2) * 2 + kpass) * 256; gp.a3 = hmid + ((size_t)(t3 < 0 ? 0 : t3) * 2 + kpass) * 256; }
        gp.b0 = (const u16*)(ws + WS_WD) + ((size_t)e * 1024 + nt * 128 + r8) * 256; gp.b1 = gp.b0 + 64 * 256;
        f32x16 acc[2][2];
        acc[0][0] = zero16(); acc[0][1] = zero16(); acc[1][0] = zero16(); acc[1][1] = zero16();
        gemm_core<false>(c, 256, gp, acc);
#pragma unroll
        for (int i = 0; i < 2; ++i)
#pragma unroll
            for (int j = 0; j < 2; ++j) {
                const int nn = nt * 128 + wn * 64 + j * 32 + l31;
#pragma unroll
                for (int r = 0; r < 16; ++r) {
                    const int tk = tok_s[wm * 64 + i * 32 + crow(r, h)];
                    if (tk >= 0) { const size_t off = (size_t)tk * 1024 + nn; out[off] = out[off] + acc[i][j][r]; }
                }
            }
    }
}

DI void phase_final(const Ctx& c_in, KArgs& a) {
    const Ctx c = fresh_ctx(c_in.lds);
    float* x = a.out;
    const float* g = a.in[24];
    for (int it = blockIdx.x; it < T_TOK / 8; it += gridDim.x) {
        const int t = it * 8 + c.wave;
        float* xr = x + (size_t)t * 1024;
        float v[16]; float ss = 0.f;
#pragma unroll
        for (int j = 0; j < 16; ++j) { v[j] = xr[c.lane + 64 * j]; ss += v[j] * v[j]; }
        ss = wsum(ss);
        const float rs = rsqrtf(ss * (1.f / 1024.f) + EPS);
#pragma unroll
        for (int j = 0; j < 16; ++j) xr[c.lane + 64 * j] = v[j] * rs * g[c.lane + 64 * j];
    }
}

#define XB_TMO      128
#define XB_XCNT(j)  (256  + 64 * (j))
#define XB_XSUB(j)  (1280 + 64 * (j))
#define XB_XGEN(j)  (2304 + 64 * (j))
#define XB_TOP      3328
#define XB_TOPGEN   3392
#define XCD_BAR_WORDS 3456
#define XB_SPIN_CAP (1u << 22)
#define LAS __attribute__((address_space(3)))
DI unsigned xb_ld(unsigned* p)              { return __hip_atomic_load(p, __ATOMIC_RELAXED, __HIP_MEMORY_SCOPE_AGENT); }
DI unsigned xb_add(unsigned* p, unsigned v) { return __hip_atomic_fetch_add(p, v, __ATOMIC_RELAXED, __HIP_MEMORY_SCOPE_AGENT); }
DI unsigned xb_xcc_id() { return (unsigned)__builtin_amdgcn_s_getreg((3 << 11) | 20) & 0xFu; }
#define XB_SPIN(cond, bar) do { unsigned _sp = 0; while (cond) { __builtin_amdgcn_s_sleep(1); \
    if ((++_sp & 255u) == 0u) { if (xb_ld(&(bar)[XB_TMO])) break; if (_sp > XB_SPIN_CAP) { atomicAdd(&(bar)[XB_TMO], 1u); break; } } } } while (0)
struct XcdBarrier { unsigned* bar; unsigned x; volatile LAS unsigned* st; };
DI XcdBarrier xcd_barrier_post(unsigned* bar, volatile LAS unsigned* st) {
    XcdBarrier b; b.bar = bar; b.x = xb_xcc_id(); b.st = st;
    if (threadIdx.x == 0) (void)xb_add(&bar[XB_XCNT(b.x)], 1u);
    return b;
}
DI void xcd_barrier_complete(unsigned* bar, unsigned x, unsigned& nloc, unsigned& nx) {
    const unsigned G = gridDim.x * gridDim.y * gridDim.z;
    unsigned sum, cnt, mine, sp = 0u;
    for (;;) {
        sum = 0u; cnt = 0u; mine = 0u;
#pragma unroll
        for (unsigned j = 0; j < 16; ++j) { const unsigned cc = xb_ld(&bar[XB_XCNT(j)]); sum += cc; cnt += (cc > 0u) ? 1u : 0u; mine = (j == x) ? cc : mine; }
        if (sum == G) break;
        __builtin_amdgcn_s_sleep(1);
        if ((++sp & 255u) == 0u) { if (xb_ld(&bar[XB_TMO])) break; if (sp > XB_SPIN_CAP) { atomicAdd(&bar[XB_TMO], 1u); break; } }
    }
    nloc = mine > 0u ? mine : 1u; nx = cnt > 0u ? cnt : 1u;
}
DI void xcd_barrier(const XcdBarrier& b) {
    asm volatile("s_waitcnt vmcnt(0)" ::: "memory");
    __syncthreads();
    if (threadIdx.x == 0) {
        unsigned* bar = b.bar;
        __builtin_amdgcn_s_waitcnt(0);
        unsigned nloc = b.st[0], nx = b.st[1];
        if (nloc == 0u) { xcd_barrier_complete(bar, b.x, nloc, nx); b.st[0] = nloc; b.st[1] = nx; }
        const unsigned old = xb_add(&bar[XB_XSUB(b.x)], 1u);
        const unsigned gen = old / nloc;
        if (old + 1u == (gen + 1u) * nloc) {
            __builtin_amdgcn_fence(__ATOMIC_RELEASE, "agent");
            asm volatile("s_waitcnt vmcnt(0)" ::: "memory");
            const unsigned og = xb_add(&bar[XB_TOP], 1u);
            const unsigned tg = og / nx;
            if (og + 1u == (tg + 1u) * nx) xb_add(&bar[XB_TOPGEN], 1u);
            else XB_SPIN(xb_ld(&bar[XB_TOPGEN]) == tg, bar);
            __builtin_amdgcn_fence(__ATOMIC_ACQUIRE, "agent");
            xb_add(&bar[XB_XGEN(b.x)], 1u);
            asm volatile("s_waitcnt vmcnt(0)" ::: "memory");
        } else {
            XB_SPIN(xb_ld(&bar[XB_XGEN(b.x)]) == gen, bar);
            __builtin_amdgcn_fence(__ATOMIC_ACQUIRE, "agent");
            asm volatile("s_waitcnt vmcnt(0)" ::: "memory");
        }
    }
    __syncthreads();
}

template <int SP>
DI void run_phase(const Ctx& c, KArgs& a, int l) {
    if constexpr (SP == 11) phase_prep(c, a);
    else if constexpr (SP == 12) phase_final(c, a);
    else if constexpr (SP == 0) phase_norm_in(c, a, l);
    else if constexpr (SP == 1) phase_inproj(c, a, l);
    else if constexpr (SP == 2) {
        const int n_ssd = 256, n_q = 128 * 3, n_kv = 128 * 4, n_tok = T_TOK / 8;
        for (int it = blockIdx.x; it < n_ssd + n_q + n_kv + n_tok; it += gridDim.x) {
            if (it < n_ssd) ssd_state_item(c, a, l, it);
            else if (it < n_ssd + n_q) mla_up_item(c, a, l, 0, it - n_ssd);
            else if (it < n_ssd + n_q + n_kv) mla_up_item(c, a, l, 1, it - n_ssd - n_q);
            else token_post_item(c, a, l, it - n_ssd - n_q - n_kv);
        }
    }
    else if constexpr (SP == 3) { for (int it = blockIdx.x; it < 512; it += gridDim.x) ssd_scan_item(c, a, it); }
    else if constexpr (SP == 4) {
        const int n_at = 512, n_ssd = 256, n_idx = 4096;
        for (int it = blockIdx.x; it < 2 * n_at + n_ssd + n_idx; it += gridDim.x) {
            if (it < 2 * n_at) { if (it & 1) attn_item<64, 1>(c, a, it >> 1); else attn_item<96, 0>(c, a, it >> 1); }
            else if (it < 2 * n_at + n_ssd) ssd_out_item(c, a, l, it - 2 * n_at);
            else dsa_index_item(c, a, it - 2 * n_at - n_ssd);
            __syncthreads();
        }
    }
    else if constexpr (SP == 5) { for (int it = blockIdx.x; it < 512; it += gridDim.x) { attn_item<64, 2>(c, a, it); __syncthreads(); } }
    else if constexpr (SP == 6) phase_outproj(c, a, l);
    else if constexpr (SP == 7) phase_router(c, a, l);
    else if constexpr (SP == 8) phase_moe_up(c, a);
    else if constexpr (SP == 9) phase_moe_down(c, a, 0);
    else if constexpr (SP == 10) phase_moe_down(c, a, 1);
}

#ifndef ONE_LAUNCH
#define ONE_LAUNCH 1
#endif

#if ONE_LAUNCH
__global__ void __launch_bounds__(NTHR) mega(Args a_unused) {
    extern __shared__ __attribute__((aligned(16))) unsigned char lds[];
    cg::grid_group grid = cg::this_grid();
    Ctx c; c.tid = threadIdx.x; c.lane = c.tid & 63; c.wave = 0; c.lds = lds;
    volatile LAS unsigned* st = (volatile LAS unsigned*)(lds + LDS_BYTES - 16);
    if (threadIdx.x == 0) { st[0] = 0u; st[1] = 0u; }
    __syncthreads();
    XcdBarrier bar = xcd_barrier_post((unsigned*)(a_unused.ws + WS_BAR), st);
    for (int ph = 0; ph < 24; ++ph) {
        if (ph == 1) grid.sync();
        else if (ph > 1) xcd_barrier(bar);
        KArgs* kp = (KArgs*)__builtin_amdgcn_kernarg_segment_ptr();
        asm volatile("" : "+s"(kp));
        KArgs& a = *kp;
        const int l = (ph - 1) / 11;
        const int sp = (ph == 0) ? 11 : (ph == 23) ? 12 : (ph - 1) % 11;
#ifdef PROBE_SP
        unsigned long long pt0 = 0; if (sp == PROBE_SP) pt0 = __builtin_amdgcn_s_memrealtime();
#endif
        switch (sp) {
        case 0: run_phase<0>(c, a, l); break;
        case 1: run_phase<1>(c, a, l); break;
        case 2: run_phase<2>(c, a, l); break;
        case 3: run_phase<3>(c, a, l); break;
        case 4: run_phase<4>(c, a, l); break;
        case 5: run_phase<5>(c, a, l); break;
        case 6: run_phase<6>(c, a, l); break;
        case 7: run_phase<7>(c, a, l); break;
        case 8: run_phase<8>(c, a, l); break;
        case 9: run_phase<9>(c, a, l); break;
        case 10: run_phase<10>(c, a, l); break;
        case 11: run_phase<11>(c, a, l); break;
        default: run_phase<12>(c, a, l); break;
        }
#ifdef PROBE_SP
        if (sp == PROBE_SP) {
            xcd_barrier(bar);
            const unsigned long long pt1 = __builtin_amdgcn_s_memrealtime();
            while (__builtin_amdgcn_s_memrealtime() - pt1 < (pt1 - pt0)) __builtin_amdgcn_s_sleep(8);
        }
#endif
    }
}
#else
template <int SP>
__global__ void __launch_bounds__(NTHR) kphase(Args a, int l) {
    extern __shared__ __attribute__((aligned(16))) unsigned char lds[];
    Ctx c; c.tid = threadIdx.x; c.lane = c.tid & 63; c.wave = __builtin_amdgcn_readfirstlane(c.tid >> 6); c.lds = lds;
    KArgs* kp = (KArgs*)__builtin_amdgcn_kernarg_segment_ptr();
    run_phase<SP>(c, *kp, l);
}
template <int SP>
static void launch_phase(const Args& a, int l, int grid, hipStream_t stream) {
    static bool attr_set = false;
    if (!attr_set) { (void)hipFuncSetAttribute((const void*)kphase<SP>, hipFuncAttributeMaxDynamicSharedMemorySize, LDS_BYTES); attr_set = true; }
    hipLaunchKernelGGL(kphase<SP>, dim3(grid), dim3(NTHR), LDS_BYTES, stream, a, l);
}
#endif

extern "C" void kernel_launch(void* const* d_in, const int* in_sizes, int n_in, void* d_out, int out_size, void* d_ws, size_t ws_size, hipStream_t stream) {
    static int grid = 0;
    if (grid == 0) {
        if (n_in != 25 || ws_size < WS_END) { fprintf(stderr, "kernel_launch: unexpected inputs (n_in %d, ws %zu, need %zu)\n", n_in, ws_size, (size_t)WS_END); grid = -1; return; }
        int dev = 0, cus = 0;
        (void)hipGetDevice(&dev);
        (void)hipDeviceGetAttribute(&cus, hipDeviceAttributeMultiprocessorCount, dev);
        if (cus <= 0) cus = 256;
#if ONE_LAUNCH
        int per_cu = 0;
        if (hipFuncSetAttribute((const void*)mega, hipFuncAttributeMaxDynamicSharedMemorySize, LDS_BYTES) != hipSuccess) { fprintf(stderr, "kernel_launch: hipFuncSetAttribute failed\n"); grid = -1; return; }
        if (hipOccupancyMaxActiveBlocksPerMultiprocessor(&per_cu, (const void*)mega, NTHR, LDS_BYTES) != hipSuccess || per_cu < 1) { fprintf(stderr, "kernel_launch: occupancy query says %d blocks per CU\n", per_cu); (void)hipGetLastError(); grid = -1; return; }
        grid = cus;
#else
        grid = cus;
#endif
    }
    if (grid < 0) return;
    Args a{};
    for (int i = 0; i < 25; ++i) a.in[i] = (const float*)d_in[i];
    a.out = (float*)d_out; a.ws = (unsigned char*)d_ws;
    for (int i = 0; i < 8; ++i) a.inv16[i] = (float)pow(500000.0, -(double)i / 8.0);
    for (int i = 0; i < 16; ++i) a.inv32[i] = (float)pow(500000.0, -(double)i / 16.0);
    a.ph_lo = 0; a.ph_hi = 0;
#if ONE_LAUNCH
    (void)hipMemsetAsync((unsigned char*)d_ws + WS_CTL, 0, WS_CTL_BYTES, stream);
    void* kargs[] = { &a };
    hipError_t e = hipLaunchCooperativeKernel((const void*)mega, dim3(grid), dim3(NTHR), kargs, LDS_BYTES, stream);
    if (e != hipSuccess) fprintf(stderr, "kernel_launch: cooperative launch failed: %s (grid %d)\n", hipGetErrorString(e), grid);
#else
    launch_phase<11>(a, 0, grid, stream);
    for (int l = 0; l < DEPTH; ++l) {
        launch_phase<0>(a, l, grid, stream);
        launch_phase<1>(a, l, grid, stream);
        launch_phase<2>(a, l, grid, stream);
        launch_phase<3>(a, l, grid, stream);
        launch_phase<4>(a, l, grid, stream);
        launch_phase<5>(a, l, grid, stream);
        launch_phase<6>(a, l, grid, stream);
        launch_phase<7>(a, l, grid, stream);
        launch_phase<8>(a, l, grid, stream);
        launch_phase<9>(a, l, grid, stream);
        launch_phase<10>(a, l, grid, stream);
    }
    launch_phase<12>(a, 0, grid, stream);
#endif
}
```

```cpp
#include <hip/hip_runtime.h>
#include <hip/hip_cooperative_groups.h>
#include <cstdio>
#include <cmath>
#include <cstdint>


namespace cg = cooperative_groups;

typedef __attribute__((ext_vector_type(8))) short bf16x8;
typedef __attribute__((ext_vector_type(4))) short bf16x4;
typedef __attribute__((ext_vector_type(16))) float f32x16;
typedef unsigned short u16;
typedef unsigned long long u64;

#define DI __device__ __forceinline__
#define MFMA32(a, b, c) __builtin_amdgcn_mfma_f32_32x32x16_bf16((a), (b), (c), 0, 0, 0)

constexpr int T_TOK = 32768, SEQ = 4096, NB = 8, DM = 1024, DEPTH = 2;
constexpr int NREF = 3184;
constexpr int NPAD = 3200;
constexpr int LDP = 2848;
constexpr int PC_Z = 0, PC_XBC = 256, PC_DSAQ = 1024, PC_DSAK = 1280, PC_IDXQ = 1344, PC_IDXK = 1856,
              PC_CQ = 1920, PC_CKV = 2176, PC_KR = 2304, PC_FOXQ = 2336, PC_FOXK = 2592;
constexpr int NC_DSAV = 2848, NC_FOXV = 2912, NC_SMALL = 3168;
constexpr float EPS = 1e-6f;
constexpr float LOG2E = 1.4426950408889634f;
constexpr int NTHR = 512;
constexpr int LDS_BYTES = 147456;

constexpr size_t al256(size_t x) { return (x + 255) & ~(size_t)255; }
constexpr size_t WS_CTL   = 0;
constexpr size_t WS_BAR   = 4096;
constexpr size_t WS_CTL_BYTES = 32768;
constexpr size_t WS_WIN   = 32768;
constexpr size_t WS_WUQ   = WS_WIN  + (size_t)2 * NPAD * 1024 * 2;
constexpr size_t WS_WUKV  = WS_WUQ  + (size_t)2 * 384 * 256 * 2;
constexpr size_t WS_WOUT  = WS_WUKV + (size_t)2 * 512 * 128 * 2;
constexpr size_t WS_WG    = WS_WOUT + (size_t)2 * 1024 * 1024 * 2;
constexpr size_t WS_WU    = WS_WG   + (size_t)32 * 256 * 1024 * 2;
constexpr size_t WS_WD    = WS_WU   + (size_t)32 * 256 * 1024 * 2;
constexpr size_t WS_TRIG  = WS_WD   + (size_t)32 * 256 * 1024 * 2;
constexpr size_t WS_ACT   = WS_TRIG + (size_t)T_TOK * 48 * 4;
constexpr size_t WS_PROJ  = WS_ACT  + (size_t)T_TOK * 1024 * 2;
constexpr size_t WS_SMALL = WS_PROJ + (size_t)T_TOK * LDP * 2;
constexpr size_t WS_MLAQ  = WS_SMALL + (size_t)T_TOK * 16 * 4;
constexpr size_t WS_MLAK  = WS_MLAQ + (size_t)T_TOK * 384 * 2;
constexpr size_t WS_MLAVT = WS_MLAK + (size_t)T_TOK * 384 * 2;
constexpr size_t WS_DSAVT = WS_MLAVT + (size_t)T_TOK * 256 * 2;
constexpr size_t WS_FOXVT = WS_DSAVT + (size_t)T_TOK * 64 * 2;
constexpr size_t WS_FLOG  = WS_FOXVT + (size_t)T_TOK * 256 * 2;
constexpr size_t WS_CS    = WS_FLOG + (size_t)T_TOK * 4 * 4;
constexpr size_t WS_CDEC  = WS_CS   + (size_t)8 * 32 * 4 * 64 * 128 * 4;
constexpr size_t WS_MASK  = WS_CDEC + 4096;
constexpr size_t WS_TOKW  = WS_MASK + (size_t)T_TOK * 64 * 8;
constexpr size_t WS_WRH   = WS_TOKW + (size_t)T_TOK * 2 * 4;
constexpr size_t WS_WRL   = WS_WRH + (size_t)2 * 64 * 1024 * 2;
constexpr size_t WS_END   = WS_WRL + (size_t)2 * 64 * 1024 * 2;
constexpr size_t WS_LIST  = WS_PROJ;
constexpr size_t WS_HMID  = WS_PROJ + (size_t)64 * 32768 * 4;
static_assert(WS_HMID + (size_t)T_TOK * 512 * 2 <= WS_SMALL, "aliases must fit in PROJ");
static_assert(WS_END <= (size_t)512 * 1024 * 1024, "workspace budget");

struct Args {
    const float* in[25];
    float* out;
    unsigned char* ws;
    float inv16[8];
    float inv32[16];
    int ph_lo, ph_hi;
};

typedef const __attribute__((address_space(4))) Args KArgs;
struct Ctx { int tid, lane, wave; unsigned char* lds; };
__device__ __forceinline__ Ctx fresh_ctx(unsigned char* lds) {
    int t = threadIdx.x; asm volatile("" : "+v"(t));
    Ctx c; c.tid = t; c.lane = t & 63; c.wave = __builtin_amdgcn_readfirstlane(t >> 6); c.lds = lds; return c;
}

typedef __attribute__((ext_vector_type(2))) float f32x2;
typedef __attribute__((ext_vector_type(2))) __bf16 bf16x2_t;
DI u16 f2bf(float x) { return __builtin_bit_cast(u16, (__bf16)x); }
DI float bf2f(u16 h) { return __uint_as_float(((unsigned)h) << 16); }
DI unsigned pack2(float a, float b) { f32x2 v = {a, b}; return __builtin_bit_cast(unsigned, __builtin_convertvector(v, bf16x2_t)); }
DI float ex2(float x) { return __builtin_amdgcn_exp2f(x); }
DI float max3f(float a, float b, float c) { float r; asm("v_max3_f32 %0, %1, %2, %3" : "=v"(r) : "v"(a), "v"(b), "v"(c)); return r; }
DI float wsum(float v) { for (int o = 32; o >= 1; o >>= 1) v += __shfl_xor(v, o); return v; }
DI float wmaxf(float v) { for (int o = 32; o >= 1; o >>= 1) v = fmaxf(v, __shfl_xor(v, o)); return v; }
DI float wminf(float v) { for (int o = 32; o >= 1; o >>= 1) v = fminf(v, __shfl_xor(v, o)); return v; }
DI float siluf(float x) { return x / (1.f + __expf(-x)); }
DI float softplusf(float x) { return fmaxf(x, 0.f) + log1pf(__expf(-fabsf(x))); }
DI int crow(int reg, int h) { return (reg & 3) + 8 * (reg >> 2) + 4 * h; }
DI bf16x8 pack8(const f32x16& x, int s) {
    uint4 p;
    p.x = pack2(x[8 * s + 0], x[8 * s + 1]); p.y = pack2(x[8 * s + 2], x[8 * s + 3]);
    p.z = pack2(x[8 * s + 4], x[8 * s + 5]); p.w = pack2(x[8 * s + 6], x[8 * s + 7]);
    return __builtin_bit_cast(bf16x8, p);
}
DI f32x16 zero16() { f32x16 z; for (int i = 0; i < 16; ++i) z[i] = 0.f; return z; }

DI int ref_col(int n) {
    if (n < 1024) return n;
    if (n < 1280) return n - 1024 + 1028;
    if (n < 1344) return n - 1280 + 1284;
    if (n < 1856) return n - 1344 + 1412;
    if (n < 1920) return n - 1856 + 1924;
    if (n < 2176) return n - 1920 + 1996;
    if (n < 2304) return n - 2176 + 2252;
    if (n < 2336) return n - 2304 + 2380;
    if (n < 2592) return n - 2336 + 2412;
    if (n < 2848) return n - 2592 + 2668;
    if (n < 2912) return n - 2848 + 1348;
    if (n < 3168) return n - 2912 + 2924;
    if (n < 3172) return n - 3168 + 1024;
    if (n < 3180) return n - 3172 + 1988;
    if (n < 3184) return n - 3180 + 3180;
    return -1;
}

DI int vblock() { const int G = gridDim.x, bx = blockIdx.x; return (G % 8 == 0) ? (bx % 8) * (G / 8) + bx / 8 : bx; }

constexpr int G_LDT = 72;
constexpr int G_AEL = 256 * G_LDT, G_BEL = 128 * G_LDT, G_STEL = G_AEL + G_BEL;
constexpr int G_LDS_BYTES = 2 * G_STEL * 2;

struct GP { const u16 *a0, *a1, *a2, *a3, *b0, *b1; };

template <bool PAIRED>
DI void gemm_core(const Ctx& c, int K, const GP& gp, f32x16 (&acc)[2][2]) {
    u16* S = (u16*)c.lds;
    const int r8 = c.tid >> 3, kc = c.tid & 7;
    const int wm = c.wave & 3, wn = c.wave >> 2, l31 = c.lane & 31, h = c.lane >> 5;
    const int nb0 = PAIRED ? wn * 32 : wn * 64, nb1 = PAIRED ? 64 + wn * 32 : wn * 64 + 32;
    uint4 ra0, ra1, ra2, ra3, rb0, rb1;
    uint4 sa0, sa1, sa2, sa3, sb0, sb1;
    const int nk = K >> 6;
#define G_LOAD(P, KOFF) do { \
        P##a0 = *(const uint4*)(gp.a0 + (KOFF) + kc * 8); P##a1 = *(const uint4*)(gp.a1 + (KOFF) + kc * 8); \
        P##a2 = *(const uint4*)(gp.a2 + (KOFF) + kc * 8); P##a3 = *(const uint4*)(gp.a3 + (KOFF) + kc * 8); \
        P##b0 = *(const uint4*)(gp.b0 + (KOFF) + kc * 8); P##b1 = *(const uint4*)(gp.b1 + (KOFF) + kc * 8); } while (0)
#define G_STORE(P, SP) do { u16* sp_ = (SP); \
        *(uint4*)(sp_ + (r8) * G_LDT + kc * 8) = P##a0; *(uint4*)(sp_ + (r8 + 64) * G_LDT + kc * 8) = P##a1; \
        *(uint4*)(sp_ + (r8 + 128) * G_LDT + kc * 8) = P##a2; *(uint4*)(sp_ + (r8 + 192) * G_LDT + kc * 8) = P##a3; \
        *(uint4*)(sp_ + G_AEL + (r8) * G_LDT + kc * 8) = P##b0; *(uint4*)(sp_ + G_AEL + (r8 + 64) * G_LDT + kc * 8) = P##b1; } while (0)
#define G_COMPUTE(ST) do { \
        const u16* As = S + (ST) * G_STEL; const u16* Bs = As + G_AEL; \
        _Pragma("unroll") for (int ks = 0; ks < 4; ++ks) { \
            const bf16x8 a0 = *(const bf16x8*)(As + (wm * 64 + l31) * G_LDT + ks * 16 + h * 8); \
            const bf16x8 a1 = *(const bf16x8*)(As + (wm * 64 + 32 + l31) * G_LDT + ks * 16 + h * 8); \
            const bf16x8 b0 = *(const bf16x8*)(Bs + (nb0 + l31) * G_LDT + ks * 16 + h * 8); \
            const bf16x8 b1 = *(const bf16x8*)(Bs + (nb1 + l31) * G_LDT + ks * 16 + h * 8); \
            acc[0][0] = MFMA32(a0, b0, acc[0][0]); acc[0][1] = MFMA32(a0, b1, acc[0][1]); \
            acc[1][0] = MFMA32(a1, b0, acc[1][0]); acc[1][1] = MFMA32(a1, b1, acc[1][1]); } } while (0)
    G_LOAD(r, 0);
    G_STORE(r, S);
    if (nk > 1) G_LOAD(r, 64);
    __syncthreads();
    for (int kt = 0; kt < nk; kt += 2) {
        if (kt + 2 < nk) G_LOAD(s, (kt + 2) * 64);
        G_COMPUTE(0);
        if (kt + 1 < nk) G_STORE(r, S + G_STEL);
        __syncthreads();
        if (kt + 1 >= nk) break;
        if (kt + 3 < nk) G_LOAD(r, (kt + 3) * 64);
        G_COMPUTE(1);
        if (kt + 2 < nk) G_STORE(s, S);
        __syncthreads();
    }
#undef G_LOAD
#undef G_STORE
#undef G_COMPUTE
}

DI void xpose_tile(const Ctx& c, const float* in, int ld_in, int k0, int n0, int colmode, const float* kscale, u16* out, int ld_out) {
    float* tile = (float*)c.lds;
    const int j = c.tid & 63, r0 = c.tid >> 6;
    const int n = n0 + j;
    const int rc = colmode ? ref_col(n) : n;
#pragma unroll
    for (int rr = 0; rr < 8; ++rr) {
        const int kk = r0 + 8 * rr;
        float v = 0.f;
        if (rc >= 0) { v = in[(size_t)(k0 + kk) * ld_in + rc]; if (kscale) v *= kscale[k0 + kk]; }
        tile[kk * 65 + j] = v;
    }
    __syncthreads();
#pragma unroll
    for (int rr = 0; rr < 8; ++rr) {
        const int jj = r0 + 8 * rr;
        out[(size_t)(n0 + jj) * ld_out + k0 + j] = f2bf(tile[j * 65 + jj]);
    }
    __syncthreads();
}

DI void phase_prep(const Ctx& c_in, KArgs& a) {
    const Ctx c = fresh_ctx(c_in.lds);
    unsigned char* ws = a.ws;
    const int n_win = 2 * 50 * 16;
    const int n_wuq = 2 * 6 * 4;
    const int n_wukv = 2 * 8 * 2;
    const int n_wout = 2 * 16 * 16;
    const int n_trig = T_TOK * 24 / NTHR;
    const int n_wr = 2 * 64 * 1024 / NTHR;
    const int total = n_win + n_wuq + n_wukv + n_wout + n_trig + n_wr;
    for (int it = blockIdx.x; it < total; it += gridDim.x) {
        int i = it;
        if (i < n_win) {
            const int l = i / 800, r = i % 800, nt = r / 16, kt = r % 16;
            xpose_tile(c, a.in[3] + (size_t)l * 1024 * NREF, NREF, kt * 64, nt * 64, 1, nullptr, (u16*)(ws + WS_WIN) + (size_t)l * NPAD * 1024, 1024);
            continue;
        }
        i -= n_win;
        if (i < n_wuq) {
            const int l = i / 24, r = i % 24, nt = r / 4, kt = r % 4;
            xpose_tile(c, a.in[11] + (size_t)l * 256 * 384, 384, kt * 64, nt * 64, 0, a.in[10] + l * 256, (u16*)(ws + WS_WUQ) + (size_t)l * 384 * 256, 256);
            continue;
        }
        i -= n_wuq;
        if (i < n_wukv) {
            const int l = i / 16, r = i % 16, nt = r / 2, kt = r % 2;
            xpose_tile(c, a.in[13] + (size_t)l * 128 * 512, 512, kt * 64, nt * 64, 0, a.in[12] + l * 128, (u16*)(ws + WS_WUKV) + (size_t)l * 512 * 128, 128);
            continue;
        }
        i -= n_wukv;
        if (i < n_wout) {
            const int l = i / 256, r = i % 256, nt = r / 16, kt = r % 16;
            xpose_tile(c, a.in[15] + (size_t)l * 1024 * 1024, 1024, kt * 64, nt * 64, 0, nullptr, (u16*)(ws + WS_WOUT) + (size_t)l * 1024 * 1024, 1024);
            continue;
        }
        i -= n_wout;
        if (i >= n_trig) {
            const int e = (i - n_trig) * NTHR + c.tid;
            const int l = e >> 16, n = (e >> 10) & 63, k = e & 1023;
            float v = 0.f;
            if (n < 4) v = a.in[17][((size_t)l * 1024 + k) * 4 + n];
            else if (n < 36) v = a.in[19][((size_t)l * 1024 + k) * 32 + (n - 4)];
            const u16 hi = f2bf(v);
            ((u16*)(ws + WS_WRH))[e] = hi;
            ((u16*)(ws + WS_WRL))[e] = f2bf(v - bf2f(hi));
            continue;
        }
        {
            const int e = i * NTHR + c.tid;
            const int t = e / 24, j = e % 24;
            const int pos = ((const int*)a.in[1])[t];
            const float inv = (j < 8) ? a.inv16[j] : a.inv32[j - 8];
            const float ang = (float)pos * inv;
            const double ad = (double)ang;
            const double r = ad - 6.283185307179586476925 * rint(ad * 0.15915494309189533577);
            const float rf = (float)r;
            const float cs = cosf(rf), sn = sinf(rf);
            float* trig = (float*)(ws + WS_TRIG) + (size_t)t * 48;
            if (j < 8) { trig[j] = cs; trig[8 + j] = sn; } else { trig[16 + (j - 8)] = cs; trig[32 + (j - 8)] = sn; }
        }
    }
}

DI void phase_norm_in(const Ctx& c_in, KArgs& a, int l) {
    const Ctx c = fresh_ctx(c_in.lds);
    unsigned char* ws = a.ws;
    const float* x = (l == 0) ? a.in[0] : a.out;
    const float* g = a.in[2] + l * 1024;
    u16* act = (u16*)(ws + WS_ACT);
    const int n_norm = T_TOK / 8;
    const int n_exp = 3 * 32 * 64;
    if (blockIdx.x == 0 && c.tid < 64) ((int*)(ws + WS_CTL))[c.tid] = 0;
    for (int it = blockIdx.x; it < n_norm + n_exp; it += gridDim.x) {
        if (it < n_exp) {
            const int which = it / 2048, r = it % 2048, e = r / 64, tt = r % 64;
            if (which < 2) {
                const float* src = a.in[21 + which] + ((size_t)l * 32 + e) * 1024 * 256;
                u16* dst = (u16*)(ws + (which == 0 ? WS_WG : WS_WU)) + (size_t)e * 256 * 1024;
                const int nt = tt / 16, kt = tt % 16;
                xpose_tile(c, src, 256, kt * 64, nt * 64, 0, nullptr, dst, 1024);
            } else {
                const float* src = a.in[23] + ((size_t)l * 32 + e) * 256 * 1024;
                u16* dst = (u16*)(ws + WS_WD) + (size_t)e * 1024 * 256;
                const int nt = tt / 4, kt = tt % 4;
                xpose_tile(c, src, 1024, kt * 64, nt * 64, 0, nullptr, dst, 256);
            }
        } else {
            const int t = (it - n_exp) * 8 + c.wave;
            const float* xr = x + (size_t)t * 1024;
            float v[16]; float ss = 0.f;
#pragma unroll
            for (int j = 0; j < 16; ++j) { v[j] = xr[c.lane + 64 * j]; ss += v[j] * v[j]; }
            ss = wsum(ss);
            const float rs = rsqrtf(ss * (1.f / 1024.f) + EPS);
#pragma unroll
            for (int j = 0; j < 16; ++j) act[(size_t)t * 1024 + c.lane + 64 * j] = f2bf(v[j] * rs * g[c.lane + 64 * j]);
        }
    }
}

DI void phase_inproj(const Ctx& c_in, KArgs& a, int l) {
    const Ctx c = fresh_ctx(c_in.lds);
    unsigned char* ws = a.ws;
    const u16* act = (const u16*)(ws + WS_ACT);
    const u16* w = (const u16*)(ws + WS_WIN) + (size_t)l * NPAD * 1024;
    u16* proj = (u16*)(ws + WS_PROJ);
    u16* dsavt = (u16*)(ws + WS_DSAVT);
    u16* foxvt = (u16*)(ws + WS_FOXVT);
    float* small = (float*)(ws + WS_SMALL);
    const int r8 = c.tid >> 3;
    const int wm = c.wave & 3, wn = c.wave >> 2, l31 = c.lane & 31, h = c.lane >> 5;
    const int ntiles = (T_TOK / 256) * (NPAD / 128);
    for (int tile = vblock(); tile < ntiles; tile += gridDim.x) {
        const int grp = tile / 100, rr = tile % 100;
        const int mt = grp * 4 + (rr & 3), nt = rr >> 2;
        GP gp;
        gp.a0 = act + (size_t)(mt * 256 + r8) * 1024; gp.a1 = gp.a0 + 64 * 1024; gp.a2 = gp.a0 + 128 * 1024; gp.a3 = gp.a0 + 192 * 1024;
        gp.b0 = w + (size_t)(nt * 128 + r8) * 1024; gp.b1 = gp.b0 + 64 * 1024;
        f32x16 acc[2][2];
        acc[0][0] = zero16(); acc[0][1] = zero16(); acc[1][0] = zero16(); acc[1][1] = zero16();
        gemm_core<false>(c, 1024, gp, acc);
#pragma unroll
        for (int i = 0; i < 2; ++i)
#pragma unroll
            for (int j = 0; j < 2; ++j) {
                const int m0 = mt * 256 + wm * 64 + i * 32, n0 = nt * 128 + wn * 64 + j * 32;
                const int n = n0 + l31;
                if (n0 < LDP) {
#pragma unroll
                    for (int r = 0; r < 16; ++r) proj[(size_t)(m0 + crow(r, h)) * LDP + n] = f2bf(acc[i][j][r]);
                } else if (n0 < NC_SMALL) {
                    const int b = m0 >> 12, s0 = m0 & 4095;
                    u16* base = (n0 < NC_FOXV) ? dsavt + ((size_t)b * 64 + (n - NC_DSAV)) * 4096 : foxvt + ((size_t)b * 256 + (n - NC_FOXV)) * 4096;
#pragma unroll
                    for (int q = 0; q < 4; ++q) {
                        uint2 pk; pk.x = pack2(acc[i][j][4 * q], acc[i][j][4 * q + 1]); pk.y = pack2(acc[i][j][4 * q + 2], acc[i][j][4 * q + 3]);
                        *(uint2*)(base + s0 + 8 * q + 4 * h) = pk;
                    }
                } else {
                    const int cc = n - NC_SMALL;
                    if (cc < 16) {
#pragma unroll
                        for (int r = 0; r < 16; ++r) small[(size_t)(m0 + crow(r, h)) * 16 + cc] = acc[i][j][r];
                    }
                }
            }
    }
}

constexpr int SSD_LD = 136;
constexpr int SSD_TILE_B = 128 * SSD_LD * 2;
constexpr int SSD_OFF_DT = 3 * SSD_TILE_B;
constexpr int SSD_OFF_ACS = SSD_OFF_DT + 2048;
constexpr int SSD_OFF_SSQ = SSD_OFF_ACS + 2048;

DI void ssd_dt_acs(const Ctx& c, KArgs& a, int l, int tok0, float* dt_s, float* acs_s) {
    const float* small = (const float*)(a.ws + WS_SMALL);
    {
        const int t = c.tid >> 2, hd = c.tid & 3;
        const float raw = small[(size_t)(tok0 + t) * 16 + hd] + a.in[6][l * 4 + hd];
        dt_s[hd * 128 + t] = softplusf(raw);
    }
    __syncthreads();
    if (c.wave < 4) {
        const int hd = c.wave;
        const float av = -__expf(a.in[7][l * 4 + hd]);
        const float v0 = dt_s[hd * 128 + 2 * c.lane] * av, v1 = dt_s[hd * 128 + 2 * c.lane + 1] * av;
        const float s = v0 + v1;
        float inc = s;
#pragma unroll
        for (int o = 1; o < 64; o <<= 1) { const float tv = __shfl_up(inc, o); if (c.lane >= o) inc += tv; }
        const float ex = inc - s;
        acs_s[hd * 128 + 2 * c.lane] = ex + v0;
        acs_s[hd * 128 + 2 * c.lane + 1] = ex + v0 + v1;
    }
    __syncthreads();
}

DI float ssd_conv(const u16* proj, const float* cw, const float* cb, int b, int s, int xc) {
    float acc = cb[xc];
#pragma unroll
    for (int j = 0; j < 4; ++j) {
        const int sp = s - 3 + j;
        if (sp >= 0) acc += cw[j * 768 + xc] * bf2f(proj[(size_t)(b * 4096 + sp) * LDP + PC_XBC + xc]);
    }
    return siluf(acc);
}

template <bool TRANSPOSED>
DI void conv_stage_unit(const Ctx& c, const u16* proj, const float* cw, const float* cb, int b, int s0, int tseg, int xc0, u16* dst,
                        const float* dt_s, const float* acs_s, int head0) {
    const int ch = 2 * c.lane, xc = xc0 + ch;
    float w0[4], w1[4];
#pragma unroll
    for (int j = 0; j < 4; ++j) { w0[j] = cw[j * 768 + xc]; w1[j] = cw[j * 768 + xc + 1]; }
    const float bias0 = cb[xc], bias1 = cb[xc + 1];
    const int sb = s0 + tseg * 32 - 3;
    const u16* src = proj + (size_t)(b * 4096) * LDP + PC_XBC + xc;
    unsigned raw[35];
#pragma unroll
    for (int i = 0; i < 35; ++i) { const int sp = sb + i; raw[i] = (sp >= 0) ? *(const unsigned*)(src + (size_t)sp * LDP) : 0u; }
    const int head = head0 + (ch >> 6);
#pragma unroll
    for (int t = 0; t < 32; ++t) {
        float x0 = bias0, x1 = bias1;
#pragma unroll
        for (int j = 0; j < 4; ++j) { x0 += w0[j] * bf2f((u16)(raw[t + j] & 0xffff)); x1 += w1[j] * bf2f((u16)(raw[t + j] >> 16)); }
        x0 = siluf(x0); x1 = siluf(x1);
        const int tt = tseg * 32 + t;
        if (dt_s) { const float sc = dt_s[head * 128 + tt] * __expf(acs_s[head * 128 + 127] - acs_s[head * 128 + tt]); x0 *= sc; x1 *= sc; }
        if (TRANSPOSED) { dst[ch * SSD_LD + tt] = f2bf(x0); dst[(ch + 1) * SSD_LD + tt] = f2bf(x1); }
        else *(unsigned*)(dst + tt * SSD_LD + ch) = pack2(x0, x1);
    }
}

DI void ssd_state_item(const Ctx& c_in, KArgs& a, int l, int item) {
    const Ctx c = fresh_ctx(c_in.lds);
    unsigned char* ws = a.ws;
    const u16* proj = (const u16*)(ws + WS_PROJ);
    const float* cw = a.in[4] + (size_t)l * 4 * 768;
    const float* cb = a.in[5] + (size_t)l * 768;
    float* cs = (float*)(ws + WS_CS);
    float* cdec = (float*)(ws + WS_CDEC);
    const int b = item >> 5, ch = item & 31, tok0 = b * 4096 + ch * 128, s0 = ch * 128;
    u16* XT = (u16*)c.lds;
    u16* BT = (u16*)(c.lds + SSD_TILE_B);
    float* dt_s = (float*)(c.lds + SSD_OFF_DT);
    float* acs_s = (float*)(c.lds + SSD_OFF_ACS);
    const int l31 = c.lane & 31, h = c.lane >> 5;
    ssd_dt_acs(c, a, l, tok0, dt_s, acs_s);
    if (c.tid < 4) cdec[(b * 32 + ch) * 4 + c.tid] = __expf(acs_s[c.tid * 128 + 127]);
    for (int g = 0; g < 2; ++g) {
        if (c.wave < 4) conv_stage_unit<true>(c, proj, cw, cb, b, s0, c.wave, 128 * g, XT, dt_s, acs_s, 2 * g);
        else conv_stage_unit<true>(c, proj, cw, cb, b, s0, c.wave - 4, 256 + 128 * g, BT, nullptr, nullptr, 0);
        __syncthreads();
        {
            const int hh = c.wave >> 2, pt = (c.wave >> 1) & 1, nh = c.wave & 1;
            f32x16 acc0 = zero16(), acc1 = zero16();
#pragma unroll
            for (int ks = 0; ks < 8; ++ks) {
                const bf16x8 af = *(const bf16x8*)(XT + (hh * 64 + pt * 32 + l31) * SSD_LD + ks * 16 + h * 8);
                const bf16x8 b0 = *(const bf16x8*)(BT + (nh * 64 + l31) * SSD_LD + ks * 16 + h * 8);
                const bf16x8 b1 = *(const bf16x8*)(BT + (nh * 64 + 32 + l31) * SSD_LD + ks * 16 + h * 8);
                acc0 = MFMA32(af, b0, acc0);
                acc1 = MFMA32(af, b1, acc1);
            }
            const int head = 2 * g + hh;
            float* dst = cs + ((size_t)((b * 32 + ch) * 4 + head) * 64) * 128;
#pragma unroll
            for (int r = 0; r < 16; ++r) {
                const int p = pt * 32 + crow(r, h);
                dst[p * 128 + nh * 64 + l31] = acc0[r];
                dst[p * 128 + nh * 64 + 32 + l31] = acc1[r];
            }
        }
        __syncthreads();
    }
}

DI void ssd_scan_item(const Ctx& c_in, KArgs& a, int item) {
    const Ctx c = fresh_ctx(c_in.lds);
    float* cs = (float*)(a.ws + WS_CS);
    const float* cdec = (const float*)(a.ws + WS_CDEC);
    const int idx = item * NTHR + c.tid;
    const int bh = idx >> 13, pn = idx & 8191, b = bh >> 2, hd = bh & 3;
    float s = 0.f;
    for (int ch = 0; ch < 32; ++ch) {
        const size_t off = ((size_t)((b * 32 + ch) * 4 + hd)) * 8192 + pn;
        const float v = cs[off];
        cs[off] = s;
        s = s * cdec[(b * 32 + ch) * 4 + hd] + v;
    }
}

DI void ssd_out_item(const Ctx& c_in, KArgs& a, int l, int item) {
    const Ctx c = fresh_ctx(c_in.lds);
    unsigned char* ws = a.ws;
    const u16* proj = (const u16*)(ws + WS_PROJ);
    const float* cw = a.in[4] + (size_t)l * 4 * 768;
    const float* cb = a.in[5] + (size_t)l * 768;
    const float* prev = (const float*)(ws + WS_CS);
    u16* act = (u16*)(ws + WS_ACT);
    const int b = item >> 5, ch = item & 31, tok0 = b * 4096 + ch * 128, s0 = ch * 128;
    u16* XT = (u16*)c.lds;
    u16* BM = (u16*)(c.lds + SSD_TILE_B);
    u16* CM = (u16*)(c.lds + 2 * SSD_TILE_B);
    float* dt_s = (float*)(c.lds + SSD_OFF_DT);
    float* acs_s = (float*)(c.lds + SSD_OFF_ACS);
    float* ssq = (float*)(c.lds + SSD_OFF_SSQ);
    const int l31 = c.lane & 31, h = c.lane >> 5;
    ssd_dt_acs(c, a, l, tok0, dt_s, acs_s);
    f32x16 yreg[2][2];
    const int hh = c.wave >> 2, qt = c.wave & 3;
    const int q = qt * 32 + l31;
#pragma unroll
    for (int g = 0; g < 2; ++g) {
        for (int u = c.wave; u < 12; u += 8) {
            const int part = u >> 2, tseg = u & 3;
            if (part == 0) conv_stage_unit<true>(c, proj, cw, cb, b, s0, tseg, 128 * g, XT, nullptr, nullptr, 0);
            else if (part == 1) conv_stage_unit<false>(c, proj, cw, cb, b, s0, tseg, 256 + 128 * g, BM, nullptr, nullptr, 0);
            else conv_stage_unit<false>(c, proj, cw, cb, b, s0, tseg, 512 + 128 * g, CM, nullptr, nullptr, 0);
        }
        __syncthreads();
        {
            const int head = 2 * g + hh;
            const float acs_q = acs_s[head * 128 + q];
            bf16x8 cf[8];
#pragma unroll
            for (int ks = 0; ks < 8; ++ks) cf[ks] = *(const bf16x8*)(CM + q * SSD_LD + ks * 16 + h * 8);
            f32x16 yo0 = zero16(), yo1 = zero16();
            for (int kt = 0; kt <= qt; ++kt) {
                f32x16 gt = zero16();
#pragma unroll
                for (int ks = 0; ks < 8; ++ks) {
                    const bf16x8 bf = *(const bf16x8*)(BM + (kt * 32 + l31) * SSD_LD + ks * 16 + h * 8);
                    gt = MFMA32(bf, cf[ks], gt);
                }
#pragma unroll
                for (int r = 0; r < 16; ++r) {
                    const int k = kt * 32 + crow(r, h);
                    const float dec = __expf(fminf(acs_q - acs_s[head * 128 + k], 0.f)) * dt_s[head * 128 + k];
                    gt[r] = (k <= q) ? gt[r] * dec : 0.f;
                }
#pragma unroll
                for (int s2 = 0; s2 < 2; ++s2) {
                    const bf16x8 pb = pack8(gt, s2);
                    const int koff = kt * 32 + 16 * s2 + 4 * h;
                    {
                        const u16* xr = XT + (hh * 64 + l31) * SSD_LD + koff;
                        const uint2 lo = *(const uint2*)xr, hi = *(const uint2*)(xr + 8);
                        const bf16x8 xa = __builtin_bit_cast(bf16x8, make_uint4(lo.x, lo.y, hi.x, hi.y));
                        yo0 = MFMA32(xa, pb, yo0);
                    }
                    {
                        const u16* xr = XT + (hh * 64 + 32 + l31) * SSD_LD + koff;
                        const uint2 lo = *(const uint2*)xr, hi = *(const uint2*)(xr + 8);
                        const bf16x8 xa = __builtin_bit_cast(bf16x8, make_uint4(lo.x, lo.y, hi.x, hi.y));
                        yo1 = MFMA32(xa, pb, yo1);
                    }
                }
            }
            f32x16 yf0 = zero16(), yf1 = zero16();
            const float* pv = prev + ((size_t)((b * 32 + ch) * 4 + head) * 64) * 128;
#pragma unroll
            for (int ks = 0; ks < 8; ++ks) {
                {
                    const float* pr = pv + (size_t)l31 * 128 + ks * 16 + h * 8;
                    const float4 f0 = *(const float4*)pr, f1 = *(const float4*)(pr + 4);
                    const bf16x8 pa = __builtin_bit_cast(bf16x8, make_uint4(pack2(f0.x, f0.y), pack2(f0.z, f0.w), pack2(f1.x, f1.y), pack2(f1.z, f1.w)));
                    yf0 = MFMA32(pa, cf[ks], yf0);
                }
                {
                    const float* pr = pv + (size_t)(32 + l31) * 128 + ks * 16 + h * 8;
                    const float4 f0 = *(const float4*)pr, f1 = *(const float4*)(pr + 4);
                    const bf16x8 pa = __builtin_bit_cast(bf16x8, make_uint4(pack2(f0.x, f0.y), pack2(f0.z, f0.w), pack2(f1.x, f1.y), pack2(f1.z, f1.w)));
                    yf1 = MFMA32(pa, cf[ks], yf1);
                }
            }
            const float eq = __expf(acs_q);
            const float dsk = a.in[8][l * 4 + head];
            float part = 0.f;
#pragma unroll
            for (int pt = 0; pt < 2; ++pt) {
#pragma unroll
                for (int qd = 0; qd < 4; ++qd) {
                    const int p0 = pt * 32 + 8 * qd + 4 * h;
                    const uint2 zz = *(const uint2*)(proj + (size_t)(tok0 + q) * LDP + PC_Z + head * 64 + p0);
                    const float zf[4] = { bf2f((u16)(zz.x & 0xffff)), bf2f((u16)(zz.x >> 16)), bf2f((u16)(zz.y & 0xffff)), bf2f((u16)(zz.y >> 16)) };
#pragma unroll
                    for (int r3 = 0; r3 < 4; ++r3) {
                        const int r = 4 * qd + r3;
                        const float yo = pt ? yo1[r] : yo0[r];
                        const float yf = pt ? yf1[r] : yf0[r];
                        const float xv = bf2f(XT[(hh * 64 + p0 + r3) * SSD_LD + q]);
                        const float y = (yo + yf * eq + dsk * xv) * siluf(zf[r3]);
                        yreg[g][pt][r] = y;
                        part += y * y;
                    }
                }
            }
            part += __shfl_xor(part, 32);
            if (h == 0) ssq[head * 128 + q] = part;
        }
        __syncthreads();
    }
    {
        const float rs = rsqrtf((ssq[q] + ssq[128 + q] + ssq[256 + q] + ssq[384 + q]) * (1.f / 256.f) + EPS);
        const float* nw = a.in[9] + l * 256;
#pragma unroll
        for (int g = 0; g < 2; ++g) {
            const int head = 2 * g + hh;
#pragma unroll
            for (int pt = 0; pt < 2; ++pt)
#pragma unroll
                for (int qd = 0; qd < 4; ++qd) {
                    const int p0 = pt * 32 + 8 * qd + 4 * h;
                    const float* w4 = nw + head * 64 + p0;
                    uint2 pk;
                    pk.x = pack2(yreg[g][pt][4 * qd] * rs * w4[0], yreg[g][pt][4 * qd + 1] * rs * w4[1]);
                    pk.y = pack2(yreg[g][pt][4 * qd + 2] * rs * w4[2], yreg[g][pt][4 * qd + 3] * rs * w4[3]);
                    *(uint2*)(act + (size_t)(tok0 + q) * 1024 + head * 64 + p0) = pk;
                }
        }
    }
    __syncthreads();
}

DI void token_post_item(const Ctx& c_in, KArgs& a, int l, int item) {
    const Ctx c = fresh_ctx(c_in.lds);
    unsigned char* ws = a.ws;
    u16* proj = (u16*)(ws + WS_PROJ);
    u16* mlak = (u16*)(ws + WS_MLAK);
    const float* trig = (const float*)(ws + WS_TRIG);
    const float* small = (const float*)(ws + WS_SMALL);
    float* flog = (float*)(ws + WS_FLOG);
    const int t = item * 8 + c.wave;
    u16* pr = proj + (size_t)t * LDP;
    const float* tg = trig + (size_t)t * 48;
#pragma unroll
    for (int r = 0; r < 2; ++r) {
        const int pid = c.lane + 64 * r;
        if (pid < 112) {
            int col, i;
            if (pid < 32)       { col = PC_DSAQ + (pid >> 3) * 64; i = pid & 7; }
            else if (pid < 40)  { col = PC_DSAK; i = pid - 32; }
            else if (pid < 104) { const int p = pid - 40; col = PC_IDXQ + (p >> 3) * 64; i = p & 7; }
            else                { col = PC_IDXK; i = pid - 104; }
            const float x1 = bf2f(pr[col + i]), x2 = bf2f(pr[col + 8 + i]);
            const float cs = tg[i], sn = tg[8 + i];
            pr[col + i] = f2bf(x1 * cs - x2 * sn);
            pr[col + 8 + i] = f2bf(x2 * cs + x1 * sn);
        } else {
            const int i = pid - 112;
            const float x1 = bf2f(pr[PC_KR + i]), x2 = bf2f(pr[PC_KR + 16 + i]);
            const float cs = tg[16 + i], sn = tg[32 + i];
            const u16 o1 = f2bf(x1 * cs - x2 * sn), o2 = f2bf(x2 * cs + x1 * sn);
#pragma unroll
            for (int hd = 0; hd < 4; ++hd) { mlak[(size_t)t * 384 + hd * 96 + 64 + i] = o1; mlak[(size_t)t * 384 + hd * 96 + 80 + i] = o2; }
        }
    }
    if (c.lane < 4) {
        const float f = small[(size_t)t * 16 + 12 + c.lane] + a.in[14][l * 4 + c.lane];
        const float ls = fminf(f, 0.f) - log1pf(__expf(-fabsf(f)));
        const int b = t >> 12, s = t & 4095;
        flog[(size_t)(b * 4 + c.lane) * 4096 + s] = ls;
    }
}

DI void mla_up_item(const Ctx& c_in, KArgs& a, int l, int which, int item) {
    const Ctx c = fresh_ctx(c_in.lds);
    unsigned char* ws = a.ws;
    const u16* proj = (const u16*)(ws + WS_PROJ);
    const float* trig = (const float*)(ws + WS_TRIG);
    float* rs_s = (float*)(c.lds + G_LDS_BYTES);
    const int r8 = c.tid >> 3;
    const int wm = c.wave & 3, wn = c.wave >> 2, l31 = c.lane & 31, h = c.lane >> 5;
    const int K = which == 0 ? 256 : 128;
    const int pc = which == 0 ? PC_CQ : PC_CKV;
    const int ntn = which == 0 ? 3 : 4;
    const int mt = item / ntn, nt = item % ntn;
    const u16* w = which == 0 ? (const u16*)(ws + WS_WUQ) + (size_t)l * 384 * 256 : (const u16*)(ws + WS_WUKV) + (size_t)l * 512 * 128;
    {
        const int row = c.tid >> 1, half = c.tid & 1;
        const u16* p = proj + (size_t)(mt * 256 + row) * LDP + pc + half * (K / 2);
        float ss = 0.f;
        for (int i = 0; i < K / 2; i += 8) {
            const uint4 v = *(const uint4*)(p + i);
            const unsigned w4[4] = { v.x, v.y, v.z, v.w };
#pragma unroll
            for (int j = 0; j < 4; ++j) { const float f0 = bf2f((u16)(w4[j] & 0xffff)), f1 = bf2f((u16)(w4[j] >> 16)); ss += f0 * f0 + f1 * f1; }
        }
        ss += __shfl_xor(ss, 1);
        if (half == 0) rs_s[row] = rsqrtf(ss / (float)K + EPS);
    }
    __syncthreads();
    GP gp;
    gp.a0 = proj + (size_t)(mt * 256 + r8) * LDP + pc; gp.a1 = gp.a0 + 64 * LDP; gp.a2 = gp.a0 + 128 * LDP; gp.a3 = gp.a0 + 192 * LDP;
    gp.b0 = w + (size_t)(nt * 128 + r8) * K; gp.b1 = gp.b0 + 64 * K;
    f32x16 acc[2][2];
    acc[0][0] = zero16(); acc[0][1] = zero16(); acc[1][0] = zero16(); acc[1][1] = zero16();
    gemm_core<false>(c, K, gp, acc);
    u16* mlaq = (u16*)(ws + WS_MLAQ);
    u16* mlak = (u16*)(ws + WS_MLAK);
    u16* mlavt = (u16*)(ws + WS_MLAVT);
#pragma unroll
    for (int i = 0; i < 2; ++i)
#pragma unroll
        for (int j = 0; j < 2; ++j) {
            const int ml0 = wm * 64 + i * 32, m0 = mt * 256 + ml0, n0 = nt * 128 + wn * 64 + j * 32;
            const int n = n0 + l31;
            if (which == 0) {
                const bool rope = ((n0 >> 5) % 3) == 2;
#pragma unroll
                for (int r = 0; r < 16; ++r) {
                    const int ml = ml0 + crow(r, h), m = mt * 256 + ml;
                    float v = acc[i][j][r] * rs_s[ml];
                    if (rope) {
                        const float pv = __shfl_xor(v, 16);
                        const int ii = l31 & 15;
                        const float cs = trig[(size_t)m * 48 + 16 + ii], sn = trig[(size_t)m * 48 + 32 + ii];
                        v = (l31 < 16) ? (v * cs - pv * sn) : (v * cs + pv * sn);
                    }
                    mlaq[(size_t)m * 384 + n] = f2bf(v);
                }
            } else {
                const int head = n0 >> 7, wi = n0 & 127;
                if (wi < 64) {
#pragma unroll
                    for (int r = 0; r < 16; ++r) {
                        const int ml = ml0 + crow(r, h), m = mt * 256 + ml;
                        mlak[(size_t)m * 384 + head * 96 + wi + l31] = f2bf(acc[i][j][r] * rs_s[ml]);
                    }
                } else {
                    const int b = m0 >> 12, s0 = m0 & 4095, d = wi - 64 + l31;
                    u16* base = mlavt + ((size_t)(b * 4 + head) * 64 + d) * 4096 + s0;
#pragma unroll
                    for (int q = 0; q < 4; ++q) {
                        const int mlq = ml0 + 8 * q + 4 * h;
                        uint2 pk;
                        pk.x = pack2(acc[i][j][4 * q] * rs_s[mlq], acc[i][j][4 * q + 1] * rs_s[mlq + 1]);
                        pk.y = pack2(acc[i][j][4 * q + 2] * rs_s[mlq + 2], acc[i][j][4 * q + 3] * rs_s[mlq + 3]);
                        *(uint2*)(base + 8 * q + 4 * h) = pk;
                    }
                }
            }
        }
    __syncthreads();
}

constexpr int AT_LDV = 68;
template <int DQ, int MODE>
DI void attn_item(const Ctx& c_in, KArgs& a, int item) {
    const Ctx c = fresh_ctx(c_in.lds);
    unsigned char* ws = a.ws;
    constexpr int LDK = DQ + 8;
    constexpr int K_EL = 64 * LDK, V_EL = 64 * AT_LDV, ST_EL = K_EL + V_EL;
    constexpr int NKS = DQ / 16;
    constexpr int KCH = DQ / 8;
    u16* S = (u16*)c.lds;
    float* fc_s = (float*)(c.lds + 2 * ST_EL * 2 + 64);
    const int l31 = c.lane & 31, h = c.lane >> 5;
    int b, hd, wq0, nkt;
    const u16 *Qp, *Kp, *Vp; int ldq, ldk, ocol;
    float scale;
    if (MODE == 0) {
        const int qb = 15 - (item >> 5), rem = item & 31; b = rem >> 2; hd = rem & 3;
        wq0 = qb * 256 + c.wave * 32; nkt = qb * 4 + 4;
        Qp = (const u16*)(ws + WS_MLAQ) + (size_t)b * 4096 * 384 + hd * 96; ldq = 384;
        Kp = (const u16*)(ws + WS_MLAK) + (size_t)b * 4096 * 384 + hd * 96; ldk = 384;
        Vp = (const u16*)(ws + WS_MLAVT) + (size_t)(b * 4 + hd) * 64 * 4096;
        ocol = 512 + hd * 64; scale = 0.10206207261596575f;
    } else if (MODE == 1) {
        const int qb = 15 - (item >> 5), rem = item & 31; b = rem >> 2; hd = rem & 3;
        wq0 = qb * 256 + c.wave * 32; nkt = qb * 4 + 4;
        Qp = (const u16*)(ws + WS_PROJ) + (size_t)b * 4096 * LDP + PC_FOXQ + hd * 64; ldq = LDP;
        Kp = (const u16*)(ws + WS_PROJ) + (size_t)b * 4096 * LDP + PC_FOXK + hd * 64; ldk = LDP;
        Vp = (const u16*)(ws + WS_FOXVT) + (size_t)(b * 4 + hd) * 64 * 4096;
        ocol = 768 + hd * 64; scale = 0.125f;
    } else {
        const int qb = 63 - (item >> 3); b = item & 7; hd = c.wave & 3;
        wq0 = qb * 64 + (c.wave >> 2) * 32; nkt = qb + 1;
        Qp = (const u16*)(ws + WS_PROJ) + (size_t)b * 4096 * LDP + PC_DSAQ + hd * 64; ldq = LDP;
        Kp = (const u16*)(ws + WS_PROJ) + (size_t)b * 4096 * LDP + PC_DSAK; ldk = LDP;
        Vp = (const u16*)(ws + WS_DSAVT) + (size_t)b * 64 * 4096;
        ocol = 256 + hd * 64; scale = 0.125f;
    }
    const float sc2 = scale * LOG2E;
    const int q = wq0 + l31;
    bf16x8 qf[NKS];
#pragma unroll
    for (int ks = 0; ks < NKS; ++ks) qf[ks] = *(const bf16x8*)(Qp + (size_t)q * ldq + ks * 16 + h * 8);
    float fq = 0.f;
    if (MODE == 1) {
        const float* fl = (const float*)(ws + WS_FLOG) + (size_t)(b * 4 + hd) * 4096;
        float* wtot = (float*)(c.lds + 2 * ST_EL * 2);
        const int nk = nkt * 64;
        float v[8]; float s = 0.f;
#pragma unroll
        for (int j = 0; j < 8; ++j) { const int idx = c.tid * 8 + j; v[j] = (idx < nk) ? fl[idx] : 0.f; s += v[j]; v[j] = s; }
        float inc = s;
#pragma unroll
        for (int o = 1; o < 64; o <<= 1) { const float tv = __shfl_up(inc, o); if (c.lane >= o) inc += tv; }
        if (c.lane == 63) wtot[c.wave] = inc;
        __syncthreads();
        float base = inc - s;
        for (int w2 = 0; w2 < c.wave; ++w2) base += wtot[w2];
#pragma unroll
        for (int j = 0; j < 8; ++j) fc_s[c.tid * 8 + j] = (base + v[j]) * LOG2E;
        __syncthreads();
        fq = fc_s[q];
    }
    const int krow0 = c.tid / KCH, kch0 = c.tid % KCH;
    const int c1 = c.tid + NTHR; const int krow1 = c1 / KCH, kch1 = c1 % KCH; const bool has1 = (KCH * 64 > NTHR) && (c1 < KCH * 64);
    const int vrow = c.tid >> 3, vch = c.tid & 7;
    uint4 rk0, rk1, rv; rk1 = make_uint4(0, 0, 0, 0);
    auto gload = [&](int kt) {
        rk0 = *(const uint4*)(Kp + (size_t)(kt * 64 + krow0) * ldk + kch0 * 8);
        if (has1) rk1 = *(const uint4*)(Kp + (size_t)(kt * 64 + krow1) * ldk + kch1 * 8);
        rv = *(const uint4*)(Vp + (size_t)vrow * 4096 + kt * 64 + vch * 8);
    };
    auto sstore = [&](int st) {
        u16* Ks = S + st * ST_EL; u16* Vs = Ks + K_EL;
        *(uint4*)(Ks + krow0 * LDK + kch0 * 8) = rk0;
        if (has1) *(uint4*)(Ks + krow1 * LDK + kch1 * 8) = rk1;
        *(uint2*)(Vs + vrow * AT_LDV + vch * 8) = make_uint2(rv.x, rv.y);
        *(uint2*)(Vs + vrow * AT_LDV + vch * 8 + 4) = make_uint2(rv.z, rv.w);
    };
    f32x16 o0 = zero16(), o1 = zero16();
    float m_run = -1e30f, l_run = 0.f;
    const u64* mrow = (const u64*)(ws + WS_MASK) + (size_t)(b * 4096 + q) * 64;
    u64 mw_cur = 0, mw_nxt = 0;
    if (MODE == 2) mw_cur = mrow[0];
    gload(0); sstore(0);
    __syncthreads();
    for (int kt = 0; kt < nkt; ++kt) {
        const bool more = (kt + 1 < nkt);
        if (more) { gload(kt + 1); if (MODE == 2) mw_nxt = mrow[kt + 1]; }
        if (kt * 64 <= wq0 + 31) {
            const u16* Ks = S + (kt & 1) * ST_EL; const u16* Vs = Ks + K_EL;
            f32x16 s0 = zero16(), s1 = zero16();
#pragma unroll
            for (int ks = 0; ks < NKS; ++ks) {
                const bf16x8 k0 = *(const bf16x8*)(Ks + l31 * LDK + ks * 16 + h * 8);
                const bf16x8 k1 = *(const bf16x8*)(Ks + (32 + l31) * LDK + ks * 16 + h * 8);
                s0 = MFMA32(k0, qf[ks], s0);
                s1 = MFMA32(k1, qf[ks], s1);
            }
            const float scx = (MODE == 1) ? 1.0f : sc2;
            if (MODE == 1) {
#pragma unroll
                for (int g4 = 0; g4 < 4; ++g4) {
                    const float4 f0 = *(const float4*)(fc_s + kt * 64 + 8 * g4 + 4 * h);
                    const float4 f1 = *(const float4*)(fc_s + kt * 64 + 32 + 8 * g4 + 4 * h);
                    s0[4 * g4 + 0] = fmaf(s0[4 * g4 + 0], sc2, fq) - f0.x; s0[4 * g4 + 1] = fmaf(s0[4 * g4 + 1], sc2, fq) - f0.y;
                    s0[4 * g4 + 2] = fmaf(s0[4 * g4 + 2], sc2, fq) - f0.z; s0[4 * g4 + 3] = fmaf(s0[4 * g4 + 3], sc2, fq) - f0.w;
                    s1[4 * g4 + 0] = fmaf(s1[4 * g4 + 0], sc2, fq) - f1.x; s1[4 * g4 + 1] = fmaf(s1[4 * g4 + 1], sc2, fq) - f1.y;
                    s1[4 * g4 + 2] = fmaf(s1[4 * g4 + 2], sc2, fq) - f1.z; s1[4 * g4 + 3] = fmaf(s1[4 * g4 + 3], sc2, fq) - f1.w;
                }
            }
            if (MODE == 2) {
                const unsigned mlo = (unsigned)(mw_cur >> (4 * h)), mhi = (unsigned)(mw_cur >> (32 + 4 * h));
#pragma unroll
                for (int r = 0; r < 16; ++r) {
                    const int kr = (r & 3) + 8 * (r >> 2);
                    s0[r] = ((mlo >> kr) & 1u) ? s0[r] : -1e30f;
                    s1[r] = ((mhi >> kr) & 1u) ? s1[r] : -1e30f;
                }
            } else if (__builtin_amdgcn_readfirstlane(kt * 64 + 63 - wq0) > 0) {
                asm volatile("" ::: "memory");
                const int qrel = q - kt * 64 - 4 * h;
#pragma unroll
                for (int r = 0; r < 16; ++r) {
                    const int kr = (r & 3) + 8 * (r >> 2);
                    s0[r] = (kr <= qrel) ? s0[r] : -1e30f;
                    s1[r] = (kr + 32 <= qrel) ? s1[r] : -1e30f;
                }
            }
            float mx;
            {
                float t0 = max3f(s0[0], s0[1], s0[2]), t1 = max3f(s0[3], s0[4], s0[5]), t2 = max3f(s0[6], s0[7], s0[8]), t3 = max3f(s0[9], s0[10], s0[11]);
                float t4 = max3f(s0[12], s0[13], s0[14]), t5 = max3f(s0[15], s1[0], s1[1]), t6 = max3f(s1[2], s1[3], s1[4]), t7 = max3f(s1[5], s1[6], s1[7]);
                float t8 = max3f(s1[8], s1[9], s1[10]), t9 = max3f(s1[11], s1[12], s1[13]), t10 = max3f(s1[14], s1[15], t0);
                t1 = max3f(t1, t2, t3); t4 = max3f(t4, t5, t6); t7 = max3f(t7, t8, t9);
                mx = max3f(t1, t4, t7); mx = max3f(mx, t10, __shfl_xor(max3f(t1, t4, max3f(t7, t10, t10)), 32));
            }
            const float m_new = max3f(m_run, mx, mx);
            const float m_use = (MODE == 2) ? max3f(m_new, -1e20f, -1e20f) : m_new;
            const float alpha = ex2((m_run - m_new) * scx);
            const float nm = -m_use * scx;
            f32x2 rs2 = {0.f, 0.f};
            const f32x2 sc2v = {scx, scx}, nm2 = {nm, nm};
#pragma unroll
            for (int r = 0; r < 16; r += 2) {
                f32x2 xv = {s0[r], s0[r + 1]};
                xv = xv * sc2v + nm2;
                xv[0] = ex2(xv[0]); xv[1] = ex2(xv[1]);
                s0[r] = xv[0]; s0[r + 1] = xv[1];
                rs2 += xv;
                f32x2 yv = {s1[r], s1[r + 1]};
                yv = yv * sc2v + nm2;
                yv[0] = ex2(yv[0]); yv[1] = ex2(yv[1]);
                s1[r] = yv[0]; s1[r + 1] = yv[1];
                rs2 += yv;
            }
            float rsum = rs2[0] + rs2[1];
            rsum += __shfl_xor(rsum, 32);
            l_run = l_run * alpha + rsum; m_run = m_new;
            if (__any(alpha != 1.0f)) {
#pragma unroll
                for (int r = 0; r < 16; ++r) { o0[r] *= alpha; o1[r] *= alpha; }
            }
#pragma unroll
            for (int sub = 0; sub < 2; ++sub)
#pragma unroll
                for (int s2 = 0; s2 < 2; ++s2) {
                    const bf16x8 pb = pack8(sub ? s1 : s0, s2);
                    const int koff = sub * 32 + 16 * s2 + 4 * h;
                    {
                        const u16* vr = Vs + l31 * AT_LDV + koff;
                        const uint2 lo = *(const uint2*)vr, hi = *(const uint2*)(vr + 8);
                        o0 = MFMA32(__builtin_bit_cast(bf16x8, make_uint4(lo.x, lo.y, hi.x, hi.y)), pb, o0);
                    }
                    {
                        const u16* vr = Vs + (32 + l31) * AT_LDV + koff;
                        const uint2 lo = *(const uint2*)vr, hi = *(const uint2*)(vr + 8);
                        o1 = MFMA32(__builtin_bit_cast(bf16x8, make_uint4(lo.x, lo.y, hi.x, hi.y)), pb, o1);
                    }
                }
        }
        if (more) sstore((kt + 1) & 1);
        if (MODE == 2) mw_cur = mw_nxt;
        __syncthreads();
    }
    {
        const float inv = 1.f / l_run;
        u16* act = (u16*)(ws + WS_ACT) + (size_t)(b * 4096 + q) * 1024 + ocol;
#pragma unroll
        for (int qd = 0; qd < 4; ++qd) {
            uint2 pk;
            pk.x = pack2(o0[4 * qd] * inv, o0[4 * qd + 1] * inv); pk.y = pack2(o0[4 * qd + 2] * inv, o0[4 * qd + 3] * inv);
            *(uint2*)(act + 8 * qd + 4 * h) = pk;
            pk.x = pack2(o1[4 * qd] * inv, o1[4 * qd + 1] * inv); pk.y = pack2(o1[4 * qd + 2] * inv, o1[4 * qd + 3] * inv);
            *(uint2*)(act + 32 + 8 * qd + 4 * h) = pk;
        }
    }
}

constexpr int SC_LD = 4100;
DI void dsa_index_item(const Ctx& c_in, KArgs& a, int item) {
    const Ctx c = fresh_ctx(c_in.lds);
    unsigned char* ws = a.ws;
    const u16* proj = (const u16*)(ws + WS_PROJ);
    const float* small = (const float*)(ws + WS_SMALL);
    u64* mask = (u64*)(ws + WS_MASK);
    float* SC = (float*)c.lds;
    unsigned* HIST = (unsigned*)(c.lds + 8 * SC_LD * 4);
    const int l31 = c.lane & 31, h = c.lane >> 5;
    const int sg = 511 - (item >> 3), b = item & 7, s0 = sg * 8;
    const int tok0 = b * 4096 + s0;
    const int ntile = ((s0 + 7) >> 5) + 1;
    bf16x8 qa[2][4];
    float wv[2][16];
#pragma unroll
    for (int rt = 0; rt < 2; ++rt) {
        const int r = rt * 32 + l31, ql = r >> 3, j = r & 7;
        const u16* p = proj + (size_t)(tok0 + ql) * LDP + PC_IDXQ + j * 64 + h * 8;
#pragma unroll
        for (int ks = 0; ks < 4; ++ks) qa[rt][ks] = *(const bf16x8*)(p + ks * 16);
#pragma unroll
        for (int r2 = 0; r2 < 16; ++r2) {
            const int qq = (r2 >> 2) + 4 * rt, jj = (r2 & 3) + 4 * h;
            wv[rt][r2] = small[(size_t)(tok0 + qq) * 16 + 4 + jj] * 0.044194173824159216f;
        }
    }
    const u16* kbase = proj + (size_t)(b * 4096 + l31) * LDP + PC_IDXK + h * 8;
    bf16x8 kb[4], kn[4];
    if (c.wave < ntile) {
#pragma unroll
        for (int ks = 0; ks < 4; ++ks) kb[ks] = *(const bf16x8*)(kbase + (size_t)(c.wave * 32) * LDP + ks * 16);
    }
    for (int kt = c.wave; kt < ntile; kt += 8) {
        const int key = kt * 32 + l31;
        if (kt + 8 < ntile) {
#pragma unroll
            for (int ks = 0; ks < 4; ++ks) kn[ks] = *(const bf16x8*)(kbase + (size_t)((kt + 8) * 32) * LDP + ks * 16);
        }
        f32x16 a0 = zero16(), a1 = zero16();
#pragma unroll
        for (int ks = 0; ks < 4; ++ks) { a0 = MFMA32(qa[0][ks], kb[ks], a0); a1 = MFMA32(qa[1][ks], kb[ks], a1); }
#pragma unroll
        for (int g = 0; g < 4; ++g) {
            float p0 = 0.f, p1 = 0.f;
#pragma unroll
            for (int r3 = 0; r3 < 4; ++r3) {
                p0 += wv[0][4 * g + r3] * fmaxf(a0[4 * g + r3], 0.f);
                p1 += wv[1][4 * g + r3] * fmaxf(a1[4 * g + r3], 0.f);
            }
            const float t0 = p0 + __shfl_xor(p0, 32);
            const float t1 = p1 + __shfl_xor(p1, 32);
            SC[(4 * h + g) * SC_LD + key] = h ? t1 : t0;
        }
#pragma unroll
        for (int ks = 0; ks < 4; ++ks) kb[ks] = kn[ks];
    }
    __syncthreads();
    {
        const int qi = s0 + c.wave, n = qi + 1;
        const float* sc = SC + c.wave * SC_LD;
        unsigned* hist = HIST + c.wave * 272;
        const int nit = (n + 63) >> 6;
        unsigned key[64];
#pragma unroll
        for (int g = 0; g < 8; ++g) {
#pragma unroll
            for (int j = 0; j < 8; ++j) key[g * 8 + j] = 0u;
            if (g * 8 < nit) {
#pragma unroll
                for (int j = 0; j < 8; ++j) {
                    const int i = (g * 8 + j) * 64 + c.lane;
                    const unsigned bits = __float_as_uint(sc[i] + 0.0f);
                    const unsigned k = bits ^ ((unsigned)((int)bits >> 31) | 0x80000000u);
                    key[g * 8 + j] = (i < n) ? k : 0u;
                }
            }
        }
        unsigned thr = 1u; int cut = 0x7fffffff;
        if (n > 256) {
            unsigned lo = 0xffffffffu, hi = 0u;
#pragma unroll
            for (int g = 0; g < 8; ++g) if (g * 8 < nit) {
#pragma unroll
                for (int j = 0; j < 8; ++j) { const unsigned k = key[g * 8 + j]; hi = max(hi, k); lo = min(lo, k ? k : 0xffffffffu); }
            }
#pragma unroll
            for (int o = 32; o >= 1; o >>= 1) { lo = min(lo, (unsigned)__shfl_xor((int)lo, o)); hi = max(hi, (unsigned)__shfl_xor((int)hi, o)); }
            int kk = 256;
            for (int iter = 0; iter < 5; ++iter) {
                const unsigned width = hi - lo;
                const int shift = max(0, 24 - (int)__clz(width | 1u));
#pragma unroll
                for (int j = 0; j < 5; ++j) { const int idx = c.lane + 64 * j; if (idx < 272) hist[idx] = 0u; }
#pragma unroll
                for (int g = 0; g < 8; ++g) if (g * 8 < nit) {
#pragma unroll
                    for (int j = 0; j < 8; ++j) {
                        const unsigned d = key[g * 8 + j] - lo;
                        if (d <= width) atomicAdd(&hist[d >> shift], 1u);
                    }
                }
                const unsigned c0 = hist[4 * c.lane], c1 = hist[4 * c.lane + 1], c2 = hist[4 * c.lane + 2], c3 = hist[4 * c.lane + 3];
                const unsigned ls = c0 + c1 + c2 + c3;
                unsigned suf = ls;
#pragma unroll
                for (int o = 1; o < 64; o <<= 1) { const unsigned tv = __shfl_down(suf, o); if (c.lane + o < 64) suf += tv; }
                const unsigned above_lane = suf - ls;
                const bool mine = (suf >= (unsigned)kk) && (above_lane < (unsigned)kk);
                int bstar = 0; unsigned above = 0, cntb = 0;
                if (mine) {
                    unsigned run = above_lane;
                    if (run + c3 >= (unsigned)kk) { bstar = 4 * c.lane + 3; above = run; cntb = c3; }
                    else { run += c3;
                        if (run + c2 >= (unsigned)kk) { bstar = 4 * c.lane + 2; above = run; cntb = c2; }
                        else { run += c2;
                            if (run + c1 >= (unsigned)kk) { bstar = 4 * c.lane + 1; above = run; cntb = c1; }
                            else { run += c1; bstar = 4 * c.lane; above = run; cntb = c0; } } }
                }
                const u64 mm = __ballot(mine);
                const int src = __ffsll((long long)mm) - 1;
                bstar = __shfl(bstar, src); above = __shfl(above, src); cntb = __shfl(cntb, src);
                kk -= (int)above;
                const unsigned nlo = lo + ((unsigned)bstar << shift);
                const unsigned nhi = min(hi, nlo + ((1u << shift) - 1u));
                lo = nlo; hi = nhi; thr = lo;
                if ((int)cntb == kk) break;
                if (shift == 0) {
                    int need = kk;
                    for (int it = 0; it < nit; ++it) {
                        const int i = it * 64 + c.lane;
                        unsigned k = 0u;
                        if (i < n) { const unsigned bits = __float_as_uint(sc[i] + 0.0f); k = bits ^ ((unsigned)((int)bits >> 31) | 0x80000000u); }
                        const bool e = (k == thr);
                        const u64 mk = __ballot(e); const int cn = __popcll(mk);
                        if (need <= cn) {
                            const u64 sel = __ballot(e && (__popcll(mk & ((1ull << c.lane) - 1ull)) == need - 1));
                            cut = it * 64 + (__ffsll((long long)sel) - 1);
                            break;
                        }
                        need -= cn;
                    }
                    break;
                }
            }
        }
        u64* mrow = mask + (size_t)(b * 4096 + qi) * 64;
        u64 myword = 0;
        const bool tie = (cut != 0x7fffffff);
#pragma unroll
        for (int it = 0; it < 64; ++it) {
            u64 wd = 0;
            if (it < nit) {
                const unsigned k = key[it];
                bool sel = (k >= thr);
                if (tie) sel = (k > thr) || (k == thr && (it * 64 + c.lane) <= cut);
                wd = __ballot(sel);
            }
            if (c.lane == it) myword = wd;
        }
        mrow[c.lane] = myword;
    }
    __syncthreads();
}

DI void phase_outproj(const Ctx& c_in, KArgs& a, int l) {
    const Ctx c = fresh_ctx(c_in.lds);
    unsigned char* ws = a.ws;
    const u16* act = (const u16*)(ws + WS_ACT);
    const u16* w = (const u16*)(ws + WS_WOUT) + (size_t)l * 1024 * 1024;
    const float* xin = (l == 0) ? a.in[0] : a.out;
    float* out = a.out;
    const int r8 = c.tid >> 3;
    const int wm = c.wave & 3, wn = c.wave >> 2, l31 = c.lane & 31, h = c.lane >> 5;
    const int ntiles = (T_TOK / 256) * 8;
    for (int tile = vblock(); tile < ntiles; tile += gridDim.x) {
        const int mt = (tile >> 5) * 4 + (tile & 3), nt = (tile >> 2) & 7;
        GP gp;
        gp.a0 = act + (size_t)(mt * 256 + r8) * 1024; gp.a1 = gp.a0 + 64 * 1024; gp.a2 = gp.a0 + 128 * 1024; gp.a3 = gp.a0 + 192 * 1024;
        gp.b0 = w + (size_t)(nt * 128 + r8) * 1024; gp.b1 = gp.b0 + 64 * 1024;
        f32x16 acc[2][2];
        acc[0][0] = zero16(); acc[0][1] = zero16(); acc[1][0] = zero16(); acc[1][1] = zero16();
        gemm_core<false>(c, 1024, gp, acc);
#pragma unroll
        for (int i = 0; i < 2; ++i)
#pragma unroll
            for (int j = 0; j < 2; ++j) {
                const int m0 = mt * 256 + wm * 64 + i * 32, n = nt * 128 + wn * 64 + j * 32 + l31;
#pragma unroll
                for (int r = 0; r < 16; ++r) acc[i][j][r] += xin[(size_t)(m0 + crow(r, h)) * 1024 + n];
            }
#pragma unroll
        for (int i = 0; i < 2; ++i)
#pragma unroll
            for (int j = 0; j < 2; ++j) {
                const int m0 = mt * 256 + wm * 64 + i * 32, n = nt * 128 + wn * 64 + j * 32 + l31;
#pragma unroll
                for (int r = 0; r < 16; ++r) out[(size_t)(m0 + crow(r, h)) * 1024 + n] = acc[i][j][r];
            }
    }
}

constexpr int RT_LD = 1032;
DI void phase_router(const Ctx& c_in, KArgs& a, int l) {
    const Ctx c = fresh_ctx(c_in.lds);
    unsigned char* ws = a.ws;
    const float* x = a.out;
    const float* g = a.in[16] + l * 1024;
    const float* brg = a.in[18] + l * 4;
    const float* bre = a.in[20] + l * 32;
    const u16* wrh = (const u16*)(ws + WS_WRH) + (size_t)l * 64 * 1024;
    const u16* wrl = (const u16*)(ws + WS_WRL) + (size_t)l * 64 * 1024;
    u16* act = (u16*)(ws + WS_ACT);
    int* cnt = (int*)(ws + WS_CTL);
    int* list = (int*)(ws + WS_LIST);
    float* tokw = (float*)(ws + WS_TOKW);
    u16* HI = (u16*)c.lds;
    u16* LO = HI + 32 * RT_LD;
    float* LG = (float*)(c.lds + 2 * 32 * RT_LD * 2);
    const int l31 = c.lane & 31, h = c.lane >> 5;
    for (int it = blockIdx.x; it < T_TOK / 32; it += gridDim.x) {
        const int t0 = it * 32;
#pragma unroll
        for (int tt = 0; tt < 4; ++tt) {
            const int tl = c.wave * 4 + tt, t = t0 + tl;
            const float* xr = x + (size_t)t * 1024 + c.lane * 4;
            float4 v[4]; float ss = 0.f;
#pragma unroll
            for (int j = 0; j < 4; ++j) { v[j] = *(const float4*)(xr + 256 * j); ss += v[j].x * v[j].x + v[j].y * v[j].y + v[j].z * v[j].z + v[j].w * v[j].w; }
            ss = wsum(ss);
            const float rs = rsqrtf(ss * (1.f / 1024.f) + EPS);
#pragma unroll
            for (int j = 0; j < 4; ++j) {
                const float4 gg = *(const float4*)(g + c.lane * 4 + 256 * j);
                const float h0 = v[j].x * rs * gg.x, h1 = v[j].y * rs * gg.y, h2 = v[j].z * rs * gg.z, h3 = v[j].w * rs * gg.w;
                const u16 b0 = f2bf(h0), b1 = f2bf(h1), b2 = f2bf(h2), b3 = f2bf(h3);
                const uint2 hp = make_uint2((unsigned)b0 | ((unsigned)b1 << 16), (unsigned)b2 | ((unsigned)b3 << 16));
                const uint2 lp = make_uint2(pack2(h0 - bf2f(b0), h1 - bf2f(b1)), pack2(h2 - bf2f(b2), h3 - bf2f(b3)));
                *(uint2*)(act + (size_t)t * 1024 + c.lane * 4 + 256 * j) = hp;
                *(uint2*)(HI + tl * RT_LD + c.lane * 4 + 256 * j) = hp;
                *(uint2*)(LO + tl * RT_LD + c.lane * 4 + 256 * j) = lp;
            }
        }
        __syncthreads();
        {
            const int k0 = c.wave * 128 + h * 8;
            f32x16 acc0 = zero16(), acc1 = zero16();
#pragma unroll
            for (int ks = 0; ks < 8; ++ks) {
                const int k = k0 + ks * 16;
                const bf16x8 ah = *(const bf16x8*)(HI + l31 * RT_LD + k);
                const bf16x8 al = *(const bf16x8*)(LO + l31 * RT_LD + k);
                const bf16x8 bh0 = *(const bf16x8*)(wrh + (size_t)l31 * 1024 + k);
                const bf16x8 bh1 = *(const bf16x8*)(wrh + (size_t)(32 + l31) * 1024 + k);
                const bf16x8 bl0 = *(const bf16x8*)(wrl + (size_t)l31 * 1024 + k);
                const bf16x8 bl1 = *(const bf16x8*)(wrl + (size_t)(32 + l31) * 1024 + k);
                acc0 = MFMA32(ah, bh0, acc0); acc0 = MFMA32(ah, bl0, acc0); acc0 = MFMA32(al, bh0, acc0);
                acc1 = MFMA32(ah, bh1, acc1); acc1 = MFMA32(ah, bl1, acc1); acc1 = MFMA32(al, bh1, acc1);
            }
            __syncthreads();
            float* PART = (float*)c.lds + c.wave * (32 * 37);
#pragma unroll
            for (int r = 0; r < 16; ++r) {
                PART[crow(r, h) * 37 + l31] = acc0[r];
                if (l31 < 4) PART[crow(r, h) * 37 + 32 + l31] = acc1[r];
            }
        }
        __syncthreads();
        for (int i = c.tid; i < 32 * 36; i += NTHR) {
            const int tk = i / 36, e = i % 36;
            float s = 0.f;
#pragma unroll
            for (int w2 = 0; w2 < 8; ++w2) s += ((const float*)c.lds)[w2 * (32 * 37) + tk * 37 + e];
            LG[tk * 65 + e] = s;
        }
        __syncthreads();
        if (c.tid < 32) {
            const int t = t0 + c.tid;
            const float* lg = LG + c.tid * 65;
            float gl[4];
#pragma unroll
            for (int e = 0; e < 4; ++e) gl[e] = lg[e] + brg[e];
            int gi = 0; float gm = gl[0];
#pragma unroll
            for (int e = 1; e < 4; ++e) if (gl[e] > gm) { gm = gl[e]; gi = e; }
            float den = 0.f;
#pragma unroll
            for (int e = 0; e < 4; ++e) den += __expf(gl[e] - gm);
            const float gp = 1.f / den;
            float el[8];
#pragma unroll
            for (int e = 0; e < 8; ++e) el[e] = lg[4 + gi * 8 + e] + bre[gi * 8 + e];
            int i1 = 0; float v1 = el[0];
#pragma unroll
            for (int e = 1; e < 8; ++e) if (el[e] > v1) { v1 = el[e]; i1 = e; }
            int i2 = 0; float v2 = -INFINITY;
#pragma unroll
            for (int e = 0; e < 8; ++e) if (e != i1 && el[e] > v2) { v2 = el[e]; i2 = e; }
            const float ex = __expf(v2 - v1);
            const float w1 = gp / (1.f + ex), w2 = gp * ex / (1.f + ex);
            const int e1 = gi * 8 + i1, e2 = gi * 8 + i2;
            const int s1 = atomicAdd(&cnt[e1 * 2 + 0], 1);
            list[(size_t)(e1 * 2 + 0) * 32768 + s1] = t;
            const int s2 = atomicAdd(&cnt[e2 * 2 + 1], 1);
            list[(size_t)(e2 * 2 + 1) * 32768 + s2] = t;
            tokw[t * 2] = w1; tokw[t * 2 + 1] = w2;
        }
        __syncthreads();
    }
}

DI int moe_setup(const Ctx& c, KArgs& a, int ntn, int kfilter, int* tstart  ) {
    const int* cnt = (const int*)(a.ws + WS_CTL);
    if (c.tid == 0) {
        int run = 0;
        for (int L = 0; L < 64; ++L) {
            tstart[L] = run;
            const int n = __hip_atomic_load(&cnt[L], __ATOMIC_RELAXED, __HIP_MEMORY_SCOPE_AGENT);
            if (kfilter < 0 || (L & 1) == kfilter) run += ((n + 255) >> 8) * ntn;
        }
        tstart[64] = run;
    }
    __syncthreads();
    return tstart[64];
}

DI void phase_moe_up(const Ctx& c_in, KArgs& a) {
    const Ctx c = fresh_ctx(c_in.lds);
    unsigned char* ws = a.ws;
    const u16* act = (const u16*)(ws + WS_ACT);
    const int* cnt = (const int*)(ws + WS_CTL);
    const int* list = (const int*)(ws + WS_LIST);
    const float* tokw = (const float*)(ws + WS_TOKW);
    u16* hmid = (u16*)(ws + WS_HMID);
    int* tstart = (int*)(c.lds + G_LDS_BYTES);
    int* tok_s = (int*)(c.lds + G_LDS_BYTES + 512);
    const int r8 = c.tid >> 3;
    const int wm = c.wave & 3, wn = c.wave >> 2, l31 = c.lane & 31, h = c.lane >> 5;
    const int total = moe_setup(c, a, 4, -1, tstart);
    for (int tile = vblock(); tile < total; tile += gridDim.x) {
        int L = 0;
        for (int j = 0; j < 64; ++j) if (tstart[j + 1] <= tile) L = j + 1;
        const int rel = tile - tstart[L], mi = rel >> 2, nt = rel & 3;
        const int e = L >> 1, kr = L & 1;
        const int n = __hip_atomic_load(&cnt[L], __ATOMIC_RELAXED, __HIP_MEMORY_SCOPE_AGENT);
        __syncthreads();
        if (c.tid < 256) { const int r = mi * 256 + c.tid; tok_s[c.tid] = (r < n) ? list[(size_t)L * 32768 + r] : -1; }
        __syncthreads();
        GP gp;
        { const int t0 = tok_s[r8], t1 = tok_s[r8 + 64], t2 = tok_s[r8 + 128], t3 = tok_s[r8 + 192];
          gp.a0 = act + (size_t)(t0 < 0 ? 0 : t0) * 1024; gp.a1 = act + (size_t)(t1 < 0 ? 0 : t1) * 1024;
          gp.a2 = act + (size_t)(t2 < 0 ? 0 : t2) * 1024; gp.a3 = act + (size_t)(t3 < 0 ? 0 : t3) * 1024; }
        gp.b0 = (const u16*)(ws + WS_WG) + ((size_t)e * 256 + nt * 64 + r8) * 1024;
        gp.b1 = (const u16*)(ws + WS_WU) + ((size_t)e * 256 + nt * 64 + r8) * 1024;
        f32x16 acc[2][2];
        acc[0][0] = zero16(); acc[0][1] = zero16(); acc[1][0] = zero16(); acc[1][1] = zero16();
        gemm_core<true>(c, 1024, gp, acc);
#pragma unroll
        for (int i = 0; i < 2; ++i) {
            const int nn = nt * 64 + wn * 32 + l31;
#pragma unroll
            for (int r = 0; r < 16; ++r) {
                const int ml = wm * 64 + i * 32 + crow(r, h);
                const int tk = tok_s[ml];
                if (tk >= 0) {
                    const float gv = acc[i][0][r], uv = acc[i][1][r];
                    hmid[((size_t)tk * 2 + kr) * 256 + nn] = f2bf(siluf(gv) * uv * tokw[tk * 2 + kr]);
                }
            }
        }
    }
}

DI void phase_moe_down(const Ctx& c_in, KArgs& a, int kpass) {
    const Ctx c = fresh_ctx(c_in.lds);
    unsigned char* ws = a.ws;
    const int* cnt = (const int*)(ws + WS_CTL);
    const int* list = (const int*)(ws + WS_LIST);
    const u16* hmid = (const u16*)(ws + WS_HMID);
    float* out = a.out;
    int* tstart = (int*)(c.lds + G_LDS_BYTES);
    int* tok_s = (int*)(c.lds + G_LDS_BYTES + 512);
    const int r8 = c.tid >> 3;
    const int wm = c.wave & 3, wn = c.wave >> 2, l31 = c.lane & 31, h = c.lane >> 5;
    const int total = moe_setup(c, a, 8, kpass, tstart);
    for (int tile = vblock(); tile < total; tile += gridDim.x) {
        int L = 0;
        for (int j = 0; j < 64; ++j) if (tstart[j + 1] <= tile) L = j + 1;
        const int rel = tile - tstart[L], mi = rel >> 3, nt = rel & 7;
        const int e = L >> 1;
        const int n = __hip_atomic_load(&cnt[L], __ATOMIC_RELAXED, __HIP_MEMORY_SCOPE_AGENT);
        __syncthreads();
        if (c.tid < 256) { const int r = mi * 256 + c.tid; tok_s[c.tid] = (r < n) ? list[(size_t)L * 32768 + r] : -1; }
        __syncthreads();
        GP gp;
        { const int t0 = tok_s[r8], t1 = tok_s[r8 + 64], t2 = tok_s[r8 + 128], t3 = tok_s[r8 + 192];
          gp.a0 = hmid + ((size_t)(t0 < 0 ? 0 : t0) * 2 + kpass) * 256; gp.a1 = hmid + ((size_t)(t1 < 0 ? 0 : t1) * 2 + kpass) * 256;
          gp.a2 = hmid + ((size_t)(t2 < 0 ? 0 : t2) * 2 + kpass) * 256; gp.a3 = hmid + ((size_t)(t3 < 0 ? 0 : t3) * 2 + kpass) * 256; }
        gp.b0 = (const u16*)(ws + WS_WD) + ((size_t)e * 1024 + nt * 128 + r8) * 256; gp.b1 = gp.b0 + 64 * 256;
        f32x16 acc[2][2];
        acc[0][0] = zero16(); acc[0][1] = zero16(); acc[1][0] = zero16(); acc[1][1] = zero16();
        gemm_core<false>(c, 256, gp, acc);
#pragma unroll
        for (int i = 0; i < 2; ++i) {
            int tkr[16];
#pragma unroll
            for (int r = 0; r < 16; ++r) tkr[r] = tok_s[wm * 64 + i * 32 + crow(r, h)];
#pragma unroll
            for (int j = 0; j < 2; ++j) {
                const int nn = nt * 128 + wn * 64 + j * 32 + l31;
#pragma unroll
                for (int r = 0; r < 16; ++r) if (tkr[r] >= 0) acc[i][j][r] += out[(size_t)tkr[r] * 1024 + nn];
            }
#pragma unroll
            for (int j = 0; j < 2; ++j) {
                const int nn = nt * 128 + wn * 64 + j * 32 + l31;
#pragma unroll
                for (int r = 0; r < 16; ++r) if (tkr[r] >= 0) out[(size_t)tkr[r] * 1024 + nn] = acc[i][j][r];
            }
        }
    }
}

DI void phase_final(const Ctx& c_in, KArgs& a) {
    const Ctx c = fresh_ctx(c_in.lds);
    float* x = a.out;
    const float* g = a.in[24];
    for (int it = blockIdx.x; it < T_TOK / 8; it += gridDim.x) {
        const int t = it * 8 + c.wave;
        float* xr = x + (size_t)t * 1024;
        float v[16]; float ss = 0.f;
#pragma unroll
        for (int j = 0; j < 16; ++j) { v[j] = xr[c.lane + 64 * j]; ss += v[j] * v[j]; }
        ss = wsum(ss);
        const float rs = rsqrtf(ss * (1.f / 1024.f) + EPS);
#pragma unroll
        for (int j = 0; j < 16; ++j) xr[c.lane + 64 * j] = v[j] * rs * g[c.lane + 64 * j];
    }
}

#define XB_TMO      128
#define XB_XCNT(j)  (256  + 64 * (j))
#define XB_XSUB(j)  (1280 + 64 * (j))
#define XB_XGEN(j)  (2304 + 64 * (j))
#define XB_TOP      3328
#define XB_TOPGEN   3392
#define XCD_BAR_WORDS 3456
#define XB_SPIN_CAP (1u << 22)
#define LAS __attribute__((address_space(3)))
DI unsigned xb_ld(unsigned* p)              { return __hip_atomic_load(p, __ATOMIC_RELAXED, __HIP_MEMORY_SCOPE_AGENT); }
DI unsigned xb_add(unsigned* p, unsigned v) { return __hip_atomic_fetch_add(p, v, __ATOMIC_RELAXED, __HIP_MEMORY_SCOPE_AGENT); }
DI unsigned xb_xcc_id() { return (unsigned)__builtin_amdgcn_s_getreg((3 << 11) | 20) & 0xFu; }
#define XB_SPIN(cond, bar) do { unsigned _sp = 0; while (cond) { __builtin_amdgcn_s_sleep(1); \
    if ((++_sp & 255u) == 0u) { if (xb_ld(&(bar)[XB_TMO])) break; if (_sp > XB_SPIN_CAP) { atomicAdd(&(bar)[XB_TMO], 1u); break; } } } } while (0)
struct XcdBarrier { unsigned* bar; unsigned x; volatile LAS unsigned* st; };
DI XcdBarrier xcd_barrier_post(unsigned* bar, volatile LAS unsigned* st) {
    XcdBarrier b; b.bar = bar; b.x = xb_xcc_id(); b.st = st;
    if (threadIdx.x == 0) (void)xb_add(&bar[XB_XCNT(b.x)], 1u);
    return b;
}
DI void xcd_barrier_complete(unsigned* bar, unsigned x, unsigned& nloc, unsigned& nx) {
    const unsigned G = gridDim.x * gridDim.y * gridDim.z;
    unsigned sum, cnt, mine, sp = 0u;
    for (;;) {
        sum = 0u; cnt = 0u; mine = 0u;
#pragma unroll
        for (unsigned j = 0; j < 16; ++j) { const unsigned cc = xb_ld(&bar[XB_XCNT(j)]); sum += cc; cnt += (cc > 0u) ? 1u : 0u; mine = (j == x) ? cc : mine; }
        if (sum == G) break;
        __builtin_amdgcn_s_sleep(1);
        if ((++sp & 255u) == 0u) { if (xb_ld(&bar[XB_TMO])) break; if (sp > XB_SPIN_CAP) { atomicAdd(&bar[XB_TMO], 1u); break; } }
    }
    nloc = mine > 0u ? mine : 1u; nx = cnt > 0u ? cnt : 1u;
}
DI void xcd_barrier(const XcdBarrier& b) {
    asm volatile("s_waitcnt vmcnt(0)" ::: "memory");
    __syncthreads();
    if (threadIdx.x == 0) {
        unsigned* bar = b.bar;
        __builtin_amdgcn_s_waitcnt(0);
        unsigned nloc = b.st[0], nx = b.st[1];
        if (nloc == 0u) { xcd_barrier_complete(bar, b.x, nloc, nx); b.st[0] = nloc; b.st[1] = nx; }
        const unsigned old = xb_add(&bar[XB_XSUB(b.x)], 1u);
        const unsigned gen = old / nloc;
        if (old + 1u == (gen + 1u) * nloc) {
            __builtin_amdgcn_fence(__ATOMIC_RELEASE, "agent");
            asm volatile("s_waitcnt vmcnt(0)" ::: "memory");
            const unsigned og = xb_add(&bar[XB_TOP], 1u);
            const unsigned tg = og / nx;
            if (og + 1u == (tg + 1u) * nx) xb_add(&bar[XB_TOPGEN], 1u);
            else XB_SPIN(xb_ld(&bar[XB_TOPGEN]) == tg, bar);
            __builtin_amdgcn_fence(__ATOMIC_ACQUIRE, "agent");
            xb_add(&bar[XB_XGEN(b.x)], 1u);
            asm volatile("s_waitcnt vmcnt(0)" ::: "memory");
        } else {
            XB_SPIN(xb_ld(&bar[XB_XGEN(b.x)]) == gen, bar);
            __builtin_amdgcn_fence(__ATOMIC_ACQUIRE, "agent");
            asm volatile("s_waitcnt vmcnt(0)" ::: "memory");
        }
    }
    __syncthreads();
}

template <int SP>
DI void run_phase(const Ctx& c, KArgs& a, int l) {
    if constexpr (SP == 11) phase_prep(c, a);
    else if constexpr (SP == 12) phase_final(c, a);
    else if constexpr (SP == 0) phase_norm_in(c, a, l);
    else if constexpr (SP == 1) phase_inproj(c, a, l);
    else if constexpr (SP == 2) {
        const int n_ssd = 256, n_q = 128 * 3, n_kv = 128 * 4, n_tok = T_TOK / 8;
        for (int it = blockIdx.x; it < n_ssd + n_q + n_kv + n_tok; it += gridDim.x) {
            if (it < n_ssd) ssd_state_item(c, a, l, it);
            else if (it < n_ssd + n_q) mla_up_item(c, a, l, 0, it - n_ssd);
            else if (it < n_ssd + n_q + n_kv) mla_up_item(c, a, l, 1, it - n_ssd - n_q);
            else token_post_item(c, a, l, it - n_ssd - n_q - n_kv);
        }
    }
    else if constexpr (SP == 3) { for (int it = blockIdx.x; it < 512; it += gridDim.x) ssd_scan_item(c, a, it); }
    else if constexpr (SP == 4) {
        const int n_at = 512, n_ssd = 256, n_idx = 4096;
        for (int it = blockIdx.x; it < 2 * n_at + n_ssd + n_idx; it += gridDim.x) {
            if (it < 2 * n_at) { if (it & 1) attn_item<64, 1>(c, a, it >> 1); else attn_item<96, 0>(c, a, it >> 1); }
            else if (it < 2 * n_at + n_ssd) ssd_out_item(c, a, l, it - 2 * n_at);
            else dsa_index_item(c, a, it - 2 * n_at - n_ssd);
            __syncthreads();
        }
    }
    else if constexpr (SP == 5) { for (int it = blockIdx.x; it < 512; it += gridDim.x) { attn_item<64, 2>(c, a, it); __syncthreads(); } }
    else if constexpr (SP == 6) phase_outproj(c, a, l);
    else if constexpr (SP == 7) phase_router(c, a, l);
    else if constexpr (SP == 8) phase_moe_up(c, a);
    else if constexpr (SP == 9) phase_moe_down(c, a, 0);
    else if constexpr (SP == 10) phase_moe_down(c, a, 1);
}

#ifndef ONE_LAUNCH
#define ONE_LAUNCH 1
#endif

#if ONE_LAUNCH
__global__ void __launch_bounds__(NTHR) mega(Args a_unused) {
    extern __shared__ __attribute__((aligned(16))) unsigned char lds[];
    cg::grid_group grid = cg::this_grid();
    Ctx c; c.tid = threadIdx.x; c.lane = c.tid & 63; c.wave = 0; c.lds = lds;
    volatile LAS unsigned* st = (volatile LAS unsigned*)(lds + LDS_BYTES - 16);
    if (threadIdx.x == 0) { st[0] = 0u; st[1] = 0u; }
    __syncthreads();
    XcdBarrier bar = xcd_barrier_post((unsigned*)(a_unused.ws + WS_BAR), st);
    for (int ph = 0; ph < 24; ++ph) {
        if (ph == 1) grid.sync();
        else if (ph > 1) xcd_barrier(bar);
        KArgs* kp = (KArgs*)__builtin_amdgcn_kernarg_segment_ptr();
        asm volatile("" : "+s"(kp));
        KArgs& a = *kp;
        const int l = (ph - 1) / 11;
        const int sp = (ph == 0) ? 11 : (ph == 23) ? 12 : (ph - 1) % 11;
#ifdef PROBE_SP
        unsigned long long pt0 = 0; if (sp == PROBE_SP) pt0 = __builtin_amdgcn_s_memrealtime();
#endif
        switch (sp) {
        case 0: run_phase<0>(c, a, l); break;
        case 1: run_phase<1>(c, a, l); break;
        case 2: run_phase<2>(c, a, l); break;
        case 3: run_phase<3>(c, a, l); break;
        case 4: run_phase<4>(c, a, l); break;
        case 5: run_phase<5>(c, a, l); break;
        case 6: run_phase<6>(c, a, l); break;
        case 7: run_phase<7>(c, a, l); break;
        case 8: run_phase<8>(c, a, l); break;
        case 9: run_phase<9>(c, a, l); break;
        case 10: run_phase<10>(c, a, l); break;
        case 11: run_phase<11>(c, a, l); break;
        default: run_phase<12>(c, a, l); break;
        }
#ifdef PROBE_SP
        if (sp == PROBE_SP) {
            xcd_barrier(bar);
            const unsigned long long pt1 = __builtin_amdgcn_s_memrealtime();
            while (__builtin_amdgcn_s_memrealtime() - pt1 < (pt1 - pt0)) __builtin_amdgcn_s_sleep(8);
        }
#endif
    }
}
#else
template <int SP>
__global__ void __launch_bounds__(NTHR) kphase(Args a, int l) {
    extern __shared__ __attribute__((aligned(16))) unsigned char lds[];
    Ctx c; c.tid = threadIdx.x; c.lane = c.tid & 63; c.wave = __builtin_amdgcn_readfirstlane(c.tid >> 6); c.lds = lds;
    KArgs* kp = (KArgs*)__builtin_amdgcn_kernarg_segment_ptr();
    run_phase<SP>(c, *kp, l);
}
template <int SP>
static void launch_phase(const Args& a, int l, int grid, hipStream_t stream) {
    static bool attr_set = false;
    if (!attr_set) { (void)hipFuncSetAttribute((const void*)kphase<SP>, hipFuncAttributeMaxDynamicSharedMemorySize, LDS_BYTES); attr_set = true; }
    hipLaunchKernelGGL(kphase<SP>, dim3(grid), dim3(NTHR), LDS_BYTES, stream, a, l);
}
#endif

extern "C" void kernel_launch(void* const* d_in, const int* in_sizes, int n_in, void* d_out, int out_size, void* d_ws, size_t ws_size, hipStream_t stream) {
    static int grid = 0;
    if (grid == 0) {
        if (n_in != 25 || ws_size < WS_END) { fprintf(stderr, "kernel_launch: unexpected inputs (n_in %d, ws %zu, need %zu)\n", n_in, ws_size, (size_t)WS_END); grid = -1; return; }
        int dev = 0, cus = 0;
        (void)hipGetDevice(&dev);
        (void)hipDeviceGetAttribute(&cus, hipDeviceAttributeMultiprocessorCount, dev);
        if (cus <= 0) cus = 256;
#if ONE_LAUNCH
        int per_cu = 0;
        if (hipFuncSetAttribute((const void*)mega, hipFuncAttributeMaxDynamicSharedMemorySize, LDS_BYTES) != hipSuccess) { fprintf(stderr, "kernel_launch: hipFuncSetAttribute failed\n"); grid = -1; return; }
        if (hipOccupancyMaxActiveBlocksPerMultiprocessor(&per_cu, (const void*)mega, NTHR, LDS_BYTES) != hipSuccess || per_cu < 1) { fprintf(stderr, "kernel_launch: occupancy query says %d blocks per CU\n", per_cu); (void)hipGetLastError(); grid = -1; return; }
        grid = cus;
#else
        grid = cus;
#endif
    }
    if (grid < 0) return;
    Args a{};
    for (int i = 0; i < 25; ++i) a.in[i] = (const float*)d_in[i];
    a.out = (float*)d_out; a.ws = (unsigned char*)d_ws;
    for (int i = 0; i < 8; ++i) a.inv16[i] = (float)pow(500000.0, -(double)i / 8.0);
    for (int i = 0; i < 16; ++i) a.inv32[i] = (float)pow(500000.0, -(double)i / 16.0);
    a.ph_lo = 0; a.ph_hi = 0;
#if ONE_LAUNCH
    (void)hipMemsetAsync((unsigned char*)d_ws + WS_CTL, 0, WS_CTL_BYTES, stream);
    void* kargs[] = { &a };
    hipError_t e = hipLaunchCooperativeKernel((const void*)mega, dim3(grid), dim3(NTHR), kargs, LDS_BYTES, stream);
    if (e != hipSuccess) fprintf(stderr, "kernel_launch: cooperative launch failed: %s (grid %d)\n", hipGetErrorString(e), grid);
#else
    launch_phase<11>(a, 0, grid, stream);
    for (int l = 0; l < DEPTH; ++l) {
        launch_phase<0>(a, l, grid, stream);
        launch_phase<1>(a, l, grid, stream);
        launch_phase<2>(a, l, grid, stream);
        launch_phase<3>(a, l, grid, stream);
        launch_phase<4>(a, l, grid, stream);
        launch_phase<5>(a, l, grid, stream);
        launch_phase<6>(a, l, grid, stream);
        launch_phase<7>(a, l, grid, stream);
        launch_phase<8>(a, l, grid, stream);
        launch_phase<9>(a, l, grid, stream);
        launch_phase<10>(a, l, grid, stream);
    }
    launch_phase<12>(a, 0, grid, stream);
#endif
}
```

```cpp
#include <hip/hip_runtime.h>
#include <hip/hip_cooperative_groups.h>
#include <cstdio>
#include <cmath>
#include <cstdint>


namespace cg = cooperative_groups;

typedef __attribute__((ext_vector_type(8))) short bf16x8;
typedef __attribute__((ext_vector_type(4))) short bf16x4;
typedef __attribute__((ext_vector_type(16))) float f32x16;
typedef unsigned short u16;
typedef unsigned long long u64;

#define DI __device__ __forceinline__
#define MFMA32(a, b, c) __builtin_amdgcn_mfma_f32_32x32x16_bf16((a), (b), (c), 0, 0, 0)

constexpr int T_TOK = 32768, SEQ = 4096, NB = 8, DM = 1024, DEPTH = 2;
constexpr int NREF = 3184;
constexpr int NPAD = 3200;
constexpr int LDP = 2848;
constexpr int PC_Z = 0, PC_XBC = 256, PC_DSAQ = 1024, PC_DSAK = 1280, PC_IDXQ = 1344, PC_IDXK = 1856,
              PC_CQ = 1920, PC_CKV = 2176, PC_KR = 2304, PC_FOXQ = 2336, PC_FOXK = 2592;
constexpr int NC_DSAV = 2848, NC_FOXV = 2912, NC_SMALL = 3168;
constexpr float EPS = 1e-6f;
constexpr float LOG2E = 1.4426950408889634f;
constexpr int NTHR = 512;
constexpr int LDS_BYTES = 147456;

constexpr size_t al256(size_t x) { return (x + 255) & ~(size_t)255; }
constexpr size_t WS_CTL   = 0;
constexpr size_t WS_BAR   = 4096;
constexpr size_t WS_CTL_BYTES = 32768;
constexpr size_t WS_WIN   = 32768;
constexpr size_t WS_WUQ   = WS_WIN  + (size_t)2 * NPAD * 1024 * 2;
constexpr size_t WS_WUKV  = WS_WUQ  + (size_t)2 * 384 * 256 * 2;
constexpr size_t WS_WOUT  = WS_WUKV + (size_t)2 * 512 * 128 * 2;
constexpr size_t WS_WG    = WS_WOUT + (size_t)2 * 1024 * 1024 * 2;
constexpr size_t WS_WU    = WS_WG   + (size_t)32 * 256 * 1024 * 2;
constexpr size_t WS_WD    = WS_WU   + (size_t)32 * 256 * 1024 * 2;
constexpr size_t WS_TRIG  = WS_WD   + (size_t)32 * 256 * 1024 * 2;
constexpr size_t WS_ACT   = WS_TRIG + (size_t)T_TOK * 48 * 4;
constexpr size_t WS_PROJ  = WS_ACT  + (size_t)T_TOK * 1024 * 2;
constexpr size_t WS_SMALL = WS_PROJ + (size_t)T_TOK * LDP * 2;
constexpr size_t WS_MLAQ  = WS_SMALL + (size_t)T_TOK * 16 * 4;
constexpr size_t WS_MLAK  = WS_MLAQ + (size_t)T_TOK * 384 * 2;
constexpr size_t WS_MLAVT = WS_MLAK + (size_t)T_TOK * 384 * 2;
constexpr size_t WS_DSAVT = WS_MLAVT + (size_t)T_TOK * 256 * 2;
constexpr size_t WS_FOXVT = WS_DSAVT + (size_t)T_TOK * 64 * 2;
constexpr size_t WS_FLOG  = WS_FOXVT + (size_t)T_TOK * 256 * 2;
constexpr size_t WS_CS    = WS_FLOG + (size_t)T_TOK * 4 * 4;
constexpr size_t WS_CDEC  = WS_CS   + (size_t)8 * 32 * 4 * 64 * 128 * 4;
constexpr size_t WS_MASK  = WS_CDEC + 4096;
constexpr size_t WS_TOKW  = WS_MASK + (size_t)T_TOK * 64 * 8;
constexpr size_t WS_WRH   = WS_TOKW + (size_t)T_TOK * 2 * 4;
constexpr size_t WS_WRL   = WS_WRH + (size_t)2 * 64 * 1024 * 2;
constexpr size_t WS_END   = WS_WRL + (size_t)2 * 64 * 1024 * 2;
constexpr size_t WS_LIST  = WS_PROJ;
constexpr size_t WS_HMID  = WS_PROJ + (size_t)64 * 32768 * 4;
constexpr size_t WS_YFFN  = WS_HMID + (size_t)T_TOK * 512 * 2;
static_assert(WS_YFFN + (size_t)T_TOK * 2048 * 2 <= WS_SMALL, "aliases must fit in PROJ");
static_assert(WS_END <= (size_t)512 * 1024 * 1024, "workspace budget");

struct Args {
    const float* in[25];
    float* out;
    unsigned char* ws;
    float inv16[8];
    float inv32[16];
    int ph_lo, ph_hi;
};

typedef const __attribute__((address_space(4))) Args KArgs;
struct Ctx { int tid, lane, wave; unsigned char* lds; };
__device__ __forceinline__ Ctx fresh_ctx(unsigned char* lds) {
    int t = threadIdx.x; asm volatile("" : "+v"(t));
    Ctx c; c.tid = t; c.lane = t & 63; c.wave = __builtin_amdgcn_readfirstlane(t >> 6); c.lds = lds; return c;
}

typedef __attribute__((ext_vector_type(2))) float f32x2;
typedef __attribute__((ext_vector_type(2))) __bf16 bf16x2_t;
DI u16 f2bf(float x) { return __builtin_bit_cast(u16, (__bf16)x); }
DI float bf2f(u16 h) { return __uint_as_float(((unsigned)h) << 16); }
DI unsigned pack2(float a, float b) { f32x2 v = {a, b}; return __builtin_bit_cast(unsigned, __builtin_convertvector(v, bf16x2_t)); }
DI float ex2(float x) { return __builtin_amdgcn_exp2f(x); }
DI float max3f(float a, float b, float c) { float r; asm("v_max3_f32 %0, %1, %2, %3" : "=v"(r) : "v"(a), "v"(b), "v"(c)); return r; }
DI float wsum(float v) { for (int o = 32; o >= 1; o >>= 1) v += __shfl_xor(v, o); return v; }
DI float wmaxf(float v) { for (int o = 32; o >= 1; o >>= 1) v = fmaxf(v, __shfl_xor(v, o)); return v; }
DI float wminf(float v) { for (int o = 32; o >= 1; o >>= 1) v = fminf(v, __shfl_xor(v, o)); return v; }
DI float siluf(float x) { return x / (1.f + __expf(-x)); }
DI float softplusf(float x) { return fmaxf(x, 0.f) + log1pf(__expf(-fabsf(x))); }
DI int crow(int reg, int h) { return (reg & 3) + 8 * (reg >> 2) + 4 * h; }
DI bf16x8 pack8(const f32x16& x, int s) {
    uint4 p;
    p.x = pack2(x[8 * s + 0], x[8 * s + 1]); p.y = pack2(x[8 * s + 2], x[8 * s + 3]);
    p.z = pack2(x[8 * s + 4], x[8 * s + 5]); p.w = pack2(x[8 * s + 6], x[8 * s + 7]);
    return __builtin_bit_cast(bf16x8, p);
}
DI f32x16 zero16() { f32x16 z; for (int i = 0; i < 16; ++i) z[i] = 0.f; return z; }

DI int ref_col(int n) {
    if (n < 1024) return n;
    if (n < 1280) return n - 1024 + 1028;
    if (n < 1344) return n - 1280 + 1284;
    if (n < 1856) return n - 1344 + 1412;
    if (n < 1920) return n - 1856 + 1924;
    if (n < 2176) return n - 1920 + 1996;
    if (n < 2304) return n - 2176 + 2252;
    if (n < 2336) return n - 2304 + 2380;
    if (n < 2592) return n - 2336 + 2412;
    if (n < 2848) return n - 2592 + 2668;
    if (n < 2912) return n - 2848 + 1348;
    if (n < 3168) return n - 2912 + 2924;
    if (n < 3172) return n - 3168 + 1024;
    if (n < 3180) return n - 3172 + 1988;
    if (n < 3184) return n - 3180 + 3180;
    return -1;
}

DI int vblock() { const int G = gridDim.x, bx = blockIdx.x; return (G % 8 == 0) ? (bx % 8) * (G / 8) + bx / 8 : bx; }

constexpr int G_LDT = 72;
constexpr int G_AEL = 256 * G_LDT, G_BEL = 128 * G_LDT, G_STEL = G_AEL + G_BEL;
constexpr int G_LDS_BYTES = 2 * G_STEL * 2;

struct GP { const u16 *a0, *a1, *a2, *a3, *b0, *b1; };

template <bool PAIRED>
DI void gemm_core(const Ctx& c, int K, const GP& gp, f32x16 (&acc)[2][2]) {
    u16* S = (u16*)c.lds;
    const int r8 = c.tid >> 3, kc = c.tid & 7;
    const int wm = c.wave & 3, wn = c.wave >> 2, l31 = c.lane & 31, h = c.lane >> 5;
    const int nb0 = PAIRED ? wn * 32 : wn * 64, nb1 = PAIRED ? 64 + wn * 32 : wn * 64 + 32;
    uint4 ra0, ra1, ra2, ra3, rb0, rb1;
    uint4 sa0, sa1, sa2, sa3, sb0, sb1;
    const int nk = K >> 6;
#define G_LOAD(P, KOFF) do { \
        P##a0 = *(const uint4*)(gp.a0 + (KOFF) + kc * 8); P##a1 = *(const uint4*)(gp.a1 + (KOFF) + kc * 8); \
        P##a2 = *(const uint4*)(gp.a2 + (KOFF) + kc * 8); P##a3 = *(const uint4*)(gp.a3 + (KOFF) + kc * 8); \
        P##b0 = *(const uint4*)(gp.b0 + (KOFF) + kc * 8); P##b1 = *(const uint4*)(gp.b1 + (KOFF) + kc * 8); } while (0)
#define G_STORE(P, SP) do { u16* sp_ = (SP); \
        *(uint4*)(sp_ + (r8) * G_LDT + kc * 8) = P##a0; *(uint4*)(sp_ + (r8 + 64) * G_LDT + kc * 8) = P##a1; \
        *(uint4*)(sp_ + (r8 + 128) * G_LDT + kc * 8) = P##a2; *(uint4*)(sp_ + (r8 + 192) * G_LDT + kc * 8) = P##a3; \
        *(uint4*)(sp_ + G_AEL + (r8) * G_LDT + kc * 8) = P##b0; *(uint4*)(sp_ + G_AEL + (r8 + 64) * G_LDT + kc * 8) = P##b1; } while (0)
#define G_COMPUTE_KS(ST, KS0, KS1) do { \
        const u16* As = S + (ST) * G_STEL; const u16* Bs = As + G_AEL; \
        _Pragma("unroll") for (int ks = (KS0); ks < (KS1); ++ks) { \
            const bf16x8 a0 = *(const bf16x8*)(As + (wm * 64 + l31) * G_LDT + ks * 16 + h * 8); \
            const bf16x8 a1 = *(const bf16x8*)(As + (wm * 64 + 32 + l31) * G_LDT + ks * 16 + h * 8); \
            const bf16x8 b0 = *(const bf16x8*)(Bs + (nb0 + l31) * G_LDT + ks * 16 + h * 8); \
            const bf16x8 b1 = *(const bf16x8*)(Bs + (nb1 + l31) * G_LDT + ks * 16 + h * 8); \
            acc[0][0] = MFMA32(a0, b0, acc[0][0]); acc[0][1] = MFMA32(a0, b1, acc[0][1]); \
            acc[1][0] = MFMA32(a1, b0, acc[1][0]); acc[1][1] = MFMA32(a1, b1, acc[1][1]); } } while (0)
    G_LOAD(r, 0);
    G_STORE(r, S);
    if (nk > 1) G_LOAD(r, 64);
    __syncthreads();
    for (int kt = 0; kt < nk; kt += 2) {
        if (kt + 2 < nk) G_LOAD(s, (kt + 2) * 64);
        G_COMPUTE_KS(0, 0, 1);
        if (kt + 1 < nk) G_STORE(r, S + G_STEL);
        G_COMPUTE_KS(0, 1, 4);
        __syncthreads();
        if (kt + 1 >= nk) break;
        if (kt + 3 < nk) G_LOAD(r, (kt + 3) * 64);
        G_COMPUTE_KS(1, 0, 1);
        if (kt + 2 < nk) G_STORE(s, S);
        G_COMPUTE_KS(1, 1, 4);
        __syncthreads();
    }
#undef G_LOAD
#undef G_STORE
#undef G_COMPUTE_KS
}

DI void xpose_tile(const Ctx& c, const float* in, int ld_in, int k0, int n0, int colmode, const float* kscale, u16* out, int ld_out) {
    float* tile = (float*)c.lds;
    if (!colmode) {
        const int j4 = (c.tid & 15) * 4, r0 = c.tid >> 4;
#pragma unroll
        for (int rr = 0; rr < 2; ++rr) {
            const int kk = r0 + 32 * rr;
            float4 v = *(const float4*)(in + (size_t)(k0 + kk) * ld_in + n0 + j4);
            if (kscale) { const float s = kscale[k0 + kk]; v.x *= s; v.y *= s; v.z *= s; v.w *= s; }
            *(float4*)(tile + kk * 68 + j4) = v;
        }
    } else {
        const int j = c.tid & 63, r0 = c.tid >> 6;
        const int rc = ref_col(n0 + j);
#pragma unroll
        for (int rr = 0; rr < 8; ++rr) {
            const int kk = r0 + 8 * rr;
            tile[kk * 68 + j] = (rc >= 0) ? in[(size_t)(k0 + kk) * ld_in + rc] : 0.f;
        }
    }
    __syncthreads();
    {
        const int jj = c.tid >> 3, k8 = (c.tid & 7) * 8;
        uint4 pk;
        pk.x = pack2(tile[(k8 + 0) * 68 + jj], tile[(k8 + 1) * 68 + jj]);
        pk.y = pack2(tile[(k8 + 2) * 68 + jj], tile[(k8 + 3) * 68 + jj]);
        pk.z = pack2(tile[(k8 + 4) * 68 + jj], tile[(k8 + 5) * 68 + jj]);
        pk.w = pack2(tile[(k8 + 6) * 68 + jj], tile[(k8 + 7) * 68 + jj]);
        *(uint4*)(out + (size_t)(n0 + jj) * ld_out + k0 + k8) = pk;
    }
    __syncthreads();
}

DI void phase_prep(const Ctx& c_in, KArgs& a) {
    const Ctx c = fresh_ctx(c_in.lds);
    unsigned char* ws = a.ws;
    const int n_win = 2 * 50 * 16;
    const int n_wuq = 2 * 6 * 4;
    const int n_wukv = 2 * 8 * 2;
    const int n_wout = 2 * 16 * 16;
    const int n_trig = T_TOK * 24 / NTHR;
    const int n_wr = 2 * 64 * 1024 / NTHR;
    const int total = n_win + n_wuq + n_wukv + n_wout + n_trig + n_wr;
    for (int it = blockIdx.x; it < total; it += gridDim.x) {
        int i = it;
        if (i < n_win) {
            const int l = i / 800, r = i % 800, nt = r / 16, kt = r % 16;
            xpose_tile(c, a.in[3] + (size_t)l * 1024 * NREF, NREF, kt * 64, nt * 64, 1, nullptr, (u16*)(ws + WS_WIN) + (size_t)l * NPAD * 1024, 1024);
            continue;
        }
        i -= n_win;
        if (i < n_wuq) {
            const int l = i / 24, r = i % 24, nt = r / 4, kt = r % 4;
            xpose_tile(c, a.in[11] + (size_t)l * 256 * 384, 384, kt * 64, nt * 64, 0, a.in[10] + l * 256, (u16*)(ws + WS_WUQ) + (size_t)l * 384 * 256, 256);
            continue;
        }
        i -= n_wuq;
        if (i < n_wukv) {
            const int l = i / 16, r = i % 16, nt = r / 2, kt = r % 2;
            xpose_tile(c, a.in[13] + (size_t)l * 128 * 512, 512, kt * 64, nt * 64, 0, a.in[12] + l * 128, (u16*)(ws + WS_WUKV) + (size_t)l * 512 * 128, 128);
            continue;
        }
        i -= n_wukv;
        if (i < n_wout) {
            const int l = i / 256, r = i % 256, nt = r / 16, kt = r % 16;
            xpose_tile(c, a.in[15] + (size_t)l * 1024 * 1024, 1024, kt * 64, nt * 64, 0, nullptr, (u16*)(ws + WS_WOUT) + (size_t)l * 1024 * 1024, 1024);
            continue;
        }
        i -= n_wout;
        if (i >= n_trig) {
            const int e = (i - n_trig) * NTHR + c.tid;
            const int l = e >> 16, n = (e >> 10) & 63, k = e & 1023;
            float v = 0.f;
            if (n < 4) v = a.in[17][((size_t)l * 1024 + k) * 4 + n];
            else if (n < 36) v = a.in[19][((size_t)l * 1024 + k) * 32 + (n - 4)];
            const u16 hi = f2bf(v);
            ((u16*)(ws + WS_WRH))[e] = hi;
            ((u16*)(ws + WS_WRL))[e] = f2bf(v - bf2f(hi));
            continue;
        }
        {
            const int e = i * NTHR + c.tid;
            const int t = e / 24, j = e % 24;
            const int pos = ((const int*)a.in[1])[t];
            const float inv = (j < 8) ? a.inv16[j] : a.inv32[j - 8];
            const float ang = (float)pos * inv;
            const double ad = (double)ang;
            const double r = ad - 6.283185307179586476925 * rint(ad * 0.15915494309189533577);
            const float rf = (float)r;
            const float cs = cosf(rf), sn = sinf(rf);
            float* trig = (float*)(ws + WS_TRIG) + (size_t)t * 48;
            if (j < 8) { trig[j] = cs; trig[8 + j] = sn; } else { trig[16 + (j - 8)] = cs; trig[32 + (j - 8)] = sn; }
        }
    }
}

DI void phase_norm_in(const Ctx& c_in, KArgs& a, int l) {
    const Ctx c = fresh_ctx(c_in.lds);
    unsigned char* ws = a.ws;
    const float* x = (l == 0) ? a.in[0] : a.out;
    const float* g = a.in[2] + l * 1024;
    u16* act = (u16*)(ws + WS_ACT);
    const int n_norm = T_TOK / 8;
    const int n_exp = 3 * 32 * 64;
    if (blockIdx.x == 0 && c.tid < 96) ((int*)(ws + WS_CTL))[c.tid] = 0;
    for (int it = blockIdx.x; it < n_norm + n_exp; it += gridDim.x) {
        if (it < n_exp) {
            const int which = it / 2048, r = it % 2048, e = r / 64, tt = r % 64;
            if (which < 2) {
                const float* src = a.in[21 + which] + ((size_t)l * 32 + e) * 1024 * 256;
                u16* dst = (u16*)(ws + (which == 0 ? WS_WG : WS_WU)) + (size_t)e * 256 * 1024;
                const int nt = tt / 16, kt = tt % 16;
                xpose_tile(c, src, 256, kt * 64, nt * 64, 0, nullptr, dst, 1024);
            } else {
                const float* src = a.in[23] + ((size_t)l * 32 + e) * 256 * 1024;
                u16* dst = (u16*)(ws + WS_WD) + (size_t)e * 1024 * 256;
                const int nt = tt / 4, kt = tt % 4;
                xpose_tile(c, src, 1024, kt * 64, nt * 64, 0, nullptr, dst, 256);
            }
        } else {
            const int t = (it - n_exp) * 8 + c.wave;
            const float* xr = x + (size_t)t * 1024;
            float v[16]; float ss = 0.f;
            if (l == 0) {
#pragma unroll
                for (int j = 0; j < 16; ++j) v[j] = xr[c.lane + 64 * j];
            } else {
                const u16* y0 = (const u16*)(ws + WS_YFFN) + (size_t)t * 2048;
#pragma unroll
                for (int j = 0; j < 16; ++j) { v[j] = xr[c.lane + 64 * j] + bf2f(y0[c.lane + 64 * j]) + bf2f(y0[1024 + c.lane + 64 * j]); a.out[(size_t)t * 1024 + c.lane + 64 * j] = v[j]; }
            }
#pragma unroll
            for (int j = 0; j < 16; ++j) ss += v[j] * v[j];
            ss = wsum(ss);
            const float rs = rsqrtf(ss * (1.f / 1024.f) + EPS);
#pragma unroll
            for (int j = 0; j < 16; ++j) act[(size_t)t * 1024 + c.lane + 64 * j] = f2bf(v[j] * rs * g[c.lane + 64 * j]);
        }
    }
}

DI void phase_inproj(const Ctx& c_in, KArgs& a, int l) {
    const Ctx c = fresh_ctx(c_in.lds);
    unsigned char* ws = a.ws;
    const u16* act = (const u16*)(ws + WS_ACT);
    const u16* w = (const u16*)(ws + WS_WIN) + (size_t)l * NPAD * 1024;
    u16* proj = (u16*)(ws + WS_PROJ);
    u16* dsavt = (u16*)(ws + WS_DSAVT);
    u16* foxvt = (u16*)(ws + WS_FOXVT);
    float* small = (float*)(ws + WS_SMALL);
    const int r8 = c.tid >> 3;
    const int wm = c.wave & 3, wn = c.wave >> 2, l31 = c.lane & 31, h = c.lane >> 5;
    const int ntiles = (T_TOK / 256) * (NPAD / 128);
    for (int tile = vblock(); tile < ntiles; tile += gridDim.x) {
        const int grp = tile / 100, rr = tile % 100;
        const int mt = grp * 4 + (rr & 3), nt = rr >> 2;
        GP gp;
        gp.a0 = act + (size_t)(mt * 256 + r8) * 1024; gp.a1 = gp.a0 + 64 * 1024; gp.a2 = gp.a0 + 128 * 1024; gp.a3 = gp.a0 + 192 * 1024;
        gp.b0 = w + (size_t)(nt * 128 + r8) * 1024; gp.b1 = gp.b0 + 64 * 1024;
        f32x16 acc[2][2];
        acc[0][0] = zero16(); acc[0][1] = zero16(); acc[1][0] = zero16(); acc[1][1] = zero16();
        gemm_core<false>(c, 1024, gp, acc);
#pragma unroll
        for (int i = 0; i < 2; ++i)
#pragma unroll
            for (int j = 0; j < 2; ++j) {
                const int m0 = mt * 256 + wm * 64 + i * 32, n0 = nt * 128 + wn * 64 + j * 32;
                const int n = n0 + l31;
                if (n0 < LDP) {
#pragma unroll
                    for (int r = 0; r < 16; ++r) proj[(size_t)(m0 + crow(r, h)) * LDP + n] = f2bf(acc[i][j][r]);
                } else if (n0 < NC_SMALL) {
                    const int b = m0 >> 12, s0 = m0 & 4095;
                    u16* base = (n0 < NC_FOXV) ? dsavt + ((size_t)b * 64 + (n - NC_DSAV)) * 4096 : foxvt + ((size_t)b * 256 + (n - NC_FOXV)) * 4096;
#pragma unroll
                    for (int q = 0; q < 4; ++q) {
                        uint2 pk; pk.x = pack2(acc[i][j][4 * q], acc[i][j][4 * q + 1]); pk.y = pack2(acc[i][j][4 * q + 2], acc[i][j][4 * q + 3]);
                        *(uint2*)(base + s0 + 8 * q + 4 * h) = pk;
                    }
                } else {
                    const int cc = n - NC_SMALL;
                    if (cc < 16) {
#pragma unroll
                        for (int r = 0; r < 16; ++r) small[(size_t)(m0 + crow(r, h)) * 16 + cc] = acc[i][j][r];
                    }
                }
            }
    }
}

constexpr int SSD_LD = 136;
constexpr int SSD_TILE_B = 128 * SSD_LD * 2;
constexpr int SSD_OFF_DT = 3 * SSD_TILE_B;
constexpr int SSD_OFF_ACS = SSD_OFF_DT + 2048;
constexpr int SSD_OFF_SSQ = SSD_OFF_ACS + 2048;

DI void ssd_dt_acs(const Ctx& c, KArgs& a, int l, int tok0, float* dt_s, float* acs_s) {
    const float* small = (const float*)(a.ws + WS_SMALL);
    {
        const int t = c.tid >> 2, hd = c.tid & 3;
        const float raw = small[(size_t)(tok0 + t) * 16 + hd] + a.in[6][l * 4 + hd];
        dt_s[hd * 128 + t] = softplusf(raw);
    }
    __syncthreads();
    if (c.wave < 4) {
        const int hd = c.wave;
        const float av = -__expf(a.in[7][l * 4 + hd]);
        const float v0 = dt_s[hd * 128 + 2 * c.lane] * av, v1 = dt_s[hd * 128 + 2 * c.lane + 1] * av;
        const float s = v0 + v1;
        float inc = s;
#pragma unroll
        for (int o = 1; o < 64; o <<= 1) { const float tv = __shfl_up(inc, o); if (c.lane >= o) inc += tv; }
        const float ex = inc - s;
        acs_s[hd * 128 + 2 * c.lane] = ex + v0;
        acs_s[hd * 128 + 2 * c.lane + 1] = ex + v0 + v1;
    }
    __syncthreads();
}

DI float ssd_conv(const u16* proj, const float* cw, const float* cb, int b, int s, int xc) {
    float acc = cb[xc];
#pragma unroll
    for (int j = 0; j < 4; ++j) {
        const int sp = s - 3 + j;
        if (sp >= 0) acc += cw[j * 768 + xc] * bf2f(proj[(size_t)(b * 4096 + sp) * LDP + PC_XBC + xc]);
    }
    return siluf(acc);
}

template <bool TRANSPOSED>
DI void conv_stage_unit(const Ctx& c, const u16* proj, const float* cw, const float* cb, int b, int s0, int tseg, int xc0, u16* dst,
                        const float* dt_s, const float* acs_s, int head0) {
    const int ch = 2 * c.lane, xc = xc0 + ch;
    float w0[4], w1[4];
#pragma unroll
    for (int j = 0; j < 4; ++j) { w0[j] = cw[j * 768 + xc]; w1[j] = cw[j * 768 + xc + 1]; }
    const float bias0 = cb[xc], bias1 = cb[xc + 1];
    const u16* src = proj + (size_t)(b * 4096) * LDP + PC_XBC + xc;
    const int head = head0 + (ch >> 6);
#pragma unroll 1
    for (int half = 0; half < 2; ++half) {
        const int sb = s0 + tseg * 32 + half * 16 - 3;
        unsigned raw[19];
#pragma unroll
        for (int i = 0; i < 19; ++i) { const int sp = sb + i; raw[i] = (sp >= 0) ? *(const unsigned*)(src + (size_t)sp * LDP) : 0u; }
#pragma unroll
        for (int t = 0; t < 16; ++t) {
            float x0 = bias0, x1 = bias1;
#pragma unroll
            for (int j = 0; j < 4; ++j) { x0 += w0[j] * bf2f((u16)(raw[t + j] & 0xffff)); x1 += w1[j] * bf2f((u16)(raw[t + j] >> 16)); }
            x0 = siluf(x0); x1 = siluf(x1);
            const int tt = tseg * 32 + half * 16 + t;
            if (dt_s) { const float sc = dt_s[head * 128 + tt] * __expf(acs_s[head * 128 + 127] - acs_s[head * 128 + tt]); x0 *= sc; x1 *= sc; }
            if (TRANSPOSED) { dst[ch * SSD_LD + tt] = f2bf(x0); dst[(ch + 1) * SSD_LD + tt] = f2bf(x1); }
            else *(unsigned*)(dst + tt * SSD_LD + ch) = pack2(x0, x1);
        }
    }
}

DI void ssd_state_item(const Ctx& c_in, KArgs& a, int l, int item) {
    const Ctx c = fresh_ctx(c_in.lds);
    unsigned char* ws = a.ws;
    const u16* proj = (const u16*)(ws + WS_PROJ);
    const float* cw = a.in[4] + (size_t)l * 4 * 768;
    const float* cb = a.in[5] + (size_t)l * 768;
    float* cs = (float*)(ws + WS_CS);
    float* cdec = (float*)(ws + WS_CDEC);
    const int b = item >> 5, ch = item & 31, tok0 = b * 4096 + ch * 128, s0 = ch * 128;
    u16* XT = (u16*)c.lds;
    u16* BT = (u16*)(c.lds + SSD_TILE_B);
    float* dt_s = (float*)(c.lds + SSD_OFF_DT);
    float* acs_s = (float*)(c.lds + SSD_OFF_ACS);
    const int l31 = c.lane & 31, h = c.lane >> 5;
    ssd_dt_acs(c, a, l, tok0, dt_s, acs_s);
    if (c.tid < 4) cdec[(b * 32 + ch) * 4 + c.tid] = __expf(acs_s[c.tid * 128 + 127]);
    for (int g = 0; g < 2; ++g) {
        if (c.wave < 4) conv_stage_unit<true>(c, proj, cw, cb, b, s0, c.wave, 128 * g, XT, dt_s, acs_s, 2 * g);
        else conv_stage_unit<true>(c, proj, cw, cb, b, s0, c.wave - 4, 256 + 128 * g, BT, nullptr, nullptr, 0);
        __syncthreads();
        {
            const int hh = c.wave >> 2, pt = (c.wave >> 1) & 1, nh = c.wave & 1;
            f32x16 acc0 = zero16(), acc1 = zero16();
#pragma unroll
            for (int ks = 0; ks < 8; ++ks) {
                const bf16x8 af = *(const bf16x8*)(XT + (hh * 64 + pt * 32 + l31) * SSD_LD + ks * 16 + h * 8);
                const bf16x8 b0 = *(const bf16x8*)(BT + (nh * 64 + l31) * SSD_LD + ks * 16 + h * 8);
                const bf16x8 b1 = *(const bf16x8*)(BT + (nh * 64 + 32 + l31) * SSD_LD + ks * 16 + h * 8);
                acc0 = MFMA32(af, b0, acc0);
                acc1 = MFMA32(af, b1, acc1);
            }
            const int head = 2 * g + hh;
            float* dst = cs + ((size_t)((b * 32 + ch) * 4 + head) * 64) * 128;
#pragma unroll
            for (int r = 0; r < 16; ++r) {
                const int p = pt * 32 + crow(r, h);
                dst[p * 128 + nh * 64 + l31] = acc0[r];
                dst[p * 128 + nh * 64 + 32 + l31] = acc1[r];
            }
        }
        __syncthreads();
    }
}

DI void ssd_scan_item(const Ctx& c_in, KArgs& a, int item) {
    const Ctx c = fresh_ctx(c_in.lds);
    float* cs = (float*)(a.ws + WS_CS);
    const float* cdec = (const float*)(a.ws + WS_CDEC);
    const int idx = item * NTHR + c.tid;
    const int bh = idx >> 13, pn = idx & 8191, b = bh >> 2, hd = bh & 3;
    float v[32], dcy[32];
#pragma unroll
    for (int ch = 0; ch < 32; ++ch) {
        v[ch] = cs[((size_t)((b * 32 + ch) * 4 + hd)) * 8192 + pn];
        dcy[ch] = cdec[(b * 32 + ch) * 4 + hd];
    }
    float s = 0.f;
#pragma unroll
    for (int ch = 0; ch < 32; ++ch) {
        cs[((size_t)((b * 32 + ch) * 4 + hd)) * 8192 + pn] = s;
        s = s * dcy[ch] + v[ch];
    }
}

DI void ssd_out_item(const Ctx& c_in, KArgs& a, int l, int item) {
    const Ctx c = fresh_ctx(c_in.lds);
    unsigned char* ws = a.ws;
    const u16* proj = (const u16*)(ws + WS_PROJ);
    const float* cw = a.in[4] + (size_t)l * 4 * 768;
    const float* cb = a.in[5] + (size_t)l * 768;
    const float* prev = (const float*)(ws + WS_CS);
    u16* act = (u16*)(ws + WS_ACT);
    const int b = item >> 5, ch = item & 31, tok0 = b * 4096 + ch * 128, s0 = ch * 128;
    u16* XT = (u16*)c.lds;
    u16* BM = (u16*)(c.lds + SSD_TILE_B);
    u16* CM = (u16*)(c.lds + 2 * SSD_TILE_B);
    float* dt_s = (float*)(c.lds + SSD_OFF_DT);
    float* acs_s = (float*)(c.lds + SSD_OFF_ACS);
    float* ssq = (float*)(c.lds + SSD_OFF_SSQ);
    const int l31 = c.lane & 31, h = c.lane >> 5;
    ssd_dt_acs(c, a, l, tok0, dt_s, acs_s);
    f32x16 yreg[2][2];
    const int hh = c.wave >> 2, qt = c.wave & 3;
    const int q = qt * 32 + l31;
#pragma unroll
    for (int g = 0; g < 2; ++g) {
        for (int u = c.wave; u < 12; u += 8) {
            const int part = u >> 2, tseg = u & 3;
            if (part == 0) conv_stage_unit<true>(c, proj, cw, cb, b, s0, tseg, 128 * g, XT, nullptr, nullptr, 0);
            else if (part == 1) conv_stage_unit<false>(c, proj, cw, cb, b, s0, tseg, 256 + 128 * g, BM, nullptr, nullptr, 0);
            else conv_stage_unit<false>(c, proj, cw, cb, b, s0, tseg, 512 + 128 * g, CM, nullptr, nullptr, 0);
        }
        __syncthreads();
        {
            const int head = 2 * g + hh;
            const float acs_q = acs_s[head * 128 + q];
            bf16x8 cf[8];
#pragma unroll
            for (int ks = 0; ks < 8; ++ks) cf[ks] = *(const bf16x8*)(CM + q * SSD_LD + ks * 16 + h * 8);
            f32x16 yo0 = zero16(), yo1 = zero16();
            for (int kt = 0; kt <= qt; ++kt) {
                f32x16 gt = zero16();
#pragma unroll
                for (int ks = 0; ks < 8; ++ks) {
                    const bf16x8 bf = *(const bf16x8*)(BM + (kt * 32 + l31) * SSD_LD + ks * 16 + h * 8);
                    gt = MFMA32(bf, cf[ks], gt);
                }
#pragma unroll
                for (int r = 0; r < 16; ++r) {
                    const int k = kt * 32 + crow(r, h);
                    const float dec = __expf(fminf(acs_q - acs_s[head * 128 + k], 0.f)) * dt_s[head * 128 + k];
                    gt[r] = (k <= q) ? gt[r] * dec : 0.f;
                }
#pragma unroll
                for (int s2 = 0; s2 < 2; ++s2) {
                    const bf16x8 pb = pack8(gt, s2);
                    const int koff = kt * 32 + 16 * s2 + 4 * h;
                    {
                        const u16* xr = XT + (hh * 64 + l31) * SSD_LD + koff;
                        const uint2 lo = *(const uint2*)xr, hi = *(const uint2*)(xr + 8);
                        const bf16x8 xa = __builtin_bit_cast(bf16x8, make_uint4(lo.x, lo.y, hi.x, hi.y));
                        yo0 = MFMA32(xa, pb, yo0);
                    }
                    {
                        const u16* xr = XT + (hh * 64 + 32 + l31) * SSD_LD + koff;
                        const uint2 lo = *(const uint2*)xr, hi = *(const uint2*)(xr + 8);
                        const bf16x8 xa = __builtin_bit_cast(bf16x8, make_uint4(lo.x, lo.y, hi.x, hi.y));
                        yo1 = MFMA32(xa, pb, yo1);
                    }
                }
            }
            f32x16 yf0 = zero16(), yf1 = zero16();
            const float* pv = prev + ((size_t)((b * 32 + ch) * 4 + head) * 64) * 128;
#pragma unroll
            for (int ks = 0; ks < 8; ++ks) {
                {
                    const float* pr = pv + (size_t)l31 * 128 + ks * 16 + h * 8;
                    const float4 f0 = *(const float4*)pr, f1 = *(const float4*)(pr + 4);
                    const bf16x8 pa = __builtin_bit_cast(bf16x8, make_uint4(pack2(f0.x, f0.y), pack2(f0.z, f0.w), pack2(f1.x, f1.y), pack2(f1.z, f1.w)));
                    yf0 = MFMA32(pa, cf[ks], yf0);
                }
                {
                    const float* pr = pv + (size_t)(32 + l31) * 128 + ks * 16 + h * 8;
                    const float4 f0 = *(const float4*)pr, f1 = *(const float4*)(pr + 4);
                    const bf16x8 pa = __builtin_bit_cast(bf16x8, make_uint4(pack2(f0.x, f0.y), pack2(f0.z, f0.w), pack2(f1.x, f1.y), pack2(f1.z, f1.w)));
                    yf1 = MFMA32(pa, cf[ks], yf1);
                }
            }
            const float eq = __expf(acs_q);
            const float dsk = a.in[8][l * 4 + head];
            float part = 0.f;
#pragma unroll
            for (int pt = 0; pt < 2; ++pt) {
#pragma unroll
                for (int qd = 0; qd < 4; ++qd) {
                    const int p0 = pt * 32 + 8 * qd + 4 * h;
                    const uint2 zz = *(const uint2*)(proj + (size_t)(tok0 + q) * LDP + PC_Z + head * 64 + p0);
                    const float zf[4] = { bf2f((u16)(zz.x & 0xffff)), bf2f((u16)(zz.x >> 16)), bf2f((u16)(zz.y & 0xffff)), bf2f((u16)(zz.y >> 16)) };
#pragma unroll
                    for (int r3 = 0; r3 < 4; ++r3) {
                        const int r = 4 * qd + r3;
                        const float yo = pt ? yo1[r] : yo0[r];
                        const float yf = pt ? yf1[r] : yf0[r];
                        const float xv = bf2f(XT[(hh * 64 + p0 + r3) * SSD_LD + q]);
                        const float y = (yo + yf * eq + dsk * xv) * siluf(zf[r3]);
                        yreg[g][pt][r] = y;
                        part += y * y;
                    }
                }
            }
            part += __shfl_xor(part, 32);
            if (h == 0) ssq[head * 128 + q] = part;
        }
        __syncthreads();
    }
    {
        const float rs = rsqrtf((ssq[q] + ssq[128 + q] + ssq[256 + q] + ssq[384 + q]) * (1.f / 256.f) + EPS);
        const float* nw = a.in[9] + l * 256;
#pragma unroll
        for (int g = 0; g < 2; ++g) {
            const int head = 2 * g + hh;
#pragma unroll
            for (int pt = 0; pt < 2; ++pt)
#pragma unroll
                for (int qd = 0; qd < 4; ++qd) {
                    const int p0 = pt * 32 + 8 * qd + 4 * h;
                    const float* w4 = nw + head * 64 + p0;
                    uint2 pk;
                    pk.x = pack2(yreg[g][pt][4 * qd] * rs * w4[0], yreg[g][pt][4 * qd + 1] * rs * w4[1]);
                    pk.y = pack2(yreg[g][pt][4 * qd + 2] * rs * w4[2], yreg[g][pt][4 * qd + 3] * rs * w4[3]);
                    *(uint2*)(act + (size_t)(tok0 + q) * 1024 + head * 64 + p0) = pk;
                }
        }
    }
    __syncthreads();
}

DI void token_post_item(const Ctx& c_in, KArgs& a, int l, int item) {
    const Ctx c = fresh_ctx(c_in.lds);
    unsigned char* ws = a.ws;
    u16* proj = (u16*)(ws + WS_PROJ);
    u16* mlak = (u16*)(ws + WS_MLAK);
    const float* trig = (const float*)(ws + WS_TRIG);
    const float* small = (const float*)(ws + WS_SMALL);
    float* flog = (float*)(ws + WS_FLOG);
    const int t = item * 8 + c.wave;
    u16* pr = proj + (size_t)t * LDP;
    const float* tg = trig + (size_t)t * 48;
#pragma unroll
    for (int r = 0; r < 2; ++r) {
        const int pid = c.lane + 64 * r;
        if (pid < 112) {
            int col, i;
            if (pid < 32)       { col = PC_DSAQ + (pid >> 3) * 64; i = pid & 7; }
            else if (pid < 40)  { col = PC_DSAK; i = pid - 32; }
            else if (pid < 104) { const int p = pid - 40; col = PC_IDXQ + (p >> 3) * 64; i = p & 7; }
            else                { col = PC_IDXK; i = pid - 104; }
            const float x1 = bf2f(pr[col + i]), x2 = bf2f(pr[col + 8 + i]);
            const float cs = tg[i], sn = tg[8 + i];
            pr[col + i] = f2bf(x1 * cs - x2 * sn);
            pr[col + 8 + i] = f2bf(x2 * cs + x1 * sn);
        } else {
            const int i = pid - 112;
            const float x1 = bf2f(pr[PC_KR + i]), x2 = bf2f(pr[PC_KR + 16 + i]);
            const float cs = tg[16 + i], sn = tg[32 + i];
            const u16 o1 = f2bf(x1 * cs - x2 * sn), o2 = f2bf(x2 * cs + x1 * sn);
#pragma unroll
            for (int hd = 0; hd < 4; ++hd) { mlak[(size_t)t * 384 + hd * 96 + 64 + i] = o1; mlak[(size_t)t * 384 + hd * 96 + 80 + i] = o2; }
        }
    }
    {
        const int hd = c.lane >> 4, d0 = (c.lane & 15) * 4;
        const uint2 kk = *(const uint2*)(pr + PC_FOXK + hd * 64 + d0);
        const float k0 = bf2f((u16)(kk.x & 0xffff)), k1 = bf2f((u16)(kk.x >> 16)), k2 = bf2f((u16)(kk.y & 0xffff)), k3 = bf2f((u16)(kk.y >> 16));
        float ss = k0 * k0 + k1 * k1 + k2 * k2 + k3 * k3;
        ss += __shfl_xor(ss, 1); ss += __shfl_xor(ss, 2); ss += __shfl_xor(ss, 4); ss += __shfl_xor(ss, 8);
        if ((c.lane & 15) == 0) {
            unsigned* km = (unsigned*)(ws + WS_CTL) + 64 + (t >> 12) * 4 + hd;
            const unsigned sb = __float_as_uint(ss);
            if (sb > __hip_atomic_load(km, __ATOMIC_RELAXED, __HIP_MEMORY_SCOPE_AGENT)) atomicMax(km, sb);
        }
    }
    if (c.lane < 4) {
        const float f = small[(size_t)t * 16 + 12 + c.lane] + a.in[14][l * 4 + c.lane];
        const float ls = fminf(f, 0.f) - log1pf(__expf(-fabsf(f)));
        const int b = t >> 12, s = t & 4095;
        flog[(size_t)(b * 4 + c.lane) * 4096 + s] = ls;
    }
}

DI void mla_up_item(const Ctx& c_in, KArgs& a, int l, int which, int item) {
    const Ctx c = fresh_ctx(c_in.lds);
    unsigned char* ws = a.ws;
    const u16* proj = (const u16*)(ws + WS_PROJ);
    const float* trig = (const float*)(ws + WS_TRIG);
    float* rs_s = (float*)(c.lds + G_LDS_BYTES);
    const int r8 = c.tid >> 3;
    const int wm = c.wave & 3, wn = c.wave >> 2, l31 = c.lane & 31, h = c.lane >> 5;
    const int K = which == 0 ? 256 : 128;
    const int pc = which == 0 ? PC_CQ : PC_CKV;
    const int ntn = which == 0 ? 3 : 4;
    const int mt = item / ntn, nt = item % ntn;
    const u16* w = which == 0 ? (const u16*)(ws + WS_WUQ) + (size_t)l * 384 * 256 : (const u16*)(ws + WS_WUKV) + (size_t)l * 512 * 128;
    {
        const int row = c.tid >> 1, half = c.tid & 1;
        const u16* p = proj + (size_t)(mt * 256 + row) * LDP + pc + half * (K / 2);
        float ss = 0.f;
        for (int i = 0; i < K / 2; i += 8) {
            const uint4 v = *(const uint4*)(p + i);
            const unsigned w4[4] = { v.x, v.y, v.z, v.w };
#pragma unroll
            for (int j = 0; j < 4; ++j) { const float f0 = bf2f((u16)(w4[j] & 0xffff)), f1 = bf2f((u16)(w4[j] >> 16)); ss += f0 * f0 + f1 * f1; }
        }
        ss += __shfl_xor(ss, 1);
        if (half == 0) rs_s[row] = rsqrtf(ss / (float)K + EPS);
    }
    __syncthreads();
    GP gp;
    gp.a0 = proj + (size_t)(mt * 256 + r8) * LDP + pc; gp.a1 = gp.a0 + 64 * LDP; gp.a2 = gp.a0 + 128 * LDP; gp.a3 = gp.a0 + 192 * LDP;
    gp.b0 = w + (size_t)(nt * 128 + r8) * K; gp.b1 = gp.b0 + 64 * K;
    f32x16 acc[2][2];
    acc[0][0] = zero16(); acc[0][1] = zero16(); acc[1][0] = zero16(); acc[1][1] = zero16();
    gemm_core<false>(c, K, gp, acc);
    u16* mlaq = (u16*)(ws + WS_MLAQ);
    u16* mlak = (u16*)(ws + WS_MLAK);
    u16* mlavt = (u16*)(ws + WS_MLAVT);
#pragma unroll
    for (int i = 0; i < 2; ++i)
#pragma unroll
        for (int j = 0; j < 2; ++j) {
            const int ml0 = wm * 64 + i * 32, m0 = mt * 256 + ml0, n0 = nt * 128 + wn * 64 + j * 32;
            const int n = n0 + l31;
            if (which == 0) {
                const bool rope = ((n0 >> 5) % 3) == 2;
#pragma unroll
                for (int r = 0; r < 16; ++r) {
                    const int ml = ml0 + crow(r, h), m = mt * 256 + ml;
                    float v = acc[i][j][r] * rs_s[ml];
                    if (rope) {
                        const float pv = __shfl_xor(v, 16);
                        const int ii = l31 & 15;
                        const float cs = trig[(size_t)m * 48 + 16 + ii], sn = trig[(size_t)m * 48 + 32 + ii];
                        v = (l31 < 16) ? (v * cs - pv * sn) : (v * cs + pv * sn);
                    }
                    mlaq[(size_t)m * 384 + n] = f2bf(v);
                }
            } else {
                const int head = n0 >> 7, wi = n0 & 127;
                if (wi < 64) {
#pragma unroll
                    for (int r = 0; r < 16; ++r) {
                        const int ml = ml0 + crow(r, h), m = mt * 256 + ml;
                        mlak[(size_t)m * 384 + head * 96 + wi + l31] = f2bf(acc[i][j][r] * rs_s[ml]);
                    }
                } else {
                    const int b = m0 >> 12, s0 = m0 & 4095, d = wi - 64 + l31;
                    u16* base = mlavt + ((size_t)(b * 4 + head) * 64 + d) * 4096 + s0;
#pragma unroll
                    for (int q = 0; q < 4; ++q) {
                        const int mlq = ml0 + 8 * q + 4 * h;
                        uint2 pk;
                        pk.x = pack2(acc[i][j][4 * q] * rs_s[mlq], acc[i][j][4 * q + 1] * rs_s[mlq + 1]);
                        pk.y = pack2(acc[i][j][4 * q + 2] * rs_s[mlq + 2], acc[i][j][4 * q + 3] * rs_s[mlq + 3]);
                        *(uint2*)(base + 8 * q + 4 * h) = pk;
                    }
                }
            }
        }
    __syncthreads();
}

constexpr int AT_LDV = 68;
template <int DQ, int MODE>
DI void attn_item(const Ctx& c_in, KArgs& a, int b, int hd_in, int qb) {
    const Ctx c = fresh_ctx(c_in.lds);
    unsigned char* ws = a.ws;
    constexpr int LDK = DQ + 8;
    constexpr int K_EL = 64 * LDK, V_EL = 64 * AT_LDV, ST_EL = K_EL + V_EL;
    constexpr int NKS = DQ / 16;
    constexpr int KCH = DQ / 8;
    u16* S = (u16*)c.lds;
    float* fc_s = (float*)(c.lds + 2 * ST_EL * 2 + 64);
    const int l31 = c.lane & 31, h = c.lane >> 5;
    int hd, wq0, nkt;
    const u16 *Qp, *Kp, *Vp; int ldq, ldk, ocol;
    float scale;
    if (MODE == 0) {
        hd = hd_in;
        wq0 = qb * 256 + c.wave * 32; nkt = qb * 4 + 4;
        Qp = (const u16*)(ws + WS_MLAQ) + (size_t)b * 4096 * 384 + hd * 96; ldq = 384;
        Kp = (const u16*)(ws + WS_MLAK) + (size_t)b * 4096 * 384 + hd * 96; ldk = 384;
        Vp = (const u16*)(ws + WS_MLAVT) + (size_t)(b * 4 + hd) * 64 * 4096;
        ocol = 512 + hd * 64; scale = 0.10206207261596575f;
    } else if (MODE == 1) {
        hd = hd_in;
        wq0 = qb * 256 + c.wave * 32; nkt = qb * 4 + 4;
        Qp = (const u16*)(ws + WS_PROJ) + (size_t)b * 4096 * LDP + PC_FOXQ + hd * 64; ldq = LDP;
        Kp = (const u16*)(ws + WS_PROJ) + (size_t)b * 4096 * LDP + PC_FOXK + hd * 64; ldk = LDP;
        Vp = (const u16*)(ws + WS_FOXVT) + (size_t)(b * 4 + hd) * 64 * 4096;
        ocol = 768 + hd * 64; scale = 0.125f;
    } else {
        hd = c.wave & 3;
        wq0 = qb * 64 + (c.wave >> 2) * 32; nkt = qb + 1;
        Qp = (const u16*)(ws + WS_PROJ) + (size_t)b * 4096 * LDP + PC_DSAQ + hd * 64; ldq = LDP;
        Kp = (const u16*)(ws + WS_PROJ) + (size_t)b * 4096 * LDP + PC_DSAK; ldk = LDP;
        Vp = (const u16*)(ws + WS_DSAVT) + (size_t)b * 64 * 4096;
        ocol = 256 + hd * 64; scale = 0.125f;
    }
    const float sc2 = scale * LOG2E;
    const int q = wq0 + l31;
    bf16x8 qf[NKS];
#pragma unroll
    for (int ks = 0; ks < NKS; ++ks) qf[ks] = *(const bf16x8*)(Qp + (size_t)q * ldq + ks * 16 + h * 8);
    float fq = 0.f;
    if (MODE == 1) {
        const float* fl = (const float*)(ws + WS_FLOG) + (size_t)(b * 4 + hd) * 4096;
        float* wtot = (float*)(c.lds + 2 * ST_EL * 2);
        const int nk = nkt * 64;
        float v[8]; float s = 0.f;
#pragma unroll
        for (int j = 0; j < 8; ++j) { const int idx = c.tid * 8 + j; v[j] = (idx < nk) ? fl[idx] : 0.f; s += v[j]; v[j] = s; }
        float inc = s;
#pragma unroll
        for (int o = 1; o < 64; o <<= 1) { const float tv = __shfl_up(inc, o); if (c.lane >= o) inc += tv; }
        if (c.lane == 63) wtot[c.wave] = inc;
        __syncthreads();
        float base = inc - s;
        for (int w2 = 0; w2 < c.wave; ++w2) base += wtot[w2];
#pragma unroll
        for (int j = 0; j < 8; ++j) fc_s[c.tid * 8 + j] = (base + v[j]) * LOG2E;
        __syncthreads();
        fq = fc_s[q];
    }
    float sbound = 0.f;
    int* dflag = (int*)(c.lds + 2 * ST_EL * 2 + 64 + 4096 * 4);
    if (MODE == 1) {
        float qq = 0.f;
#pragma unroll
        for (int ks = 0; ks < NKS; ++ks)
#pragma unroll
            for (int j = 0; j < 8; ++j) { const float f = bf2f((u16)qf[ks][j]); qq += f * f; }
        qq += __shfl_xor(qq, 32);
        const float kmax2 = __uint_as_float(__hip_atomic_load((const unsigned*)(ws + WS_CTL) + 64 + b * 4 + hd, __ATOMIC_RELAXED, __HIP_MEMORY_SCOPE_AGENT));
        sbound = sqrtf(qq * kmax2) * sc2 * 1.02f + 1.0f;
        if (c.tid < 16) dflag[c.tid] = 0;
    }
    bool wdone = false;
    const int krow0 = c.tid / KCH, kch0 = c.tid % KCH;
    const int c1 = c.tid + NTHR; const int krow1 = c1 / KCH, kch1 = c1 % KCH; const bool has1 = (KCH * 64 > NTHR) && (c1 < KCH * 64);
    const int vrow = c.tid >> 3, vch = c.tid & 7;
    uint4 rk0, rk1, rv; rk1 = make_uint4(0, 0, 0, 0);
    auto gload = [&](int kt) {
        rk0 = *(const uint4*)(Kp + (size_t)(kt * 64 + krow0) * ldk + kch0 * 8);
        if (has1) rk1 = *(const uint4*)(Kp + (size_t)(kt * 64 + krow1) * ldk + kch1 * 8);
        rv = *(const uint4*)(Vp + (size_t)vrow * 4096 + kt * 64 + vch * 8);
    };
    auto sstore = [&](int st) {
        u16* Ks = S + st * ST_EL; u16* Vs = Ks + K_EL;
        *(uint4*)(Ks + krow0 * LDK + kch0 * 8) = rk0;
        if (has1) *(uint4*)(Ks + krow1 * LDK + kch1 * 8) = rk1;
        *(uint2*)(Vs + vrow * AT_LDV + vch * 8) = make_uint2(rv.x, rv.y);
        *(uint2*)(Vs + vrow * AT_LDV + vch * 8 + 4) = make_uint2(rv.z, rv.w);
    };
    f32x16 o0 = zero16(), o1 = zero16();
    float m_run = -1e30f, l_run = 0.f;
    const u64* mrow = (const u64*)(ws + WS_MASK) + (size_t)(b * 4096 + q) * 64;
    u64 mw_cur = 0, mw_nxt = 0;
    if (MODE == 2) mw_cur = mrow[0];
    gload(MODE == 1 ? nkt - 1 : 0); sstore(0);
    __syncthreads();
    for (int it = 0; it < nkt; ++it) {
        const int kt = (MODE == 1) ? nkt - 1 - it : it;
        const bool more = (it + 1 < nkt);
        if (more) { gload(MODE == 1 ? kt - 1 : kt + 1); if (MODE == 2) mw_nxt = mrow[kt + 1]; }
        if (kt * 64 <= wq0 + 31 && !wdone) {
            const u16* Ks = S + (it & 1) * ST_EL; const u16* Vs = Ks + K_EL;
            f32x16 s0 = zero16(), s1 = zero16();
#pragma unroll
            for (int ks = 0; ks < NKS; ++ks) {
                const bf16x8 k0 = *(const bf16x8*)(Ks + l31 * LDK + ks * 16 + h * 8);
                const bf16x8 k1 = *(const bf16x8*)(Ks + (32 + l31) * LDK + ks * 16 + h * 8);
                s0 = MFMA32(k0, qf[ks], s0);
                s1 = MFMA32(k1, qf[ks], s1);
            }
            const float scx = (MODE == 1) ? 1.0f : sc2;
            if (MODE == 1) {
#pragma unroll
                for (int g4 = 0; g4 < 4; ++g4) {
                    const float4 f0 = *(const float4*)(fc_s + kt * 64 + 8 * g4 + 4 * h);
                    const float4 f1 = *(const float4*)(fc_s + kt * 64 + 32 + 8 * g4 + 4 * h);
                    s0[4 * g4 + 0] = fmaf(s0[4 * g4 + 0], sc2, fq) - f0.x; s0[4 * g4 + 1] = fmaf(s0[4 * g4 + 1], sc2, fq) - f0.y;
                    s0[4 * g4 + 2] = fmaf(s0[4 * g4 + 2], sc2, fq) - f0.z; s0[4 * g4 + 3] = fmaf(s0[4 * g4 + 3], sc2, fq) - f0.w;
                    s1[4 * g4 + 0] = fmaf(s1[4 * g4 + 0], sc2, fq) - f1.x; s1[4 * g4 + 1] = fmaf(s1[4 * g4 + 1], sc2, fq) - f1.y;
                    s1[4 * g4 + 2] = fmaf(s1[4 * g4 + 2], sc2, fq) - f1.z; s1[4 * g4 + 3] = fmaf(s1[4 * g4 + 3], sc2, fq) - f1.w;
                }
            }
            if (MODE == 2) {
                const unsigned mlo = (unsigned)(mw_cur >> (4 * h)), mhi = (unsigned)(mw_cur >> (32 + 4 * h));
#pragma unroll
                for (int r = 0; r < 16; ++r) {
                    const int kr = (r & 3) + 8 * (r >> 2);
                    s0[r] = ((mlo >> kr) & 1u) ? s0[r] : -1e30f;
                    s1[r] = ((mhi >> kr) & 1u) ? s1[r] : -1e30f;
                }
            } else if (__builtin_amdgcn_readfirstlane(kt * 64 + 63 - wq0) > 0) {
                asm volatile("" ::: "memory");
                const int qrel = q - kt * 64 - 4 * h;
#pragma unroll
                for (int r = 0; r < 16; ++r) {
                    const int kr = (r & 3) + 8 * (r >> 2);
                    s0[r] = (kr <= qrel) ? s0[r] : -1e30f;
                    s1[r] = (kr + 32 <= qrel) ? s1[r] : -1e30f;
                }
            }
            float mx;
            {
                float t0 = max3f(s0[0], s0[1], s0[2]), t1 = max3f(s0[3], s0[4], s0[5]), t2 = max3f(s0[6], s0[7], s0[8]), t3 = max3f(s0[9], s0[10], s0[11]);
                float t4 = max3f(s0[12], s0[13], s0[14]), t5 = max3f(s0[15], s1[0], s1[1]), t6 = max3f(s1[2], s1[3], s1[4]), t7 = max3f(s1[5], s1[6], s1[7]);
                float t8 = max3f(s1[8], s1[9], s1[10]), t9 = max3f(s1[11], s1[12], s1[13]), t10 = max3f(s1[14], s1[15], t0);
                t1 = max3f(t1, t2, t3); t4 = max3f(t4, t5, t6); t7 = max3f(t7, t8, t9);
                mx = max3f(t1, t4, t7); mx = max3f(mx, t10, __shfl_xor(max3f(t1, t4, max3f(t7, t10, t10)), 32));
            }
            const float m_new = max3f(m_run, mx, mx);
            const float m_use = (MODE == 2) ? max3f(m_new, -1e20f, -1e20f) : m_new;
            const float alpha = ex2((m_run - m_new) * scx);
            const float nm = -m_use * scx;
            f32x2 rs2 = {0.f, 0.f};
            const f32x2 sc2v = {scx, scx}, nm2 = {nm, nm};
#pragma unroll
            for (int r = 0; r < 16; r += 2) {
                f32x2 xv = {s0[r], s0[r + 1]};
                xv = xv * sc2v + nm2;
                xv[0] = ex2(xv[0]); xv[1] = ex2(xv[1]);
                s0[r] = xv[0]; s0[r + 1] = xv[1];
                rs2 += xv;
                f32x2 yv = {s1[r], s1[r + 1]};
                yv = yv * sc2v + nm2;
                yv[0] = ex2(yv[0]); yv[1] = ex2(yv[1]);
                s1[r] = yv[0]; s1[r + 1] = yv[1];
                rs2 += yv;
            }
            float rsum = rs2[0] + rs2[1];
            rsum += __shfl_xor(rsum, 32);
            l_run = l_run * alpha + rsum; m_run = m_new;
            if (__any(alpha != 1.0f)) {
#pragma unroll
                for (int r = 0; r < 16; ++r) { o0[r] *= alpha; o1[r] *= alpha; }
            }
#pragma unroll
            for (int sub = 0; sub < 2; ++sub)
#pragma unroll
                for (int s2 = 0; s2 < 2; ++s2) {
                    const bf16x8 pb = pack8(sub ? s1 : s0, s2);
                    const int koff = sub * 32 + 16 * s2 + 4 * h;
                    {
                        const u16* vr = Vs + l31 * AT_LDV + koff;
                        const uint2 lo = *(const uint2*)vr, hi = *(const uint2*)(vr + 8);
                        o0 = MFMA32(__builtin_bit_cast(bf16x8, make_uint4(lo.x, lo.y, hi.x, hi.y)), pb, o0);
                    }
                    {
                        const u16* vr = Vs + (32 + l31) * AT_LDV + koff;
                        const uint2 lo = *(const uint2*)vr, hi = *(const uint2*)(vr + 8);
                        o1 = MFMA32(__builtin_bit_cast(bf16x8, make_uint4(lo.x, lo.y, hi.x, hi.y)), pb, o1);
                    }
                }
        }
        if (more) sstore((it + 1) & 1);
        if (MODE == 2) mw_cur = mw_nxt;
        if (MODE == 1) {
            if (kt * 64 <= wq0 + 31 && !wdone && kt > 0) wdone = __all(sbound + (fq - fc_s[kt * 64 - 1]) < m_run - 40.f);
            if (c.lane == 0) dflag[(it & 1) * 8 + c.wave] = wdone ? 1 : 0;
        }
        __syncthreads();
        if (MODE == 1) {
            const int4 f0 = *(const int4*)(dflag + (it & 1) * 8), f1 = *(const int4*)(dflag + (it & 1) * 8 + 4);
            if ((f0.x & f0.y & f0.z & f0.w & f1.x & f1.y & f1.z & f1.w) != 0) break;
        }
    }
    if (MODE == 1) __syncthreads();
    {
        const float inv = 1.f / l_run;
        u16* act = (u16*)(ws + WS_ACT) + (size_t)(b * 4096 + q) * 1024 + ocol;
#pragma unroll
        for (int qd = 0; qd < 4; ++qd) {
            uint2 pk;
            pk.x = pack2(o0[4 * qd] * inv, o0[4 * qd + 1] * inv); pk.y = pack2(o0[4 * qd + 2] * inv, o0[4 * qd + 3] * inv);
            *(uint2*)(act + 8 * qd + 4 * h) = pk;
            pk.x = pack2(o1[4 * qd] * inv, o1[4 * qd + 1] * inv); pk.y = pack2(o1[4 * qd + 2] * inv, o1[4 * qd + 3] * inv);
            *(uint2*)(act + 32 + 8 * qd + 4 * h) = pk;
        }
    }
}

constexpr int SC_LD = 4100;
DI void dsa_index_item(const Ctx& c_in, KArgs& a, int b, int s0) {
    const Ctx c = fresh_ctx(c_in.lds);
    unsigned char* ws = a.ws;
    const u16* proj = (const u16*)(ws + WS_PROJ);
    const float* small = (const float*)(ws + WS_SMALL);
    u64* mask = (u64*)(ws + WS_MASK);
    float* SC = (float*)c.lds;
    unsigned* HIST = (unsigned*)(c.lds + 8 * SC_LD * 4);
    const int l31 = c.lane & 31, h = c.lane >> 5;
    const int tok0 = b * 4096 + s0;
    const int ntile = ((s0 + 7) >> 5) + 1;
    bf16x8 qa[2][4];
    float wv[2][16];
#pragma unroll
    for (int rt = 0; rt < 2; ++rt) {
        const int r = rt * 32 + l31, ql = r >> 3, j = r & 7;
        const u16* p = proj + (size_t)(tok0 + ql) * LDP + PC_IDXQ + j * 64 + h * 8;
#pragma unroll
        for (int ks = 0; ks < 4; ++ks) qa[rt][ks] = *(const bf16x8*)(p + ks * 16);
#pragma unroll
        for (int r2 = 0; r2 < 16; ++r2) {
            const int qq = (r2 >> 2) + 4 * rt, jj = (r2 & 3) + 4 * h;
            wv[rt][r2] = small[(size_t)(tok0 + qq) * 16 + 4 + jj] * 0.044194173824159216f;
        }
    }
    const u16* kbase = proj + (size_t)(b * 4096 + l31) * LDP + PC_IDXK + h * 8;
    bf16x8 kb[4], kn[4];
    if (c.wave < ntile) {
#pragma unroll
        for (int ks = 0; ks < 4; ++ks) kb[ks] = *(const bf16x8*)(kbase + (size_t)(c.wave * 32) * LDP + ks * 16);
    }
    for (int kt = c.wave; kt < ntile; kt += 8) {
        const int key = kt * 32 + l31;
        if (kt + 8 < ntile) {
#pragma unroll
            for (int ks = 0; ks < 4; ++ks) kn[ks] = *(const bf16x8*)(kbase + (size_t)((kt + 8) * 32) * LDP + ks * 16);
        }
        f32x16 a0 = zero16(), a1 = zero16();
#pragma unroll
        for (int ks = 0; ks < 4; ++ks) { a0 = MFMA32(qa[0][ks], kb[ks], a0); a1 = MFMA32(qa[1][ks], kb[ks], a1); }
#pragma unroll
        for (int g = 0; g < 4; ++g) {
            float p0 = 0.f, p1 = 0.f;
#pragma unroll
            for (int r3 = 0; r3 < 4; ++r3) {
                p0 += wv[0][4 * g + r3] * fmaxf(a0[4 * g + r3], 0.f);
                p1 += wv[1][4 * g + r3] * fmaxf(a1[4 * g + r3], 0.f);
            }
            const float t0 = p0 + __shfl_xor(p0, 32);
            const float t1 = p1 + __shfl_xor(p1, 32);
            SC[(4 * h + g) * SC_LD + key] = h ? t1 : t0;
        }
#pragma unroll
        for (int ks = 0; ks < 4; ++ks) kb[ks] = kn[ks];
    }
    __syncthreads();
    {
        const int qi = s0 + c.wave, n = qi + 1;
        const float* sc = SC + c.wave * SC_LD;
        unsigned* hist = HIST + c.wave * 272;
        const int nit = (n + 63) >> 6;
        unsigned key[64];
#pragma unroll
        for (int g = 0; g < 8; ++g) {
#pragma unroll
            for (int j = 0; j < 8; ++j) key[g * 8 + j] = 0u;
            if (g * 8 < nit) {
#pragma unroll
                for (int j = 0; j < 8; ++j) {
                    const int i = (g * 8 + j) * 64 + c.lane;
                    const unsigned bits = __float_as_uint(sc[i] + 0.0f);
                    const unsigned k = bits ^ ((unsigned)((int)bits >> 31) | 0x80000000u);
                    key[g * 8 + j] = (i < n) ? k : 0u;
                }
            }
        }
        unsigned thr = 1u; int cut = 0x7fffffff;
        if (n > 256) {
            unsigned lo = 0xffffffffu, hi = 0u;
#pragma unroll
            for (int g = 0; g < 8; ++g) if (g * 8 < nit) {
#pragma unroll
                for (int j = 0; j < 8; ++j) { const unsigned k = key[g * 8 + j]; hi = max(hi, k); lo = min(lo, k ? k : 0xffffffffu); }
            }
#pragma unroll
            for (int o = 32; o >= 1; o >>= 1) { lo = min(lo, (unsigned)__shfl_xor((int)lo, o)); hi = max(hi, (unsigned)__shfl_xor((int)hi, o)); }
            int kk = 256;
            for (int iter = 0; iter < 5; ++iter) {
                const unsigned width = hi - lo;
                const int shift = max(0, 24 - (int)__clz(width | 1u));
#pragma unroll
                for (int j = 0; j < 5; ++j) { const int idx = c.lane + 64 * j; if (idx < 272) hist[idx] = 0u; }
#pragma unroll
                for (int g = 0; g < 8; ++g) if (g * 8 < nit) {
#pragma unroll
                    for (int j = 0; j < 8; ++j) {
                        const unsigned d = key[g * 8 + j] - lo;
                        if (d <= width) atomicAdd(&hist[d >> shift], 1u);
                    }
                }
                const unsigned c0 = hist[4 * c.lane], c1 = hist[4 * c.lane + 1], c2 = hist[4 * c.lane + 2], c3 = hist[4 * c.lane + 3];
                const unsigned ls = c0 + c1 + c2 + c3;
                unsigned suf = ls;
#pragma unroll
                for (int o = 1; o < 64; o <<= 1) { const unsigned tv = __shfl_down(suf, o); if (c.lane + o < 64) suf += tv; }
                const unsigned above_lane = suf - ls;
                const bool mine = (suf >= (unsigned)kk) && (above_lane < (unsigned)kk);
                int bstar = 0; unsigned above = 0, cntb = 0;
                if (mine) {
                    unsigned run = above_lane;
                    if (run + c3 >= (unsigned)kk) { bstar = 4 * c.lane + 3; above = run; cntb = c3; }
                    else { run += c3;
                        if (run + c2 >= (unsigned)kk) { bstar = 4 * c.lane + 2; above = run; cntb = c2; }
                        else { run += c2;
                            if (run + c1 >= (unsigned)kk) { bstar = 4 * c.lane + 1; above = run; cntb = c1; }
                            else { run += c1; bstar = 4 * c.lane; above = run; cntb = c0; } } }
                }
                const u64 mm = __ballot(mine);
                const int src = __ffsll((long long)mm) - 1;
                bstar = __shfl(bstar, src); above = __shfl(above, src); cntb = __shfl(cntb, src);
                kk -= (int)above;
                const unsigned nlo = lo + ((unsigned)bstar << shift);
                const unsigned nhi = min(hi, nlo + ((1u << shift) - 1u));
                lo = nlo; hi = nhi; thr = lo;
                if ((int)cntb == kk) break;
                if (shift == 0) {
                    int need = kk;
                    for (int it = 0; it < nit; ++it) {
                        const int i = it * 64 + c.lane;
                        unsigned k = 0u;
                        if (i < n) { const unsigned bits = __float_as_uint(sc[i] + 0.0f); k = bits ^ ((unsigned)((int)bits >> 31) | 0x80000000u); }
                        const bool e = (k == thr);
                        const u64 mk = __ballot(e); const int cn = __popcll(mk);
                        if (need <= cn) {
                            const u64 sel = __ballot(e && (__popcll(mk & ((1ull << c.lane) - 1ull)) == need - 1));
                            cut = it * 64 + (__ffsll((long long)sel) - 1);
                            break;
                        }
                        need -= cn;
                    }
                    break;
                }
            }
        }
        u64* mrow = mask + (size_t)(b * 4096 + qi) * 64;
        u64 myword = 0;
        const bool tie = (cut != 0x7fffffff);
#pragma unroll
        for (int it = 0; it < 64; ++it) {
            u64 wd = 0;
            if (it < nit) {
                const unsigned k = key[it];
                bool sel = (k >= thr);
                if (tie) sel = (k > thr) || (k == thr && (it * 64 + c.lane) <= cut);
                wd = __ballot(sel);
            }
            if (c.lane == it) myword = wd;
        }
        mrow[c.lane] = myword;
    }
    __syncthreads();
}

DI void phase_outproj(const Ctx& c_in, KArgs& a, int l) {
    const Ctx c = fresh_ctx(c_in.lds);
    unsigned char* ws = a.ws;
    const u16* act = (const u16*)(ws + WS_ACT);
    const u16* w = (const u16*)(ws + WS_WOUT) + (size_t)l * 1024 * 1024;
    const float* xin = (l == 0) ? a.in[0] : a.out;
    float* out = a.out;
    const int r8 = c.tid >> 3;
    const int wm = c.wave & 3, wn = c.wave >> 2, l31 = c.lane & 31, h = c.lane >> 5;
    const int ntiles = (T_TOK / 256) * 8;
    for (int tile = vblock(); tile < ntiles; tile += gridDim.x) {
        const int mt = (tile >> 5) * 4 + (tile & 3), nt = (tile >> 2) & 7;
        GP gp;
        gp.a0 = act + (size_t)(mt * 256 + r8) * 1024; gp.a1 = gp.a0 + 64 * 1024; gp.a2 = gp.a0 + 128 * 1024; gp.a3 = gp.a0 + 192 * 1024;
        gp.b0 = w + (size_t)(nt * 128 + r8) * 1024; gp.b1 = gp.b0 + 64 * 1024;
        f32x16 acc[2][2];
        acc[0][0] = zero16(); acc[0][1] = zero16(); acc[1][0] = zero16(); acc[1][1] = zero16();
        gemm_core<false>(c, 1024, gp, acc);
#pragma unroll
        for (int i = 0; i < 2; ++i)
#pragma unroll
            for (int j = 0; j < 2; ++j) {
                const int m0 = mt * 256 + wm * 64 + i * 32, n = nt * 128 + wn * 64 + j * 32 + l31;
#pragma unroll
                for (int r = 0; r < 16; ++r) acc[i][j][r] += xin[(size_t)(m0 + crow(r, h)) * 1024 + n];
            }
#pragma unroll
        for (int i = 0; i < 2; ++i)
#pragma unroll
            for (int j = 0; j < 2; ++j) {
                const int m0 = mt * 256 + wm * 64 + i * 32, n = nt * 128 + wn * 64 + j * 32 + l31;
#pragma unroll
                for (int r = 0; r < 16; ++r) out[(size_t)(m0 + crow(r, h)) * 1024 + n] = acc[i][j][r];
            }
    }
}

constexpr int RT_LD = 1032;
DI void phase_router(const Ctx& c_in, KArgs& a, int l) {
    const Ctx c = fresh_ctx(c_in.lds);
    unsigned char* ws = a.ws;
    const float* x = a.out;
    const float* g = a.in[16] + l * 1024;
    const float* brg = a.in[18] + l * 4;
    const float* bre = a.in[20] + l * 32;
    const u16* wrh = (const u16*)(ws + WS_WRH) + (size_t)l * 64 * 1024;
    const u16* wrl = (const u16*)(ws + WS_WRL) + (size_t)l * 64 * 1024;
    u16* act = (u16*)(ws + WS_ACT);
    int* cnt = (int*)(ws + WS_CTL);
    int* list = (int*)(ws + WS_LIST);
    float* tokw = (float*)(ws + WS_TOKW);
    u16* HI = (u16*)c.lds;
    u16* LO = HI + 32 * RT_LD;
    float* LG = (float*)(c.lds + 2 * 32 * RT_LD * 2);
    const int l31 = c.lane & 31, h = c.lane >> 5;
    for (int it = blockIdx.x; it < T_TOK / 32; it += gridDim.x) {
        const int t0 = it * 32;
#pragma unroll
        for (int tt = 0; tt < 4; ++tt) {
            const int tl = c.wave * 4 + tt, t = t0 + tl;
            const float* xr = x + (size_t)t * 1024 + c.lane * 4;
            float4 v[4]; float ss = 0.f;
#pragma unroll
            for (int j = 0; j < 4; ++j) { v[j] = *(const float4*)(xr + 256 * j); ss += v[j].x * v[j].x + v[j].y * v[j].y + v[j].z * v[j].z + v[j].w * v[j].w; }
            ss = wsum(ss);
            const float rs = rsqrtf(ss * (1.f / 1024.f) + EPS);
#pragma unroll
            for (int j = 0; j < 4; ++j) {
                const float4 gg = *(const float4*)(g + c.lane * 4 + 256 * j);
                const float h0 = v[j].x * rs * gg.x, h1 = v[j].y * rs * gg.y, h2 = v[j].z * rs * gg.z, h3 = v[j].w * rs * gg.w;
                const u16 b0 = f2bf(h0), b1 = f2bf(h1), b2 = f2bf(h2), b3 = f2bf(h3);
                const uint2 hp = make_uint2((unsigned)b0 | ((unsigned)b1 << 16), (unsigned)b2 | ((unsigned)b3 << 16));
                const uint2 lp = make_uint2(pack2(h0 - bf2f(b0), h1 - bf2f(b1)), pack2(h2 - bf2f(b2), h3 - bf2f(b3)));
                *(uint2*)(act + (size_t)t * 1024 + c.lane * 4 + 256 * j) = hp;
                *(uint2*)(HI + tl * RT_LD + c.lane * 4 + 256 * j) = hp;
                *(uint2*)(LO + tl * RT_LD + c.lane * 4 + 256 * j) = lp;
            }
        }
        __syncthreads();
        {
            const int k0 = c.wave * 128 + h * 8;
            f32x16 acc0 = zero16(), acc1 = zero16();
#pragma unroll
            for (int ks = 0; ks < 8; ++ks) {
                const int k = k0 + ks * 16;
                const bf16x8 ah = *(const bf16x8*)(HI + l31 * RT_LD + k);
                const bf16x8 al = *(const bf16x8*)(LO + l31 * RT_LD + k);
                const bf16x8 bh0 = *(const bf16x8*)(wrh + (size_t)l31 * 1024 + k);
                const bf16x8 bh1 = *(const bf16x8*)(wrh + (size_t)(32 + l31) * 1024 + k);
                const bf16x8 bl0 = *(const bf16x8*)(wrl + (size_t)l31 * 1024 + k);
                const bf16x8 bl1 = *(const bf16x8*)(wrl + (size_t)(32 + l31) * 1024 + k);
                acc0 = MFMA32(ah, bh0, acc0); acc0 = MFMA32(ah, bl0, acc0); acc0 = MFMA32(al, bh0, acc0);
                acc1 = MFMA32(ah, bh1, acc1); acc1 = MFMA32(ah, bl1, acc1); acc1 = MFMA32(al, bh1, acc1);
            }
            __syncthreads();
            float* PART = (float*)c.lds + c.wave * (32 * 37);
#pragma unroll
            for (int r = 0; r < 16; ++r) {
                PART[crow(r, h) * 37 + l31] = acc0[r];
                if (l31 < 4) PART[crow(r, h) * 37 + 32 + l31] = acc1[r];
            }
        }
        __syncthreads();
        for (int i = c.tid; i < 32 * 36; i += NTHR) {
            const int tk = i / 36, e = i % 36;
            float s = 0.f;
#pragma unroll
            for (int w2 = 0; w2 < 8; ++w2) s += ((const float*)c.lds)[w2 * (32 * 37) + tk * 37 + e];
            LG[tk * 65 + e] = s;
        }
        __syncthreads();
        if (c.tid < 32) {
            const int t = t0 + c.tid;
            const float* lg = LG + c.tid * 65;
            float gl[4];
#pragma unroll
            for (int e = 0; e < 4; ++e) gl[e] = lg[e] + brg[e];
            int gi = 0; float gm = gl[0];
#pragma unroll
            for (int e = 1; e < 4; ++e) if (gl[e] > gm) { gm = gl[e]; gi = e; }
            float den = 0.f;
#pragma unroll
            for (int e = 0; e < 4; ++e) den += __expf(gl[e] - gm);
            const float gp = 1.f / den;
            float el[8];
#pragma unroll
            for (int e = 0; e < 8; ++e) el[e] = lg[4 + gi * 8 + e] + bre[gi * 8 + e];
            int i1 = 0; float v1 = el[0];
#pragma unroll
            for (int e = 1; e < 8; ++e) if (el[e] > v1) { v1 = el[e]; i1 = e; }
            int i2 = 0; float v2 = -INFINITY;
#pragma unroll
            for (int e = 0; e < 8; ++e) if (e != i1 && el[e] > v2) { v2 = el[e]; i2 = e; }
            const float ex = __expf(v2 - v1);
            const float w1 = gp / (1.f + ex), w2 = gp * ex / (1.f + ex);
            const int e1 = gi * 8 + i1, e2 = gi * 8 + i2;
            const int s1 = atomicAdd(&cnt[e1 * 2 + 0], 1);
            list[(size_t)(e1 * 2 + 0) * 32768 + s1] = t;
            const int s2 = atomicAdd(&cnt[e2 * 2 + 1], 1);
            list[(size_t)(e2 * 2 + 1) * 32768 + s2] = t;
            tokw[t * 2] = w1; tokw[t * 2 + 1] = w2;
        }
        __syncthreads();
    }
}

DI int moe_setup(const Ctx& c, KArgs& a, int ntn, int kfilter, int* tstart  ) {
    const int* cnt = (const int*)(a.ws + WS_CTL);
    if (c.tid < 64) {
        const int L = c.tid;
        const int n = __hip_atomic_load(&cnt[L], __ATOMIC_RELAXED, __HIP_MEMORY_SCOPE_AGENT);
        const int mine = (kfilter < 0 || (L & 1) == kfilter) ? ((n + 255) >> 8) * ntn : 0;
        int inc = mine;
#pragma unroll
        for (int o = 1; o < 64; o <<= 1) { const int tv = __shfl_up(inc, o); if (L >= o) inc += tv; }
        tstart[L] = inc - mine;
        if (L == 63) tstart[64] = inc;
    }
    __syncthreads();
    return tstart[64];
}

DI void phase_moe_up(const Ctx& c_in, KArgs& a) {
    const Ctx c = fresh_ctx(c_in.lds);
    unsigned char* ws = a.ws;
    const u16* act = (const u16*)(ws + WS_ACT);
    const int* cnt = (const int*)(ws + WS_CTL);
    const int* list = (const int*)(ws + WS_LIST);
    const float* tokw = (const float*)(ws + WS_TOKW);
    u16* hmid = (u16*)(ws + WS_HMID);
    int* tstart = (int*)(c.lds + G_LDS_BYTES);
    int* tok_s = (int*)(c.lds + G_LDS_BYTES + 512);
    const int r8 = c.tid >> 3;
    const int wm = c.wave & 3, wn = c.wave >> 2, l31 = c.lane & 31, h = c.lane >> 5;
    const int total = moe_setup(c, a, 4, -1, tstart);
    for (int tile = vblock(); tile < total; tile += gridDim.x) {
        int L = 0;
        for (int j = 0; j < 64; ++j) if (tstart[j + 1] <= tile) L = j + 1;
        const int rel = tile - tstart[L], mi = rel >> 2, nt = rel & 3;
        const int e = L >> 1, kr = L & 1;
        const int n = __hip_atomic_load(&cnt[L], __ATOMIC_RELAXED, __HIP_MEMORY_SCOPE_AGENT);
        __syncthreads();
        if (c.tid < 256) { const int r = mi * 256 + c.tid; tok_s[c.tid] = (r < n) ? list[(size_t)L * 32768 + r] : -1; }
        __syncthreads();
        GP gp;
        { const int t0 = tok_s[r8], t1 = tok_s[r8 + 64], t2 = tok_s[r8 + 128], t3 = tok_s[r8 + 192];
          gp.a0 = act + (size_t)(t0 < 0 ? 0 : t0) * 1024; gp.a1 = act + (size_t)(t1 < 0 ? 0 : t1) * 1024;
          gp.a2 = act + (size_t)(t2 < 0 ? 0 : t2) * 1024; gp.a3 = act + (size_t)(t3 < 0 ? 0 : t3) * 1024; }
        gp.b0 = (const u16*)(ws + WS_WG) + ((size_t)e * 256 + nt * 64 + r8) * 1024;
        gp.b1 = (const u16*)(ws + WS_WU) + ((size_t)e * 256 + nt * 64 + r8) * 1024;
        f32x16 acc[2][2];
        acc[0][0] = zero16(); acc[0][1] = zero16(); acc[1][0] = zero16(); acc[1][1] = zero16();
        gemm_core<true>(c, 1024, gp, acc);
#pragma unroll
        for (int i = 0; i < 2; ++i) {
            const int nn = nt * 64 + wn * 32 + l31;
#pragma unroll
            for (int r = 0; r < 16; ++r) {
                const int ml = wm * 64 + i * 32 + crow(r, h);
                const int tk = tok_s[ml];
                if (tk >= 0) {
                    const float gv = acc[i][0][r], uv = acc[i][1][r];
                    hmid[((size_t)tk * 2 + kr) * 256 + nn] = f2bf(siluf(gv) * uv * tokw[tk * 2 + kr]);
                }
            }
        }
    }
}

DI void phase_moe_down(const Ctx& c_in, KArgs& a) {
    const Ctx c = fresh_ctx(c_in.lds);
    unsigned char* ws = a.ws;
    const int* cnt = (const int*)(ws + WS_CTL);
    const int* list = (const int*)(ws + WS_LIST);
    const u16* hmid = (const u16*)(ws + WS_HMID);
    u16* yffn = (u16*)(ws + WS_YFFN);
    int* tstart = (int*)(c.lds + G_LDS_BYTES);
    int* tok_s = (int*)(c.lds + G_LDS_BYTES + 512);
    const int r8 = c.tid >> 3;
    const int wm = c.wave & 3, wn = c.wave >> 2, l31 = c.lane & 31, h = c.lane >> 5;
    const int total = moe_setup(c, a, 8, -1, tstart);
    for (int tile = vblock(); tile < total; tile += gridDim.x) {
        int L = 0;
        for (int j = 0; j < 64; ++j) if (tstart[j + 1] <= tile) L = j + 1;
        const int rel = tile - tstart[L], mi = rel >> 3, nt = rel & 7;
        const int e = L >> 1, kr = L & 1;
        const int n = __hip_atomic_load(&cnt[L], __ATOMIC_RELAXED, __HIP_MEMORY_SCOPE_AGENT);
        __syncthreads();
        if (c.tid < 256) { const int r = mi * 256 + c.tid; tok_s[c.tid] = (r < n) ? list[(size_t)L * 32768 + r] : -1; }
        __syncthreads();
        GP gp;
        { const int t0 = tok_s[r8], t1 = tok_s[r8 + 64], t2 = tok_s[r8 + 128], t3 = tok_s[r8 + 192];
          gp.a0 = hmid + ((size_t)(t0 < 0 ? 0 : t0) * 2 + kr) * 256; gp.a1 = hmid + ((size_t)(t1 < 0 ? 0 : t1) * 2 + kr) * 256;
          gp.a2 = hmid + ((size_t)(t2 < 0 ? 0 : t2) * 2 + kr) * 256; gp.a3 = hmid + ((size_t)(t3 < 0 ? 0 : t3) * 2 + kr) * 256; }
        gp.b0 = (const u16*)(ws + WS_WD) + ((size_t)e * 1024 + nt * 128 + r8) * 256; gp.b1 = gp.b0 + 64 * 256;
        f32x16 acc[2][2];
        acc[0][0] = zero16(); acc[0][1] = zero16(); acc[1][0] = zero16(); acc[1][1] = zero16();
        gemm_core<false>(c, 256, gp, acc);
#pragma unroll
        for (int i = 0; i < 2; ++i)
#pragma unroll
            for (int j = 0; j < 2; ++j) {
                const int nn = nt * 128 + wn * 64 + j * 32 + l31;
#pragma unroll
                for (int r = 0; r < 16; ++r) {
                    const int tk = tok_s[wm * 64 + i * 32 + crow(r, h)];
                    if (tk >= 0) yffn[((size_t)tk * 2 + kr) * 1024 + nn] = f2bf(acc[i][j][r]);
                }
            }
    }
}

DI void phase_final(const Ctx& c_in, KArgs& a) {
    const Ctx c = fresh_ctx(c_in.lds);
    float* x = a.out;
    const float* g = a.in[24];
    for (int it = blockIdx.x; it < T_TOK / 8; it += gridDim.x) {
        const int t = it * 8 + c.wave;
        float* xr = x + (size_t)t * 1024;
        float v[16]; float ss = 0.f;
        const u16* y0 = (const u16*)(a.ws + WS_YFFN) + (size_t)t * 2048;
#pragma unroll
        for (int j = 0; j < 16; ++j) { v[j] = xr[c.lane + 64 * j] + bf2f(y0[c.lane + 64 * j]) + bf2f(y0[1024 + c.lane + 64 * j]); ss += v[j] * v[j]; }
        ss = wsum(ss);
        const float rs = rsqrtf(ss * (1.f / 1024.f) + EPS);
#pragma unroll
        for (int j = 0; j < 16; ++j) xr[c.lane + 64 * j] = v[j] * rs * g[c.lane + 64 * j];
    }
}

#define XB_TMO      128
#define XB_XCNT(j)  (256  + 64 * (j))
#define XB_XSUB(j)  (1280 + 64 * (j))
#define XB_XGEN(j)  (2304 + 64 * (j))
#define XB_TOP      3328
#define XB_TOPGEN   3392
#define XCD_BAR_WORDS 3456
#define XB_SPIN_CAP (1u << 22)
#define LAS __attribute__((address_space(3)))
DI unsigned xb_ld(unsigned* p)              { return __hip_atomic_load(p, __ATOMIC_RELAXED, __HIP_MEMORY_SCOPE_AGENT); }
DI unsigned xb_add(unsigned* p, unsigned v) { return __hip_atomic_fetch_add(p, v, __ATOMIC_RELAXED, __HIP_MEMORY_SCOPE_AGENT); }
DI unsigned xb_xcc_id() { return (unsigned)__builtin_amdgcn_s_getreg((3 << 11) | 20) & 0xFu; }
#define XB_SPIN(cond, bar) do { unsigned _sp = 0; while (cond) { __builtin_amdgcn_s_sleep(1); \
    if ((++_sp & 255u) == 0u) { if (xb_ld(&(bar)[XB_TMO])) break; if (_sp > XB_SPIN_CAP) { atomicAdd(&(bar)[XB_TMO], 1u); break; } } } } while (0)
struct XcdBarrier { unsigned* bar; unsigned x; volatile LAS unsigned* st; };
DI XcdBarrier xcd_barrier_post(unsigned* bar, volatile LAS unsigned* st) {
    XcdBarrier b; b.bar = bar; b.x = xb_xcc_id(); b.st = st;
    if (threadIdx.x == 0) (void)xb_add(&bar[XB_XCNT(b.x)], 1u);
    return b;
}
DI void xcd_barrier_complete(unsigned* bar, unsigned x, unsigned& nloc, unsigned& nx) {
    const unsigned G = gridDim.x * gridDim.y * gridDim.z;
    unsigned sum, cnt, mine, sp = 0u;
    for (;;) {
        sum = 0u; cnt = 0u; mine = 0u;
#pragma unroll
        for (unsigned j = 0; j < 16; ++j) { const unsigned cc = xb_ld(&bar[XB_XCNT(j)]); sum += cc; cnt += (cc > 0u) ? 1u : 0u; mine = (j == x) ? cc : mine; }
        if (sum == G) break;
        __builtin_amdgcn_s_sleep(1);
        if ((++sp & 255u) == 0u) { if (xb_ld(&bar[XB_TMO])) break; if (sp > XB_SPIN_CAP) { atomicAdd(&bar[XB_TMO], 1u); break; } }
    }
    nloc = mine > 0u ? mine : 1u; nx = cnt > 0u ? cnt : 1u;
}
DI void xcd_barrier(const XcdBarrier& b) {
    asm volatile("s_waitcnt vmcnt(0)" ::: "memory");
    __syncthreads();
    if (threadIdx.x == 0) {
        unsigned* bar = b.bar;
        __builtin_amdgcn_s_waitcnt(0);
        unsigned nloc = b.st[0], nx = b.st[1];
        if (nloc == 0u) { xcd_barrier_complete(bar, b.x, nloc, nx); b.st[0] = nloc; b.st[1] = nx; }
        const unsigned old = xb_add(&bar[XB_XSUB(b.x)], 1u);
        const unsigned gen = old / nloc;
        if (old + 1u == (gen + 1u) * nloc) {
            __builtin_amdgcn_fence(__ATOMIC_RELEASE, "agent");
            asm volatile("s_waitcnt vmcnt(0)" ::: "memory");
            const unsigned og = xb_add(&bar[XB_TOP], 1u);
            const unsigned tg = og / nx;
            if (og + 1u == (tg + 1u) * nx) xb_add(&bar[XB_TOPGEN], 1u);
            else XB_SPIN(xb_ld(&bar[XB_TOPGEN]) == tg, bar);
            __builtin_amdgcn_fence(__ATOMIC_ACQUIRE, "agent");
            xb_add(&bar[XB_XGEN(b.x)], 1u);
            asm volatile("s_waitcnt vmcnt(0)" ::: "memory");
        } else {
            XB_SPIN(xb_ld(&bar[XB_XGEN(b.x)]) == gen, bar);
            __builtin_amdgcn_fence(__ATOMIC_ACQUIRE, "agent");
            asm volatile("s_waitcnt vmcnt(0)" ::: "memory");
        }
    }
    __syncthreads();
}

template <int SP>
DI void run_phase(const Ctx& c, KArgs& a, int l) {
    if constexpr (SP == 11) phase_prep(c, a);
    else if constexpr (SP == 12) phase_final(c, a);
    else if constexpr (SP == 0) phase_norm_in(c, a, l);
    else if constexpr (SP == 1) phase_inproj(c, a, l);
    else if constexpr (SP == 2) {
        const int n_ssd = 256, n_q = 128 * 3, n_kv = 128 * 4, n_tok = T_TOK / 8;
        for (int it = blockIdx.x; it < n_ssd + n_q + n_kv + n_tok; it += gridDim.x) {
            if (it < n_ssd) ssd_state_item(c, a, l, it);
            else if (it < n_ssd + n_q) mla_up_item(c, a, l, 0, it - n_ssd);
            else if (it < n_ssd + n_q + n_kv) mla_up_item(c, a, l, 1, it - n_ssd - n_q);
            else token_post_item(c, a, l, it - n_ssd - n_q - n_kv);
        }
    }
    else if constexpr (SP == 3) { for (int it = blockIdx.x; it < 512; it += gridDim.x) ssd_scan_item(c, a, it); }
    else if constexpr (SP == 4) {
        int* ctr = (int*)(a.ws + WS_CTL) + 128 + l;
        volatile int* s_item = (volatile int*)(c.lds + LDS_BYTES - 32);
        for (;;) {
            __syncthreads();
            if (threadIdx.x == 0) *s_item = atomicAdd(ctr, 1);
            __syncthreads();
            const int it = *s_item;
            if (it >= 1024 + 512 + 256) break;
            if (it < 1024) {
                const int j = 15 - (it >> 6), r = it & 63;
                if (r >= 8 && r < 40) { const int rem = r - 8; attn_item<96, 0>(c, a, rem >> 2, rem & 3, j); }
                else {
                    const int sub = (r < 8) ? 3 : 2 - ((r - 40) >> 3);
                    const int b = r & 7, qb = 4 * j + sub;
                    for (int g8 = 0; g8 < 8; ++g8) dsa_index_item(c, a, b, qb * 64 + g8 * 8);
                    asm volatile("s_waitcnt vmcnt(0)" ::: "memory");
                    __syncthreads();
                    attn_item<64, 2>(c, a, b, 0, qb);
                }
            } else if (it < 1536) { const int i2 = it - 1024; attn_item<64, 1>(c, a, (i2 & 31) >> 2, i2 & 3, 15 - (i2 >> 5)); }
            else ssd_out_item(c, a, l, it - 1536);
        }
    }
    else if constexpr (SP == 5) phase_outproj(c, a, l);
    else if constexpr (SP == 6) phase_router(c, a, l);
    else if constexpr (SP == 7) phase_moe_up(c, a);
    else if constexpr (SP == 8) phase_moe_down(c, a);
}

#ifndef ONE_LAUNCH
#define ONE_LAUNCH 1
#endif

#if ONE_LAUNCH
__global__ void __launch_bounds__(NTHR) mega(Args a_unused) {
    extern __shared__ __attribute__((aligned(16))) unsigned char lds[];
    cg::grid_group grid = cg::this_grid();
    Ctx c; c.tid = threadIdx.x; c.lane = c.tid & 63; c.wave = 0; c.lds = lds;
    volatile LAS unsigned* st = (volatile LAS unsigned*)(lds + LDS_BYTES - 16);
    if (threadIdx.x == 0) { st[0] = 0u; st[1] = 0u; }
    __syncthreads();
    XcdBarrier bar = xcd_barrier_post((unsigned*)(a_unused.ws + WS_BAR), st);
    for (int ph = 0; ph < 20; ++ph) {
        if (ph == 1) grid.sync();
        else if (ph > 1) xcd_barrier(bar);
        KArgs* kp = (KArgs*)__builtin_amdgcn_kernarg_segment_ptr();
        asm volatile("" : "+s"(kp));
        KArgs& a = *kp;
        const int l = (ph - 1) / 9;
        const int sp = (ph == 0) ? 11 : (ph == 19) ? 12 : (ph - 1) % 9;
#ifdef PROBE_SP
        unsigned long long pt0 = 0; if (sp == PROBE_SP) pt0 = __builtin_amdgcn_s_memrealtime();
#endif
        switch (sp) {
        case 0: run_phase<0>(c, a, l); break;
        case 1: run_phase<1>(c, a, l); break;
        case 2: run_phase<2>(c, a, l); break;
        case 3: run_phase<3>(c, a, l); break;
        case 4: run_phase<4>(c, a, l); break;
        case 5: run_phase<5>(c, a, l); break;
        case 6: run_phase<6>(c, a, l); break;
        case 7: run_phase<7>(c, a, l); break;
        case 8: run_phase<8>(c, a, l); break;
        case 11: run_phase<11>(c, a, l); break;
        default: run_phase<12>(c, a, l); break;
        }
#ifdef PROBE_SP
        if (sp == PROBE_SP) {
            xcd_barrier(bar);
            const unsigned long long pt1 = __builtin_amdgcn_s_memrealtime();
            while (__builtin_amdgcn_s_memrealtime() - pt1 < (pt1 - pt0)) __builtin_amdgcn_s_sleep(8);
        }
#endif
    }
}
#else
template <int SP>
__global__ void __launch_bounds__(NTHR) kphase(Args a, int l) {
    extern __shared__ __attribute__((aligned(16))) unsigned char lds[];
    Ctx c; c.tid = threadIdx.x; c.lane = c.tid & 63; c.wave = __builtin_amdgcn_readfirstlane(c.tid >> 6); c.lds = lds;
    KArgs* kp = (KArgs*)__builtin_amdgcn_kernarg_segment_ptr();
    run_phase<SP>(c, *kp, l);
}
template <int SP>
static void launch_phase(const Args& a, int l, int grid, hipStream_t stream) {
    static bool attr_set = false;
    if (!attr_set) { (void)hipFuncSetAttribute((const void*)kphase<SP>, hipFuncAttributeMaxDynamicSharedMemorySize, LDS_BYTES); attr_set = true; }
    hipLaunchKernelGGL(kphase<SP>, dim3(grid), dim3(NTHR), LDS_BYTES, stream, a, l);
}
#endif

extern "C" void kernel_launch(void* const* d_in, const int* in_sizes, int n_in, void* d_out, int out_size, void* d_ws, size_t ws_size, hipStream_t stream) {
    static int grid = 0;
    if (grid == 0) {
        if (n_in != 25 || ws_size < WS_END) { fprintf(stderr, "kernel_launch: unexpected inputs (n_in %d, ws %zu, need %zu)\n", n_in, ws_size, (size_t)WS_END); grid = -1; return; }
        int dev = 0, cus = 0;
        (void)hipGetDevice(&dev);
        (void)hipDeviceGetAttribute(&cus, hipDeviceAttributeMultiprocessorCount, dev);
        if (cus <= 0) cus = 256;
#if ONE_LAUNCH
        int per_cu = 0;
        if (hipFuncSetAttribute((const void*)mega, hipFuncAttributeMaxDynamicSharedMemorySize, LDS_BYTES) != hipSuccess) { fprintf(stderr, "kernel_launch: hipFuncSetAttribute failed\n"); grid = -1; return; }
        if (hipOccupancyMaxActiveBlocksPerMultiprocessor(&per_cu, (const void*)mega, NTHR, LDS_BYTES) != hipSuccess || per_cu < 1) { fprintf(stderr, "kernel_launch: occupancy query says %d blocks per CU\n", per_cu); (void)hipGetLastError(); grid = -1; return; }
        grid = cus;
#else
        grid = cus;
#endif
    }
    if (grid < 0) return;
    Args a{};
    for (int i = 0; i < 25; ++i) a.in[i] = (const float*)d_in[i];
    a.out = (float*)d_out; a.ws = (unsigned char*)d_ws;
    for (int i = 0; i < 8; ++i) a.inv16[i] = (float)pow(500000.0, -(double)i / 8.0);
    for (int i = 0; i < 16; ++i) a.inv32[i] = (float)pow(500000.0, -(double)i / 16.0);
    a.ph_lo = 0; a.ph_hi = 0;
#if ONE_LAUNCH
    (void)hipMemsetAsync((unsigned char*)d_ws + WS_CTL, 0, WS_CTL_BYTES, stream);
    void* kargs[] = { &a };
    hipError_t e = hipLaunchCooperativeKernel((const void*)mega, dim3(grid), dim3(NTHR), kargs, LDS_BYTES, stream);
    if (e != hipSuccess) fprintf(stderr, "kernel_launch: cooperative launch failed: %s (grid %d)\n", hipGetErrorString(e), grid);
#else
    launch_phase<11>(a, 0, grid, stream);
    for (int l = 0; l < DEPTH; ++l) {
        launch_phase<0>(a, l, grid, stream);
        launch_phase<1>(a, l, grid, stream);
        launch_phase<2>(a, l, grid, stream);
        launch_phase<3>(a, l, grid, stream);
        launch_phase<4>(a, l, grid, stream);
        launch_phase<5>(a, l, grid, stream);
        launch_phase<6>(a, l, grid, stream);
        launch_phase<7>(a, l, grid, stream);
        launch_phase<8>(a, l, grid, stream);
    }
    launch_phase<12>(a, 0, grid, stream);
#endif
}
```

```cpp
#include <hip/hip_runtime.h>
#include <hip/hip_cooperative_groups.h>
#include <cstdio>
#include <cmath>
#include <cstdint>


namespace cg = cooperative_groups;

typedef __attribute__((ext_vector_type(8))) short bf16x8;
typedef __attribute__((ext_vector_type(4))) short bf16x4;
typedef __attribute__((ext_vector_type(16))) float f32x16;
typedef unsigned short u16;
typedef unsigned long long u64;

#define DI __device__ __forceinline__
#define MFMA32(a, b, c) __builtin_amdgcn_mfma_f32_32x32x16_bf16((a), (b), (c), 0, 0, 0)

constexpr int T_TOK = 32768, SEQ = 4096, NB = 8, DM = 1024, DEPTH = 2;
constexpr int NREF = 3184;
constexpr int NPAD = 3328;
constexpr int LDP = 2848;
constexpr int PC_Z = 0, PC_XBC = 256, PC_DSAQ = 1024, PC_DSAK = 1280, PC_IDXQ = 1344, PC_IDXK = 1856,
              PC_CQ = 1920, PC_CKV = 2176, PC_KR = 2304, PC_FOXQ = 2336, PC_FOXK = 2592;
constexpr int NC_DSAV = 2848, NC_FOXV = 2912, NC_SMALL = 3168;
constexpr float EPS = 1e-6f;
constexpr float LOG2E = 1.4426950408889634f;
constexpr int NTHR = 512;
constexpr int LDS_BYTES = 147456;

constexpr size_t al256(size_t x) { return (x + 255) & ~(size_t)255; }
constexpr size_t WS_CTL   = 0;
constexpr size_t WS_BAR   = 4096;
constexpr size_t WS_CTL_BYTES = 32768;
constexpr size_t WS_WIN   = 32768;
constexpr size_t WS_WUQ   = WS_WIN  + (size_t)2 * NPAD * 1024 * 2;
constexpr size_t WS_WUKV  = WS_WUQ  + (size_t)2 * 384 * 256 * 2;
constexpr size_t WS_WOUT  = WS_WUKV + (size_t)2 * 512 * 128 * 2;
constexpr size_t WS_WG    = WS_WOUT + (size_t)2 * 1024 * 1024 * 2;
constexpr size_t WS_WU    = WS_WG   + (size_t)32 * 256 * 1024 * 2;
constexpr size_t WS_WD    = WS_WU   + (size_t)32 * 256 * 1024 * 2;
constexpr size_t WS_TRIG  = WS_WD   + (size_t)32 * 256 * 1024 * 2;
constexpr size_t WS_ACT   = WS_TRIG + (size_t)T_TOK * 48 * 4;
constexpr size_t WS_PROJ  = WS_ACT  + (size_t)T_TOK * 1024 * 2;
constexpr size_t WS_SMALL = WS_PROJ + (size_t)T_TOK * LDP * 2;
constexpr size_t WS_MLAQ  = WS_SMALL + (size_t)T_TOK * 16 * 4;
constexpr size_t WS_MLAK  = WS_MLAQ + (size_t)T_TOK * 384 * 2;
constexpr size_t WS_MLAVT = WS_MLAK + (size_t)T_TOK * 384 * 2;
constexpr size_t WS_DSAVT = WS_MLAVT + (size_t)T_TOK * 256 * 2;
constexpr size_t WS_FOXVT = WS_DSAVT + (size_t)T_TOK * 64 * 2;
constexpr size_t WS_FLOG  = WS_FOXVT + (size_t)T_TOK * 256 * 2;
constexpr size_t WS_CS    = WS_FLOG + (size_t)T_TOK * 4 * 4;
constexpr size_t WS_CDEC  = WS_CS   + (size_t)8 * 32 * 4 * 64 * 128 * 4;
constexpr size_t WS_MASK  = WS_CDEC + 4096;
constexpr size_t WS_TOKW  = WS_MASK + (size_t)T_TOK * 64 * 8;
constexpr size_t WS_WRH   = WS_TOKW + (size_t)T_TOK * 2 * 4;
constexpr size_t WS_WRL   = WS_WRH + (size_t)2 * 64 * 1024 * 2;
constexpr size_t WS_END   = WS_WRL + (size_t)2 * 64 * 1024 * 2;
constexpr size_t WS_LIST  = WS_PROJ;
constexpr size_t WS_HMID  = WS_PROJ + (size_t)64 * 32768 * 4;
constexpr size_t WS_YFFN  = WS_HMID + (size_t)T_TOK * 512 * 2;
static_assert(WS_YFFN + (size_t)T_TOK * 2048 * 2 <= WS_SMALL, "aliases must fit in PROJ");
static_assert(WS_END <= (size_t)512 * 1024 * 1024, "workspace budget");

struct Args {
    const float* in[25];
    float* out;
    unsigned char* ws;
    float inv16[8];
    float inv32[16];
    int ph_lo, ph_hi;
};

typedef const __attribute__((address_space(4))) Args KArgs;
struct Ctx { int tid, lane, wave; unsigned char* lds; };
__device__ __forceinline__ Ctx fresh_ctx(unsigned char* lds) {
    int t = threadIdx.x; asm volatile("" : "+v"(t));
    Ctx c; c.tid = t; c.lane = t & 63; c.wave = __builtin_amdgcn_readfirstlane(t >> 6); c.lds = lds; return c;
}

typedef __attribute__((ext_vector_type(2))) float f32x2;
typedef __attribute__((ext_vector_type(2))) __bf16 bf16x2_t;
DI u16 f2bf(float x) { return __builtin_bit_cast(u16, (__bf16)x); }
DI float bf2f(u16 h) { return __uint_as_float(((unsigned)h) << 16); }
DI unsigned pack2(float a, float b) { f32x2 v = {a, b}; return __builtin_bit_cast(unsigned, __builtin_convertvector(v, bf16x2_t)); }
DI float ex2(float x) { return __builtin_amdgcn_exp2f(x); }
DI float max3f(float a, float b, float c) { float r; asm("v_max3_f32 %0, %1, %2, %3" : "=v"(r) : "v"(a), "v"(b), "v"(c)); return r; }
DI float wsum(float v) { for (int o = 32; o >= 1; o >>= 1) v += __shfl_xor(v, o); return v; }
DI float wmaxf(float v) { for (int o = 32; o >= 1; o >>= 1) v = fmaxf(v, __shfl_xor(v, o)); return v; }
DI float wminf(float v) { for (int o = 32; o >= 1; o >>= 1) v = fminf(v, __shfl_xor(v, o)); return v; }
DI float siluf(float x) { return x / (1.f + __expf(-x)); }
DI float softplusf(float x) { return fmaxf(x, 0.f) + log1pf(__expf(-fabsf(x))); }
DI int crow(int reg, int h) { return (reg & 3) + 8 * (reg >> 2) + 4 * h; }
DI bf16x8 pack8(const f32x16& x, int s) {
    uint4 p;
    p.x = pack2(x[8 * s + 0], x[8 * s + 1]); p.y = pack2(x[8 * s + 2], x[8 * s + 3]);
    p.z = pack2(x[8 * s + 4], x[8 * s + 5]); p.w = pack2(x[8 * s + 6], x[8 * s + 7]);
    return __builtin_bit_cast(bf16x8, p);
}
DI f32x16 zero16() { f32x16 z; for (int i = 0; i < 16; ++i) z[i] = 0.f; return z; }

DI int ref_col(int n) {
    if (n < 1024) return n;
    if (n < 1280) return n - 1024 + 1028;
    if (n < 1344) return n - 1280 + 1284;
    if (n < 1856) return n - 1344 + 1412;
    if (n < 1920) return n - 1856 + 1924;
    if (n < 2176) return n - 1920 + 1996;
    if (n < 2304) return n - 2176 + 2252;
    if (n < 2336) return n - 2304 + 2380;
    if (n < 2592) return n - 2336 + 2412;
    if (n < 2848) return n - 2592 + 2668;
    if (n < 2912) return n - 2848 + 1348;
    if (n < 3168) return n - 2912 + 2924;
    if (n < 3172) return n - 3168 + 1024;
    if (n < 3180) return n - 3172 + 1988;
    if (n < 3184) return n - 3180 + 3180;
    return -1;
}

DI int vblock() { const int G = gridDim.x, bx = blockIdx.x; return (G % 8 == 0) ? (bx % 8) * (G / 8) + bx / 8 : bx; }

constexpr int G_LDT = 72;
constexpr int G_AEL = 256 * G_LDT, G_BEL = 128 * G_LDT, G_STEL = G_AEL + G_BEL;
constexpr int G_LDS_BYTES = 2 * G_STEL * 2;

struct GP { const u16 *a0, *a1, *a2, *a3, *b0, *b1; };

template <bool PAIRED>
DI void gemm_core(const Ctx& c, int K, const GP& gp, f32x16 (&acc)[2][2]) {
    u16* S = (u16*)c.lds;
    const int r8 = c.tid >> 3, kc = c.tid & 7;
    const int wm = c.wave & 3, wn = c.wave >> 2, l31 = c.lane & 31, h = c.lane >> 5;
    const int nb0 = PAIRED ? wn * 32 : wn * 64, nb1 = PAIRED ? 64 + wn * 32 : wn * 64 + 32;
    uint4 ra0, ra1, ra2, ra3, rb0, rb1;
    uint4 sa0, sa1, sa2, sa3, sb0, sb1;
    const int nk = K >> 6;
#define G_LOAD(P, KOFF) do { \
        P##a0 = *(const uint4*)(gp.a0 + (KOFF) + kc * 8); P##a1 = *(const uint4*)(gp.a1 + (KOFF) + kc * 8); \
        P##a2 = *(const uint4*)(gp.a2 + (KOFF) + kc * 8); P##a3 = *(const uint4*)(gp.a3 + (KOFF) + kc * 8); \
        P##b0 = *(const uint4*)(gp.b0 + (KOFF) + kc * 8); P##b1 = *(const uint4*)(gp.b1 + (KOFF) + kc * 8); } while (0)
#define G_STORE(P, SP) do { u16* sp_ = (SP); \
        *(uint4*)(sp_ + (r8) * G_LDT + kc * 8) = P##a0; *(uint4*)(sp_ + (r8 + 64) * G_LDT + kc * 8) = P##a1; \
        *(uint4*)(sp_ + (r8 + 128) * G_LDT + kc * 8) = P##a2; *(uint4*)(sp_ + (r8 + 192) * G_LDT + kc * 8) = P##a3; \
        *(uint4*)(sp_ + G_AEL + (r8) * G_LDT + kc * 8) = P##b0; *(uint4*)(sp_ + G_AEL + (r8 + 64) * G_LDT + kc * 8) = P##b1; } while (0)
#define G_COMPUTE_KS(ST, KS0, KS1) do { \
        const u16* As = S + (ST) * G_STEL; const u16* Bs = As + G_AEL; \
        _Pragma("unroll") for (int ks = (KS0); ks < (KS1); ++ks) { \
            const bf16x8 a0 = *(const bf16x8*)(As + (wm * 64 + l31) * G_LDT + ks * 16 + h * 8); \
            const bf16x8 a1 = *(const bf16x8*)(As + (wm * 64 + 32 + l31) * G_LDT + ks * 16 + h * 8); \
            const bf16x8 b0 = *(const bf16x8*)(Bs + (nb0 + l31) * G_LDT + ks * 16 + h * 8); \
            const bf16x8 b1 = *(const bf16x8*)(Bs + (nb1 + l31) * G_LDT + ks * 16 + h * 8); \
            acc[0][0] = MFMA32(a0, b0, acc[0][0]); acc[0][1] = MFMA32(a0, b1, acc[0][1]); \
            acc[1][0] = MFMA32(a1, b0, acc[1][0]); acc[1][1] = MFMA32(a1, b1, acc[1][1]); } } while (0)
    G_LOAD(r, 0);
    G_STORE(r, S);
    if (nk > 1) G_LOAD(r, 64);
    __syncthreads();
    for (int kt = 0; kt < nk; kt += 2) {
        if (kt + 2 < nk) G_LOAD(s, (kt + 2) * 64);
        G_COMPUTE_KS(0, 0, 1);
        if (kt + 1 < nk) G_STORE(r, S + G_STEL);
        G_COMPUTE_KS(0, 1, 4);
        __syncthreads();
        if (kt + 1 >= nk) break;
        if (kt + 3 < nk) G_LOAD(r, (kt + 3) * 64);
        G_COMPUTE_KS(1, 0, 1);
        if (kt + 2 < nk) G_STORE(s, S);
        G_COMPUTE_KS(1, 1, 4);
        __syncthreads();
    }
#undef G_LOAD
#undef G_STORE
#undef G_COMPUTE_KS
}

typedef __attribute__((ext_vector_type(4))) float f32x4;
#define LAS3 __attribute__((address_space(3)))
constexpr int G2_HTB = 128 * 64 * 2;
constexpr int G2_LDS_BYTES = 8 * G2_HTB;
DI int g2_lds_byte(int r, int cc0) { const int st = (r >> 4) * 2 + (cc0 >> 5), rr = r & 15, cc = cc0 & 31, ob = rr * 64 + cc * 2; return st * 1024 + (ob ^ (((ob >> 9) & 1) << 5)); }
DI void g2_stage_rc(int b, int& R, int& C) { const int st = b / 1024, sb = b % 1024, swz = sb ^ (((sb >> 9) & 1) << 5); R = (st >> 1) * 16 + swz / 64; C = (st & 1) * 32 + (swz % 64) / 2; }

struct G2Ptrs { __amdgpu_buffer_rsrc_t ra, rb; unsigned va00, va01, va10, va11, vb0, vb1; unsigned sa, sb0, sb1; };
DI __amdgpu_buffer_rsrc_t g2_rsrc(const void* p) { return __builtin_amdgcn_make_buffer_rsrc((void*)p, 0, 0x7ffffff0, 0x00020000); }

template <class EPI>
DI void gemm256_unit(const Ctx& c, const G2Ptrs& g, int K, EPI&& epi) {
    LAS3 unsigned char* lds = (LAS3 unsigned char*)c.lds;
    const int wid = c.wave, lane = c.lane, wr = wid >> 2, wc = wid & 3, fr = lane & 15, fq = lane >> 4;
    const unsigned ldsw = (unsigned)wid * 1024u;
    const int aoff = g2_lds_byte(wr * 64 + fr, fq * 8), boff = g2_lds_byte(wc * 32 + fr, fq * 8);
#define G2_SA(b, h) (((b) * 2 + (h)) * G2_HTB)
#define G2_SB(b, h) ((4 + (b) * 2 + (h)) * G2_HTB)
#define G2_STAGE(bufoff, rs, v0, v1, so) do { \
        __builtin_amdgcn_raw_ptr_buffer_load_lds((rs), (LAS3 unsigned*)(lds + (bufoff) + ldsw), 16, (v0), (so), 0, 0); \
        __builtin_amdgcn_raw_ptr_buffer_load_lds((rs), (LAS3 unsigned*)(lds + (bufoff) + ldsw + 8192), 16, (v1), (so), 0, 0); } while (0)
#define G2_STA0(b, kt) G2_STAGE(G2_SA(b, 0), g.ra, g.va00, g.va01, g.sa + (unsigned)(kt) * 128u)
#define G2_STA1(b, kt) G2_STAGE(G2_SA(b, 1), g.ra, g.va10, g.va11, g.sa + (unsigned)(kt) * 128u)
#define G2_STB0(b, kt) G2_STAGE(G2_SB(b, 0), g.rb, g.vb0, g.vb1, g.sb0 + (unsigned)(kt) * 128u)
#define G2_STB1(b, kt) G2_STAGE(G2_SB(b, 1), g.rb, g.vb0, g.vb1, g.sb1 + (unsigned)(kt) * 128u)
#define G2_LDA(dst, b, h) do { _Pragma("unroll") for (int m = 0; m < 4; ++m) _Pragma("unroll") for (int k = 0; k < 2; ++k) dst[m][k] = *(const LAS3 bf16x8*)(lds + G2_SA(b, h) + aoff + m * 2048 + k * 1024); } while (0)
#define G2_LDB(dst, b, h) do { _Pragma("unroll") for (int n = 0; n < 2; ++n) _Pragma("unroll") for (int k = 0; k < 2; ++k) dst[n][k] = *(const LAS3 bf16x8*)(lds + G2_SB(b, h) + boff + n * 2048 + k * 1024); } while (0)
#define G2_MMA(ai, bj, At_, Bt_) do { __builtin_amdgcn_s_setprio(1); \
        _Pragma("unroll") for (int m = 0; m < 4; ++m) _Pragma("unroll") for (int n = 0; n < 2; ++n) _Pragma("unroll") for (int k = 0; k < 2; ++k) \
            acc[ai][bj][m][n] = __builtin_amdgcn_mfma_f32_16x16x32_bf16(Bt_[n][k], At_[m][k], acc[ai][bj][m][n], 0, 0, 0); \
        __builtin_amdgcn_s_setprio(0); } while (0)
#define G2_WAIT_V(n) asm volatile("s_waitcnt vmcnt(" #n ")" ::: "memory")
#define G2_WAIT_L(n) asm volatile("s_waitcnt lgkmcnt(" #n ")" ::: "memory")
#define G2_BAR __builtin_amdgcn_s_barrier()
#define G2_SCHED __builtin_amdgcn_sched_barrier(0)
    f32x4 acc[2][2][4][2];
#pragma unroll
    for (int i0 = 0; i0 < 2; ++i0)
#pragma unroll
        for (int i1 = 0; i1 < 2; ++i1)
#pragma unroll
            for (int i2 = 0; i2 < 4; ++i2)
#pragma unroll
                for (int i3 = 0; i3 < 2; ++i3) acc[i0][i1][i2][i3] = (f32x4){0.f, 0.f, 0.f, 0.f};
    bf16x8 At[4][2], B0[2][2], B1[2][2];
    int nt = K / 64; asm volatile("" : "+s"(nt));
    G2_STB0(0, 0); G2_STA0(0, 0); G2_STB1(0, 0); G2_STA1(0, 0);
    if (wr == 1) G2_BAR;
    G2_WAIT_V(4); G2_BAR;
    G2_STB0(1, 1); G2_STA0(1, 1); G2_STB1(1, 1);
    G2_WAIT_V(6); G2_BAR;
    for (int t = 0; t < nt - 2; t += 2) {
        G2_LDB(B0, 0, 0); G2_SCHED; G2_LDA(At, 0, 0); G2_STA1(1, t + 1);
        G2_WAIT_L(8); G2_BAR; G2_WAIT_L(0); G2_MMA(0, 0, At, B0); G2_BAR; G2_SCHED;
        G2_LDB(B1, 0, 1); G2_STB0(0, t + 2);
        G2_BAR; G2_WAIT_L(0); G2_MMA(0, 1, At, B1); G2_BAR;
        G2_LDA(At, 0, 1); G2_STA0(0, t + 2);
        G2_BAR; G2_WAIT_L(0); G2_MMA(1, 0, At, B0); G2_BAR; G2_SCHED;
        G2_STB1(0, t + 2);
        G2_WAIT_V(6); G2_BAR; G2_MMA(1, 1, At, B1); G2_BAR;
        G2_LDB(B0, 1, 0); G2_SCHED; G2_LDA(At, 1, 0); G2_STA1(0, t + 2);
        G2_WAIT_L(8); G2_BAR; G2_WAIT_L(0); G2_MMA(0, 0, At, B0); G2_BAR; G2_SCHED;
        G2_LDB(B1, 1, 1); G2_STB0(1, t + 3);
        G2_BAR; G2_WAIT_L(0); G2_MMA(0, 1, At, B1); G2_BAR;
        G2_LDA(At, 1, 1); G2_STA0(1, t + 3);
        G2_BAR; G2_WAIT_L(0); G2_MMA(1, 0, At, B0); G2_BAR; G2_SCHED;
        G2_STB1(1, t + 3);
        G2_WAIT_V(6); G2_BAR; G2_MMA(1, 1, At, B1); G2_BAR;
    }
    { G2_LDB(B0, 0, 0); G2_LDA(At, 0, 0); G2_STA1(1, nt - 1);
      G2_BAR; G2_WAIT_L(0); G2_MMA(0, 0, At, B0); G2_BAR;
      G2_LDB(B1, 0, 1); G2_BAR; G2_WAIT_L(0); G2_MMA(0, 1, At, B1); G2_BAR;
      G2_LDA(At, 0, 1); G2_WAIT_V(4); G2_BAR; G2_WAIT_L(0); G2_MMA(1, 0, At, B0); G2_MMA(1, 1, At, B1); G2_BAR; }
    { G2_LDB(B0, 1, 0); G2_LDA(At, 1, 0); G2_WAIT_V(2); G2_BAR; G2_WAIT_L(0); G2_MMA(0, 0, At, B0); G2_BAR;
      G2_LDB(B1, 1, 1); G2_WAIT_V(0); G2_BAR; G2_WAIT_L(0); G2_MMA(0, 1, At, B1); G2_BAR;
      G2_LDA(At, 1, 1); G2_BAR; G2_WAIT_L(0); G2_MMA(1, 0, At, B0); G2_MMA(1, 1, At, B1); G2_BAR; }
    if (wr == 0) G2_BAR;
    { int fr_ = fr, fq_ = fq; asm volatile("" : "+v"(fr_), "+v"(fq_));
      epi(acc, wr, wc, fr_, fq_); }
#undef G2_SA
#undef G2_SB
#undef G2_STAGE
#undef G2_STA0
#undef G2_STA1
#undef G2_STB0
#undef G2_STB1
#undef G2_LDA
#undef G2_LDB
#undef G2_MMA
#undef G2_WAIT_V
#undef G2_WAIT_L
#undef G2_BAR
#undef G2_SCHED
}

DI void xpose_tile(const Ctx& c, const float* in, int ld_in, int k0, int n0, int colmode, const float* kscale, u16* out, int ld_out) {
    float* tile = (float*)c.lds;
    if (!colmode) {
        const int j4 = (c.tid & 15) * 4, r0 = c.tid >> 4;
#pragma unroll
        for (int rr = 0; rr < 2; ++rr) {
            const int kk = r0 + 32 * rr;
            float4 v = *(const float4*)(in + (size_t)(k0 + kk) * ld_in + n0 + j4);
            if (kscale) { const float s = kscale[k0 + kk]; v.x *= s; v.y *= s; v.z *= s; v.w *= s; }
            *(float4*)(tile + kk * 68 + j4) = v;
        }
    } else {
        const int j = c.tid & 63, r0 = c.tid >> 6;
        const int rc = ref_col(n0 + j);
#pragma unroll
        for (int rr = 0; rr < 8; ++rr) {
            const int kk = r0 + 8 * rr;
            tile[kk * 68 + j] = (rc >= 0) ? in[(size_t)(k0 + kk) * ld_in + rc] : 0.f;
        }
    }
    __syncthreads();
    {
        const int jj = c.tid >> 3, k8 = (c.tid & 7) * 8;
        uint4 pk;
        pk.x = pack2(tile[(k8 + 0) * 68 + jj], tile[(k8 + 1) * 68 + jj]);
        pk.y = pack2(tile[(k8 + 2) * 68 + jj], tile[(k8 + 3) * 68 + jj]);
        pk.z = pack2(tile[(k8 + 4) * 68 + jj], tile[(k8 + 5) * 68 + jj]);
        pk.w = pack2(tile[(k8 + 6) * 68 + jj], tile[(k8 + 7) * 68 + jj]);
        *(uint4*)(out + (size_t)(n0 + jj) * ld_out + k0 + k8) = pk;
    }
    __syncthreads();
}

DI void phase_prep(const Ctx& c_in, KArgs& a) {
    const Ctx c = fresh_ctx(c_in.lds);
    unsigned char* ws = a.ws;
    const int n_win = 2 * 52 * 16;
    const int n_wuq = 2 * 6 * 4;
    const int n_wukv = 2 * 8 * 2;
    const int n_wout = 2 * 16 * 16;
    const int n_trig = T_TOK * 24 / NTHR;
    const int n_wr = 2 * 64 * 1024 / NTHR;
    const int total = n_win + n_wuq + n_wukv + n_wout + n_trig + n_wr;
    for (int it = blockIdx.x; it < total; it += gridDim.x) {
        int i = it;
        if (i < n_win) {
            const int l = i / 832, r = i % 832, nt = r / 16, kt = r % 16;
            xpose_tile(c, a.in[3] + (size_t)l * 1024 * NREF, NREF, kt * 64, nt * 64, 1, nullptr, (u16*)(ws + WS_WIN) + (size_t)l * NPAD * 1024, 1024);
            continue;
        }
        i -= n_win;
        if (i < n_wuq) {
            const int l = i / 24, r = i % 24, nt = r / 4, kt = r % 4;
            xpose_tile(c, a.in[11] + (size_t)l * 256 * 384, 384, kt * 64, nt * 64, 0, a.in[10] + l * 256, (u16*)(ws + WS_WUQ) + (size_t)l * 384 * 256, 256);
            continue;
        }
        i -= n_wuq;
        if (i < n_wukv) {
            const int l = i / 16, r = i % 16, nt = r / 2, kt = r % 2;
            xpose_tile(c, a.in[13] + (size_t)l * 128 * 512, 512, kt * 64, nt * 64, 0, a.in[12] + l * 128, (u16*)(ws + WS_WUKV) + (size_t)l * 512 * 128, 128);
            continue;
        }
        i -= n_wukv;
        if (i < n_wout) {
            const int l = i / 256, r = i % 256, nt = r / 16, kt = r % 16;
            xpose_tile(c, a.in[15] + (size_t)l * 1024 * 1024, 1024, kt * 64, nt * 64, 0, nullptr, (u16*)(ws + WS_WOUT) + (size_t)l * 1024 * 1024, 1024);
            continue;
        }
        i -= n_wout;
        if (i >= n_trig) {
            const int e = (i - n_trig) * NTHR + c.tid;
            const int l = e >> 16, n = (e >> 10) & 63, k = e & 1023;
            float v = 0.f;
            if (n < 4) v = a.in[17][((size_t)l * 1024 + k) * 4 + n];
            else if (n < 36) v = a.in[19][((size_t)l * 1024 + k) * 32 + (n - 4)];
            const u16 hi = f2bf(v);
            ((u16*)(ws + WS_WRH))[e] = hi;
            ((u16*)(ws + WS_WRL))[e] = f2bf(v - bf2f(hi));
            continue;
        }
        {
            const int e = i * NTHR + c.tid;
            const int t = e / 24, j = e % 24;
            const int pos = ((const int*)a.in[1])[t];
            const float inv = (j < 8) ? a.inv16[j] : a.inv32[j - 8];
            const float ang = (float)pos * inv;
            const double ad = (double)ang;
            const double r = ad - 6.283185307179586476925 * rint(ad * 0.15915494309189533577);
            const float rf = (float)r;
            const float cs = cosf(rf), sn = sinf(rf);
            float* trig = (float*)(ws + WS_TRIG) + (size_t)t * 48;
            if (j < 8) { trig[j] = cs; trig[8 + j] = sn; } else { trig[16 + (j - 8)] = cs; trig[32 + (j - 8)] = sn; }
        }
    }
}

DI void phase_norm_in(const Ctx& c_in, KArgs& a, int l) {
    const Ctx c = fresh_ctx(c_in.lds);
    unsigned char* ws = a.ws;
    const float* x = (l == 0) ? a.in[0] : a.out;
    const float* g = a.in[2] + l * 1024;
    u16* act = (u16*)(ws + WS_ACT);
    const int n_norm = T_TOK / 8;
    const int n_exp = 3 * 32 * 64;
    if (blockIdx.x == 0 && c.tid < 96) ((int*)(ws + WS_CTL))[c.tid] = 0;
    for (int it = blockIdx.x; it < n_norm + n_exp; it += gridDim.x) {
        if (it < n_exp) {
            const int which = it / 2048, r = it % 2048, e = r / 64, tt = r % 64;
            if (which < 2) {
                const float* src = a.in[21 + which] + ((size_t)l * 32 + e) * 1024 * 256;
                u16* dst = (u16*)(ws + (which == 0 ? WS_WG : WS_WU)) + (size_t)e * 256 * 1024;
                const int nt = tt / 16, kt = tt % 16;
                xpose_tile(c, src, 256, kt * 64, nt * 64, 0, nullptr, dst, 1024);
            } else {
                const float* src = a.in[23] + ((size_t)l * 32 + e) * 256 * 1024;
                u16* dst = (u16*)(ws + WS_WD) + (size_t)e * 1024 * 256;
                const int nt = tt / 4, kt = tt % 4;
                xpose_tile(c, src, 1024, kt * 64, nt * 64, 0, nullptr, dst, 256);
            }
        } else {
            const int t = (it - n_exp) * 8 + c.wave;
            const float* xr = x + (size_t)t * 1024;
            float v[16]; float ss = 0.f;
            if (l == 0) {
#pragma unroll
                for (int j = 0; j < 16; ++j) v[j] = xr[c.lane + 64 * j];
            } else {
                const u16* y0 = (const u16*)(ws + WS_YFFN) + (size_t)t * 2048;
#pragma unroll
                for (int j = 0; j < 16; ++j) { v[j] = xr[c.lane + 64 * j] + bf2f(y0[c.lane + 64 * j]) + bf2f(y0[1024 + c.lane + 64 * j]); a.out[(size_t)t * 1024 + c.lane + 64 * j] = v[j]; }
            }
#pragma unroll
            for (int j = 0; j < 16; ++j) ss += v[j] * v[j];
            ss = wsum(ss);
            const float rs = rsqrtf(ss * (1.f / 1024.f) + EPS);
#pragma unroll
            for (int j = 0; j < 16; ++j) act[(size_t)t * 1024 + c.lane + 64 * j] = f2bf(v[j] * rs * g[c.lane + 64 * j]);
        }
    }
}

DI void phase_inproj(const Ctx& c_in, KArgs& a, int l) {
    const Ctx c = fresh_ctx(c_in.lds);
    unsigned char* ws = a.ws;
    const u16* act = (const u16*)(ws + WS_ACT);
    const u16* w = (const u16*)(ws + WS_WIN) + (size_t)l * NPAD * 1024;
    u16* proj = (u16*)(ws + WS_PROJ);
    u16* dsavt = (u16*)(ws + WS_DSAVT);
    u16* foxvt = (u16*)(ws + WS_FOXVT);
    float* small = (float*)(ws + WS_SMALL);
    int R, C; g2_stage_rc(c.tid * 16, R, C);
    const int nunits = (T_TOK / 256) * 13;
    for (int u = vblock(); u < nunits; u += gridDim.x) {
        const int grp = u / 52, rr = u % 52;
        const int pm = grp * 4 + (rr & 3), pn = rr >> 2;
        G2Ptrs g;
        g.ra = g2_rsrc(act); g.rb = g2_rsrc(w);
        g.va00 = (unsigned)(R * 1024 + C) * 2u; g.va01 = g.va00 + 64 * 2048; g.va10 = g.va00 + 128 * 2048; g.va11 = g.va00 + 192 * 2048;
        g.vb0 = g.va00; g.vb1 = g.va01;
        g.sa = (unsigned)pm * (256u * 2048u); g.sb0 = (unsigned)pn * (256u * 2048u); g.sb1 = g.sb0 + 128u * 2048u;
        __syncthreads();
        gemm256_unit(c, g, 1024, [&](const f32x4 (&acc)[2][2][4][2], int wr, int wc, int fr, int fq) {
#pragma unroll
            for (int bj = 0; bj < 2; ++bj)
#pragma unroll
                for (int n = 0; n < 2; ++n) {
                    const int col0 = pn * 256 + bj * 128 + wc * 32 + n * 16;
                    if (col0 < LDP) {
#pragma unroll
                        for (int ai = 0; ai < 2; ++ai)
#pragma unroll
                            for (int m = 0; m < 4; ++m) {
                                const int row = pm * 256 + ai * 128 + wr * 64 + m * 16 + fr;
                                const f32x4 v = acc[ai][bj][m][n];
                                uint2 pk; pk.x = pack2(v[0], v[1]); pk.y = pack2(v[2], v[3]);
                                *(uint2*)(proj + (size_t)row * LDP + col0 + 4 * fq) = pk;
                            }
                    } else if (col0 < NC_SMALL) {
                        u16* vt = (col0 < NC_FOXV) ? dsavt + (size_t)(col0 - NC_DSAV + 4 * fq) * 4096 : foxvt + (size_t)(col0 - NC_FOXV + 4 * fq) * 4096;
                        const size_t bstride = (col0 < NC_FOXV) ? (size_t)64 * 4096 : (size_t)256 * 4096;
#pragma unroll
                        for (int ai = 0; ai < 2; ++ai)
#pragma unroll
                            for (int m = 0; m < 4; ++m) {
                                const int row = pm * 256 + ai * 128 + wr * 64 + m * 16 + fr;
                                u16* p = vt + (size_t)(row >> 12) * bstride + (row & 4095);
                                const f32x4 v = acc[ai][bj][m][n];
                                p[0] = f2bf(v[0]); p[4096] = f2bf(v[1]); p[2 * 4096] = f2bf(v[2]); p[3 * 4096] = f2bf(v[3]);
                            }
                    } else if (col0 == NC_SMALL) {
#pragma unroll
                        for (int ai = 0; ai < 2; ++ai)
#pragma unroll
                            for (int m = 0; m < 4; ++m) {
                                const int row = pm * 256 + ai * 128 + wr * 64 + m * 16 + fr;
                                *(f32x4*)(small + (size_t)row * 16 + 4 * fq) = acc[ai][bj][m][n];
                            }
                    }
                }
        });
    }
}

constexpr int SSD_LD = 136;
constexpr int SSD_TILE_B = 128 * SSD_LD * 2;
constexpr int SSD_OFF_DT = 3 * SSD_TILE_B;
constexpr int SSD_OFF_ACS = SSD_OFF_DT + 2048;
constexpr int SSD_OFF_SSQ = SSD_OFF_ACS + 2048;

DI void ssd_dt_acs(const Ctx& c, KArgs& a, int l, int tok0, float* dt_s, float* acs_s) {
    const float* small = (const float*)(a.ws + WS_SMALL);
    {
        const int t = c.tid >> 2, hd = c.tid & 3;
        const float raw = small[(size_t)(tok0 + t) * 16 + hd] + a.in[6][l * 4 + hd];
        dt_s[hd * 128 + t] = softplusf(raw);
    }
    __syncthreads();
    if (c.wave < 4) {
        const int hd = c.wave;
        const float av = -__expf(a.in[7][l * 4 + hd]);
        const float v0 = dt_s[hd * 128 + 2 * c.lane] * av, v1 = dt_s[hd * 128 + 2 * c.lane + 1] * av;
        const float s = v0 + v1;
        float inc = s;
#pragma unroll
        for (int o = 1; o < 64; o <<= 1) { const float tv = __shfl_up(inc, o); if (c.lane >= o) inc += tv; }
        const float ex = inc - s;
        acs_s[hd * 128 + 2 * c.lane] = ex + v0;
        acs_s[hd * 128 + 2 * c.lane + 1] = ex + v0 + v1;
    }
    __syncthreads();
}

DI float ssd_conv(const u16* proj, const float* cw, const float* cb, int b, int s, int xc) {
    float acc = cb[xc];
#pragma unroll
    for (int j = 0; j < 4; ++j) {
        const int sp = s - 3 + j;
        if (sp >= 0) acc += cw[j * 768 + xc] * bf2f(proj[(size_t)(b * 4096 + sp) * LDP + PC_XBC + xc]);
    }
    return siluf(acc);
}

template <bool TRANSPOSED>
DI void conv_stage_unit(const Ctx& c, const u16* proj, const float* cw, const float* cb, int b, int s0, int tseg, int xc0, u16* dst,
                        const float* dt_s, const float* acs_s, int head0) {
    const int ch = 2 * c.lane, xc = xc0 + ch;
    float w0[4], w1[4];
#pragma unroll
    for (int j = 0; j < 4; ++j) { w0[j] = cw[j * 768 + xc]; w1[j] = cw[j * 768 + xc + 1]; }
    const float bias0 = cb[xc], bias1 = cb[xc + 1];
    const u16* src = proj + (size_t)(b * 4096) * LDP + PC_XBC + xc;
    const int head = head0 + (ch >> 6);
#pragma unroll 1
    for (int half = 0; half < 2; ++half) {
        const int sb = s0 + tseg * 32 + half * 16 - 3;
        unsigned raw[19];
#pragma unroll
        for (int i = 0; i < 19; ++i) { const int sp = sb + i; raw[i] = (sp >= 0) ? *(const unsigned*)(src + (size_t)sp * LDP) : 0u; }
#pragma unroll
        for (int t = 0; t < 16; ++t) {
            float x0 = bias0, x1 = bias1;
#pragma unroll
            for (int j = 0; j < 4; ++j) { x0 += w0[j] * bf2f((u16)(raw[t + j] & 0xffff)); x1 += w1[j] * bf2f((u16)(raw[t + j] >> 16)); }
            x0 = siluf(x0); x1 = siluf(x1);
            const int tt = tseg * 32 + half * 16 + t;
            if (dt_s) { const float sc = dt_s[head * 128 + tt] * __expf(acs_s[head * 128 + 127] - acs_s[head * 128 + tt]); x0 *= sc; x1 *= sc; }
            if (TRANSPOSED) { dst[ch * SSD_LD + tt] = f2bf(x0); dst[(ch + 1) * SSD_LD + tt] = f2bf(x1); }
            else *(unsigned*)(dst + tt * SSD_LD + ch) = pack2(x0, x1);
        }
    }
}

DI void ssd_state_item(const Ctx& c_in, KArgs& a, int l, int item) {
    const Ctx c = fresh_ctx(c_in.lds);
    unsigned char* ws = a.ws;
    const u16* proj = (const u16*)(ws + WS_PROJ);
    const float* cw = a.in[4] + (size_t)l * 4 * 768;
    const float* cb = a.in[5] + (size_t)l * 768;
    float* cs = (float*)(ws + WS_CS);
    float* cdec = (float*)(ws + WS_CDEC);
    const int b = item >> 5, ch = item & 31, tok0 = b * 4096 + ch * 128, s0 = ch * 128;
    u16* XT = (u16*)c.lds;
    u16* BT = (u16*)(c.lds + SSD_TILE_B);
    float* dt_s = (float*)(c.lds + SSD_OFF_DT);
    float* acs_s = (float*)(c.lds + SSD_OFF_ACS);
    const int l31 = c.lane & 31, h = c.lane >> 5;
    ssd_dt_acs(c, a, l, tok0, dt_s, acs_s);
    if (c.tid < 4) cdec[(b * 32 + ch) * 4 + c.tid] = __expf(acs_s[c.tid * 128 + 127]);
    for (int g = 0; g < 2; ++g) {
        if (c.wave < 4) conv_stage_unit<true>(c, proj, cw, cb, b, s0, c.wave, 128 * g, XT, dt_s, acs_s, 2 * g);
        else conv_stage_unit<true>(c, proj, cw, cb, b, s0, c.wave - 4, 256 + 128 * g, BT, nullptr, nullptr, 0);
        __syncthreads();
        {
            const int hh = c.wave >> 2, pt = (c.wave >> 1) & 1, nh = c.wave & 1;
            f32x16 acc0 = zero16(), acc1 = zero16();
#pragma unroll
            for (int ks = 0; ks < 8; ++ks) {
                const bf16x8 af = *(const bf16x8*)(XT + (hh * 64 + pt * 32 + l31) * SSD_LD + ks * 16 + h * 8);
                const bf16x8 b0 = *(const bf16x8*)(BT + (nh * 64 + l31) * SSD_LD + ks * 16 + h * 8);
                const bf16x8 b1 = *(const bf16x8*)(BT + (nh * 64 + 32 + l31) * SSD_LD + ks * 16 + h * 8);
                acc0 = MFMA32(af, b0, acc0);
                acc1 = MFMA32(af, b1, acc1);
            }
            const int head = 2 * g + hh;
            float* dst = cs + ((size_t)((b * 32 + ch) * 4 + head) * 64) * 128;
#pragma unroll
            for (int r = 0; r < 16; ++r) {
                const int p = pt * 32 + crow(r, h);
                dst[p * 128 + nh * 64 + l31] = acc0[r];
                dst[p * 128 + nh * 64 + 32 + l31] = acc1[r];
            }
        }
        __syncthreads();
    }
}

DI void ssd_scan_item(const Ctx& c_in, KArgs& a, int item) {
    const Ctx c = fresh_ctx(c_in.lds);
    float* cs = (float*)(a.ws + WS_CS);
    const float* cdec = (const float*)(a.ws + WS_CDEC);
    const int idx = item * NTHR + c.tid;
    const int bh = idx >> 13, pn = idx & 8191, b = bh >> 2, hd = bh & 3;
    float v[32], dcy[32];
#pragma unroll
    for (int ch = 0; ch < 32; ++ch) {
        v[ch] = cs[((size_t)((b * 32 + ch) * 4 + hd)) * 8192 + pn];
        dcy[ch] = cdec[(b * 32 + ch) * 4 + hd];
    }
    float s = 0.f;
#pragma unroll
    for (int ch = 0; ch < 32; ++ch) {
        cs[((size_t)((b * 32 + ch) * 4 + hd)) * 8192 + pn] = s;
        s = s * dcy[ch] + v[ch];
    }
}

DI void ssd_out_item(const Ctx& c_in, KArgs& a, int l, int item) {
    const Ctx c = fresh_ctx(c_in.lds);
    unsigned char* ws = a.ws;
    const u16* proj = (const u16*)(ws + WS_PROJ);
    const float* cw = a.in[4] + (size_t)l * 4 * 768;
    const float* cb = a.in[5] + (size_t)l * 768;
    const float* prev = (const float*)(ws + WS_CS);
    u16* act = (u16*)(ws + WS_ACT);
    const int b = item >> 5, ch = item & 31, tok0 = b * 4096 + ch * 128, s0 = ch * 128;
    u16* XT = (u16*)c.lds;
    u16* BM = (u16*)(c.lds + SSD_TILE_B);
    u16* CM = (u16*)(c.lds + 2 * SSD_TILE_B);
    float* dt_s = (float*)(c.lds + SSD_OFF_DT);
    float* acs_s = (float*)(c.lds + SSD_OFF_ACS);
    float* ssq = (float*)(c.lds + SSD_OFF_SSQ);
    const int l31 = c.lane & 31, h = c.lane >> 5;
    ssd_dt_acs(c, a, l, tok0, dt_s, acs_s);
    f32x16 yreg[2][2];
    const int hh = c.wave >> 2, qt = c.wave & 3;
    const int q = qt * 32 + l31;
#pragma unroll
    for (int g = 0; g < 2; ++g) {
        for (int u = c.wave; u < 12; u += 8) {
            const int part = u >> 2, tseg = u & 3;
            if (part == 0) conv_stage_unit<true>(c, proj, cw, cb, b, s0, tseg, 128 * g, XT, nullptr, nullptr, 0);
            else if (part == 1) conv_stage_unit<false>(c, proj, cw, cb, b, s0, tseg, 256 + 128 * g, BM, nullptr, nullptr, 0);
            else conv_stage_unit<false>(c, proj, cw, cb, b, s0, tseg, 512 + 128 * g, CM, nullptr, nullptr, 0);
        }
        __syncthreads();
        {
            const int head = 2 * g + hh;
            const float acs_q = acs_s[head * 128 + q];
            bf16x8 cf[8];
#pragma unroll
            for (int ks = 0; ks < 8; ++ks) cf[ks] = *(const bf16x8*)(CM + q * SSD_LD + ks * 16 + h * 8);
            f32x16 yo0 = zero16(), yo1 = zero16();
            for (int kt = 0; kt <= qt; ++kt) {
                f32x16 gt = zero16();
#pragma unroll
                for (int ks = 0; ks < 8; ++ks) {
                    const bf16x8 bf = *(const bf16x8*)(BM + (kt * 32 + l31) * SSD_LD + ks * 16 + h * 8);
                    gt = MFMA32(bf, cf[ks], gt);
                }
#pragma unroll
                for (int r = 0; r < 16; ++r) {
                    const int k = kt * 32 + crow(r, h);
                    const float dec = __expf(fminf(acs_q - acs_s[head * 128 + k], 0.f)) * dt_s[head * 128 + k];
                    gt[r] = (k <= q) ? gt[r] * dec : 0.f;
                }
#pragma unroll
                for (int s2 = 0; s2 < 2; ++s2) {
                    const bf16x8 pb = pack8(gt, s2);
                    const int koff = kt * 32 + 16 * s2 + 4 * h;
                    {
                        const u16* xr = XT + (hh * 64 + l31) * SSD_LD + koff;
                        const uint2 lo = *(const uint2*)xr, hi = *(const uint2*)(xr + 8);
                        const bf16x8 xa = __builtin_bit_cast(bf16x8, make_uint4(lo.x, lo.y, hi.x, hi.y));
                        yo0 = MFMA32(xa, pb, yo0);
                    }
                    {
                        const u16* xr = XT + (hh * 64 + 32 + l31) * SSD_LD + koff;
                        const uint2 lo = *(const uint2*)xr, hi = *(const uint2*)(xr + 8);
                        const bf16x8 xa = __builtin_bit_cast(bf16x8, make_uint4(lo.x, lo.y, hi.x, hi.y));
                        yo1 = MFMA32(xa, pb, yo1);
                    }
                }
            }
            f32x16 yf0 = zero16(), yf1 = zero16();
            const float* pv = prev + ((size_t)((b * 32 + ch) * 4 + head) * 64) * 128;
#pragma unroll
            for (int ks = 0; ks < 8; ++ks) {
                {
                    const float* pr = pv + (size_t)l31 * 128 + ks * 16 + h * 8;
                    const float4 f0 = *(const float4*)pr, f1 = *(const float4*)(pr + 4);
                    const bf16x8 pa = __builtin_bit_cast(bf16x8, make_uint4(pack2(f0.x, f0.y), pack2(f0.z, f0.w), pack2(f1.x, f1.y), pack2(f1.z, f1.w)));
                    yf0 = MFMA32(pa, cf[ks], yf0);
                }
                {
                    const float* pr = pv + (size_t)(32 + l31) * 128 + ks * 16 + h * 8;
                    const float4 f0 = *(const float4*)pr, f1 = *(const float4*)(pr + 4);
                    const bf16x8 pa = __builtin_bit_cast(bf16x8, make_uint4(pack2(f0.x, f0.y), pack2(f0.z, f0.w), pack2(f1.x, f1.y), pack2(f1.z, f1.w)));
                    yf1 = MFMA32(pa, cf[ks], yf1);
                }
            }
            const float eq = __expf(acs_q);
            const float dsk = a.in[8][l * 4 + head];
            float part = 0.f;
#pragma unroll
            for (int pt = 0; pt < 2; ++pt) {
#pragma unroll
                for (int qd = 0; qd < 4; ++qd) {
                    const int p0 = pt * 32 + 8 * qd + 4 * h;
                    const uint2 zz = *(const uint2*)(proj + (size_t)(tok0 + q) * LDP + PC_Z + head * 64 + p0);
                    const float zf[4] = { bf2f((u16)(zz.x & 0xffff)), bf2f((u16)(zz.x >> 16)), bf2f((u16)(zz.y & 0xffff)), bf2f((u16)(zz.y >> 16)) };
#pragma unroll
                    for (int r3 = 0; r3 < 4; ++r3) {
                        const int r = 4 * qd + r3;
                        const float yo = pt ? yo1[r] : yo0[r];
                        const float yf = pt ? yf1[r] : yf0[r];
                        const float xv = bf2f(XT[(hh * 64 + p0 + r3) * SSD_LD + q]);
                        const float y = (yo + yf * eq + dsk * xv) * siluf(zf[r3]);
                        yreg[g][pt][r] = y;
                        part += y * y;
                    }
                }
            }
            part += __shfl_xor(part, 32);
            if (h == 0) ssq[head * 128 + q] = part;
        }
        __syncthreads();
    }
    {
        const float rs = rsqrtf((ssq[q] + ssq[128 + q] + ssq[256 + q] + ssq[384 + q]) * (1.f / 256.f) + EPS);
        const float* nw = a.in[9] + l * 256;
#pragma unroll
        for (int g = 0; g < 2; ++g) {
            const int head = 2 * g + hh;
#pragma unroll
            for (int pt = 0; pt < 2; ++pt)
#pragma unroll
                for (int qd = 0; qd < 4; ++qd) {
                    const int p0 = pt * 32 + 8 * qd + 4 * h;
                    const float* w4 = nw + head * 64 + p0;
                    uint2 pk;
                    pk.x = pack2(yreg[g][pt][4 * qd] * rs * w4[0], yreg[g][pt][4 * qd + 1] * rs * w4[1]);
                    pk.y = pack2(yreg[g][pt][4 * qd + 2] * rs * w4[2], yreg[g][pt][4 * qd + 3] * rs * w4[3]);
                    *(uint2*)(act + (size_t)(tok0 + q) * 1024 + head * 64 + p0) = pk;
                }
        }
    }
    __syncthreads();
}

DI void token_post_item(const Ctx& c_in, KArgs& a, int l, int item) {
    const Ctx c = fresh_ctx(c_in.lds);
    unsigned char* ws = a.ws;
    u16* proj = (u16*)(ws + WS_PROJ);
    u16* mlak = (u16*)(ws + WS_MLAK);
    const float* trig = (const float*)(ws + WS_TRIG);
    const float* small = (const float*)(ws + WS_SMALL);
    float* flog = (float*)(ws + WS_FLOG);
    const int t = item * 8 + c.wave;
    u16* pr = proj + (size_t)t * LDP;
    const float* tg = trig + (size_t)t * 48;
#pragma unroll
    for (int r = 0; r < 2; ++r) {
        const int pid = c.lane + 64 * r;
        if (pid < 112) {
            int col, i;
            if (pid < 32)       { col = PC_DSAQ + (pid >> 3) * 64; i = pid & 7; }
            else if (pid < 40)  { col = PC_DSAK; i = pid - 32; }
            else if (pid < 104) { const int p = pid - 40; col = PC_IDXQ + (p >> 3) * 64; i = p & 7; }
            else                { col = PC_IDXK; i = pid - 104; }
            const float x1 = bf2f(pr[col + i]), x2 = bf2f(pr[col + 8 + i]);
            const float cs = tg[i], sn = tg[8 + i];
            pr[col + i] = f2bf(x1 * cs - x2 * sn);
            pr[col + 8 + i] = f2bf(x2 * cs + x1 * sn);
        } else {
            const int i = pid - 112;
            const float x1 = bf2f(pr[PC_KR + i]), x2 = bf2f(pr[PC_KR + 16 + i]);
            const float cs = tg[16 + i], sn = tg[32 + i];
            const u16 o1 = f2bf(x1 * cs - x2 * sn), o2 = f2bf(x2 * cs + x1 * sn);
#pragma unroll
            for (int hd = 0; hd < 4; ++hd) { mlak[(size_t)t * 384 + hd * 96 + 64 + i] = o1; mlak[(size_t)t * 384 + hd * 96 + 80 + i] = o2; }
        }
    }
    {
        const int hd = c.lane >> 4, d0 = (c.lane & 15) * 4;
        const uint2 kk = *(const uint2*)(pr + PC_FOXK + hd * 64 + d0);
        const float k0 = bf2f((u16)(kk.x & 0xffff)), k1 = bf2f((u16)(kk.x >> 16)), k2 = bf2f((u16)(kk.y & 0xffff)), k3 = bf2f((u16)(kk.y >> 16));
        float ss = k0 * k0 + k1 * k1 + k2 * k2 + k3 * k3;
        ss += __shfl_xor(ss, 1); ss += __shfl_xor(ss, 2); ss += __shfl_xor(ss, 4); ss += __shfl_xor(ss, 8);
        if ((c.lane & 15) == 0) {
            unsigned* km = (unsigned*)(ws + WS_CTL) + 64 + (t >> 12) * 4 + hd;
            const unsigned sb = __float_as_uint(ss);
            if (sb > __hip_atomic_load(km, __ATOMIC_RELAXED, __HIP_MEMORY_SCOPE_AGENT)) atomicMax(km, sb);
        }
    }
    if (c.lane < 4) {
        const float f = small[(size_t)t * 16 + 12 + c.lane] + a.in[14][l * 4 + c.lane];
        const float ls = fminf(f, 0.f) - log1pf(__expf(-fabsf(f)));
        const int b = t >> 12, s = t & 4095;
        flog[(size_t)(b * 4 + c.lane) * 4096 + s] = ls;
    }
}

DI void mla_up_item(const Ctx& c_in, KArgs& a, int l, int which, int item) {
    const Ctx c = fresh_ctx(c_in.lds);
    unsigned char* ws = a.ws;
    const u16* proj = (const u16*)(ws + WS_PROJ);
    const float* trig = (const float*)(ws + WS_TRIG);
    float* rs_s = (float*)(c.lds + G_LDS_BYTES);
    const int r8 = c.tid >> 3;
    const int wm = c.wave & 3, wn = c.wave >> 2, l31 = c.lane & 31, h = c.lane >> 5;
    const int K = which == 0 ? 256 : 128;
    const int pc = which == 0 ? PC_CQ : PC_CKV;
    const int ntn = which == 0 ? 3 : 4;
    const int mt = item / ntn, nt = item % ntn;
    const u16* w = which == 0 ? (const u16*)(ws + WS_WUQ) + (size_t)l * 384 * 256 : (const u16*)(ws + WS_WUKV) + (size_t)l * 512 * 128;
    {
        const int row = c.tid >> 1, half = c.tid & 1;
        const u16* p = proj + (size_t)(mt * 256 + row) * LDP + pc + half * (K / 2);
        float ss = 0.f;
        for (int i = 0; i < K / 2; i += 8) {
            const uint4 v = *(const uint4*)(p + i);
            const unsigned w4[4] = { v.x, v.y, v.z, v.w };
#pragma unroll
            for (int j = 0; j < 4; ++j) { const float f0 = bf2f((u16)(w4[j] & 0xffff)), f1 = bf2f((u16)(w4[j] >> 16)); ss += f0 * f0 + f1 * f1; }
        }
        ss += __shfl_xor(ss, 1);
        if (half == 0) rs_s[row] = rsqrtf(ss / (float)K + EPS);
    }
    __syncthreads();
    GP gp;
    gp.a0 = proj + (size_t)(mt * 256 + r8) * LDP + pc; gp.a1 = gp.a0 + 64 * LDP; gp.a2 = gp.a0 + 128 * LDP; gp.a3 = gp.a0 + 192 * LDP;
    gp.b0 = w + (size_t)(nt * 128 + r8) * K; gp.b1 = gp.b0 + 64 * K;
    f32x16 acc[2][2];
    acc[0][0] = zero16(); acc[0][1] = zero16(); acc[1][0] = zero16(); acc[1][1] = zero16();
    gemm_core<false>(c, K, gp, acc);
    u16* mlaq = (u16*)(ws + WS_MLAQ);
    u16* mlak = (u16*)(ws + WS_MLAK);
    u16* mlavt = (u16*)(ws + WS_MLAVT);
#pragma unroll
    for (int i = 0; i < 2; ++i)
#pragma unroll
        for (int j = 0; j < 2; ++j) {
            const int ml0 = wm * 64 + i * 32, m0 = mt * 256 + ml0, n0 = nt * 128 + wn * 64 + j * 32;
            const int n = n0 + l31;
            if (which == 0) {
                const bool rope = ((n0 >> 5) % 3) == 2;
#pragma unroll
                for (int r = 0; r < 16; ++r) {
                    const int ml = ml0 + crow(r, h), m = mt * 256 + ml;
                    float v = acc[i][j][r] * rs_s[ml];
                    if (rope) {
                        const float pv = __shfl_xor(v, 16);
                        const int ii = l31 & 15;
                        const float cs = trig[(size_t)m * 48 + 16 + ii], sn = trig[(size_t)m * 48 + 32 + ii];
                        v = (l31 < 16) ? (v * cs - pv * sn) : (v * cs + pv * sn);
                    }
                    mlaq[(size_t)m * 384 + n] = f2bf(v);
                }
            } else {
                const int head = n0 >> 7, wi = n0 & 127;
                if (wi < 64) {
#pragma unroll
                    for (int r = 0; r < 16; ++r) {
                        const int ml = ml0 + crow(r, h), m = mt * 256 + ml;
                        mlak[(size_t)m * 384 + head * 96 + wi + l31] = f2bf(acc[i][j][r] * rs_s[ml]);
                    }
                } else {
                    const int b = m0 >> 12, s0 = m0 & 4095, d = wi - 64 + l31;
                    u16* base = mlavt + ((size_t)(b * 4 + head) * 64 + d) * 4096 + s0;
#pragma unroll
                    for (int q = 0; q < 4; ++q) {
                        const int mlq = ml0 + 8 * q + 4 * h;
                        uint2 pk;
                        pk.x = pack2(acc[i][j][4 * q] * rs_s[mlq], acc[i][j][4 * q + 1] * rs_s[mlq + 1]);
                        pk.y = pack2(acc[i][j][4 * q + 2] * rs_s[mlq + 2], acc[i][j][4 * q + 3] * rs_s[mlq + 3]);
                        *(uint2*)(base + 8 * q + 4 * h) = pk;
                    }
                }
            }
        }
    __syncthreads();
}

constexpr int AT_LDV = 68;
template <int DQ, int MODE>
DI void attn_item(const Ctx& c_in, KArgs& a, int b, int hd_in, int qb) {
    const Ctx c = fresh_ctx(c_in.lds);
    unsigned char* ws = a.ws;
    constexpr int LDK = DQ + 8;
    constexpr int K_EL = 64 * LDK, V_EL = 64 * AT_LDV, ST_EL = K_EL + V_EL;
    constexpr int NKS = DQ / 16;
    constexpr int KCH = DQ / 8;
    u16* S = (u16*)c.lds;
    float* fc_s = (float*)(c.lds + 2 * ST_EL * 2 + 64);
    const int l31 = c.lane & 31, h = c.lane >> 5;
    int hd, wq0, nkt;
    const u16 *Qp, *Kp, *Vp; int ldq, ldk, ocol;
    float scale;
    if (MODE == 0) {
        hd = hd_in;
        wq0 = qb * 256 + c.wave * 32; nkt = qb * 4 + 4;
        Qp = (const u16*)(ws + WS_MLAQ) + (size_t)b * 4096 * 384 + hd * 96; ldq = 384;
        Kp = (const u16*)(ws + WS_MLAK) + (size_t)b * 4096 * 384 + hd * 96; ldk = 384;
        Vp = (const u16*)(ws + WS_MLAVT) + (size_t)(b * 4 + hd) * 64 * 4096;
        ocol = 512 + hd * 64; scale = 0.10206207261596575f;
    } else if (MODE == 1) {
        hd = hd_in;
        wq0 = qb * 256 + c.wave * 32; nkt = qb * 4 + 4;
        Qp = (const u16*)(ws + WS_PROJ) + (size_t)b * 4096 * LDP + PC_FOXQ + hd * 64; ldq = LDP;
        Kp = (const u16*)(ws + WS_PROJ) + (size_t)b * 4096 * LDP + PC_FOXK + hd * 64; ldk = LDP;
        Vp = (const u16*)(ws + WS_FOXVT) + (size_t)(b * 4 + hd) * 64 * 4096;
        ocol = 768 + hd * 64; scale = 0.125f;
    } else {
        hd = c.wave & 3;
        wq0 = qb * 64 + (c.wave >> 2) * 32; nkt = qb + 1;
        Qp = (const u16*)(ws + WS_PROJ) + (size_t)b * 4096 * LDP + PC_DSAQ + hd * 64; ldq = LDP;
        Kp = (const u16*)(ws + WS_PROJ) + (size_t)b * 4096 * LDP + PC_DSAK; ldk = LDP;
        Vp = (const u16*)(ws + WS_DSAVT) + (size_t)b * 64 * 4096;
        ocol = 256 + hd * 64; scale = 0.125f;
    }
    const float sc2 = scale * LOG2E;
    const int q = wq0 + l31;
    bf16x8 qf[NKS];
#pragma unroll
    for (int ks = 0; ks < NKS; ++ks) qf[ks] = *(const bf16x8*)(Qp + (size_t)q * ldq + ks * 16 + h * 8);
    float fq = 0.f;
    if (MODE == 1) {
        const float* fl = (const float*)(ws + WS_FLOG) + (size_t)(b * 4 + hd) * 4096;
        float* wtot = (float*)(c.lds + 2 * ST_EL * 2);
        const int nk = nkt * 64;
        float v[8]; float s = 0.f;
#pragma unroll
        for (int j = 0; j < 8; ++j) { const int idx = c.tid * 8 + j; v[j] = (idx < nk) ? fl[idx] : 0.f; s += v[j]; v[j] = s; }
        float inc = s;
#pragma unroll
        for (int o = 1; o < 64; o <<= 1) { const float tv = __shfl_up(inc, o); if (c.lane >= o) inc += tv; }
        if (c.lane == 63) wtot[c.wave] = inc;
        __syncthreads();
        float base = inc - s;
        for (int w2 = 0; w2 < c.wave; ++w2) base += wtot[w2];
#pragma unroll
        for (int j = 0; j < 8; ++j) fc_s[c.tid * 8 + j] = (base + v[j]) * LOG2E;
        __syncthreads();
        fq = fc_s[q];
    }
    float sbound = 0.f;
    int* dflag = (int*)(c.lds + 2 * ST_EL * 2 + 64 + 4096 * 4);
    if (MODE == 1) {
        float qq = 0.f;
#pragma unroll
        for (int ks = 0; ks < NKS; ++ks)
#pragma unroll
            for (int j = 0; j < 8; ++j) { const float f = bf2f((u16)qf[ks][j]); qq += f * f; }
        qq += __shfl_xor(qq, 32);
        const float kmax2 = __uint_as_float(__hip_atomic_load((const unsigned*)(ws + WS_CTL) + 64 + b * 4 + hd, __ATOMIC_RELAXED, __HIP_MEMORY_SCOPE_AGENT));
        sbound = sqrtf(qq * kmax2) * sc2 * 1.02f + 1.0f;
        if (c.tid < 16) dflag[c.tid] = 0;
    }
    bool wdone = false;
    const int krow0 = c.tid / KCH, kch0 = c.tid % KCH;
    const int c1 = c.tid + NTHR; const int krow1 = c1 / KCH, kch1 = c1 % KCH; const bool has1 = (KCH * 64 > NTHR) && (c1 < KCH * 64);
    const int vrow = c.tid >> 3, vch = c.tid & 7;
    uint4 rk0, rk1, rv; rk1 = make_uint4(0, 0, 0, 0);
    auto gload = [&](int kt) {
        rk0 = *(const uint4*)(Kp + (size_t)(kt * 64 + krow0) * ldk + kch0 * 8);
        if (has1) rk1 = *(const uint4*)(Kp + (size_t)(kt * 64 + krow1) * ldk + kch1 * 8);
        rv = *(const uint4*)(Vp + (size_t)vrow * 4096 + kt * 64 + vch * 8);
    };
    auto sstore = [&](int st) {
        u16* Ks = S + st * ST_EL; u16* Vs = Ks + K_EL;
        *(uint4*)(Ks + krow0 * LDK + kch0 * 8) = rk0;
        if (has1) *(uint4*)(Ks + krow1 * LDK + kch1 * 8) = rk1;
        *(uint2*)(Vs + vrow * AT_LDV + vch * 8) = make_uint2(rv.x, rv.y);
        *(uint2*)(Vs + vrow * AT_LDV + vch * 8 + 4) = make_uint2(rv.z, rv.w);
    };
    f32x16 o0 = zero16(), o1 = zero16();
    float m_run = -1e30f, l_run = 0.f;
    const u64* mrow = (const u64*)(ws + WS_MASK) + (size_t)(b * 4096 + q) * 64;
    u64 mw_cur = 0, mw_nxt = 0;
    if (MODE == 2) mw_cur = mrow[0];
    gload(MODE == 1 ? nkt - 1 : 0); sstore(0);
    __syncthreads();
    for (int it = 0; it < nkt; ++it) {
        const int kt = (MODE == 1) ? nkt - 1 - it : it;
        const bool more = (it + 1 < nkt);
        if (more) { gload(MODE == 1 ? kt - 1 : kt + 1); if (MODE == 2) mw_nxt = mrow[kt + 1]; }
        if (kt * 64 <= wq0 + 31 && !wdone) {
            const u16* Ks = S + (it & 1) * ST_EL; const u16* Vs = Ks + K_EL;
            f32x16 s0 = zero16(), s1 = zero16();
#pragma unroll
            for (int ks = 0; ks < NKS; ++ks) {
                const bf16x8 k0 = *(const bf16x8*)(Ks + l31 * LDK + ks * 16 + h * 8);
                const bf16x8 k1 = *(const bf16x8*)(Ks + (32 + l31) * LDK + ks * 16 + h * 8);
                s0 = MFMA32(k0, qf[ks], s0);
                s1 = MFMA32(k1, qf[ks], s1);
            }
            const float scx = (MODE == 1) ? 1.0f : sc2;
            if (MODE == 1) {
#pragma unroll
                for (int g4 = 0; g4 < 4; ++g4) {
                    const float4 f0 = *(const float4*)(fc_s + kt * 64 + 8 * g4 + 4 * h);
                    const float4 f1 = *(const float4*)(fc_s + kt * 64 + 32 + 8 * g4 + 4 * h);
                    s0[4 * g4 + 0] = fmaf(s0[4 * g4 + 0], sc2, fq) - f0.x; s0[4 * g4 + 1] = fmaf(s0[4 * g4 + 1], sc2, fq) - f0.y;
                    s0[4 * g4 + 2] = fmaf(s0[4 * g4 + 2], sc2, fq) - f0.z; s0[4 * g4 + 3] = fmaf(s0[4 * g4 + 3], sc2, fq) - f0.w;
                    s1[4 * g4 + 0] = fmaf(s1[4 * g4 + 0], sc2, fq) - f1.x; s1[4 * g4 + 1] = fmaf(s1[4 * g4 + 1], sc2, fq) - f1.y;
                    s1[4 * g4 + 2] = fmaf(s1[4 * g4 + 2], sc2, fq) - f1.z; s1[4 * g4 + 3] = fmaf(s1[4 * g4 + 3], sc2, fq) - f1.w;
                }
            }
            if (MODE == 2) {
                const unsigned mlo = (unsigned)(mw_cur >> (4 * h)), mhi = (unsigned)(mw_cur >> (32 + 4 * h));
#pragma unroll
                for (int r = 0; r < 16; ++r) {
                    const int kr = (r & 3) + 8 * (r >> 2);
                    s0[r] = ((mlo >> kr) & 1u) ? s0[r] : -1e30f;
                    s1[r] = ((mhi >> kr) & 1u) ? s1[r] : -1e30f;
                }
            } else if (__builtin_amdgcn_readfirstlane(kt * 64 + 63 - wq0) > 0) {
                asm volatile("" ::: "memory");
                const int qrel = q - kt * 64 - 4 * h;
#pragma unroll
                for (int r = 0; r < 16; ++r) {
                    const int kr = (r & 3) + 8 * (r >> 2);
                    s0[r] = (kr <= qrel) ? s0[r] : -1e30f;
                    s1[r] = (kr + 32 <= qrel) ? s1[r] : -1e30f;
                }
            }
            float mx;
            {
                float t0 = max3f(s0[0], s0[1], s0[2]), t1 = max3f(s0[3], s0[4], s0[5]), t2 = max3f(s0[6], s0[7], s0[8]), t3 = max3f(s0[9], s0[10], s0[11]);
                float t4 = max3f(s0[12], s0[13], s0[14]), t5 = max3f(s0[15], s1[0], s1[1]), t6 = max3f(s1[2], s1[3], s1[4]), t7 = max3f(s1[5], s1[6], s1[7]);
                float t8 = max3f(s1[8], s1[9], s1[10]), t9 = max3f(s1[11], s1[12], s1[13]), t10 = max3f(s1[14], s1[15], t0);
                t1 = max3f(t1, t2, t3); t4 = max3f(t4, t5, t6); t7 = max3f(t7, t8, t9);
                mx = max3f(t1, t4, t7); mx = max3f(mx, t10, __shfl_xor(max3f(t1, t4, max3f(t7, t10, t10)), 32));
            }
            const float m_new = max3f(m_run, mx, mx);
            const float m_use = (MODE == 2) ? max3f(m_new, -1e20f, -1e20f) : m_new;
            const float alpha = ex2((m_run - m_new) * scx);
            const float nm = -m_use * scx;
            f32x2 rs2 = {0.f, 0.f};
            const f32x2 sc2v = {scx, scx}, nm2 = {nm, nm};
#pragma unroll
            for (int r = 0; r < 16; r += 2) {
                f32x2 xv = {s0[r], s0[r + 1]};
                xv = xv * sc2v + nm2;
                xv[0] = ex2(xv[0]); xv[1] = ex2(xv[1]);
                s0[r] = xv[0]; s0[r + 1] = xv[1];
                rs2 += xv;
                f32x2 yv = {s1[r], s1[r + 1]};
                yv = yv * sc2v + nm2;
                yv[0] = ex2(yv[0]); yv[1] = ex2(yv[1]);
                s1[r] = yv[0]; s1[r + 1] = yv[1];
                rs2 += yv;
            }
            float rsum = rs2[0] + rs2[1];
            rsum += __shfl_xor(rsum, 32);
            l_run = l_run * alpha + rsum; m_run = m_new;
            if (__any(alpha != 1.0f)) {
#pragma unroll
                for (int r = 0; r < 16; ++r) { o0[r] *= alpha; o1[r] *= alpha; }
            }
#pragma unroll
            for (int sub = 0; sub < 2; ++sub)
#pragma unroll
                for (int s2 = 0; s2 < 2; ++s2) {
                    const bf16x8 pb = pack8(sub ? s1 : s0, s2);
                    const int koff = sub * 32 + 16 * s2 + 4 * h;
                    {
                        const u16* vr = Vs + l31 * AT_LDV + koff;
                        const uint2 lo = *(const uint2*)vr, hi = *(const uint2*)(vr + 8);
                        o0 = MFMA32(__builtin_bit_cast(bf16x8, make_uint4(lo.x, lo.y, hi.x, hi.y)), pb, o0);
                    }
                    {
                        const u16* vr = Vs + (32 + l31) * AT_LDV + koff;
                        const uint2 lo = *(const uint2*)vr, hi = *(const uint2*)(vr + 8);
                        o1 = MFMA32(__builtin_bit_cast(bf16x8, make_uint4(lo.x, lo.y, hi.x, hi.y)), pb, o1);
                    }
                }
        }
        if (more) sstore((it + 1) & 1);
        if (MODE == 2) mw_cur = mw_nxt;
        if (MODE == 1) {
            if (kt * 64 <= wq0 + 31 && !wdone && kt > 0) wdone = __all(sbound + (fq - fc_s[kt * 64 - 1]) < m_run - 40.f);
            if (c.lane == 0) dflag[(it & 1) * 8 + c.wave] = wdone ? 1 : 0;
        }
        __syncthreads();
        if (MODE == 1) {
            const int4 f0 = *(const int4*)(dflag + (it & 1) * 8), f1 = *(const int4*)(dflag + (it & 1) * 8 + 4);
            if ((f0.x & f0.y & f0.z & f0.w & f1.x & f1.y & f1.z & f1.w) != 0) break;
        }
    }
    if (MODE == 1) __syncthreads();
    {
        const float inv = 1.f / l_run;
        u16* act = (u16*)(ws + WS_ACT) + (size_t)(b * 4096 + q) * 1024 + ocol;
#pragma unroll
        for (int qd = 0; qd < 4; ++qd) {
            uint2 pk;
            pk.x = pack2(o0[4 * qd] * inv, o0[4 * qd + 1] * inv); pk.y = pack2(o0[4 * qd + 2] * inv, o0[4 * qd + 3] * inv);
            *(uint2*)(act + 8 * qd + 4 * h) = pk;
            pk.x = pack2(o1[4 * qd] * inv, o1[4 * qd + 1] * inv); pk.y = pack2(o1[4 * qd + 2] * inv, o1[4 * qd + 3] * inv);
            *(uint2*)(act + 32 + 8 * qd + 4 * h) = pk;
        }
    }
}

constexpr int SC_LD = 4100;
DI void dsa_index_item(const Ctx& c_in, KArgs& a, int b, int s0) {
    const Ctx c = fresh_ctx(c_in.lds);
    unsigned char* ws = a.ws;
    const u16* proj = (const u16*)(ws + WS_PROJ);
    const float* small = (const float*)(ws + WS_SMALL);
    u64* mask = (u64*)(ws + WS_MASK);
    float* SC = (float*)c.lds;
    unsigned* HIST = (unsigned*)(c.lds + 8 * SC_LD * 4);
    const int l31 = c.lane & 31, h = c.lane >> 5;
    const int tok0 = b * 4096 + s0;
    const int ntile = ((s0 + 7) >> 5) + 1;
    bf16x8 qa[2][4];
    float wv[2][16];
#pragma unroll
    for (int rt = 0; rt < 2; ++rt) {
        const int r = rt * 32 + l31, ql = r >> 3, j = r & 7;
        const u16* p = proj + (size_t)(tok0 + ql) * LDP + PC_IDXQ + j * 64 + h * 8;
#pragma unroll
        for (int ks = 0; ks < 4; ++ks) qa[rt][ks] = *(const bf16x8*)(p + ks * 16);
#pragma unroll
        for (int r2 = 0; r2 < 16; ++r2) {
            const int qq = (r2 >> 2) + 4 * rt, jj = (r2 & 3) + 4 * h;
            wv[rt][r2] = small[(size_t)(tok0 + qq) * 16 + 4 + jj] * 0.044194173824159216f;
        }
    }
    const u16* kbase = proj + (size_t)(b * 4096 + l31) * LDP + PC_IDXK + h * 8;
    bf16x8 kb[4], kn[4];
    if (c.wave < ntile) {
#pragma unroll
        for (int ks = 0; ks < 4; ++ks) kb[ks] = *(const bf16x8*)(kbase + (size_t)(c.wave * 32) * LDP + ks * 16);
    }
    for (int kt = c.wave; kt < ntile; kt += 8) {
        const int key = kt * 32 + l31;
        if (kt + 8 < ntile) {
#pragma unroll
            for (int ks = 0; ks < 4; ++ks) kn[ks] = *(const bf16x8*)(kbase + (size_t)((kt + 8) * 32) * LDP + ks * 16);
        }
        f32x16 a0 = zero16(), a1 = zero16();
#pragma unroll
        for (int ks = 0; ks < 4; ++ks) { a0 = MFMA32(qa[0][ks], kb[ks], a0); a1 = MFMA32(qa[1][ks], kb[ks], a1); }
#pragma unroll
        for (int g = 0; g < 4; ++g) {
            float p0 = 0.f, p1 = 0.f;
#pragma unroll
            for (int r3 = 0; r3 < 4; ++r3) {
                p0 += wv[0][4 * g + r3] * fmaxf(a0[4 * g + r3], 0.f);
                p1 += wv[1][4 * g + r3] * fmaxf(a1[4 * g + r3], 0.f);
            }
            const float t0 = p0 + __shfl_xor(p0, 32);
            const float t1 = p1 + __shfl_xor(p1, 32);
            SC[(4 * h + g) * SC_LD + key] = h ? t1 : t0;
        }
#pragma unroll
        for (int ks = 0; ks < 4; ++ks) kb[ks] = kn[ks];
    }
    __syncthreads();
    {
        const int qi = s0 + c.wave, n = qi + 1;
        const float* sc = SC + c.wave * SC_LD;
        unsigned* hist = HIST + c.wave * 272;
        const int nit = (n + 63) >> 6;
        unsigned key[64];
#pragma unroll
        for (int g = 0; g < 8; ++g) {
#pragma unroll
            for (int j = 0; j < 8; ++j) key[g * 8 + j] = 0u;
            if (g * 8 < nit) {
#pragma unroll
                for (int j = 0; j < 8; ++j) {
                    const int i = (g * 8 + j) * 64 + c.lane;
                    const unsigned bits = __float_as_uint(sc[i] + 0.0f);
                    const unsigned k = bits ^ ((unsigned)((int)bits >> 31) | 0x80000000u);
                    key[g * 8 + j] = (i < n) ? k : 0u;
                }
            }
        }
        unsigned thr = 1u; int cut = 0x7fffffff;
        if (n > 256) {
            unsigned lo = 0xffffffffu, hi = 0u;
#pragma unroll
            for (int g = 0; g < 8; ++g) if (g * 8 < nit) {
#pragma unroll
                for (int j = 0; j < 8; ++j) { const unsigned k = key[g * 8 + j]; hi = max(hi, k); lo = min(lo, k ? k : 0xffffffffu); }
            }
#pragma unroll
            for (int o = 32; o >= 1; o >>= 1) { lo = min(lo, (unsigned)__shfl_xor((int)lo, o)); hi = max(hi, (unsigned)__shfl_xor((int)hi, o)); }
            int kk = 256;
            for (int iter = 0; iter < 5; ++iter) {
                const unsigned width = hi - lo;
                const int shift = max(0, 24 - (int)__clz(width | 1u));
#pragma unroll
                for (int j = 0; j < 5; ++j) { const int idx = c.lane + 64 * j; if (idx < 272) hist[idx] = 0u; }
#pragma unroll
                for (int g = 0; g < 8; ++g) if (g * 8 < nit) {
#pragma unroll
                    for (int j = 0; j < 8; ++j) {
                        const unsigned d = key[g * 8 + j] - lo;
                        if (d <= width) atomicAdd(&hist[d >> shift], 1u);
                    }
                }
                const unsigned c0 = hist[4 * c.lane], c1 = hist[4 * c.lane + 1], c2 = hist[4 * c.lane + 2], c3 = hist[4 * c.lane + 3];
                const unsigned ls = c0 + c1 + c2 + c3;
                unsigned suf = ls;
#pragma unroll
                for (int o = 1; o < 64; o <<= 1) { const unsigned tv = __shfl_down(suf, o); if (c.lane + o < 64) suf += tv; }
                const unsigned above_lane = suf - ls;
                const bool mine = (suf >= (unsigned)kk) && (above_lane < (unsigned)kk);
                int bstar = 0; unsigned above = 0, cntb = 0;
                if (mine) {
                    unsigned run = above_lane;
                    if (run + c3 >= (unsigned)kk) { bstar = 4 * c.lane + 3; above = run; cntb = c3; }
                    else { run += c3;
                        if (run + c2 >= (unsigned)kk) { bstar = 4 * c.lane + 2; above = run; cntb = c2; }
                        else { run += c2;
                            if (run + c1 >= (unsigned)kk) { bstar = 4 * c.lane + 1; above = run; cntb = c1; }
                            else { run += c1; bstar = 4 * c.lane; above = run; cntb = c0; } } }
                }
                const u64 mm = __ballot(mine);
                const int src = __ffsll((long long)mm) - 1;
                bstar = __shfl(bstar, src); above = __shfl(above, src); cntb = __shfl(cntb, src);
                kk -= (int)above;
                const unsigned nlo = lo + ((unsigned)bstar << shift);
                const unsigned nhi = min(hi, nlo + ((1u << shift) - 1u));
                lo = nlo; hi = nhi; thr = lo;
                if ((int)cntb == kk) break;
                if (shift == 0) {
                    int need = kk;
                    for (int it = 0; it < nit; ++it) {
                        const int i = it * 64 + c.lane;
                        unsigned k = 0u;
                        if (i < n) { const unsigned bits = __float_as_uint(sc[i] + 0.0f); k = bits ^ ((unsigned)((int)bits >> 31) | 0x80000000u); }
                        const bool e = (k == thr);
                        const u64 mk = __ballot(e); const int cn = __popcll(mk);
                        if (need <= cn) {
                            const u64 sel = __ballot(e && (__popcll(mk & ((1ull << c.lane) - 1ull)) == need - 1));
                            cut = it * 64 + (__ffsll((long long)sel) - 1);
                            break;
                        }
                        need -= cn;
                    }
                    break;
                }
            }
        }
        u64* mrow = mask + (size_t)(b * 4096 + qi) * 64;
        u64 myword = 0;
        const bool tie = (cut != 0x7fffffff);
#pragma unroll
        for (int it = 0; it < 64; ++it) {
            u64 wd = 0;
            if (it < nit) {
                const unsigned k = key[it];
                bool sel = (k >= thr);
                if (tie) sel = (k > thr) || (k == thr && (it * 64 + c.lane) <= cut);
                wd = __ballot(sel);
            }
            if (c.lane == it) myword = wd;
        }
        mrow[c.lane] = myword;
    }
    __syncthreads();
}

DI void phase_outproj(const Ctx& c_in, KArgs& a, int l) {
    const Ctx c = fresh_ctx(c_in.lds);
    unsigned char* ws = a.ws;
    const u16* act = (const u16*)(ws + WS_ACT);
    const u16* w = (const u16*)(ws + WS_WOUT) + (size_t)l * 1024 * 1024;
    const float* xin = (l == 0) ? a.in[0] : a.out;
    float* out = a.out;
    int R, C; g2_stage_rc(c.tid * 16, R, C);
    const int nunits = (T_TOK / 256) * 4;
    for (int u = vblock(); u < nunits; u += gridDim.x) {
        const int pm = (u >> 4) * 4 + (u & 3), pn = (u >> 2) & 3;
        G2Ptrs g;
        g.ra = g2_rsrc(act); g.rb = g2_rsrc(w);
        g.va00 = (unsigned)(R * 1024 + C) * 2u; g.va01 = g.va00 + 64 * 2048; g.va10 = g.va00 + 128 * 2048; g.va11 = g.va00 + 192 * 2048;
        g.vb0 = g.va00; g.vb1 = g.va01;
        g.sa = (unsigned)pm * (256u * 2048u); g.sb0 = (unsigned)pn * (256u * 2048u); g.sb1 = g.sb0 + 128u * 2048u;
        __syncthreads();
        gemm256_unit(c, g, 1024, [&](const f32x4 (&acc)[2][2][4][2], int wr, int wc, int fr, int fq) {
#pragma unroll
            for (int ai = 0; ai < 2; ++ai)
#pragma unroll
                for (int m = 0; m < 4; ++m) {
                    const size_t rowoff = (size_t)(pm * 256 + ai * 128 + wr * 64 + m * 16 + fr) * 1024 + pn * 256 + wc * 32 + 4 * fq;
#pragma unroll
                    for (int bj = 0; bj < 2; ++bj)
#pragma unroll
                        for (int n = 0; n < 2; ++n) {
                            const f32x4 xv = *(const f32x4*)(xin + rowoff + bj * 128 + n * 16);
                            *(f32x4*)(out + rowoff + bj * 128 + n * 16) = xv + acc[ai][bj][m][n];
                        }
                }
        });
    }
}

constexpr int RT_LD = 1032;
DI void phase_router(const Ctx& c_in, KArgs& a, int l) {
    const Ctx c = fresh_ctx(c_in.lds);
    unsigned char* ws = a.ws;
    const float* x = a.out;
    const float* g = a.in[16] + l * 1024;
    const float* brg = a.in[18] + l * 4;
    const float* bre = a.in[20] + l * 32;
    const u16* wrh = (const u16*)(ws + WS_WRH) + (size_t)l * 64 * 1024;
    const u16* wrl = (const u16*)(ws + WS_WRL) + (size_t)l * 64 * 1024;
    u16* act = (u16*)(ws + WS_ACT);
    int* cnt = (int*)(ws + WS_CTL);
    int* list = (int*)(ws + WS_LIST);
    float* tokw = (float*)(ws + WS_TOKW);
    u16* HI = (u16*)c.lds;
    u16* LO = HI + 32 * RT_LD;
    float* LG = (float*)(c.lds + 2 * 32 * RT_LD * 2);
    const int l31 = c.lane & 31, h = c.lane >> 5;
    for (int it = blockIdx.x; it < T_TOK / 32; it += gridDim.x) {
        const int t0 = it * 32;
#pragma unroll
        for (int tt = 0; tt < 4; ++tt) {
            const int tl = c.wave * 4 + tt, t = t0 + tl;
            const float* xr = x + (size_t)t * 1024 + c.lane * 4;
            float4 v[4]; float ss = 0.f;
#pragma unroll
            for (int j = 0; j < 4; ++j) { v[j] = *(const float4*)(xr + 256 * j); ss += v[j].x * v[j].x + v[j].y * v[j].y + v[j].z * v[j].z + v[j].w * v[j].w; }
            ss = wsum(ss);
            const float rs = rsqrtf(ss * (1.f / 1024.f) + EPS);
#pragma unroll
            for (int j = 0; j < 4; ++j) {
                const float4 gg = *(const float4*)(g + c.lane * 4 + 256 * j);
                const float h0 = v[j].x * rs * gg.x, h1 = v[j].y * rs * gg.y, h2 = v[j].z * rs * gg.z, h3 = v[j].w * rs * gg.w;
                const u16 b0 = f2bf(h0), b1 = f2bf(h1), b2 = f2bf(h2), b3 = f2bf(h3);
                const uint2 hp = make_uint2((unsigned)b0 | ((unsigned)b1 << 16), (unsigned)b2 | ((unsigned)b3 << 16));
                const uint2 lp = make_uint2(pack2(h0 - bf2f(b0), h1 - bf2f(b1)), pack2(h2 - bf2f(b2), h3 - bf2f(b3)));
                *(uint2*)(act + (size_t)t * 1024 + c.lane * 4 + 256 * j) = hp;
                *(uint2*)(HI + tl * RT_LD + c.lane * 4 + 256 * j) = hp;
                *(uint2*)(LO + tl * RT_LD + c.lane * 4 + 256 * j) = lp;
            }
        }
        __syncthreads();
        {
            const int k0 = c.wave * 128 + h * 8;
            f32x16 acc0 = zero16(), acc1 = zero16();
#pragma unroll
            for (int ks = 0; ks < 8; ++ks) {
                const int k = k0 + ks * 16;
                const bf16x8 ah = *(const bf16x8*)(HI + l31 * RT_LD + k);
                const bf16x8 al = *(const bf16x8*)(LO + l31 * RT_LD + k);
                const bf16x8 bh0 = *(const bf16x8*)(wrh + (size_t)l31 * 1024 + k);
                const bf16x8 bh1 = *(const bf16x8*)(wrh + (size_t)(32 + l31) * 1024 + k);
                const bf16x8 bl0 = *(const bf16x8*)(wrl + (size_t)l31 * 1024 + k);
                const bf16x8 bl1 = *(const bf16x8*)(wrl + (size_t)(32 + l31) * 1024 + k);
                acc0 = MFMA32(ah, bh0, acc0); acc0 = MFMA32(ah, bl0, acc0); acc0 = MFMA32(al, bh0, acc0);
                acc1 = MFMA32(ah, bh1, acc1); acc1 = MFMA32(ah, bl1, acc1); acc1 = MFMA32(al, bh1, acc1);
            }
            __syncthreads();
            float* PART = (float*)c.lds + c.wave * (32 * 37);
#pragma unroll
            for (int r = 0; r < 16; ++r) {
                PART[crow(r, h) * 37 + l31] = acc0[r];
                if (l31 < 4) PART[crow(r, h) * 37 + 32 + l31] = acc1[r];
            }
        }
        __syncthreads();
        for (int i = c.tid; i < 32 * 36; i += NTHR) {
            const int tk = i / 36, e = i % 36;
            float s = 0.f;
#pragma unroll
            for (int w2 = 0; w2 < 8; ++w2) s += ((const float*)c.lds)[w2 * (32 * 37) + tk * 37 + e];
            LG[tk * 65 + e] = s;
        }
        __syncthreads();
        if (c.tid < 32) {
            const int t = t0 + c.tid;
            const float* lg = LG + c.tid * 65;
            float gl[4];
#pragma unroll
            for (int e = 0; e < 4; ++e) gl[e] = lg[e] + brg[e];
            int gi = 0; float gm = gl[0];
#pragma unroll
            for (int e = 1; e < 4; ++e) if (gl[e] > gm) { gm = gl[e]; gi = e; }
            float den = 0.f;
#pragma unroll
            for (int e = 0; e < 4; ++e) den += __expf(gl[e] - gm);
            const float gp = 1.f / den;
            float el[8];
#pragma unroll
            for (int e = 0; e < 8; ++e) el[e] = lg[4 + gi * 8 + e] + bre[gi * 8 + e];
            int i1 = 0; float v1 = el[0];
#pragma unroll
            for (int e = 1; e < 8; ++e) if (el[e] > v1) { v1 = el[e]; i1 = e; }
            int i2 = 0; float v2 = -INFINITY;
#pragma unroll
            for (int e = 0; e < 8; ++e) if (e != i1 && el[e] > v2) { v2 = el[e]; i2 = e; }
            const float ex = __expf(v2 - v1);
            const float w1 = gp / (1.f + ex), w2 = gp * ex / (1.f + ex);
            const int e1 = gi * 8 + i1, e2 = gi * 8 + i2;
            const int s1 = atomicAdd(&cnt[e1 * 2 + 0], 1);
            list[(size_t)(e1 * 2 + 0) * 32768 + s1] = t;
            const int s2 = atomicAdd(&cnt[e2 * 2 + 1], 1);
            list[(size_t)(e2 * 2 + 1) * 32768 + s2] = t;
            tokw[t * 2] = w1; tokw[t * 2 + 1] = w2;
        }
        __syncthreads();
    }
}

DI int moe_setup(const Ctx& c, KArgs& a, int ntn, int kfilter, int* tstart  ) {
    const int* cnt = (const int*)(a.ws + WS_CTL);
    if (c.tid < 64) {
        const int L = c.tid;
        const int n = __hip_atomic_load(&cnt[L], __ATOMIC_RELAXED, __HIP_MEMORY_SCOPE_AGENT);
        const int mine = (kfilter < 0 || (L & 1) == kfilter) ? ((n + 255) >> 8) * ntn : 0;
        int inc = mine;
#pragma unroll
        for (int o = 1; o < 64; o <<= 1) { const int tv = __shfl_up(inc, o); if (L >= o) inc += tv; }
        tstart[L] = inc - mine;
        if (L == 63) tstart[64] = inc;
    }
    __syncthreads();
    return tstart[64];
}

constexpr int MOE_LDS_OFF = G2_LDS_BYTES;
DI void phase_moe_up(const Ctx& c_in, KArgs& a) {
    const Ctx c = fresh_ctx(c_in.lds);
    unsigned char* ws = a.ws;
    const u16* act = (const u16*)(ws + WS_ACT);
    const int* cnt = (const int*)(ws + WS_CTL);
    const int* list = (const int*)(ws + WS_LIST);
    const float* tokw = (const float*)(ws + WS_TOKW);
    u16* hmid = (u16*)(ws + WS_HMID);
    int* tstart = (int*)(c.lds + MOE_LDS_OFF);
    int* tok_s = (int*)(c.lds + MOE_LDS_OFF + 512);
    int R, C; g2_stage_rc(c.tid * 16, R, C);
    const int total = moe_setup(c, a, 2, -1, tstart);
    for (int tile = vblock(); tile < total; tile += gridDim.x) {
        int L = 0;
        for (int j = 0; j < 64; ++j) if (tstart[j + 1] <= tile) L = j + 1;
        const int rel = tile - tstart[L], mi = rel >> 1, nt = rel & 1;
        const int e = L >> 1, kr = L & 1;
        const int n = __hip_atomic_load(&cnt[L], __ATOMIC_RELAXED, __HIP_MEMORY_SCOPE_AGENT);
        __syncthreads();
        if (c.tid < 256) { const int r = mi * 256 + c.tid; tok_s[c.tid] = (r < n) ? list[(size_t)L * 32768 + r] : -1; }
        __syncthreads();
        G2Ptrs g;
        g.ra = g2_rsrc(act); g.rb = g2_rsrc(ws + WS_WG);
        { const int t0 = tok_s[R], t1 = tok_s[R + 64], t2 = tok_s[R + 128], t3 = tok_s[R + 192];
          g.va00 = (unsigned)((t0 < 0 ? 0 : t0) * 1024 + C) * 2u; g.va01 = (unsigned)((t1 < 0 ? 0 : t1) * 1024 + C) * 2u;
          g.va10 = (unsigned)((t2 < 0 ? 0 : t2) * 1024 + C) * 2u; g.va11 = (unsigned)((t3 < 0 ? 0 : t3) * 1024 + C) * 2u; }
        g.vb0 = (unsigned)(R * 1024 + C) * 2u; g.vb1 = g.vb0 + 64 * 2048;
        g.sa = 0u; g.sb0 = (unsigned)(e * 256 + nt * 128) * 2048u; g.sb1 = g.sb0 + (unsigned)(WS_WU - WS_WG);
        gemm256_unit(c, g, 1024, [&](const f32x4 (&acc)[2][2][4][2], int wr, int wc, int fr, int fq) {
#pragma unroll
            for (int ai = 0; ai < 2; ++ai)
#pragma unroll
                for (int m = 0; m < 4; ++m) {
                    const int tk = tok_s[ai * 128 + wr * 64 + m * 16 + fr];
                    if (tk >= 0) {
                        const float wgt = tokw[tk * 2 + kr];
                        u16* dst = hmid + ((size_t)tk * 2 + kr) * 256 + nt * 128 + wc * 32 + 4 * fq;
#pragma unroll
                        for (int n2 = 0; n2 < 2; ++n2) {
                            const f32x4 gv = acc[ai][0][m][n2], uv = acc[ai][1][m][n2];
                            uint2 pk;
                            pk.x = pack2(siluf(gv[0]) * uv[0] * wgt, siluf(gv[1]) * uv[1] * wgt);
                            pk.y = pack2(siluf(gv[2]) * uv[2] * wgt, siluf(gv[3]) * uv[3] * wgt);
                            *(uint2*)(dst + n2 * 16) = pk;
                        }
                    }
                }
        });
    }
}

DI void phase_moe_down(const Ctx& c_in, KArgs& a) {
    const Ctx c = fresh_ctx(c_in.lds);
    unsigned char* ws = a.ws;
    const int* cnt = (const int*)(ws + WS_CTL);
    const int* list = (const int*)(ws + WS_LIST);
    const u16* hmid = (const u16*)(ws + WS_HMID);
    u16* yffn = (u16*)(ws + WS_YFFN);
    int* tstart = (int*)(c.lds + MOE_LDS_OFF);
    int* tok_s = (int*)(c.lds + MOE_LDS_OFF + 512);
    int R, C; g2_stage_rc(c.tid * 16, R, C);
    const int total = moe_setup(c, a, 4, -1, tstart);
    for (int tile = vblock(); tile < total; tile += gridDim.x) {
        int L = 0;
        for (int j = 0; j < 64; ++j) if (tstart[j + 1] <= tile) L = j + 1;
        const int rel = tile - tstart[L], mi = rel >> 2, nt = rel & 3;
        const int e = L >> 1, kr = L & 1;
        const int n = __hip_atomic_load(&cnt[L], __ATOMIC_RELAXED, __HIP_MEMORY_SCOPE_AGENT);
        __syncthreads();
        if (c.tid < 256) { const int r = mi * 256 + c.tid; tok_s[c.tid] = (r < n) ? list[(size_t)L * 32768 + r] : -1; }
        __syncthreads();
        G2Ptrs g;
        g.ra = g2_rsrc(hmid); g.rb = g2_rsrc(ws + WS_WD);
        { const int t0 = tok_s[R], t1 = tok_s[R + 64], t2 = tok_s[R + 128], t3 = tok_s[R + 192];
          g.va00 = (unsigned)(((t0 < 0 ? 0 : t0) * 2 + kr) * 256 + C) * 2u; g.va01 = (unsigned)(((t1 < 0 ? 0 : t1) * 2 + kr) * 256 + C) * 2u;
          g.va10 = (unsigned)(((t2 < 0 ? 0 : t2) * 2 + kr) * 256 + C) * 2u; g.va11 = (unsigned)(((t3 < 0 ? 0 : t3) * 2 + kr) * 256 + C) * 2u; }
        g.vb0 = (unsigned)(R * 256 + C) * 2u; g.vb1 = g.vb0 + 64 * 512;
        g.sa = 0u; g.sb0 = (unsigned)(e * 1024 + nt * 256) * 512u; g.sb1 = g.sb0 + 128u * 512u;
        gemm256_unit(c, g, 256, [&](const f32x4 (&acc)[2][2][4][2], int wr, int wc, int fr, int fq) {
#pragma unroll
            for (int ai = 0; ai < 2; ++ai)
#pragma unroll
                for (int m = 0; m < 4; ++m) {
                    const int tk = tok_s[ai * 128 + wr * 64 + m * 16 + fr];
                    if (tk >= 0) {
                        u16* dst = yffn + ((size_t)tk * 2 + kr) * 1024 + nt * 256 + wc * 32 + 4 * fq;
#pragma unroll
                        for (int bj = 0; bj < 2; ++bj)
#pragma unroll
                            for (int n2 = 0; n2 < 2; ++n2) {
                                const f32x4 v = acc[ai][bj][m][n2];
                                uint2 pk; pk.x = pack2(v[0], v[1]); pk.y = pack2(v[2], v[3]);
                                *(uint2*)(dst + bj * 128 + n2 * 16) = pk;
                            }
                    }
                }
        });
    }
}

DI void phase_final(const Ctx& c_in, KArgs& a) {
    const Ctx c = fresh_ctx(c_in.lds);
    float* x = a.out;
    const float* g = a.in[24];
    for (int it = blockIdx.x; it < T_TOK / 8; it += gridDim.x) {
        const int t = it * 8 + c.wave;
        float* xr = x + (size_t)t * 1024;
        float v[16]; float ss = 0.f;
        const u16* y0 = (const u16*)(a.ws + WS_YFFN) + (size_t)t * 2048;
#pragma unroll
        for (int j = 0; j < 16; ++j) { v[j] = xr[c.lane + 64 * j] + bf2f(y0[c.lane + 64 * j]) + bf2f(y0[1024 + c.lane + 64 * j]); ss += v[j] * v[j]; }
        ss = wsum(ss);
        const float rs = rsqrtf(ss * (1.f / 1024.f) + EPS);
#pragma unroll
        for (int j = 0; j < 16; ++j) xr[c.lane + 64 * j] = v[j] * rs * g[c.lane + 64 * j];
    }
}

#define XB_TMO      128
#define XB_XCNT(j)  (256  + 64 * (j))
#define XB_XSUB(j)  (1280 + 64 * (j))
#define XB_XGEN(j)  (2304 + 64 * (j))
#define XB_TOP      3328
#define XB_TOPGEN   3392
#define XCD_BAR_WORDS 3456
#define XB_SPIN_CAP (1u << 22)
#define LAS __attribute__((address_space(3)))
DI unsigned xb_ld(unsigned* p)              { return __hip_atomic_load(p, __ATOMIC_RELAXED, __HIP_MEMORY_SCOPE_AGENT); }
DI unsigned xb_add(unsigned* p, unsigned v) { return __hip_atomic_fetch_add(p, v, __ATOMIC_RELAXED, __HIP_MEMORY_SCOPE_AGENT); }
DI unsigned xb_xcc_id() { return (unsigned)__builtin_amdgcn_s_getreg((3 << 11) | 20) & 0xFu; }
#define XB_SPIN(cond, bar) do { unsigned _sp = 0; while (cond) { __builtin_amdgcn_s_sleep(1); \
    if ((++_sp & 255u) == 0u) { if (xb_ld(&(bar)[XB_TMO])) break; if (_sp > XB_SPIN_CAP) { atomicAdd(&(bar)[XB_TMO], 1u); break; } } } } while (0)
struct XcdBarrier { unsigned* bar; unsigned x; volatile LAS unsigned* st; };
DI XcdBarrier xcd_barrier_post(unsigned* bar, volatile LAS unsigned* st) {
    XcdBarrier b; b.bar = bar; b.x = xb_xcc_id(); b.st = st;
    if (threadIdx.x == 0) (void)xb_add(&bar[XB_XCNT(b.x)], 1u);
    return b;
}
DI void xcd_barrier_complete(unsigned* bar, unsigned x, unsigned& nloc, unsigned& nx) {
    const unsigned G = gridDim.x * gridDim.y * gridDim.z;
    unsigned sum, cnt, mine, sp = 0u;
    for (;;) {
        sum = 0u; cnt = 0u; mine = 0u;
#pragma unroll
        for (unsigned j = 0; j < 16; ++j) { const unsigned cc = xb_ld(&bar[XB_XCNT(j)]); sum += cc; cnt += (cc > 0u) ? 1u : 0u; mine = (j == x) ? cc : mine; }
        if (sum == G) break;
        __builtin_amdgcn_s_sleep(1);
        if ((++sp & 255u) == 0u) { if (xb_ld(&bar[XB_TMO])) break; if (sp > XB_SPIN_CAP) { atomicAdd(&bar[XB_TMO], 1u); break; } }
    }
    nloc = mine > 0u ? mine : 1u; nx = cnt > 0u ? cnt : 1u;
}
DI void xcd_barrier(const XcdBarrier& b) {
    asm volatile("s_waitcnt vmcnt(0)" ::: "memory");
    __syncthreads();
    if (threadIdx.x == 0) {
        unsigned* bar = b.bar;
        __builtin_amdgcn_s_waitcnt(0);
        unsigned nloc = b.st[0], nx = b.st[1];
        if (nloc == 0u) { xcd_barrier_complete(bar, b.x, nloc, nx); b.st[0] = nloc; b.st[1] = nx; }
        const unsigned old = xb_add(&bar[XB_XSUB(b.x)], 1u);
        const unsigned gen = old / nloc;
        if (old + 1u == (gen + 1u) * nloc) {
            __builtin_amdgcn_fence(__ATOMIC_RELEASE, "agent");
            asm volatile("s_waitcnt vmcnt(0)" ::: "memory");
            const unsigned og = xb_add(&bar[XB_TOP], 1u);
            const unsigned tg = og / nx;
            if (og + 1u == (tg + 1u) * nx) xb_add(&bar[XB_TOPGEN], 1u);
            else XB_SPIN(xb_ld(&bar[XB_TOPGEN]) == tg, bar);
            __builtin_amdgcn_fence(__ATOMIC_ACQUIRE, "agent");
            xb_add(&bar[XB_XGEN(b.x)], 1u);
            asm volatile("s_waitcnt vmcnt(0)" ::: "memory");
        } else {
            XB_SPIN(xb_ld(&bar[XB_XGEN(b.x)]) == gen, bar);
            __builtin_amdgcn_fence(__ATOMIC_ACQUIRE, "agent");
            asm volatile("s_waitcnt vmcnt(0)" ::: "memory");
        }
    }
    __syncthreads();
}

template <int SP>
DI void run_phase(const Ctx& c, KArgs& a, int l) {
    if constexpr (SP == 11) phase_prep(c, a);
    else if constexpr (SP == 12) phase_final(c, a);
    else if constexpr (SP == 0) phase_norm_in(c, a, l);
    else if constexpr (SP == 1) phase_inproj(c, a, l);
    else if constexpr (SP == 2) {
        const int n_ssd = 256, n_q = 128 * 3, n_kv = 128 * 4, n_tok = T_TOK / 8;
        for (int it = blockIdx.x; it < n_ssd + n_q + n_kv + n_tok; it += gridDim.x) {
            if (it < n_ssd) ssd_state_item(c, a, l, it);
            else if (it < n_ssd + n_q) mla_up_item(c, a, l, 0, it - n_ssd);
            else if (it < n_ssd + n_q + n_kv) mla_up_item(c, a, l, 1, it - n_ssd - n_q);
            else token_post_item(c, a, l, it - n_ssd - n_q - n_kv);
        }
    }
    else if constexpr (SP == 3) { for (int it = blockIdx.x; it < 512; it += gridDim.x) ssd_scan_item(c, a, it); }
    else if constexpr (SP == 4) {
        int* ctr = (int*)(a.ws + WS_CTL) + 128 + l;
        volatile int* s_item = (volatile int*)(c.lds + LDS_BYTES - 32);
        for (;;) {
            __syncthreads();
            if (threadIdx.x == 0) *s_item = atomicAdd(ctr, 1);
            __syncthreads();
            const int it = *s_item;
            if (it >= 1024 + 512 + 256) break;
            if (it < 1024) {
                const int j = 15 - (it >> 6), r = it & 63;
                if (r >= 8 && r < 40) { const int rem = r - 8; attn_item<96, 0>(c, a, rem >> 2, rem & 3, j); }
                else {
                    const int sub = (r < 8) ? 3 : 2 - ((r - 40) >> 3);
                    const int b = r & 7, qb = 4 * j + sub;
                    for (int g8 = 0; g8 < 8; ++g8) dsa_index_item(c, a, b, qb * 64 + g8 * 8);
                    asm volatile("s_waitcnt vmcnt(0)" ::: "memory");
                    __syncthreads();
                    attn_item<64, 2>(c, a, b, 0, qb);
                }
            } else if (it < 1536) { const int i2 = it - 1024; attn_item<64, 1>(c, a, (i2 & 31) >> 2, i2 & 3, 15 - (i2 >> 5)); }
            else ssd_out_item(c, a, l, it - 1536);
        }
    }
    else if constexpr (SP == 5) phase_outproj(c, a, l);
    else if constexpr (SP == 6) phase_router(c, a, l);
    else if constexpr (SP == 7) phase_moe_up(c, a);
    else if constexpr (SP == 8) phase_moe_down(c, a);
}

#ifndef ONE_LAUNCH
#define ONE_LAUNCH 1
#endif

#if ONE_LAUNCH
__global__ void __launch_bounds__(NTHR) mega(Args a_unused) {
    extern __shared__ __attribute__((aligned(16))) unsigned char lds[];
    cg::grid_group grid = cg::this_grid();
    Ctx c; c.tid = threadIdx.x; c.lane = c.tid & 63; c.wave = 0; c.lds = lds;
    volatile LAS unsigned* st = (volatile LAS unsigned*)(lds + LDS_BYTES - 16);
    if (threadIdx.x == 0) { st[0] = 0u; st[1] = 0u; }
    __syncthreads();
    XcdBarrier bar = xcd_barrier_post((unsigned*)(a_unused.ws + WS_BAR), st);
#define MEGA_PHASE(SPN, L) do { KArgs* kp_ = (KArgs*)__builtin_amdgcn_kernarg_segment_ptr(); asm volatile("" : "+s"(kp_)); run_phase<SPN>(c, *kp_, (L)); } while (0)
    MEGA_PHASE(11, 0);
    grid.sync();
#pragma unroll 1
    for (int l = 0; l < DEPTH; ++l) {
        if (l > 0) xcd_barrier(bar);
        MEGA_PHASE(0, l); xcd_barrier(bar);
        MEGA_PHASE(1, l); xcd_barrier(bar);
        MEGA_PHASE(2, l); xcd_barrier(bar);
        MEGA_PHASE(3, l); xcd_barrier(bar);
        MEGA_PHASE(4, l); xcd_barrier(bar);
        MEGA_PHASE(5, l); xcd_barrier(bar);
        MEGA_PHASE(6, l); xcd_barrier(bar);
        MEGA_PHASE(7, l); xcd_barrier(bar);
        MEGA_PHASE(8, l);
    }
    xcd_barrier(bar);
    MEGA_PHASE(12, 0);
}
#else
template <int SP>
__global__ void __launch_bounds__(NTHR) kphase(Args a, int l) {
    extern __shared__ __attribute__((aligned(16))) unsigned char lds[];
    Ctx c; c.tid = threadIdx.x; c.lane = c.tid & 63; c.wave = __builtin_amdgcn_readfirstlane(c.tid >> 6); c.lds = lds;
    KArgs* kp = (KArgs*)__builtin_amdgcn_kernarg_segment_ptr();
    run_phase<SP>(c, *kp, l);
}
template <int SP>
static void launch_phase(const Args& a, int l, int grid, hipStream_t stream) {
    static bool attr_set = false;
    if (!attr_set) { (void)hipFuncSetAttribute((const void*)kphase<SP>, hipFuncAttributeMaxDynamicSharedMemorySize, LDS_BYTES); attr_set = true; }
    hipLaunchKernelGGL(kphase<SP>, dim3(grid), dim3(NTHR), LDS_BYTES, stream, a, l);
}
#endif

extern "C" void kernel_launch(void* const* d_in, const int* in_sizes, int n_in, void* d_out, int out_size, void* d_ws, size_t ws_size, hipStream_t stream) {
    static int grid = 0;
    if (grid == 0) {
        if (n_in != 25 || ws_size < WS_END) { fprintf(stderr, "kernel_launch: unexpected inputs (n_in %d, ws %zu, need %zu)\n", n_in, ws_size, (size_t)WS_END); grid = -1; return; }
        int dev = 0, cus = 0;
        (void)hipGetDevice(&dev);
        (void)hipDeviceGetAttribute(&cus, hipDeviceAttributeMultiprocessorCount, dev);
        if (cus <= 0) cus = 256;
#if ONE_LAUNCH
        int per_cu = 0;
        if (hipFuncSetAttribute((const void*)mega, hipFuncAttributeMaxDynamicSharedMemorySize, LDS_BYTES) != hipSuccess) { fprintf(stderr, "kernel_launch: hipFuncSetAttribute failed\n"); grid = -1; return; }
        if (hipOccupancyMaxActiveBlocksPerMultiprocessor(&per_cu, (const void*)mega, NTHR, LDS_BYTES) != hipSuccess || per_cu < 1) { fprintf(stderr, "kernel_launch: occupancy query says %d blocks per CU\n", per_cu); (void)hipGetLastError(); grid = -1; return; }
        grid = cus;
#else
        grid = cus;
#endif
    }
    if (grid < 0) return;
    Args a{};
    for (int i = 0; i < 25; ++i) a.in[i] = (const float*)d_in[i];
    a.out = (float*)d_out; a.ws = (unsigned char*)d_ws;
    for (int i = 0; i < 8; ++i) a.inv16[i] = (float)pow(500000.0, -(double)i / 8.0);
    for (int i = 0; i < 16; ++i) a.inv32[i] = (float)pow(500000.0, -(double)i / 16.0);
    a.ph_lo = 0; a.ph_hi = 0;
#if ONE_LAUNCH
    (void)hipMemsetAsync((unsigned char*)d_ws + WS_CTL, 0, WS_CTL_BYTES, stream);
    void* kargs[] = { &a };
    hipError_t e = hipLaunchCooperativeKernel((const void*)mega, dim3(grid), dim3(NTHR), kargs, LDS_BYTES, stream);
    if (e != hipSuccess) fprintf(stderr, "kernel_launch: cooperative launch failed: %s (grid %d)\n", hipGetErrorString(e), grid);
#else
    launch_phase<11>(a, 0, grid, stream);
    for (int l = 0; l < DEPTH; ++l) {
        launch_phase<0>(a, l, grid, stream);
        launch_phase<1>(a, l, grid, stream);
        launch_phase<2>(a, l, grid, stream);
        launch_phase<3>(a, l, grid, stream);
        launch_phase<4>(a, l, grid, stream);
        launch_phase<5>(a, l, grid, stream);
        launch_phase<6>(a, l, grid, stream);
        launch_phase<7>(a, l, grid, stream);
        launch_phase<8>(a, l, grid, stream);
    }
    launch_phase<12>(a, 0, grid, stream);
#endif
}
```

```cpp
#include <hip/hip_runtime.h>
#include <hip/hip_cooperative_groups.h>
#include <cstdio>
#include <cmath>
#include <cstdint>


namespace cg = cooperative_groups;

typedef __attribute__((ext_vector_type(8))) short bf16x8;
typedef __attribute__((ext_vector_type(4))) short bf16x4;
typedef __attribute__((ext_vector_type(16))) float f32x16;
typedef unsigned short u16;
typedef unsigned long long u64;

#define DI __device__ __forceinline__
#define MFMA32(a, b, c) __builtin_amdgcn_mfma_f32_32x32x16_bf16((a), (b), (c), 0, 0, 0)

constexpr int T_TOK = 32768, SEQ = 4096, NB = 8, DM = 1024, DEPTH = 2;
constexpr int NREF = 3184;
constexpr int NPAD = 3328;
constexpr int LDP = 2848;
constexpr int PC_Z = 0, PC_XBC = 256, PC_DSAQ = 1024, PC_DSAK = 1280, PC_IDXQ = 1344, PC_IDXK = 1856,
              PC_CQ = 1920, PC_CKV = 2176, PC_KR = 2304, PC_FOXQ = 2336, PC_FOXK = 2592;
constexpr int NC_DSAV = 2848, NC_FOXV = 2912, NC_SMALL = 3168;
constexpr float EPS = 1e-6f;
constexpr float LOG2E = 1.4426950408889634f;
constexpr int NTHR = 512;
constexpr int LDS_BYTES = 147456;

constexpr size_t al256(size_t x) { return (x + 255) & ~(size_t)255; }
constexpr size_t WS_CTL   = 0;
constexpr size_t WS_BAR   = 4096;
constexpr size_t WS_CTL_BYTES = 32768;
constexpr size_t WS_WIN   = 32768;
constexpr size_t WS_WUQ   = WS_WIN  + (size_t)2 * NPAD * 1024 * 2;
constexpr size_t WS_WUKV  = WS_WUQ  + (size_t)2 * 384 * 256 * 2;
constexpr size_t WS_WOUT  = WS_WUKV + (size_t)2 * 512 * 128 * 2;
constexpr size_t WS_WG    = WS_WOUT + (size_t)2 * 1024 * 1024 * 2;
constexpr size_t WS_WU    = WS_WG   + (size_t)32 * 256 * 1024 * 2;
constexpr size_t WS_WD    = WS_WU   + (size_t)32 * 256 * 1024 * 2;
constexpr size_t WS_TRIG  = WS_WD   + (size_t)32 * 256 * 1024 * 2;
constexpr size_t WS_ACT   = WS_TRIG + (size_t)T_TOK * 48 * 4;
constexpr size_t WS_PROJ  = WS_ACT  + (size_t)T_TOK * 1024 * 2;
constexpr size_t WS_SMALL = WS_PROJ + (size_t)T_TOK * LDP * 2;
constexpr size_t WS_MLAQ  = WS_SMALL + (size_t)T_TOK * 16 * 4;
constexpr size_t WS_MLAK  = WS_MLAQ + (size_t)T_TOK * 384 * 2;
constexpr size_t WS_MLAVT = WS_MLAK + (size_t)T_TOK * 384 * 2;
constexpr size_t WS_DSAVT = WS_MLAVT + (size_t)T_TOK * 256 * 2;
constexpr size_t WS_FOXVT = WS_DSAVT + (size_t)T_TOK * 64 * 2;
constexpr size_t WS_FLOG  = WS_FOXVT + (size_t)T_TOK * 256 * 2;
constexpr size_t WS_CS    = WS_FLOG + (size_t)T_TOK * 4 * 4;
constexpr size_t WS_CDEC  = WS_CS   + (size_t)8 * 32 * 4 * 64 * 128 * 4;
constexpr size_t WS_MASK  = WS_CDEC + 4096;
constexpr size_t WS_TOKW  = WS_MASK + (size_t)T_TOK * 64 * 8;
constexpr size_t WS_WRH   = WS_TOKW + (size_t)T_TOK * 2 * 4;
constexpr size_t WS_WRL   = WS_WRH + (size_t)2 * 64 * 1024 * 2;
constexpr size_t WS_END   = WS_WRL + (size_t)2 * 64 * 1024 * 2;
constexpr size_t WS_LIST  = WS_PROJ;
constexpr size_t WS_HMID  = WS_PROJ + (size_t)64 * 32768 * 4;
constexpr size_t WS_YFFN  = WS_HMID + (size_t)T_TOK * 512 * 2;
static_assert(WS_YFFN + (size_t)T_TOK * 2048 * 2 <= WS_SMALL, "aliases must fit in PROJ");
static_assert(WS_END <= (size_t)512 * 1024 * 1024, "workspace budget");

struct Args {
    const float* in[25];
    float* out;
    unsigned char* ws;
    float inv16[8];
    float inv32[16];
    int ph_lo, ph_hi;
};

typedef const __attribute__((address_space(4))) Args KArgs;
struct Ctx { int tid, lane, wave; unsigned char* lds; };
__device__ __forceinline__ Ctx fresh_ctx(unsigned char* lds) {
    int t = threadIdx.x; asm volatile("" : "+v"(t));
    Ctx c; c.tid = t; c.lane = t & 63; c.wave = __builtin_amdgcn_readfirstlane(t >> 6); c.lds = lds; return c;
}

typedef __attribute__((ext_vector_type(2))) float f32x2;
typedef __attribute__((ext_vector_type(2))) __bf16 bf16x2_t;
DI u16 f2bf(float x) { return __builtin_bit_cast(u16, (__bf16)x); }
DI float bf2f(u16 h) { return __uint_as_float(((unsigned)h) << 16); }
DI unsigned pack2(float a, float b) { f32x2 v = {a, b}; return __builtin_bit_cast(unsigned, __builtin_convertvector(v, bf16x2_t)); }
DI float ex2(float x) { return __builtin_amdgcn_exp2f(x); }
DI float max3f(float a, float b, float c) { float r; asm("v_max3_f32 %0, %1, %2, %3" : "=v"(r) : "v"(a), "v"(b), "v"(c)); return r; }
DI float wsum(float v) { for (int o = 32; o >= 1; o >>= 1) v += __shfl_xor(v, o); return v; }
DI float wmaxf(float v) { for (int o = 32; o >= 1; o >>= 1) v = fmaxf(v, __shfl_xor(v, o)); return v; }
DI float wminf(float v) { for (int o = 32; o >= 1; o >>= 1) v = fminf(v, __shfl_xor(v, o)); return v; }
DI float siluf(float x) { return x / (1.f + __expf(-x)); }
DI float softplusf(float x) { return fmaxf(x, 0.f) + log1pf(__expf(-fabsf(x))); }
DI int crow(int reg, int h) { return (reg & 3) + 8 * (reg >> 2) + 4 * h; }
DI bf16x8 pack8(const f32x16& x, int s) {
    uint4 p;
    p.x = pack2(x[8 * s + 0], x[8 * s + 1]); p.y = pack2(x[8 * s + 2], x[8 * s + 3]);
    p.z = pack2(x[8 * s + 4], x[8 * s + 5]); p.w = pack2(x[8 * s + 6], x[8 * s + 7]);
    return __builtin_bit_cast(bf16x8, p);
}
DI f32x16 zero16() { f32x16 z; for (int i = 0; i < 16; ++i) z[i] = 0.f; return z; }

DI int ref_col(int n) {
    if (n < 1024) return n;
    if (n < 1280) return n - 1024 + 1028;
    if (n < 1344) return n - 1280 + 1284;
    if (n < 1856) return n - 1344 + 1412;
    if (n < 1920) return n - 1856 + 1924;
    if (n < 2176) return n - 1920 + 1996;
    if (n < 2304) return n - 2176 + 2252;
    if (n < 2336) return n - 2304 + 2380;
    if (n < 2592) return n - 2336 + 2412;
    if (n < 2848) return n - 2592 + 2668;
    if (n < 2912) return n - 2848 + 1348;
    if (n < 3168) return n - 2912 + 2924;
    if (n < 3172) return n - 3168 + 1024;
    if (n < 3180) return n - 3172 + 1988;
    if (n < 3184) return n - 3180 + 3180;
    return -1;
}

DI int bid() { int b = blockIdx.x; asm volatile("" : "+s"(b)); return b; }
DI int vblock() { const int G = gridDim.x, bx = bid(); return (G % 8 == 0) ? (bx % 8) * (G / 8) + bx / 8 : bx; }

constexpr int G_LDT = 72;
constexpr int G_AEL = 256 * G_LDT, G_BEL = 128 * G_LDT, G_STEL = G_AEL + G_BEL;
constexpr int G_LDS_BYTES = 2 * G_STEL * 2;

struct GP { const u16 *a0, *a1, *a2, *a3, *b0, *b1; };

template <bool PAIRED>
DI void gemm_core(const Ctx& c, int K, const GP& gp, f32x16 (&acc)[2][2]) {
    u16* S = (u16*)c.lds;
    const int r8 = c.tid >> 3, kc = c.tid & 7;
    const int wm = c.wave & 3, wn = c.wave >> 2, l31 = c.lane & 31, h = c.lane >> 5;
    const int nb0 = PAIRED ? wn * 32 : wn * 64, nb1 = PAIRED ? 64 + wn * 32 : wn * 64 + 32;
    uint4 ra0, ra1, ra2, ra3, rb0, rb1;
    uint4 sa0, sa1, sa2, sa3, sb0, sb1;
    const int nk = K >> 6;
#define G_LOAD(P, KOFF) do { \
        P##a0 = *(const uint4*)(gp.a0 + (KOFF) + kc * 8); P##a1 = *(const uint4*)(gp.a1 + (KOFF) + kc * 8); \
        P##a2 = *(const uint4*)(gp.a2 + (KOFF) + kc * 8); P##a3 = *(const uint4*)(gp.a3 + (KOFF) + kc * 8); \
        P##b0 = *(const uint4*)(gp.b0 + (KOFF) + kc * 8); P##b1 = *(const uint4*)(gp.b1 + (KOFF) + kc * 8); } while (0)
#define G_STORE(P, SP) do { u16* sp_ = (SP); \
        *(uint4*)(sp_ + (r8) * G_LDT + kc * 8) = P##a0; *(uint4*)(sp_ + (r8 + 64) * G_LDT + kc * 8) = P##a1; \
        *(uint4*)(sp_ + (r8 + 128) * G_LDT + kc * 8) = P##a2; *(uint4*)(sp_ + (r8 + 192) * G_LDT + kc * 8) = P##a3; \
        *(uint4*)(sp_ + G_AEL + (r8) * G_LDT + kc * 8) = P##b0; *(uint4*)(sp_ + G_AEL + (r8 + 64) * G_LDT + kc * 8) = P##b1; } while (0)
#define G_COMPUTE_KS(ST, KS0, KS1) do { \
        const u16* As = S + (ST) * G_STEL; const u16* Bs = As + G_AEL; \
        _Pragma("unroll") for (int ks = (KS0); ks < (KS1); ++ks) { \
            const bf16x8 a0 = *(const bf16x8*)(As + (wm * 64 + l31) * G_LDT + ks * 16 + h * 8); \
            const bf16x8 a1 = *(const bf16x8*)(As + (wm * 64 + 32 + l31) * G_LDT + ks * 16 + h * 8); \
            const bf16x8 b0 = *(const bf16x8*)(Bs + (nb0 + l31) * G_LDT + ks * 16 + h * 8); \
            const bf16x8 b1 = *(const bf16x8*)(Bs + (nb1 + l31) * G_LDT + ks * 16 + h * 8); \
            acc[0][0] = MFMA32(a0, b0, acc[0][0]); acc[0][1] = MFMA32(a0, b1, acc[0][1]); \
            acc[1][0] = MFMA32(a1, b0, acc[1][0]); acc[1][1] = MFMA32(a1, b1, acc[1][1]); } } while (0)
    G_LOAD(r, 0);
    G_STORE(r, S);
    if (nk > 1) G_LOAD(r, 64);
    __syncthreads();
    for (int kt = 0; kt < nk; kt += 2) {
        if (kt + 2 < nk) G_LOAD(s, (kt + 2) * 64);
        G_COMPUTE_KS(0, 0, 1);
        if (kt + 1 < nk) G_STORE(r, S + G_STEL);
        G_COMPUTE_KS(0, 1, 4);
        __syncthreads();
        if (kt + 1 >= nk) break;
        if (kt + 3 < nk) G_LOAD(r, (kt + 3) * 64);
        G_COMPUTE_KS(1, 0, 1);
        if (kt + 2 < nk) G_STORE(s, S);
        G_COMPUTE_KS(1, 1, 4);
        __syncthreads();
    }
#undef G_LOAD
#undef G_STORE
#undef G_COMPUTE_KS
}

typedef __attribute__((ext_vector_type(4))) float f32x4;
#define LAS3 __attribute__((address_space(3)))
constexpr int G2_HTB = 128 * 64 * 2;
constexpr int G2_LDS_BYTES = 8 * G2_HTB;
DI int g2_lds_byte(int r, int cc0) { const int st = (r >> 4) * 2 + (cc0 >> 5), rr = r & 15, cc = cc0 & 31, ob = rr * 64 + cc * 2; return st * 1024 + (ob ^ (((ob >> 9) & 1) << 5)); }
DI void g2_stage_rc(int b, int& R, int& C) { const int st = b / 1024, sb = b % 1024, swz = sb ^ (((sb >> 9) & 1) << 5); R = (st >> 1) * 16 + swz / 64; C = (st & 1) * 32 + (swz % 64) / 2; }

struct G2Ptrs { __amdgpu_buffer_rsrc_t ra, rb; unsigned va00, va01, va10, va11, vb0, vb1; unsigned sa, sb0, sb1; };
DI __amdgpu_buffer_rsrc_t g2_rsrc(const void* p) { return __builtin_amdgcn_make_buffer_rsrc((void*)p, 0, 0x7ffffff0, 0x00020000); }

template <class EPI>
DI void gemm256_unit(const Ctx& c, const G2Ptrs& g, int K, EPI&& epi) {
    LAS3 unsigned char* lds = (LAS3 unsigned char*)c.lds;
    const int wid = c.wave, lane = c.lane, wr = wid >> 2, wc = wid & 3, fr = lane & 15, fq = lane >> 4;
    const unsigned ldsw = (unsigned)wid * 1024u;
    const int aoff = g2_lds_byte(wr * 64 + fr, fq * 8), boff = g2_lds_byte(wc * 32 + fr, fq * 8);
#define G2_SA(b, h) (((b) * 2 + (h)) * G2_HTB)
#define G2_SB(b, h) ((4 + (b) * 2 + (h)) * G2_HTB)
#define G2_STAGE(bufoff, rs, v0, v1, so) do { \
        __builtin_amdgcn_raw_ptr_buffer_load_lds((rs), (LAS3 unsigned*)(lds + (bufoff) + ldsw), 16, (v0), (so), 0, 0); \
        __builtin_amdgcn_raw_ptr_buffer_load_lds((rs), (LAS3 unsigned*)(lds + (bufoff) + ldsw + 8192), 16, (v1), (so), 0, 0); } while (0)
#define G2_STA0(b, kt) G2_STAGE(G2_SA(b, 0), g.ra, g.va00, g.va01, g.sa + (unsigned)(kt) * 128u)
#define G2_STA1(b, kt) G2_STAGE(G2_SA(b, 1), g.ra, g.va10, g.va11, g.sa + (unsigned)(kt) * 128u)
#define G2_STB0(b, kt) G2_STAGE(G2_SB(b, 0), g.rb, g.vb0, g.vb1, g.sb0 + (unsigned)(kt) * 128u)
#define G2_STB1(b, kt) G2_STAGE(G2_SB(b, 1), g.rb, g.vb0, g.vb1, g.sb1 + (unsigned)(kt) * 128u)
#define G2_LDA(dst, b, h) do { _Pragma("unroll") for (int m = 0; m < 4; ++m) _Pragma("unroll") for (int k = 0; k < 2; ++k) dst[m][k] = *(const LAS3 bf16x8*)(lds + G2_SA(b, h) + aoff + m * 2048 + k * 1024); } while (0)
#define G2_LDB(dst, b, h) do { _Pragma("unroll") for (int n = 0; n < 2; ++n) _Pragma("unroll") for (int k = 0; k < 2; ++k) dst[n][k] = *(const LAS3 bf16x8*)(lds + G2_SB(b, h) + boff + n * 2048 + k * 1024); } while (0)
#define G2_MMA(ai, bj, At_, Bt_) do { __builtin_amdgcn_s_setprio(1); \
        _Pragma("unroll") for (int m = 0; m < 4; ++m) _Pragma("unroll") for (int n = 0; n < 2; ++n) _Pragma("unroll") for (int k = 0; k < 2; ++k) \
            acc[ai][bj][m][n] = __builtin_amdgcn_mfma_f32_16x16x32_bf16(Bt_[n][k], At_[m][k], acc[ai][bj][m][n], 0, 0, 0); \
        __builtin_amdgcn_s_setprio(0); } while (0)
#define G2_WAIT_V(n) asm volatile("s_waitcnt vmcnt(" #n ")" ::: "memory")
#define G2_WAIT_L(n) asm volatile("s_waitcnt lgkmcnt(" #n ")" ::: "memory")
#define G2_BAR __builtin_amdgcn_s_barrier()
#define G2_SCHED __builtin_amdgcn_sched_barrier(0)
    f32x4 acc[2][2][4][2];
#pragma unroll
    for (int i0 = 0; i0 < 2; ++i0)
#pragma unroll
        for (int i1 = 0; i1 < 2; ++i1)
#pragma unroll
            for (int i2 = 0; i2 < 4; ++i2)
#pragma unroll
                for (int i3 = 0; i3 < 2; ++i3) acc[i0][i1][i2][i3] = (f32x4){0.f, 0.f, 0.f, 0.f};
    bf16x8 At[4][2], B0[2][2], B1[2][2];
    int nt = K / 64; asm volatile("" : "+s"(nt));
    G2_STB0(0, 0); G2_STA0(0, 0); G2_STB1(0, 0); G2_STA1(0, 0);
    if (wr == 1) G2_BAR;
    G2_WAIT_V(4); G2_BAR;
    G2_STB0(1, 1); G2_STA0(1, 1); G2_STB1(1, 1);
    G2_WAIT_V(6); G2_BAR;
    for (int t = 0; t < nt - 2; t += 2) {
        G2_LDB(B0, 0, 0); G2_SCHED; G2_LDA(At, 0, 0); G2_STA1(1, t + 1);
        G2_WAIT_L(8); G2_BAR; G2_WAIT_L(0); G2_MMA(0, 0, At, B0); G2_BAR; G2_SCHED;
        G2_LDB(B1, 0, 1); G2_STB0(0, t + 2);
        G2_BAR; G2_WAIT_L(0); G2_MMA(0, 1, At, B1); G2_BAR;
        G2_LDA(At, 0, 1); G2_STA0(0, t + 2);
        G2_BAR; G2_WAIT_L(0); G2_MMA(1, 0, At, B0); G2_BAR; G2_SCHED;
        G2_STB1(0, t + 2);
        G2_WAIT_V(6); G2_BAR; G2_MMA(1, 1, At, B1); G2_BAR;
        G2_LDB(B0, 1, 0); G2_SCHED; G2_LDA(At, 1, 0); G2_STA1(0, t + 2);
        G2_WAIT_L(8); G2_BAR; G2_WAIT_L(0); G2_MMA(0, 0, At, B0); G2_BAR; G2_SCHED;
        G2_LDB(B1, 1, 1); G2_STB0(1, t + 3);
        G2_BAR; G2_WAIT_L(0); G2_MMA(0, 1, At, B1); G2_BAR;
        G2_LDA(At, 1, 1); G2_STA0(1, t + 3);
        G2_BAR; G2_WAIT_L(0); G2_MMA(1, 0, At, B0); G2_BAR; G2_SCHED;
        G2_STB1(1, t + 3);
        G2_WAIT_V(6); G2_BAR; G2_MMA(1, 1, At, B1); G2_BAR;
    }
    { G2_LDB(B0, 0, 0); G2_LDA(At, 0, 0); G2_STA1(1, nt - 1);
      G2_BAR; G2_WAIT_L(0); G2_MMA(0, 0, At, B0); G2_BAR;
      G2_LDB(B1, 0, 1); G2_BAR; G2_WAIT_L(0); G2_MMA(0, 1, At, B1); G2_BAR;
      G2_LDA(At, 0, 1); G2_WAIT_V(4); G2_BAR; G2_WAIT_L(0); G2_MMA(1, 0, At, B0); G2_MMA(1, 1, At, B1); G2_BAR; }
    { G2_LDB(B0, 1, 0); G2_LDA(At, 1, 0); G2_WAIT_V(2); G2_BAR; G2_WAIT_L(0); G2_MMA(0, 0, At, B0); G2_BAR;
      G2_LDB(B1, 1, 1); G2_WAIT_V(0); G2_BAR; G2_WAIT_L(0); G2_MMA(0, 1, At, B1); G2_BAR;
      G2_LDA(At, 1, 1); G2_BAR; G2_WAIT_L(0); G2_MMA(1, 0, At, B0); G2_MMA(1, 1, At, B1); G2_BAR; }
    if (wr == 0) G2_BAR;
    { int ln_ = threadIdx.x & 63; asm volatile("" : "+v"(ln_));
      epi(acc, wr, wc, ln_ & 15, ln_ >> 4); }
#undef G2_SA
#undef G2_SB
#undef G2_STAGE
#undef G2_STA0
#undef G2_STA1
#undef G2_STB0
#undef G2_STB1
#undef G2_LDA
#undef G2_LDB
#undef G2_MMA
#undef G2_WAIT_V
#undef G2_WAIT_L
#undef G2_BAR
#undef G2_SCHED
}

DI void xpose_tile(const Ctx& c, const float* in, int ld_in, int k0, int n0, int colmode, const float* kscale, u16* out, int ld_out) {
    float* tile = (float*)c.lds;
    if (!colmode) {
        const int j4 = (c.tid & 15) * 4, r0 = c.tid >> 4;
#pragma unroll
        for (int rr = 0; rr < 2; ++rr) {
            const int kk = r0 + 32 * rr;
            float4 v = *(const float4*)(in + (size_t)(k0 + kk) * ld_in + n0 + j4);
            if (kscale) { const float s = kscale[k0 + kk]; v.x *= s; v.y *= s; v.z *= s; v.w *= s; }
            *(float4*)(tile + kk * 68 + j4) = v;
        }
    } else {
        const int j = c.tid & 63, r0 = c.tid >> 6;
        const int rc = ref_col(n0 + j);
#pragma unroll
        for (int rr = 0; rr < 8; ++rr) {
            const int kk = r0 + 8 * rr;
            tile[kk * 68 + j] = (rc >= 0) ? in[(size_t)(k0 + kk) * ld_in + rc] : 0.f;
        }
    }
    __syncthreads();
    {
        const int jj = c.tid >> 3, k8 = (c.tid & 7) * 8;
        uint4 pk;
        pk.x = pack2(tile[(k8 + 0) * 68 + jj], tile[(k8 + 1) * 68 + jj]);
        pk.y = pack2(tile[(k8 + 2) * 68 + jj], tile[(k8 + 3) * 68 + jj]);
        pk.z = pack2(tile[(k8 + 4) * 68 + jj], tile[(k8 + 5) * 68 + jj]);
        pk.w = pack2(tile[(k8 + 6) * 68 + jj], tile[(k8 + 7) * 68 + jj]);
        *(uint4*)(out + (size_t)(n0 + jj) * ld_out + k0 + k8) = pk;
    }
    __syncthreads();
}

DI void phase_prep(const Ctx& c_in, KArgs& a) {
    const Ctx c = fresh_ctx(c_in.lds);
    unsigned char* ws = a.ws;
    const int n_win = 2 * 52 * 16;
    const int n_wuq = 2 * 6 * 4;
    const int n_wukv = 2 * 8 * 2;
    const int n_wout = 2 * 16 * 16;
    const int n_trig = T_TOK * 24 / NTHR;
    const int n_wr = 2 * 64 * 1024 / NTHR;
    const int total = n_win + n_wuq + n_wukv + n_wout + n_trig + n_wr;
    for (int it = bid(); it < total; it += gridDim.x) {
        int i = it;
        if (i < n_win) {
            const int l = i / 832, r = i % 832, nt = r / 16, kt = r % 16;
            xpose_tile(c, a.in[3] + (size_t)l * 1024 * NREF, NREF, kt * 64, nt * 64, 1, nullptr, (u16*)(ws + WS_WIN) + (size_t)l * NPAD * 1024, 1024);
            continue;
        }
        i -= n_win;
        if (i < n_wuq) {
            const int l = i / 24, r = i % 24, nt = r / 4, kt = r % 4;
            xpose_tile(c, a.in[11] + (size_t)l * 256 * 384, 384, kt * 64, nt * 64, 0, a.in[10] + l * 256, (u16*)(ws + WS_WUQ) + (size_t)l * 384 * 256, 256);
            continue;
        }
        i -= n_wuq;
        if (i < n_wukv) {
            const int l = i / 16, r = i % 16, nt = r / 2, kt = r % 2;
            xpose_tile(c, a.in[13] + (size_t)l * 128 * 512, 512, kt * 64, nt * 64, 0, a.in[12] + l * 128, (u16*)(ws + WS_WUKV) + (size_t)l * 512 * 128, 128);
            continue;
        }
        i -= n_wukv;
        if (i < n_wout) {
            const int l = i / 256, r = i % 256, nt = r / 16, kt = r % 16;
            xpose_tile(c, a.in[15] + (size_t)l * 1024 * 1024, 1024, kt * 64, nt * 64, 0, nullptr, (u16*)(ws + WS_WOUT) + (size_t)l * 1024 * 1024, 1024);
            continue;
        }
        i -= n_wout;
        if (i >= n_trig) {
            const int e = (i - n_trig) * NTHR + c.tid;
            const int l = e >> 16, n = (e >> 10) & 63, k = e & 1023;
            float v = 0.f;
            if (n < 4) v = a.in[17][((size_t)l * 1024 + k) * 4 + n];
            else if (n < 36) v = a.in[19][((size_t)l * 1024 + k) * 32 + (n - 4)];
            const u16 hi = f2bf(v);
            ((u16*)(ws + WS_WRH))[e] = hi;
            ((u16*)(ws + WS_WRL))[e] = f2bf(v - bf2f(hi));
            continue;
        }
        {
            const int e = i * NTHR + c.tid;
            const int t = e / 24, j = e % 24;
            const int pos = ((const int*)a.in[1])[t];
            const float inv = (j < 8) ? a.inv16[j] : a.inv32[j - 8];
            const float ang = (float)pos * inv;
            const double ad = (double)ang;
            const double r = ad - 6.283185307179586476925 * rint(ad * 0.15915494309189533577);
            const float rf = (float)r;
            const float cs = cosf(rf), sn = sinf(rf);
            float* trig = (float*)(ws + WS_TRIG) + (size_t)t * 48;
            if (j < 8) { trig[j] = cs; trig[8 + j] = sn; } else { trig[16 + (j - 8)] = cs; trig[32 + (j - 8)] = sn; }
        }
    }
}

DI void expert_conv_tile(const Ctx& c, KArgs& a, int l, int it) {
    unsigned char* ws = a.ws;
    const int which = it / 2048, r = it % 2048, e = r / 64, tt = r % 64;
    if (which < 2) {
        const float* src = a.in[21 + which] + ((size_t)l * 32 + e) * 1024 * 256;
        u16* dst = (u16*)(ws + (which == 0 ? WS_WG : WS_WU)) + (size_t)e * 256 * 1024;
        const int nt = tt / 16, kt = tt % 16;
        xpose_tile(c, src, 256, kt * 64, nt * 64, 0, nullptr, dst, 1024);
    } else {
        const float* src = a.in[23] + ((size_t)l * 32 + e) * 256 * 1024;
        u16* dst = (u16*)(ws + WS_WD) + (size_t)e * 1024 * 256;
        const int nt = tt / 4, kt = tt % 4;
        xpose_tile(c, src, 1024, kt * 64, nt * 64, 0, nullptr, dst, 256);
    }
}

DI void phase_norm_in(const Ctx& c_in, KArgs& a, int l) {
    const Ctx c = fresh_ctx(c_in.lds);
    unsigned char* ws = a.ws;
    const float* x = (l == 0) ? a.in[0] : a.out;
    const float* g = a.in[2] + l * 1024;
    u16* act = (u16*)(ws + WS_ACT);
    const int n_norm = T_TOK / 8;
    const int n_exp = 0;
    if (bid() == 0 && c.tid < 192) ((int*)(ws + WS_CTL))[c.tid] = 0;
    for (int it = bid(); it < n_norm + n_exp; it += gridDim.x) {
        if (false) {
        } else {
            const int t = (it - n_exp) * 8 + c.wave;
            const float* xr = x + (size_t)t * 1024;
            float v[16]; float ss = 0.f;
            if (l == 0) {
#pragma unroll
                for (int j = 0; j < 16; ++j) v[j] = xr[c.lane + 64 * j];
            } else {
                const u16* y0 = (const u16*)(ws + WS_YFFN) + (size_t)t * 2048;
#pragma unroll
                for (int j = 0; j < 16; ++j) { v[j] = xr[c.lane + 64 * j] + bf2f(y0[c.lane + 64 * j]) + bf2f(y0[1024 + c.lane + 64 * j]); a.out[(size_t)t * 1024 + c.lane + 64 * j] = v[j]; }
            }
#pragma unroll
            for (int j = 0; j < 16; ++j) ss += v[j] * v[j];
            ss = wsum(ss);
            const float rs = rsqrtf(ss * (1.f / 1024.f) + EPS);
#pragma unroll
            for (int j = 0; j < 16; ++j) act[(size_t)t * 1024 + c.lane + 64 * j] = f2bf(v[j] * rs * g[c.lane + 64 * j]);
        }
    }
}

DI void phase_inproj(const Ctx& c_in, KArgs& a, int l) {
    const Ctx c = fresh_ctx(c_in.lds);
    unsigned char* ws = a.ws;
    const u16* act = (const u16*)(ws + WS_ACT);
    const u16* w = (const u16*)(ws + WS_WIN) + (size_t)l * NPAD * 1024;
    u16* proj = (u16*)(ws + WS_PROJ);
    u16* dsavt = (u16*)(ws + WS_DSAVT);
    u16* foxvt = (u16*)(ws + WS_FOXVT);
    float* small = (float*)(ws + WS_SMALL);
    u16* mlak = (u16*)(ws + WS_MLAK);
    const float* trig = (const float*)(ws + WS_TRIG);
    int R, C; g2_stage_rc(c.tid * 16, R, C);
    const int nunits = (T_TOK / 256) * 13;
    for (int u = vblock(); u < nunits; u += gridDim.x) {
        const int grp = u / 52, rr = u % 52;
        const int pm = grp * 4 + (rr & 3), pn = rr >> 2;
        G2Ptrs g;
        g.ra = g2_rsrc(act); g.rb = g2_rsrc(w);
        g.va00 = (unsigned)(R * 1024 + C) * 2u; g.va01 = g.va00 + 64 * 2048; g.va10 = g.va00 + 128 * 2048; g.va11 = g.va00 + 192 * 2048;
        g.vb0 = g.va00; g.vb1 = g.va01;
        g.sa = (unsigned)pm * (256u * 2048u); g.sb0 = (unsigned)pn * (256u * 2048u); g.sb1 = g.sb0 + 128u * 2048u;
        __syncthreads();
        gemm256_unit(c, g, 1024, [&](const f32x4 (&acc)[2][2][4][2], int wr, int wc, int fr, int fq) {
#pragma unroll
            for (int bj = 0; bj < 2; ++bj)
#pragma unroll
                for (int n = 0; n < 2; ++n) {
                    const int col0 = pn * 256 + bj * 128 + wc * 32 + n * 16;
                    if (col0 < LDP) {
                        const bool rope16 = (col0 >= PC_DSAQ) && (col0 < PC_CQ) && (((col0 - PC_DSAQ) & 63) == 0);
                        const bool kr0 = (col0 == PC_KR), kr1 = (col0 == PC_KR + 16);
                        const bool foxk = (col0 >= PC_FOXK);
                        float kmx = 0.f;
#pragma unroll
                        for (int ai = 0; ai < 2; ++ai)
#pragma unroll
                            for (int m = 0; m < 4; ++m) {
                                const int row = pm * 256 + ai * 128 + wr * 64 + m * 16 + fr;
                                f32x4 v = acc[ai][bj][m][n];
                                if (rope16) {
                                    const float* tg = trig + (size_t)row * 48 + 4 * (fq & 1);
                                    const f32x4 cs = *(const f32x4*)tg, sn = *(const f32x4*)(tg + 8);
                                    f32x4 pv;
#pragma unroll
                                    for (int j = 0; j < 4; ++j) pv[j] = __shfl_xor(v[j], 32);
                                    v = (fq < 2) ? (v * cs - pv * sn) : (v * cs + pv * sn);
                                }
                                if (kr0) {
                                    const float* tg = trig + (size_t)row * 48 + 16 + 4 * fq;
                                    const f32x4 cs = *(const f32x4*)tg, sn = *(const f32x4*)(tg + 16);
                                    const f32x4 x2 = acc[ai][bj][m][1];
                                    const f32x4 o1 = v * cs - x2 * sn, o2 = x2 * cs + v * sn;
                                    uint2 p1, p2; p1.x = pack2(o1[0], o1[1]); p1.y = pack2(o1[2], o1[3]); p2.x = pack2(o2[0], o2[1]); p2.y = pack2(o2[2], o2[3]);
#pragma unroll
                                    for (int hd = 0; hd < 4; ++hd) {
                                        *(uint2*)(mlak + (size_t)row * 384 + hd * 96 + 64 + 4 * fq) = p1;
                                        *(uint2*)(mlak + (size_t)row * 384 + hd * 96 + 80 + 4 * fq) = p2;
                                    }
                                }
                                if (!kr0 && !kr1) {
                                    uint2 pk; pk.x = pack2(v[0], v[1]); pk.y = pack2(v[2], v[3]);
                                    *(uint2*)(proj + (size_t)row * LDP + col0 + 4 * fq) = pk;
                                    if (foxk) {
                                        const float b0 = bf2f((u16)(pk.x & 0xffff)), b1 = bf2f((u16)(pk.x >> 16)), b2 = bf2f((u16)(pk.y & 0xffff)), b3 = bf2f((u16)(pk.y >> 16));
                                        float ss = b0 * b0 + b1 * b1 + b2 * b2 + b3 * b3;
                                        ss += __shfl_xor(ss, 16); ss += __shfl_xor(ss, 32);
                                        kmx = fmaxf(kmx, ss);
                                    }
                                }
                            }
                        if (foxk) {
                            kmx = fmaxf(kmx, __shfl_xor(kmx, 1)); kmx = fmaxf(kmx, __shfl_xor(kmx, 2)); kmx = fmaxf(kmx, __shfl_xor(kmx, 4)); kmx = fmaxf(kmx, __shfl_xor(kmx, 8));
                            if (c.lane == 0) {
                                const int cc = col0 - PC_FOXK;
                                atomicMax((unsigned*)(ws + WS_CTL) + 64 + (((pm * 256) >> 12) * 4 + (cc >> 6)) * 4 + ((cc >> 4) & 3), __float_as_uint(kmx));
                            }
                        }
                    } else if (col0 < NC_SMALL) {
                        u16* vt = (col0 < NC_FOXV) ? dsavt + (size_t)(col0 - NC_DSAV + 4 * fq) * 4096 : foxvt + (size_t)(col0 - NC_FOXV + 4 * fq) * 4096;
                        const size_t bstride = (col0 < NC_FOXV) ? (size_t)64 * 4096 : (size_t)256 * 4096;
#pragma unroll
                        for (int ai = 0; ai < 2; ++ai)
#pragma unroll
                            for (int m = 0; m < 4; ++m) {
                                const int row = pm * 256 + ai * 128 + wr * 64 + m * 16 + fr;
                                u16* p = vt + (size_t)(row >> 12) * bstride + (row & 4095);
                                const f32x4 v = acc[ai][bj][m][n];
                                p[0] = f2bf(v[0]); p[4096] = f2bf(v[1]); p[2 * 4096] = f2bf(v[2]); p[3 * 4096] = f2bf(v[3]);
                            }
                    } else if (col0 == NC_SMALL) {
#pragma unroll
                        for (int ai = 0; ai < 2; ++ai)
#pragma unroll
                            for (int m = 0; m < 4; ++m) {
                                const int row = pm * 256 + ai * 128 + wr * 64 + m * 16 + fr;
                                *(f32x4*)(small + (size_t)row * 16 + 4 * fq) = acc[ai][bj][m][n];
                            }
                    }
                }
        });
    }
}

constexpr int SSD_LD = 136;
constexpr int SSD_TILE_B = 128 * SSD_LD * 2;
constexpr int SSD_OFF_DT = 3 * SSD_TILE_B;
constexpr int SSD_OFF_ACS = SSD_OFF_DT + 2048;
constexpr int SSD_OFF_SSQ = SSD_OFF_ACS + 2048;

DI void ssd_dt_acs(const Ctx& c, KArgs& a, int l, int tok0, float* dt_s, float* acs_s) {
    const float* small = (const float*)(a.ws + WS_SMALL);
    {
        const int t = c.tid >> 2, hd = c.tid & 3;
        const float raw = small[(size_t)(tok0 + t) * 16 + hd] + a.in[6][l * 4 + hd];
        dt_s[hd * 128 + t] = softplusf(raw);
    }
    __syncthreads();
    if (c.wave < 4) {
        const int hd = c.wave;
        const float av = -__expf(a.in[7][l * 4 + hd]);
        const float v0 = dt_s[hd * 128 + 2 * c.lane] * av, v1 = dt_s[hd * 128 + 2 * c.lane + 1] * av;
        const float s = v0 + v1;
        float inc = s;
#pragma unroll
        for (int o = 1; o < 64; o <<= 1) { const float tv = __shfl_up(inc, o); if (c.lane >= o) inc += tv; }
        const float ex = inc - s;
        acs_s[hd * 128 + 2 * c.lane] = ex + v0;
        acs_s[hd * 128 + 2 * c.lane + 1] = ex + v0 + v1;
    }
    __syncthreads();
}

DI float ssd_conv(const u16* proj, const float* cw, const float* cb, int b, int s, int xc) {
    float acc = cb[xc];
#pragma unroll
    for (int j = 0; j < 4; ++j) {
        const int sp = s - 3 + j;
        if (sp >= 0) acc += cw[j * 768 + xc] * bf2f(proj[(size_t)(b * 4096 + sp) * LDP + PC_XBC + xc]);
    }
    return siluf(acc);
}

template <bool TRANSPOSED>
DI void conv_stage_unit(const Ctx& c, const u16* proj, const float* cw, const float* cb, int b, int s0, int tseg, int xc0, u16* dst,
                        const float* dt_s, const float* acs_s, int head0) {
    const int ch = 2 * c.lane, xc = xc0 + ch;
    float w0[4], w1[4];
#pragma unroll
    for (int j = 0; j < 4; ++j) { w0[j] = cw[j * 768 + xc]; w1[j] = cw[j * 768 + xc + 1]; }
    const float bias0 = cb[xc], bias1 = cb[xc + 1];
    const u16* src = proj + (size_t)(b * 4096) * LDP + PC_XBC + xc;
    const int head = head0 + (ch >> 6);
#pragma unroll 1
    for (int half = 0; half < 2; ++half) {
        const int sb = s0 + tseg * 32 + half * 16 - 3;
        unsigned raw[19];
#pragma unroll
        for (int i = 0; i < 19; ++i) { const int sp = sb + i; raw[i] = (sp >= 0) ? *(const unsigned*)(src + (size_t)sp * LDP) : 0u; }
#pragma unroll
        for (int t = 0; t < 16; ++t) {
            float x0 = bias0, x1 = bias1;
#pragma unroll
            for (int j = 0; j < 4; ++j) { x0 += w0[j] * bf2f((u16)(raw[t + j] & 0xffff)); x1 += w1[j] * bf2f((u16)(raw[t + j] >> 16)); }
            x0 = siluf(x0); x1 = siluf(x1);
            const int tt = tseg * 32 + half * 16 + t;
            if (dt_s) { const float sc = dt_s[head * 128 + tt] * __expf(acs_s[head * 128 + 127] - acs_s[head * 128 + tt]); x0 *= sc; x1 *= sc; }
            if (TRANSPOSED) { dst[ch * SSD_LD + tt] = f2bf(x0); dst[(ch + 1) * SSD_LD + tt] = f2bf(x1); }
            else *(unsigned*)(dst + tt * SSD_LD + ch) = pack2(x0, x1);
        }
    }
}

DI void ssd_state_item(const Ctx& c_in, KArgs& a, int l, int item) {
    const Ctx c = fresh_ctx(c_in.lds);
    unsigned char* ws = a.ws;
    const u16* proj = (const u16*)(ws + WS_PROJ);
    const float* cw = a.in[4] + (size_t)l * 4 * 768;
    const float* cb = a.in[5] + (size_t)l * 768;
    float* cs = (float*)(ws + WS_CS);
    float* cdec = (float*)(ws + WS_CDEC);
    const int b = item >> 5, ch = item & 31, tok0 = b * 4096 + ch * 128, s0 = ch * 128;
    u16* XT = (u16*)c.lds;
    u16* BT = (u16*)(c.lds + SSD_TILE_B);
    float* dt_s = (float*)(c.lds + SSD_OFF_DT);
    float* acs_s = (float*)(c.lds + SSD_OFF_ACS);
    const int l31 = c.lane & 31, h = c.lane >> 5;
    ssd_dt_acs(c, a, l, tok0, dt_s, acs_s);
    if (c.tid < 4) cdec[(b * 32 + ch) * 4 + c.tid] = __expf(acs_s[c.tid * 128 + 127]);
    for (int g = 0; g < 2; ++g) {
        if (c.wave < 4) conv_stage_unit<true>(c, proj, cw, cb, b, s0, c.wave, 128 * g, XT, dt_s, acs_s, 2 * g);
        else conv_stage_unit<true>(c, proj, cw, cb, b, s0, c.wave - 4, 256 + 128 * g, BT, nullptr, nullptr, 0);
        __syncthreads();
        {
            const int hh = c.wave >> 2, pt = (c.wave >> 1) & 1, nh = c.wave & 1;
            f32x16 acc0 = zero16(), acc1 = zero16();
#pragma unroll
            for (int ks = 0; ks < 8; ++ks) {
                const bf16x8 af = *(const bf16x8*)(XT + (hh * 64 + pt * 32 + l31) * SSD_LD + ks * 16 + h * 8);
                const bf16x8 b0 = *(const bf16x8*)(BT + (nh * 64 + l31) * SSD_LD + ks * 16 + h * 8);
                const bf16x8 b1 = *(const bf16x8*)(BT + (nh * 64 + 32 + l31) * SSD_LD + ks * 16 + h * 8);
                acc0 = MFMA32(af, b0, acc0);
                acc1 = MFMA32(af, b1, acc1);
            }
            const int head = 2 * g + hh;
            float* dst = cs + ((size_t)((b * 32 + ch) * 4 + head) * 64) * 128;
#pragma unroll
            for (int r = 0; r < 16; ++r) {
                const int p = pt * 32 + crow(r, h);
                dst[p * 128 + nh * 64 + l31] = acc0[r];
                dst[p * 128 + nh * 64 + 32 + l31] = acc1[r];
            }
        }
        __syncthreads();
    }
}

DI void ssd_scan_item(const Ctx& c_in, KArgs& a, int item) {
    const Ctx c = fresh_ctx(c_in.lds);
    float* cs = (float*)(a.ws + WS_CS);
    const float* cdec = (const float*)(a.ws + WS_CDEC);
    const int idx = item * NTHR + c.tid;
    const int bh = idx >> 13, pn = idx & 8191, b = bh >> 2, hd = bh & 3;
    float v[32], dcy[32];
#pragma unroll
    for (int ch = 0; ch < 32; ++ch) {
        v[ch] = cs[((size_t)((b * 32 + ch) * 4 + hd)) * 8192 + pn];
        dcy[ch] = cdec[(b * 32 + ch) * 4 + hd];
    }
    float s = 0.f;
#pragma unroll
    for (int ch = 0; ch < 32; ++ch) {
        cs[((size_t)((b * 32 + ch) * 4 + hd)) * 8192 + pn] = s;
        s = s * dcy[ch] + v[ch];
    }
}

DI void ssd_out_item(const Ctx& c_in, KArgs& a, int l, int item) {
    const Ctx c = fresh_ctx(c_in.lds);
    unsigned char* ws = a.ws;
    const u16* proj = (const u16*)(ws + WS_PROJ);
    const float* cw = a.in[4] + (size_t)l * 4 * 768;
    const float* cb = a.in[5] + (size_t)l * 768;
    const float* prev = (const float*)(ws + WS_CS);
    u16* act = (u16*)(ws + WS_ACT);
    const int b = item >> 5, ch = item & 31, tok0 = b * 4096 + ch * 128, s0 = ch * 128;
    u16* XT = (u16*)c.lds;
    u16* BM = (u16*)(c.lds + SSD_TILE_B);
    u16* CM = (u16*)(c.lds + 2 * SSD_TILE_B);
    float* dt_s = (float*)(c.lds + SSD_OFF_DT);
    float* acs_s = (float*)(c.lds + SSD_OFF_ACS);
    float* ssq = (float*)(c.lds + SSD_OFF_SSQ);
    const int l31 = c.lane & 31, h = c.lane >> 5;
    ssd_dt_acs(c, a, l, tok0, dt_s, acs_s);
    f32x16 yreg[2][2];
    const int hh = c.wave >> 2, qt = c.wave & 3;
    const int q = qt * 32 + l31;
#pragma unroll
    for (int g = 0; g < 2; ++g) {
        for (int u = c.wave; u < 12; u += 8) {
            const int part = u >> 2, tseg = u & 3;
            if (part == 0) conv_stage_unit<true>(c, proj, cw, cb, b, s0, tseg, 128 * g, XT, nullptr, nullptr, 0);
            else if (part == 1) conv_stage_unit<false>(c, proj, cw, cb, b, s0, tseg, 256 + 128 * g, BM, nullptr, nullptr, 0);
            else conv_stage_unit<false>(c, proj, cw, cb, b, s0, tseg, 512 + 128 * g, CM, nullptr, nullptr, 0);
        }
        __syncthreads();
        {
            const int head = 2 * g + hh;
            const float acs_q = acs_s[head * 128 + q];
            bf16x8 cf[8];
#pragma unroll
            for (int ks = 0; ks < 8; ++ks) cf[ks] = *(const bf16x8*)(CM + q * SSD_LD + ks * 16 + h * 8);
            f32x16 yf0 = zero16(), yf1 = zero16();
            const float* pv = prev + ((size_t)((b * 32 + ch) * 4 + head) * 64) * 128;
#pragma unroll
            for (int ks = 0; ks < 8; ++ks) {
                {
                    const float* pr = pv + (size_t)l31 * 128 + ks * 16 + h * 8;
                    const float4 f0 = *(const float4*)pr, f1 = *(const float4*)(pr + 4);
                    const bf16x8 pa = __builtin_bit_cast(bf16x8, make_uint4(pack2(f0.x, f0.y), pack2(f0.z, f0.w), pack2(f1.x, f1.y), pack2(f1.z, f1.w)));
                    yf0 = MFMA32(pa, cf[ks], yf0);
                }
                {
                    const float* pr = pv + (size_t)(32 + l31) * 128 + ks * 16 + h * 8;
                    const float4 f0 = *(const float4*)pr, f1 = *(const float4*)(pr + 4);
                    const bf16x8 pa = __builtin_bit_cast(bf16x8, make_uint4(pack2(f0.x, f0.y), pack2(f0.z, f0.w), pack2(f1.x, f1.y), pack2(f1.z, f1.w)));
                    yf1 = MFMA32(pa, cf[ks], yf1);
                }
            }
            const float eq = __expf(acs_q);
            f32x16 yo0, yo1;
#pragma unroll
            for (int r = 0; r < 16; ++r) { yo0[r] = yf0[r] * eq; yo1[r] = yf1[r] * eq; }
            for (int kt = 0; kt <= qt; ++kt) {
                f32x16 gt = zero16();
#pragma unroll
                for (int ks = 0; ks < 8; ++ks) {
                    const bf16x8 bf = *(const bf16x8*)(BM + (kt * 32 + l31) * SSD_LD + ks * 16 + h * 8);
                    gt = MFMA32(bf, cf[ks], gt);
                }
#pragma unroll
                for (int r = 0; r < 16; ++r) {
                    const int k = kt * 32 + crow(r, h);
                    const float dec = __expf(fminf(acs_q - acs_s[head * 128 + k], 0.f)) * dt_s[head * 128 + k];
                    gt[r] = (k <= q) ? gt[r] * dec : 0.f;
                }
#pragma unroll
                for (int s2 = 0; s2 < 2; ++s2) {
                    const bf16x8 pb = pack8(gt, s2);
                    const int koff = kt * 32 + 16 * s2 + 4 * h;
                    {
                        const u16* xr = XT + (hh * 64 + l31) * SSD_LD + koff;
                        const uint2 lo = *(const uint2*)xr, hi = *(const uint2*)(xr + 8);
                        const bf16x8 xa = __builtin_bit_cast(bf16x8, make_uint4(lo.x, lo.y, hi.x, hi.y));
                        yo0 = MFMA32(xa, pb, yo0);
                    }
                    {
                        const u16* xr = XT + (hh * 64 + 32 + l31) * SSD_LD + koff;
                        const uint2 lo = *(const uint2*)xr, hi = *(const uint2*)(xr + 8);
                        const bf16x8 xa = __builtin_bit_cast(bf16x8, make_uint4(lo.x, lo.y, hi.x, hi.y));
                        yo1 = MFMA32(xa, pb, yo1);
                    }
                }
            }
            const float dsk = a.in[8][l * 4 + head];
            float part = 0.f;
#pragma unroll
            for (int pt = 0; pt < 2; ++pt) {
#pragma unroll
                for (int qd = 0; qd < 4; ++qd) {
                    const int p0 = pt * 32 + 8 * qd + 4 * h;
                    const uint2 zz = *(const uint2*)(proj + (size_t)(tok0 + q) * LDP + PC_Z + head * 64 + p0);
                    const float zf[4] = { bf2f((u16)(zz.x & 0xffff)), bf2f((u16)(zz.x >> 16)), bf2f((u16)(zz.y & 0xffff)), bf2f((u16)(zz.y >> 16)) };
#pragma unroll
                    for (int r3 = 0; r3 < 4; ++r3) {
                        const int r = 4 * qd + r3;
                        const float yo = pt ? yo1[r] : yo0[r];
                        const float xv = bf2f(XT[(hh * 64 + p0 + r3) * SSD_LD + q]);
                        const float y = (yo + dsk * xv) * siluf(zf[r3]);
                        yreg[g][pt][r] = y;
                        part += y * y;
                    }
                }
            }
            part += __shfl_xor(part, 32);
            if (h == 0) ssq[head * 128 + q] = part;
        }
        __syncthreads();
    }
    {
        const float rs = rsqrtf((ssq[q] + ssq[128 + q] + ssq[256 + q] + ssq[384 + q]) * (1.f / 256.f) + EPS);
        const float* nw = a.in[9] + l * 256;
#pragma unroll
        for (int g = 0; g < 2; ++g) {
            const int head = 2 * g + hh;
#pragma unroll
            for (int pt = 0; pt < 2; ++pt)
#pragma unroll
                for (int qd = 0; qd < 4; ++qd) {
                    const int p0 = pt * 32 + 8 * qd + 4 * h;
                    const float* w4 = nw + head * 64 + p0;
                    uint2 pk;
                    pk.x = pack2(yreg[g][pt][4 * qd] * rs * w4[0], yreg[g][pt][4 * qd + 1] * rs * w4[1]);
                    pk.y = pack2(yreg[g][pt][4 * qd + 2] * rs * w4[2], yreg[g][pt][4 * qd + 3] * rs * w4[3]);
                    *(uint2*)(act + (size_t)(tok0 + q) * 1024 + head * 64 + p0) = pk;
                }
        }
    }
    __syncthreads();
}

DI void token_post_item(const Ctx& c_in, KArgs& a, int l, int item) {
    const Ctx c = fresh_ctx(c_in.lds);
    unsigned char* ws = a.ws;
    u16* proj = (u16*)(ws + WS_PROJ);
    u16* mlak = (u16*)(ws + WS_MLAK);
    const float* trig = (const float*)(ws + WS_TRIG);
    const float* small = (const float*)(ws + WS_SMALL);
    float* flog = (float*)(ws + WS_FLOG);
    const int t = item * 8 + c.wave;
    u16* pr = proj + (size_t)t * LDP;
    const float* tg = trig + (size_t)t * 48;
#pragma unroll
    for (int r = 0; r < 2; ++r) {
        const int pid = c.lane + 64 * r;
        if (pid < 112) {
            int col, i;
            if (pid < 32)       { col = PC_DSAQ + (pid >> 3) * 64; i = pid & 7; }
            else if (pid < 40)  { col = PC_DSAK; i = pid - 32; }
            else if (pid < 104) { const int p = pid - 40; col = PC_IDXQ + (p >> 3) * 64; i = p & 7; }
            else                { col = PC_IDXK; i = pid - 104; }
            const float x1 = bf2f(pr[col + i]), x2 = bf2f(pr[col + 8 + i]);
            const float cs = tg[i], sn = tg[8 + i];
            pr[col + i] = f2bf(x1 * cs - x2 * sn);
            pr[col + 8 + i] = f2bf(x2 * cs + x1 * sn);
        } else {
            const int i = pid - 112;
            const float x1 = bf2f(pr[PC_KR + i]), x2 = bf2f(pr[PC_KR + 16 + i]);
            const float cs = tg[16 + i], sn = tg[32 + i];
            const u16 o1 = f2bf(x1 * cs - x2 * sn), o2 = f2bf(x2 * cs + x1 * sn);
#pragma unroll
            for (int hd = 0; hd < 4; ++hd) { mlak[(size_t)t * 384 + hd * 96 + 64 + i] = o1; mlak[(size_t)t * 384 + hd * 96 + 80 + i] = o2; }
        }
    }
    {
        const int hd = c.lane >> 4, d0 = (c.lane & 15) * 4;
        const uint2 kk = *(const uint2*)(pr + PC_FOXK + hd * 64 + d0);
        const float k0 = bf2f((u16)(kk.x & 0xffff)), k1 = bf2f((u16)(kk.x >> 16)), k2 = bf2f((u16)(kk.y & 0xffff)), k3 = bf2f((u16)(kk.y >> 16));
        float ss = k0 * k0 + k1 * k1 + k2 * k2 + k3 * k3;
        ss += __shfl_xor(ss, 1); ss += __shfl_xor(ss, 2); ss += __shfl_xor(ss, 4); ss += __shfl_xor(ss, 8);
        if ((c.lane & 15) == 0) {
            unsigned* km = (unsigned*)(ws + WS_CTL) + 64 + (t >> 12) * 4 + hd;
            const unsigned sb = __float_as_uint(ss);
            if (sb > __hip_atomic_load(km, __ATOMIC_RELAXED, __HIP_MEMORY_SCOPE_AGENT)) atomicMax(km, sb);
        }
    }
    if (c.lane < 4) {
        const float f = small[(size_t)t * 16 + 12 + c.lane] + a.in[14][l * 4 + c.lane];
        const float ls = fminf(f, 0.f) - log1pf(__expf(-fabsf(f)));
        const int b = t >> 12, s = t & 4095;
        flog[(size_t)(b * 4 + c.lane) * 4096 + s] = ls;
    }
}

DI void mla_up_item(const Ctx& c_in, KArgs& a, int l, int which, int item) {
    const Ctx c = fresh_ctx(c_in.lds);
    unsigned char* ws = a.ws;
    const u16* proj = (const u16*)(ws + WS_PROJ);
    const float* trig = (const float*)(ws + WS_TRIG);
    float* rs_s = (float*)(c.lds + G_LDS_BYTES);
    const int r8 = c.tid >> 3;
    const int wm = c.wave & 3, wn = c.wave >> 2, l31 = c.lane & 31, h = c.lane >> 5;
    const int K = which == 0 ? 256 : 128;
    const int pc = which == 0 ? PC_CQ : PC_CKV;
    const int ntn = which == 0 ? 3 : 4;
    const int mt = item / ntn, nt = item % ntn;
    const u16* w = which == 0 ? (const u16*)(ws + WS_WUQ) + (size_t)l * 384 * 256 : (const u16*)(ws + WS_WUKV) + (size_t)l * 512 * 128;
    {
        const int row = c.tid >> 1, half = c.tid & 1;
        const u16* p = proj + (size_t)(mt * 256 + row) * LDP + pc + half * (K / 2);
        float ss = 0.f;
        for (int i = 0; i < K / 2; i += 8) {
            const uint4 v = *(const uint4*)(p + i);
            const unsigned w4[4] = { v.x, v.y, v.z, v.w };
#pragma unroll
            for (int j = 0; j < 4; ++j) { const float f0 = bf2f((u16)(w4[j] & 0xffff)), f1 = bf2f((u16)(w4[j] >> 16)); ss += f0 * f0 + f1 * f1; }
        }
        ss += __shfl_xor(ss, 1);
        if (half == 0) rs_s[row] = rsqrtf(ss / (float)K + EPS);
    }
    __syncthreads();
    GP gp;
    gp.a0 = proj + (size_t)(mt * 256 + r8) * LDP + pc; gp.a1 = gp.a0 + 64 * LDP; gp.a2 = gp.a0 + 128 * LDP; gp.a3 = gp.a0 + 192 * LDP;
    gp.b0 = w + (size_t)(nt * 128 + r8) * K; gp.b1 = gp.b0 + 64 * K;
    f32x16 acc[2][2];
    acc[0][0] = zero16(); acc[0][1] = zero16(); acc[1][0] = zero16(); acc[1][1] = zero16();
    gemm_core<false>(c, K, gp, acc);
    u16* mlaq = (u16*)(ws + WS_MLAQ);
    u16* mlak = (u16*)(ws + WS_MLAK);
    u16* mlavt = (u16*)(ws + WS_MLAVT);
#pragma unroll
    for (int i = 0; i < 2; ++i)
#pragma unroll
        for (int j = 0; j < 2; ++j) {
            const int ml0 = wm * 64 + i * 32, m0 = mt * 256 + ml0, n0 = nt * 128 + wn * 64 + j * 32;
            const int n = n0 + l31;
            if (which == 0) {
                const bool rope = ((n0 >> 5) % 3) == 2;
#pragma unroll
                for (int r = 0; r < 16; ++r) {
                    const int ml = ml0 + crow(r, h), m = mt * 256 + ml;
                    float v = acc[i][j][r] * rs_s[ml];
                    if (rope) {
                        const float pv = __shfl_xor(v, 16);
                        const int ii = l31 & 15;
                        const float cs = trig[(size_t)m * 48 + 16 + ii], sn = trig[(size_t)m * 48 + 32 + ii];
                        v = (l31 < 16) ? (v * cs - pv * sn) : (v * cs + pv * sn);
                    }
                    mlaq[(size_t)m * 384 + n] = f2bf(v);
                }
            } else {
                const int head = n0 >> 7, wi = n0 & 127;
                if (wi < 64) {
#pragma unroll
                    for (int r = 0; r < 16; ++r) {
                        const int ml = ml0 + crow(r, h), m = mt * 256 + ml;
                        mlak[(size_t)m * 384 + head * 96 + wi + l31] = f2bf(acc[i][j][r] * rs_s[ml]);
                    }
                } else {
                    const int b = m0 >> 12, s0 = m0 & 4095, d = wi - 64 + l31;
                    u16* base = mlavt + ((size_t)(b * 4 + head) * 64 + d) * 4096 + s0;
#pragma unroll
                    for (int q = 0; q < 4; ++q) {
                        const int mlq = ml0 + 8 * q + 4 * h;
                        uint2 pk;
                        pk.x = pack2(acc[i][j][4 * q] * rs_s[mlq], acc[i][j][4 * q + 1] * rs_s[mlq + 1]);
                        pk.y = pack2(acc[i][j][4 * q + 2] * rs_s[mlq + 2], acc[i][j][4 * q + 3] * rs_s[mlq + 3]);
                        *(uint2*)(base + 8 * q + 4 * h) = pk;
                    }
                }
            }
        }
    __syncthreads();
}

constexpr int AT_LDV = 68;
template <int DQ, int MODE>
DI void attn_item(const Ctx& c_in, KArgs& a, int l, int b, int hd_in, int qb) {
    const Ctx c = fresh_ctx(c_in.lds);
    unsigned char* ws = a.ws;
    constexpr int LDK = DQ + 8;
    constexpr int K_EL = 64 * LDK, V_EL = 64 * AT_LDV, ST_EL = K_EL + V_EL;
    constexpr int NKS = DQ / 16;
    constexpr int KCH = DQ / 8;
    u16* S = (u16*)c.lds;
    float* fc_s = (float*)(c.lds + 2 * ST_EL * 2 + 64);
    const int l31 = c.lane & 31, h = c.lane >> 5;
    int hd, wq0, nkt;
    const u16 *Qp, *Kp, *Vp; int ldq, ldk, ocol;
    float scale;
    if (MODE == 0) {
        hd = hd_in;
        wq0 = qb * 256 + c.wave * 32; nkt = qb * 4 + 4;
        Qp = (const u16*)(ws + WS_MLAQ) + (size_t)b * 4096 * 384 + hd * 96; ldq = 384;
        Kp = (const u16*)(ws + WS_MLAK) + (size_t)b * 4096 * 384 + hd * 96; ldk = 384;
        Vp = (const u16*)(ws + WS_MLAVT) + (size_t)(b * 4 + hd) * 64 * 4096;
        ocol = 512 + hd * 64; scale = 0.10206207261596575f;
    } else if (MODE == 1) {
        hd = hd_in;
        wq0 = qb * 256 + c.wave * 32; nkt = qb * 4 + 4;
        Qp = (const u16*)(ws + WS_PROJ) + (size_t)b * 4096 * LDP + PC_FOXQ + hd * 64; ldq = LDP;
        Kp = (const u16*)(ws + WS_PROJ) + (size_t)b * 4096 * LDP + PC_FOXK + hd * 64; ldk = LDP;
        Vp = (const u16*)(ws + WS_FOXVT) + (size_t)(b * 4 + hd) * 64 * 4096;
        ocol = 768 + hd * 64; scale = 0.125f;
    } else {
        hd = c.wave & 3;
        wq0 = qb * 64 + (c.wave >> 2) * 32; nkt = qb + 1;
        Qp = (const u16*)(ws + WS_PROJ) + (size_t)b * 4096 * LDP + PC_DSAQ + hd * 64; ldq = LDP;
        Kp = (const u16*)(ws + WS_PROJ) + (size_t)b * 4096 * LDP + PC_DSAK; ldk = LDP;
        Vp = (const u16*)(ws + WS_DSAVT) + (size_t)b * 64 * 4096;
        ocol = 256 + hd * 64; scale = 0.125f;
    }
    const float sc2 = scale * LOG2E;
    const int q = wq0 + l31;
    bf16x8 qf[NKS];
#pragma unroll
    for (int ks = 0; ks < NKS; ++ks) qf[ks] = *(const bf16x8*)(Qp + (size_t)q * ldq + ks * 16 + h * 8);
    float fq = 0.f;
    if (MODE == 1) {
        const float* fsm = (const float*)(ws + WS_SMALL) + (size_t)b * 4096 * 16 + 12 + hd;
        const float fbias = a.in[14][l * 4 + hd];
        float* wtot = (float*)(c.lds + 2 * ST_EL * 2);
        const int nk = nkt * 64;
        float v[8]; float s = 0.f;
#pragma unroll
        for (int j = 0; j < 8; ++j) {
            const int idx = c.tid * 8 + j;
            float lf = 0.f;
            if (idx < nk) { const float f = fsm[(size_t)idx * 16] + fbias; lf = fminf(f, 0.f) - log1pf(__expf(-fabsf(f))); }
            v[j] = lf;
        }
#pragma unroll
        for (int j = 0; j < 8; ++j) { s += v[j]; v[j] = s; }
        float inc = s;
#pragma unroll
        for (int o = 1; o < 64; o <<= 1) { const float tv = __shfl_up(inc, o); if (c.lane >= o) inc += tv; }
        if (c.lane == 63) wtot[c.wave] = inc;
        __syncthreads();
        float base = inc - s;
        for (int w2 = 0; w2 < c.wave; ++w2) base += wtot[w2];
#pragma unroll
        for (int j = 0; j < 8; ++j) fc_s[c.tid * 8 + j] = (base + v[j]) * LOG2E;
        __syncthreads();
        fq = fc_s[q];
    }
    float sbound = 0.f;
    int* dflag = (int*)(c.lds + 2 * ST_EL * 2 + 64 + 4096 * 4);
    if (MODE == 1) {
        float qq = 0.f;
#pragma unroll
        for (int ks = 0; ks < NKS; ++ks)
#pragma unroll
            for (int j = 0; j < 8; ++j) { const float f = bf2f((u16)qf[ks][j]); qq += f * f; }
        qq += __shfl_xor(qq, 32);
        float kmax2 = 0.f;
#pragma unroll
        for (int f = 0; f < 4; ++f) kmax2 += __uint_as_float(__hip_atomic_load((const unsigned*)(ws + WS_CTL) + 64 + (b * 4 + hd) * 4 + f, __ATOMIC_RELAXED, __HIP_MEMORY_SCOPE_AGENT));
        sbound = sqrtf(qq * kmax2) * sc2 * 1.02f + 1.0f;
        if (c.tid < 16) dflag[c.tid] = 0;
    }
    bool wdone = false;
    const int krow0 = c.tid / KCH, kch0 = c.tid % KCH;
    const int c1 = c.tid + NTHR; const int krow1 = c1 / KCH, kch1 = c1 % KCH; const bool has1 = (KCH * 64 > NTHR) && (c1 < KCH * 64);
    const int vrow = c.tid >> 3, vch = c.tid & 7;
    struct KV { uint4 k0, k1, v; u64 mw; };
    KV sA, sB, sC;
    sA.k1 = sB.k1 = sC.k1 = make_uint4(0, 0, 0, 0); sA.mw = sB.mw = sC.mw = 0;
    const u64* mrow = (const u64*)(ws + WS_MASK) + (size_t)(b * 4096 + q) * 64;
    auto gload = [&](KV& s, int kt) {
        s.k0 = *(const uint4*)(Kp + (size_t)(kt * 64 + krow0) * ldk + kch0 * 8);
        if (has1) s.k1 = *(const uint4*)(Kp + (size_t)(kt * 64 + krow1) * ldk + kch1 * 8);
        s.v = *(const uint4*)(Vp + (size_t)vrow * 4096 + kt * 64 + vch * 8);
        if (MODE == 2) s.mw = mrow[kt];
    };
    auto sstore = [&](const KV& s, int st) {
        u16* Ks = S + st * ST_EL; u16* Vs = Ks + K_EL;
        *(uint4*)(Ks + krow0 * LDK + kch0 * 8) = s.k0;
        if (has1) *(uint4*)(Ks + krow1 * LDK + kch1 * 8) = s.k1;
        *(uint2*)(Vs + vrow * AT_LDV + vch * 8) = make_uint2(s.v.x, s.v.y);
        *(uint2*)(Vs + vrow * AT_LDV + vch * 8 + 4) = make_uint2(s.v.z, s.v.w);
    };
    f32x16 o0 = zero16(), o1 = zero16();
    float m_run = -1e30f, l_run = 0.f;
    auto tile_of = [&](int it) { return (MODE == 1) ? nkt - 1 - it : it; };
    bool stop = false;
    auto step = [&](int it, KV& cur, const KV& nxt) {
        const int kt = tile_of(it);
        const u64 mw_cur = cur.mw;
        if (it + 3 < nkt) gload(cur, tile_of(it + 3));
        if (kt * 64 <= wq0 + 31 && !wdone) {
            const u16* Ks = S + (it & 1) * ST_EL; const u16* Vs = Ks + K_EL;
            f32x16 s0 = zero16(), s1 = zero16();
#pragma unroll
            for (int ks = 0; ks < NKS; ++ks) {
                const bf16x8 k0 = *(const bf16x8*)(Ks + l31 * LDK + ks * 16 + h * 8);
                const bf16x8 k1 = *(const bf16x8*)(Ks + (32 + l31) * LDK + ks * 16 + h * 8);
                s0 = MFMA32(k0, qf[ks], s0);
                s1 = MFMA32(k1, qf[ks], s1);
            }
            const float scx = (MODE == 1) ? 1.0f : sc2;
            if (MODE == 1) {
#pragma unroll
                for (int g4 = 0; g4 < 4; ++g4) {
                    const float4 f0 = *(const float4*)(fc_s + kt * 64 + 8 * g4 + 4 * h);
                    const float4 f1 = *(const float4*)(fc_s + kt * 64 + 32 + 8 * g4 + 4 * h);
                    s0[4 * g4 + 0] = fmaf(s0[4 * g4 + 0], sc2, fq) - f0.x; s0[4 * g4 + 1] = fmaf(s0[4 * g4 + 1], sc2, fq) - f0.y;
                    s0[4 * g4 + 2] = fmaf(s0[4 * g4 + 2], sc2, fq) - f0.z; s0[4 * g4 + 3] = fmaf(s0[4 * g4 + 3], sc2, fq) - f0.w;
                    s1[4 * g4 + 0] = fmaf(s1[4 * g4 + 0], sc2, fq) - f1.x; s1[4 * g4 + 1] = fmaf(s1[4 * g4 + 1], sc2, fq) - f1.y;
                    s1[4 * g4 + 2] = fmaf(s1[4 * g4 + 2], sc2, fq) - f1.z; s1[4 * g4 + 3] = fmaf(s1[4 * g4 + 3], sc2, fq) - f1.w;
                }
            }
            if (MODE == 2) {
                const unsigned mlo = (unsigned)(mw_cur >> (4 * h)), mhi = (unsigned)(mw_cur >> (32 + 4 * h));
#pragma unroll
                for (int r = 0; r < 16; ++r) {
                    const int kr = (r & 3) + 8 * (r >> 2);
                    s0[r] = ((mlo >> kr) & 1u) ? s0[r] : -1e30f;
                    s1[r] = ((mhi >> kr) & 1u) ? s1[r] : -1e30f;
                }
            } else if (__builtin_amdgcn_readfirstlane(kt * 64 + 63 - wq0) > 0) {
                asm volatile("" ::: "memory");
                const int qrel = q - kt * 64 - 4 * h;
#pragma unroll
                for (int r = 0; r < 16; ++r) {
                    const int kr = (r & 3) + 8 * (r >> 2);
                    s0[r] = (kr <= qrel) ? s0[r] : -1e30f;
                    s1[r] = (kr + 32 <= qrel) ? s1[r] : -1e30f;
                }
            }
            float mx;
            {
                float t0 = max3f(s0[0], s0[1], s0[2]), t1 = max3f(s0[3], s0[4], s0[5]), t2 = max3f(s0[6], s0[7], s0[8]), t3 = max3f(s0[9], s0[10], s0[11]);
                float t4 = max3f(s0[12], s0[13], s0[14]), t5 = max3f(s0[15], s1[0], s1[1]), t6 = max3f(s1[2], s1[3], s1[4]), t7 = max3f(s1[5], s1[6], s1[7]);
                float t8 = max3f(s1[8], s1[9], s1[10]), t9 = max3f(s1[11], s1[12], s1[13]), t10 = max3f(s1[14], s1[15], t0);
                t1 = max3f(t1, t2, t3); t4 = max3f(t4, t5, t6); t7 = max3f(t7, t8, t9);
                mx = max3f(t1, t4, t7); mx = max3f(mx, t10, __shfl_xor(max3f(t1, t4, max3f(t7, t10, t10)), 32));
            }
            const float m_new = max3f(m_run, mx, mx);
            const float m_use = (MODE == 2) ? max3f(m_new, -1e20f, -1e20f) : m_new;
            const float alpha = ex2((m_run - m_new) * scx);
            const float nm = -m_use * scx;
            f32x2 rs2 = {0.f, 0.f};
            const f32x2 sc2v = {scx, scx}, nm2 = {nm, nm};
#pragma unroll
            for (int r = 0; r < 16; r += 2) {
                f32x2 xv = {s0[r], s0[r + 1]};
                xv = xv * sc2v + nm2;
                xv[0] = ex2(xv[0]); xv[1] = ex2(xv[1]);
                s0[r] = xv[0]; s0[r + 1] = xv[1];
                rs2 += xv;
                f32x2 yv = {s1[r], s1[r + 1]};
                yv = yv * sc2v + nm2;
                yv[0] = ex2(yv[0]); yv[1] = ex2(yv[1]);
                s1[r] = yv[0]; s1[r + 1] = yv[1];
                rs2 += yv;
            }
            float rsum = rs2[0] + rs2[1];
            rsum += __shfl_xor(rsum, 32);
            l_run = l_run * alpha + rsum; m_run = m_new;
            if (__any(alpha != 1.0f)) {
#pragma unroll
                for (int r = 0; r < 16; ++r) { o0[r] *= alpha; o1[r] *= alpha; }
            }
#pragma unroll
            for (int sub = 0; sub < 2; ++sub)
#pragma unroll
                for (int s2 = 0; s2 < 2; ++s2) {
                    const bf16x8 pb = pack8(sub ? s1 : s0, s2);
                    const int koff = sub * 32 + 16 * s2 + 4 * h;
                    {
                        const u16* vr = Vs + l31 * AT_LDV + koff;
                        const uint2 lo = *(const uint2*)vr, hi = *(const uint2*)(vr + 8);
                        o0 = MFMA32(__builtin_bit_cast(bf16x8, make_uint4(lo.x, lo.y, hi.x, hi.y)), pb, o0);
                    }
                    {
                        const u16* vr = Vs + (32 + l31) * AT_LDV + koff;
                        const uint2 lo = *(const uint2*)vr, hi = *(const uint2*)(vr + 8);
                        o1 = MFMA32(__builtin_bit_cast(bf16x8, make_uint4(lo.x, lo.y, hi.x, hi.y)), pb, o1);
                    }
                }
        }
        if (it + 1 < nkt) sstore(nxt, (it + 1) & 1);
        if (MODE == 1) {
            if (kt * 64 <= wq0 + 31 && !wdone && kt > 0) wdone = __all(sbound + (fq - fc_s[kt * 64 - 1]) < m_run - 40.f);
            if (c.lane == 0) dflag[(it & 1) * 8 + c.wave] = wdone ? 1 : 0;
        }
        __syncthreads();
        if (MODE == 1) {
            const int4 f0 = *(const int4*)(dflag + (it & 1) * 8), f1 = *(const int4*)(dflag + (it & 1) * 8 + 4);
            if ((f0.x & f0.y & f0.z & f0.w & f1.x & f1.y & f1.z & f1.w) != 0) stop = true;
        }
    };
    gload(sA, tile_of(0));
    if (nkt > 1) gload(sB, tile_of(1));
    if (nkt > 2) gload(sC, tile_of(2));
    sstore(sA, 0);
    __syncthreads();
    for (int it = 0; it < nkt; it += 3) {
        step(it, sA, sB); if (stop || it + 1 >= nkt) break;
        step(it + 1, sB, sC); if (stop || it + 2 >= nkt) break;
        step(it + 2, sC, sA); if (stop) break;
    }
    if (MODE == 1) __syncthreads();
    {
        const float inv = 1.f / l_run;
        u16* act = (u16*)(ws + WS_ACT) + (size_t)(b * 4096 + q) * 1024 + ocol;
#pragma unroll
        for (int qd = 0; qd < 4; ++qd) {
            uint2 pk;
            pk.x = pack2(o0[4 * qd] * inv, o0[4 * qd + 1] * inv); pk.y = pack2(o0[4 * qd + 2] * inv, o0[4 * qd + 3] * inv);
            *(uint2*)(act + 8 * qd + 4 * h) = pk;
            pk.x = pack2(o1[4 * qd] * inv, o1[4 * qd + 1] * inv); pk.y = pack2(o1[4 * qd + 2] * inv, o1[4 * qd + 3] * inv);
            *(uint2*)(act + 32 + 8 * qd + 4 * h) = pk;
        }
    }
}

constexpr int SC_LD = 4100;
DI void dsa_index_item(const Ctx& c_in, KArgs& a, int b, int s0) {
    const Ctx c = fresh_ctx(c_in.lds);
    unsigned char* ws = a.ws;
    const u16* proj = (const u16*)(ws + WS_PROJ);
    const float* small = (const float*)(ws + WS_SMALL);
    u64* mask = (u64*)(ws + WS_MASK);
    float* SC = (float*)c.lds;
    unsigned* HIST = (unsigned*)(c.lds + 8 * SC_LD * 4);
    const int l31 = c.lane & 31, h = c.lane >> 5;
    const int tok0 = b * 4096 + s0;
    const int ntile = ((s0 + 7) >> 5) + 1;
    bf16x8 qa[2][4];
    float wv[2][16];
#pragma unroll
    for (int rt = 0; rt < 2; ++rt) {
        const int r = rt * 32 + l31, ql = r >> 3, j = r & 7;
        const u16* p = proj + (size_t)(tok0 + ql) * LDP + PC_IDXQ + j * 64 + h * 8;
#pragma unroll
        for (int ks = 0; ks < 4; ++ks) qa[rt][ks] = *(const bf16x8*)(p + ks * 16);
#pragma unroll
        for (int r2 = 0; r2 < 16; ++r2) {
            const int qq = (r2 >> 2) + 4 * rt, jj = (r2 & 3) + 4 * h;
            wv[rt][r2] = small[(size_t)(tok0 + qq) * 16 + 4 + jj] * 0.044194173824159216f;
        }
    }
    const u16* kbase = proj + (size_t)(b * 4096 + l31) * LDP + PC_IDXK + h * 8;
    bf16x8 kb[4], kn[4];
    if (c.wave < ntile) {
#pragma unroll
        for (int ks = 0; ks < 4; ++ks) kb[ks] = *(const bf16x8*)(kbase + (size_t)(c.wave * 32) * LDP + ks * 16);
    }
    for (int kt = c.wave; kt < ntile; kt += 8) {
        const int key = kt * 32 + l31;
        if (kt + 8 < ntile) {
#pragma unroll
            for (int ks = 0; ks < 4; ++ks) kn[ks] = *(const bf16x8*)(kbase + (size_t)((kt + 8) * 32) * LDP + ks * 16);
        }
        f32x16 a0 = zero16(), a1 = zero16();
#pragma unroll
        for (int ks = 0; ks < 4; ++ks) { a0 = MFMA32(qa[0][ks], kb[ks], a0); a1 = MFMA32(qa[1][ks], kb[ks], a1); }
#pragma unroll
        for (int g = 0; g < 4; ++g) {
            float p0 = 0.f, p1 = 0.f;
#pragma unroll
            for (int r3 = 0; r3 < 4; ++r3) {
                p0 += wv[0][4 * g + r3] * fmaxf(a0[4 * g + r3], 0.f);
                p1 += wv[1][4 * g + r3] * fmaxf(a1[4 * g + r3], 0.f);
            }
            const float t0 = p0 + __shfl_xor(p0, 32);
            const float t1 = p1 + __shfl_xor(p1, 32);
            SC[(4 * h + g) * SC_LD + key] = h ? t1 : t0;
        }
#pragma unroll
        for (int ks = 0; ks < 4; ++ks) kb[ks] = kn[ks];
    }
    __syncthreads();
    {
        const int qi = s0 + c.wave, n = qi + 1;
        const float* sc = SC + c.wave * SC_LD;
        unsigned* hist = HIST + c.wave * 272;
        const int nit = (n + 63) >> 6;
        unsigned key[64];
#pragma unroll
        for (int g = 0; g < 8; ++g) {
#pragma unroll
            for (int j = 0; j < 8; ++j) key[g * 8 + j] = 0u;
            if (g * 8 < nit) {
#pragma unroll
                for (int j = 0; j < 8; ++j) {
                    const int i = (g * 8 + j) * 64 + c.lane;
                    const unsigned bits = __float_as_uint(sc[i] + 0.0f);
                    const unsigned k = bits ^ ((unsigned)((int)bits >> 31) | 0x80000000u);
                    key[g * 8 + j] = (i < n) ? k : 0u;
                }
            }
        }
        unsigned thr = 1u; int cut = 0x7fffffff;
        if (n > 256) {
            unsigned lo = 0xffffffffu, hi = 0u;
#pragma unroll
            for (int g = 0; g < 8; ++g) if (g * 8 < nit) {
#pragma unroll
                for (int j = 0; j < 8; ++j) { const unsigned k = key[g * 8 + j]; hi = max(hi, k); lo = min(lo, k ? k : 0xffffffffu); }
            }
#pragma unroll
            for (int o = 32; o >= 1; o >>= 1) { lo = min(lo, (unsigned)__shfl_xor((int)lo, o)); hi = max(hi, (unsigned)__shfl_xor((int)hi, o)); }
            int kk = 256;
            for (int iter = 0; iter < 5; ++iter) {
                const unsigned width = hi - lo;
                const int shift = max(0, 24 - (int)__clz(width | 1u));
#pragma unroll
                for (int j = 0; j < 5; ++j) { const int idx = c.lane + 64 * j; if (idx < 272) hist[idx] = 0u; }
#pragma unroll
                for (int g = 0; g < 8; ++g) if (g * 8 < nit) {
#pragma unroll
                    for (int j = 0; j < 8; ++j) {
                        const unsigned d = key[g * 8 + j] - lo;
                        if (d <= width) atomicAdd(&hist[d >> shift], 1u);
                    }
                }
                const unsigned c0 = hist[4 * c.lane], c1 = hist[4 * c.lane + 1], c2 = hist[4 * c.lane + 2], c3 = hist[4 * c.lane + 3];
                const unsigned ls = c0 + c1 + c2 + c3;
                unsigned suf = ls;
#pragma unroll
                for (int o = 1; o < 64; o <<= 1) { const unsigned tv = __shfl_down(suf, o); if (c.lane + o < 64) suf += tv; }
                const unsigned above_lane = suf - ls;
                const bool mine = (suf >= (unsigned)kk) && (above_lane < (unsigned)kk);
                int bstar = 0; unsigned above = 0, cntb = 0;
                if (mine) {
                    unsigned run = above_lane;
                    if (run + c3 >= (unsigned)kk) { bstar = 4 * c.lane + 3; above = run; cntb = c3; }
                    else { run += c3;
                        if (run + c2 >= (unsigned)kk) { bstar = 4 * c.lane + 2; above = run; cntb = c2; }
                        else { run += c2;
                            if (run + c1 >= (unsigned)kk) { bstar = 4 * c.lane + 1; above = run; cntb = c1; }
                            else { run += c1; bstar = 4 * c.lane; above = run; cntb = c0; } } }
                }
                const u64 mm = __ballot(mine);
                const int src = __ffsll((long long)mm) - 1;
                bstar = __shfl(bstar, src); above = __shfl(above, src); cntb = __shfl(cntb, src);
                kk -= (int)above;
                const unsigned nlo = lo + ((unsigned)bstar << shift);
                const unsigned nhi = min(hi, nlo + ((1u << shift) - 1u));
                lo = nlo; hi = nhi; thr = lo;
                if ((int)cntb == kk) break;
                if (shift == 0) {
                    int need = kk;
                    for (int it = 0; it < nit; ++it) {
                        const int i = it * 64 + c.lane;
                        unsigned k = 0u;
                        if (i < n) { const unsigned bits = __float_as_uint(sc[i] + 0.0f); k = bits ^ ((unsigned)((int)bits >> 31) | 0x80000000u); }
                        const bool e = (k == thr);
                        const u64 mk = __ballot(e); const int cn = __popcll(mk);
                        if (need <= cn) {
                            const u64 sel = __ballot(e && (__popcll(mk & ((1ull << c.lane) - 1ull)) == need - 1));
                            cut = it * 64 + (__ffsll((long long)sel) - 1);
                            break;
                        }
                        need -= cn;
                    }
                    break;
                }
            }
        }
        u64* mrow = mask + (size_t)(b * 4096 + qi) * 64;
        u64 myword = 0;
        const bool tie = (cut != 0x7fffffff);
#pragma unroll
        for (int it = 0; it < 64; ++it) {
            u64 wd = 0;
            if (it < nit) {
                const unsigned k = key[it];
                bool sel = (k >= thr);
                if (tie) sel = (k > thr) || (k == thr && (it * 64 + c.lane) <= cut);
                wd = __ballot(sel);
            }
            if (c.lane == it) myword = wd;
        }
        mrow[c.lane] = myword;
    }
    __syncthreads();
}

DI void phase_outproj(const Ctx& c_in, KArgs& a, int l) {
    const Ctx c = fresh_ctx(c_in.lds);
    unsigned char* ws = a.ws;
    const u16* act = (const u16*)(ws + WS_ACT);
    const u16* w = (const u16*)(ws + WS_WOUT) + (size_t)l * 1024 * 1024;
    const float* xin = (l == 0) ? a.in[0] : a.out;
    float* out = a.out;
    int R, C; g2_stage_rc(c.tid * 16, R, C);
    const int nunits = (T_TOK / 256) * 4;
    for (int u = vblock(); u < nunits; u += gridDim.x) {
        const int pm = (u >> 4) * 4 + (u & 3), pn = (u >> 2) & 3;
        G2Ptrs g;
        g.ra = g2_rsrc(act); g.rb = g2_rsrc(w);
        g.va00 = (unsigned)(R * 1024 + C) * 2u; g.va01 = g.va00 + 64 * 2048; g.va10 = g.va00 + 128 * 2048; g.va11 = g.va00 + 192 * 2048;
        g.vb0 = g.va00; g.vb1 = g.va01;
        g.sa = (unsigned)pm * (256u * 2048u); g.sb0 = (unsigned)pn * (256u * 2048u); g.sb1 = g.sb0 + 128u * 2048u;
        __syncthreads();
        gemm256_unit(c, g, 1024, [&](const f32x4 (&acc)[2][2][4][2], int wr, int wc, int fr, int fq) {
#pragma unroll
            for (int ai = 0; ai < 2; ++ai)
#pragma unroll
                for (int m = 0; m < 4; ++m) {
                    const size_t rowoff = (size_t)(pm * 256 + ai * 128 + wr * 64 + m * 16 + fr) * 1024 + pn * 256 + wc * 32 + 4 * fq;
#pragma unroll
                    for (int bj = 0; bj < 2; ++bj)
#pragma unroll
                        for (int n = 0; n < 2; ++n) {
                            const f32x4 xv = *(const f32x4*)(xin + rowoff + bj * 128 + n * 16);
                            *(f32x4*)(out + rowoff + bj * 128 + n * 16) = xv + acc[ai][bj][m][n];
                        }
                }
        });
    }
}

constexpr int RT_LD = 1032;
DI void phase_router(const Ctx& c_in, KArgs& a, int l) {
    const Ctx c = fresh_ctx(c_in.lds);
    unsigned char* ws = a.ws;
    const float* x = a.out;
    const float* g = a.in[16] + l * 1024;
    const float* brg = a.in[18] + l * 4;
    const float* bre = a.in[20] + l * 32;
    const u16* wrh = (const u16*)(ws + WS_WRH) + (size_t)l * 64 * 1024;
    const u16* wrl = (const u16*)(ws + WS_WRL) + (size_t)l * 64 * 1024;
    u16* act = (u16*)(ws + WS_ACT);
    int* cnt = (int*)(ws + WS_CTL);
    int* list = (int*)(ws + WS_LIST);
    float* tokw = (float*)(ws + WS_TOKW);
    u16* HI = (u16*)c.lds;
    u16* LO = HI + 32 * RT_LD;
    float* LG = (float*)(c.lds + 2 * 32 * RT_LD * 2);
    const int l31 = c.lane & 31, h = c.lane >> 5;
    for (int it = bid(); it < T_TOK / 32; it += gridDim.x) {
        const int t0 = it * 32;
#pragma unroll
        for (int tt = 0; tt < 4; ++tt) {
            const int tl = c.wave * 4 + tt, t = t0 + tl;
            const float* xr = x + (size_t)t * 1024 + c.lane * 4;
            float4 v[4]; float ss = 0.f;
#pragma unroll
            for (int j = 0; j < 4; ++j) { v[j] = *(const float4*)(xr + 256 * j); ss += v[j].x * v[j].x + v[j].y * v[j].y + v[j].z * v[j].z + v[j].w * v[j].w; }
            ss = wsum(ss);
            const float rs = rsqrtf(ss * (1.f / 1024.f) + EPS);
#pragma unroll
            for (int j = 0; j < 4; ++j) {
                const float4 gg = *(const float4*)(g + c.lane * 4 + 256 * j);
                const float h0 = v[j].x * rs * gg.x, h1 = v[j].y * rs * gg.y, h2 = v[j].z * rs * gg.z, h3 = v[j].w * rs * gg.w;
                const u16 b0 = f2bf(h0), b1 = f2bf(h1), b2 = f2bf(h2), b3 = f2bf(h3);
                const uint2 hp = make_uint2((unsigned)b0 | ((unsigned)b1 << 16), (unsigned)b2 | ((unsigned)b3 << 16));
                const uint2 lp = make_uint2(pack2(h0 - bf2f(b0), h1 - bf2f(b1)), pack2(h2 - bf2f(b2), h3 - bf2f(b3)));
                *(uint2*)(act + (size_t)t * 1024 + c.lane * 4 + 256 * j) = hp;
                *(uint2*)(HI + tl * RT_LD + c.lane * 4 + 256 * j) = hp;
                *(uint2*)(LO + tl * RT_LD + c.lane * 4 + 256 * j) = lp;
            }
        }
        __syncthreads();
        {
            const int k0 = c.wave * 128 + h * 8;
            f32x16 acc0 = zero16(), acc1 = zero16();
#pragma unroll
            for (int ks = 0; ks < 8; ++ks) {
                const int k = k0 + ks * 16;
                const bf16x8 ah = *(const bf16x8*)(HI + l31 * RT_LD + k);
                const bf16x8 al = *(const bf16x8*)(LO + l31 * RT_LD + k);
                const bf16x8 bh0 = *(const bf16x8*)(wrh + (size_t)l31 * 1024 + k);
                const bf16x8 bh1 = *(const bf16x8*)(wrh + (size_t)(32 + l31) * 1024 + k);
                const bf16x8 bl0 = *(const bf16x8*)(wrl + (size_t)l31 * 1024 + k);
                const bf16x8 bl1 = *(const bf16x8*)(wrl + (size_t)(32 + l31) * 1024 + k);
                acc0 = MFMA32(ah, bh0, acc0); acc0 = MFMA32(ah, bl0, acc0); acc0 = MFMA32(al, bh0, acc0);
                acc1 = MFMA32(ah, bh1, acc1); acc1 = MFMA32(ah, bl1, acc1); acc1 = MFMA32(al, bh1, acc1);
            }
            __syncthreads();
            float* PART = (float*)c.lds + c.wave * (32 * 37);
#pragma unroll
            for (int r = 0; r < 16; ++r) {
                PART[crow(r, h) * 37 + l31] = acc0[r];
                if (l31 < 4) PART[crow(r, h) * 37 + 32 + l31] = acc1[r];
            }
        }
        __syncthreads();
        for (int i = c.tid; i < 32 * 36; i += NTHR) {
            const int tk = i / 36, e = i % 36;
            float s = 0.f;
#pragma unroll
            for (int w2 = 0; w2 < 8; ++w2) s += ((const float*)c.lds)[w2 * (32 * 37) + tk * 37 + e];
            LG[tk * 65 + e] = s;
        }
        __syncthreads();
        int* lcnt = (int*)(LG + 32 * 65);
        if (c.tid < 64) lcnt[c.tid] = 0;
        __syncthreads();
        int myL1 = 0, myL2 = 0, r1 = 0, r2 = 0; float w1 = 0.f, w2 = 0.f;
        if (c.tid < 32) {
            const float* lg = LG + c.tid * 65;
            float gl[4];
#pragma unroll
            for (int e = 0; e < 4; ++e) gl[e] = lg[e] + brg[e];
            int gi = 0; float gm = gl[0];
#pragma unroll
            for (int e = 1; e < 4; ++e) if (gl[e] > gm) { gm = gl[e]; gi = e; }
            float den = 0.f;
#pragma unroll
            for (int e = 0; e < 4; ++e) den += __expf(gl[e] - gm);
            const float gp = 1.f / den;
            float el[8];
#pragma unroll
            for (int e = 0; e < 8; ++e) el[e] = lg[4 + gi * 8 + e] + bre[gi * 8 + e];
            int i1 = 0; float v1 = el[0];
#pragma unroll
            for (int e = 1; e < 8; ++e) if (el[e] > v1) { v1 = el[e]; i1 = e; }
            int i2 = 0; float v2 = -INFINITY;
#pragma unroll
            for (int e = 0; e < 8; ++e) if (e != i1 && el[e] > v2) { v2 = el[e]; i2 = e; }
            const float ex = __expf(v2 - v1);
            w1 = gp / (1.f + ex); w2 = gp * ex / (1.f + ex);
            myL1 = (gi * 8 + i1) * 2; myL2 = (gi * 8 + i2) * 2 + 1;
            r1 = atomicAdd(&lcnt[myL1], 1); r2 = atomicAdd(&lcnt[myL2], 1);
        }
        __syncthreads();
        if (c.tid < 64) { const int n = lcnt[c.tid]; lcnt[c.tid] = (n > 0) ? atomicAdd(&cnt[c.tid], n) : 0; }
        __syncthreads();
        if (c.tid < 32) {
            const int t = t0 + c.tid;
            list[(size_t)myL1 * 32768 + lcnt[myL1] + r1] = t;
            list[(size_t)myL2 * 32768 + lcnt[myL2] + r2] = t;
            tokw[t * 2] = w1; tokw[t * 2 + 1] = w2;
        }
        __syncthreads();
    }
}

DI int moe_setup(const Ctx& c, KArgs& a, int ntn, int kfilter, int* tstart  ) {
    const int* cnt = (const int*)(a.ws + WS_CTL);
    if (c.tid < 64) {
        const int L = c.tid;
        const int n = __hip_atomic_load(&cnt[L], __ATOMIC_RELAXED, __HIP_MEMORY_SCOPE_AGENT);
        const int mine = (kfilter < 0 || (L & 1) == kfilter) ? ((n + 255) >> 8) * ntn : 0;
        int inc = mine;
#pragma unroll
        for (int o = 1; o < 64; o <<= 1) { const int tv = __shfl_up(inc, o); if (L >= o) inc += tv; }
        tstart[L] = inc - mine;
        if (L == 63) tstart[64] = inc;
    }
    __syncthreads();
    return tstart[64];
}

constexpr int MOE_LDS_OFF = G2_LDS_BYTES;
DI void phase_moe_up(const Ctx& c_in, KArgs& a) {
    const Ctx c = fresh_ctx(c_in.lds);
    unsigned char* ws = a.ws;
    const u16* act = (const u16*)(ws + WS_ACT);
    const int* cnt = (const int*)(ws + WS_CTL);
    const int* list = (const int*)(ws + WS_LIST);
    const float* tokw = (const float*)(ws + WS_TOKW);
    u16* hmid = (u16*)(ws + WS_HMID);
    int* tstart = (int*)(c.lds + MOE_LDS_OFF);
    int* tok_s = (int*)(c.lds + MOE_LDS_OFF + 512);
    int R, C; g2_stage_rc(c.tid * 16, R, C);
    const int total = moe_setup(c, a, 2, -1, tstart);
    for (int tile = vblock(); tile < total; tile += gridDim.x) {
        int L = 0;
        for (int j = 0; j < 64; ++j) if (tstart[j + 1] <= tile) L = j + 1;
        const int rel = tile - tstart[L], mi = rel >> 1, nt = rel & 1;
        const int e = L >> 1, kr = L & 1;
        const int n = __hip_atomic_load(&cnt[L], __ATOMIC_RELAXED, __HIP_MEMORY_SCOPE_AGENT);
        __syncthreads();
        if (c.tid < 256) { const int r = mi * 256 + c.tid; tok_s[c.tid] = (r < n) ? list[(size_t)L * 32768 + r] : -1; }
        __syncthreads();
        G2Ptrs g;
        g.ra = g2_rsrc(act); g.rb = g2_rsrc(ws + WS_WG);
        { const int t0 = tok_s[R], t1 = tok_s[R + 64], t2 = tok_s[R + 128], t3 = tok_s[R + 192];
          g.va00 = (unsigned)((t0 < 0 ? 0 : t0) * 1024 + C) * 2u; g.va01 = (unsigned)((t1 < 0 ? 0 : t1) * 1024 + C) * 2u;
          g.va10 = (unsigned)((t2 < 0 ? 0 : t2) * 1024 + C) * 2u; g.va11 = (unsigned)((t3 < 0 ? 0 : t3) * 1024 + C) * 2u; }
        g.vb0 = (unsigned)(R * 1024 + C) * 2u; g.vb1 = g.vb0 + 64 * 2048;
        g.sa = 0u; g.sb0 = (unsigned)(e * 256 + nt * 128) * 2048u; g.sb1 = g.sb0 + (unsigned)(WS_WU - WS_WG);
        gemm256_unit(c, g, 1024, [&](const f32x4 (&acc)[2][2][4][2], int wr, int wc, int fr, int fq) {
#pragma unroll
            for (int ai = 0; ai < 2; ++ai)
#pragma unroll
                for (int m = 0; m < 4; ++m) {
                    const int tk = tok_s[ai * 128 + wr * 64 + m * 16 + fr];
                    if (tk >= 0) {
                        const float wgt = tokw[tk * 2 + kr];
                        u16* dst = hmid + ((size_t)tk * 2 + kr) * 256 + nt * 128 + wc * 32 + 4 * fq;
#pragma unroll
                        for (int n2 = 0; n2 < 2; ++n2) {
                            const f32x4 gv = acc[ai][0][m][n2], uv = acc[ai][1][m][n2];
                            uint2 pk;
                            pk.x = pack2(siluf(gv[0]) * uv[0] * wgt, siluf(gv[1]) * uv[1] * wgt);
                            pk.y = pack2(siluf(gv[2]) * uv[2] * wgt, siluf(gv[3]) * uv[3] * wgt);
                            *(uint2*)(dst + n2 * 16) = pk;
                        }
                    }
                }
        });
    }
}

DI void phase_moe_down(const Ctx& c_in, KArgs& a) {
    const Ctx c = fresh_ctx(c_in.lds);
    unsigned char* ws = a.ws;
    const int* cnt = (const int*)(ws + WS_CTL);
    const int* list = (const int*)(ws + WS_LIST);
    const u16* hmid = (const u16*)(ws + WS_HMID);
    u16* yffn = (u16*)(ws + WS_YFFN);
    int* tstart = (int*)(c.lds + MOE_LDS_OFF);
    int* tok_s = (int*)(c.lds + MOE_LDS_OFF + 512);
    int R, C; g2_stage_rc(c.tid * 16, R, C);
    const int total = moe_setup(c, a, 4, -1, tstart);
    for (int tile = vblock(); tile < total; tile += gridDim.x) {
        int L = 0;
        for (int j = 0; j < 64; ++j) if (tstart[j + 1] <= tile) L = j + 1;
        const int rel = tile - tstart[L], mi = rel >> 2, nt = rel & 3;
        const int e = L >> 1, kr = L & 1;
        const int n = __hip_atomic_load(&cnt[L], __ATOMIC_RELAXED, __HIP_MEMORY_SCOPE_AGENT);
        __syncthreads();
        if (c.tid < 256) { const int r = mi * 256 + c.tid; tok_s[c.tid] = (r < n) ? list[(size_t)L * 32768 + r] : -1; }
        __syncthreads();
        G2Ptrs g;
        g.ra = g2_rsrc(hmid); g.rb = g2_rsrc(ws + WS_WD);
        { const int t0 = tok_s[R], t1 = tok_s[R + 64], t2 = tok_s[R + 128], t3 = tok_s[R + 192];
          g.va00 = (unsigned)(((t0 < 0 ? 0 : t0) * 2 + kr) * 256 + C) * 2u; g.va01 = (unsigned)(((t1 < 0 ? 0 : t1) * 2 + kr) * 256 + C) * 2u;
          g.va10 = (unsigned)(((t2 < 0 ? 0 : t2) * 2 + kr) * 256 + C) * 2u; g.va11 = (unsigned)(((t3 < 0 ? 0 : t3) * 2 + kr) * 256 + C) * 2u; }
        g.vb0 = (unsigned)(R * 256 + C) * 2u; g.vb1 = g.vb0 + 64 * 512;
        g.sa = 0u; g.sb0 = (unsigned)(e * 1024 + nt * 256) * 512u; g.sb1 = g.sb0 + 128u * 512u;
        gemm256_unit(c, g, 256, [&](const f32x4 (&acc)[2][2][4][2], int wr, int wc, int fr, int fq) {
#pragma unroll
            for (int ai = 0; ai < 2; ++ai)
#pragma unroll
                for (int m = 0; m < 4; ++m) {
                    const int tk = tok_s[ai * 128 + wr * 64 + m * 16 + fr];
                    if (tk >= 0) {
                        u16* dst = yffn + ((size_t)tk * 2 + kr) * 1024 + nt * 256 + wc * 32 + 4 * fq;
#pragma unroll
                        for (int bj = 0; bj < 2; ++bj)
#pragma unroll
                            for (int n2 = 0; n2 < 2; ++n2) {
                                const f32x4 v = acc[ai][bj][m][n2];
                                uint2 pk; pk.x = pack2(v[0], v[1]); pk.y = pack2(v[2], v[3]);
                                *(uint2*)(dst + bj * 128 + n2 * 16) = pk;
                            }
                    }
                }
        });
    }
}

DI void phase_final(const Ctx& c_in, KArgs& a) {
    const Ctx c = fresh_ctx(c_in.lds);
    float* x = a.out;
    const float* g = a.in[24];
    for (int it = bid(); it < T_TOK / 8; it += gridDim.x) {
        const int t = it * 8 + c.wave;
        float* xr = x + (size_t)t * 1024;
        float v[16]; float ss = 0.f;
        const u16* y0 = (const u16*)(a.ws + WS_YFFN) + (size_t)t * 2048;
#pragma unroll
        for (int j = 0; j < 16; ++j) { v[j] = xr[c.lane + 64 * j] + bf2f(y0[c.lane + 64 * j]) + bf2f(y0[1024 + c.lane + 64 * j]); ss += v[j] * v[j]; }
        ss = wsum(ss);
        const float rs = rsqrtf(ss * (1.f / 1024.f) + EPS);
#pragma unroll
        for (int j = 0; j < 16; ++j) xr[c.lane + 64 * j] = v[j] * rs * g[c.lane + 64 * j];
    }
}

#define XB_TMO      128
#define XB_XCNT(j)  (256  + 64 * (j))
#define XB_XSUB(j)  (1280 + 64 * (j))
#define XB_XGEN(j)  (2304 + 64 * (j))
#define XB_TOP      3328
#define XB_TOPGEN   3392
#define XCD_BAR_WORDS 3456
#define XB_SPIN_CAP (1u << 22)
#define LAS __attribute__((address_space(3)))
DI unsigned xb_ld(unsigned* p)              { return __hip_atomic_load(p, __ATOMIC_RELAXED, __HIP_MEMORY_SCOPE_AGENT); }
DI unsigned xb_add(unsigned* p, unsigned v) { return __hip_atomic_fetch_add(p, v, __ATOMIC_RELAXED, __HIP_MEMORY_SCOPE_AGENT); }
DI unsigned xb_xcc_id() { return (unsigned)__builtin_amdgcn_s_getreg((3 << 11) | 20) & 0xFu; }
#define XB_SPIN(cond, bar) do { unsigned _sp = 0; while (cond) { __builtin_amdgcn_s_sleep(1); \
    if ((++_sp & 255u) == 0u) { if (xb_ld(&(bar)[XB_TMO])) break; if (_sp > XB_SPIN_CAP) { atomicAdd(&(bar)[XB_TMO], 1u); break; } } } } while (0)
struct XcdBarrier { unsigned* bar; unsigned x; volatile LAS unsigned* st; };
DI XcdBarrier xcd_barrier_post(unsigned* bar, volatile LAS unsigned* st) {
    XcdBarrier b; b.bar = bar; b.x = xb_xcc_id(); b.st = st;
    if (threadIdx.x == 0) (void)xb_add(&bar[XB_XCNT(b.x)], 1u);
    return b;
}
DI void xcd_barrier_complete(unsigned* bar, unsigned x, unsigned& nloc, unsigned& nx) {
    const unsigned G = gridDim.x * gridDim.y * gridDim.z;
    unsigned sum, cnt, mine, sp = 0u;
    for (;;) {
        sum = 0u; cnt = 0u; mine = 0u;
#pragma unroll
        for (unsigned j = 0; j < 16; ++j) { const unsigned cc = xb_ld(&bar[XB_XCNT(j)]); sum += cc; cnt += (cc > 0u) ? 1u : 0u; mine = (j == x) ? cc : mine; }
        if (sum == G) break;
        __builtin_amdgcn_s_sleep(1);
        if ((++sp & 255u) == 0u) { if (xb_ld(&bar[XB_TMO])) break; if (sp > XB_SPIN_CAP) { atomicAdd(&bar[XB_TMO], 1u); break; } }
    }
    nloc = mine > 0u ? mine : 1u; nx = cnt > 0u ? cnt : 1u;
}
DI void xcd_barrier(const XcdBarrier& b) {
    asm volatile("s_waitcnt vmcnt(0)" ::: "memory");
    __syncthreads();
    if (threadIdx.x == 0) {
        unsigned* bar = b.bar;
        __builtin_amdgcn_s_waitcnt(0);
        unsigned nloc = b.st[0], nx = b.st[1];
        if (nloc == 0u) { xcd_barrier_complete(bar, b.x, nloc, nx); b.st[0] = nloc; b.st[1] = nx; }
        const unsigned old = xb_add(&bar[XB_XSUB(b.x)], 1u);
        const unsigned gen = old / nloc;
        if (old + 1u == (gen + 1u) * nloc) {
            __builtin_amdgcn_fence(__ATOMIC_RELEASE, "agent");
            asm volatile("s_waitcnt vmcnt(0)" ::: "memory");
            const unsigned og = xb_add(&bar[XB_TOP], 1u);
            const unsigned tg = og / nx;
            if (og + 1u == (tg + 1u) * nx) xb_add(&bar[XB_TOPGEN], 1u);
            else XB_SPIN(xb_ld(&bar[XB_TOPGEN]) == tg, bar);
            __builtin_amdgcn_fence(__ATOMIC_ACQUIRE, "agent");
            xb_add(&bar[XB_XGEN(b.x)], 1u);
            asm volatile("s_waitcnt vmcnt(0)" ::: "memory");
        } else {
            XB_SPIN(xb_ld(&bar[XB_XGEN(b.x)]) == gen, bar);
            __builtin_amdgcn_fence(__ATOMIC_ACQUIRE, "agent");
            asm volatile("s_waitcnt vmcnt(0)" ::: "memory");
        }
    }
    __syncthreads();
}

template <int SP>
DI void run_phase(const Ctx& c, KArgs& a, int l) {
    if constexpr (SP == 11) phase_prep(c, a);
    else if constexpr (SP == 12) phase_final(c, a);
    else if constexpr (SP == 0) phase_norm_in(c, a, l);
    else if constexpr (SP == 1) phase_inproj(c, a, l);
    else if constexpr (SP == 2) {
        const int n_ssd = 256, n_q = 128 * 3, n_kv = 128 * 4;
        for (int it = bid(); it < n_ssd + n_q + n_kv; it += gridDim.x) {
            if (it < n_ssd) ssd_state_item(c, a, l, it);
            else if (it < n_ssd + n_q) mla_up_item(c, a, l, 0, it - n_ssd);
            else mla_up_item(c, a, l, 1, it - n_ssd - n_q);
        }
    }
    else if constexpr (SP == 3) { for (int it = bid(); it < 512; it += gridDim.x) ssd_scan_item(c, a, it); }
    else if constexpr (SP == 4) {
        int* ctr = (int*)(a.ws + WS_CTL) + 256 + l;
        volatile int* s_item = (volatile int*)(c.lds + LDS_BYTES - 32);
        for (;;) {
            __syncthreads();
            if (threadIdx.x == 0) *s_item = atomicAdd(ctr, 1);
            __syncthreads();
            const int it = *s_item;
            if (it >= 1024 + 512 + 256 + 768) break;
            if (it < 1024) {
                const int j = 15 - (it >> 6), r = it & 63;
                if (r >= 8 && r < 40) { const int rem = r - 8; attn_item<96, 0>(c, a, l, rem >> 2, rem & 3, j); }
                else {
                    const int sub = (r < 8) ? 3 : 2 - ((r - 40) >> 3);
                    const int b = r & 7, qb = 4 * j + sub;
                    for (int g8 = 0; g8 < 8; ++g8) dsa_index_item(c, a, b, qb * 64 + g8 * 8);
                    asm volatile("s_waitcnt vmcnt(0)" ::: "memory");
                    __syncthreads();
                    attn_item<64, 2>(c, a, l, b, 0, qb);
                }
            } else if (it < 1536) { const int i2 = it - 1024; attn_item<64, 1>(c, a, l, (i2 & 31) >> 2, i2 & 3, 15 - (i2 >> 5)); }
            else if (it < 1792) ssd_out_item(c, a, l, it - 1536);
            else { const Ctx cc = fresh_ctx(c.lds); for (int k = 0; k < 8; ++k) expert_conv_tile(cc, a, l, (it - 1792) * 8 + k); }
        }
    }
    else if constexpr (SP == 5) phase_outproj(c, a, l);
    else if constexpr (SP == 6) phase_router(c, a, l);
    else if constexpr (SP == 7) phase_moe_up(c, a);
    else if constexpr (SP == 8) phase_moe_down(c, a);
}

#ifndef ONE_LAUNCH
#define ONE_LAUNCH 1
#endif

#if ONE_LAUNCH
__global__ void __launch_bounds__(NTHR) mega(Args a_unused) {
    extern __shared__ __attribute__((aligned(16))) unsigned char lds[];
    cg::grid_group grid = cg::this_grid();
    Ctx c; c.tid = threadIdx.x; c.lane = c.tid & 63; c.wave = 0; c.lds = lds;
    volatile LAS unsigned* st = (volatile LAS unsigned*)(lds + LDS_BYTES - 16);
    if (threadIdx.x == 0) { st[0] = 0u; st[1] = 0u; }
    __syncthreads();
    XcdBarrier bar = xcd_barrier_post((unsigned*)(a_unused.ws + WS_BAR), st);
#ifdef PROBE_SP
#define MEGA_PHASE(SPN, L) do { KArgs* kp_ = (KArgs*)__builtin_amdgcn_kernarg_segment_ptr(); asm volatile("" : "+s"(kp_)); \
        const unsigned long long pt0_ = __builtin_amdgcn_s_memrealtime(); run_phase<SPN>(c, *kp_, (L)); \
        if (SPN == PROBE_SP) { xcd_barrier(bar); const unsigned long long pt1_ = __builtin_amdgcn_s_memrealtime(); \
            while (__builtin_amdgcn_s_memrealtime() - pt1_ < (pt1_ - pt0_)) __builtin_amdgcn_s_sleep(8); } } while (0)
#else
#define MEGA_PHASE(SPN, L) do { KArgs* kp_ = (KArgs*)__builtin_amdgcn_kernarg_segment_ptr(); asm volatile("" : "+s"(kp_)); run_phase<SPN>(c, *kp_, (L)); } while (0)
#endif
    MEGA_PHASE(11, 0);
    grid.sync();
#pragma unroll 1
    for (int l = 0; l < DEPTH; ++l) {
        if (l > 0) xcd_barrier(bar);
        MEGA_PHASE(0, l); xcd_barrier(bar);
        MEGA_PHASE(1, l); xcd_barrier(bar);
        MEGA_PHASE(2, l); xcd_barrier(bar);
        MEGA_PHASE(3, l); xcd_barrier(bar);
        MEGA_PHASE(4, l); xcd_barrier(bar);
        MEGA_PHASE(5, l); xcd_barrier(bar);
        MEGA_PHASE(6, l); xcd_barrier(bar);
        MEGA_PHASE(7, l); xcd_barrier(bar);
        MEGA_PHASE(8, l);
    }
    xcd_barrier(bar);
    MEGA_PHASE(12, 0);
}
#else
template <int SP>
__global__ void __launch_bounds__(NTHR) kphase(Args a, int l) {
    extern __shared__ __attribute__((aligned(16))) unsigned char lds[];
    Ctx c; c.tid = threadIdx.x; c.lane = c.tid & 63; c.wave = __builtin_amdgcn_readfirstlane(c.tid >> 6); c.lds = lds;
    KArgs* kp = (KArgs*)__builtin_amdgcn_kernarg_segment_ptr();
    run_phase<SP>(c, *kp, l);
}
template <int SP>
static void launch_phase(const Args& a, int l, int grid, hipStream_t stream) {
    static bool attr_set = false;
    if (!attr_set) { (void)hipFuncSetAttribute((const void*)kphase<SP>, hipFuncAttributeMaxDynamicSharedMemorySize, LDS_BYTES); attr_set = true; }
    hipLaunchKernelGGL(kphase<SP>, dim3(grid), dim3(NTHR), LDS_BYTES, stream, a, l);
}
#endif

extern "C" void kernel_launch(void* const* d_in, const int* in_sizes, int n_in, void* d_out, int out_size, void* d_ws, size_t ws_size, hipStream_t stream) {
    static int grid = 0;
    if (grid == 0) {
        if (n_in != 25 || ws_size < WS_END) { fprintf(stderr, "kernel_launch: unexpected inputs (n_in %d, ws %zu, need %zu)\n", n_in, ws_size, (size_t)WS_END); grid = -1; return; }
        int dev = 0, cus = 0;
        (void)hipGetDevice(&dev);
        (void)hipDeviceGetAttribute(&cus, hipDeviceAttributeMultiprocessorCount, dev);
        if (cus <= 0) cus = 256;
#if ONE_LAUNCH
        int per_cu = 0;
        if (hipFuncSetAttribute((const void*)mega, hipFuncAttributeMaxDynamicSharedMemorySize, LDS_BYTES) != hipSuccess) { fprintf(stderr, "kernel_launch: hipFuncSetAttribute failed\n"); grid = -1; return; }
        if (hipOccupancyMaxActiveBlocksPerMultiprocessor(&per_cu, (const void*)mega, NTHR, LDS_BYTES) != hipSuccess || per_cu < 1) { fprintf(stderr, "kernel_launch: occupancy query says %d blocks per CU\n", per_cu); (void)hipGetLastError(); grid = -1; return; }
        grid = cus;
#else
        grid = cus;
#endif
    }
    if (grid < 0) return;
    Args a{};
    for (int i = 0; i < 25; ++i) a.in[i] = (const float*)d_in[i];
    a.out = (float*)d_out; a.ws = (unsigned char*)d_ws;
    for (int i = 0; i < 8; ++i) a.inv16[i] = (float)pow(500000.0, -(double)i / 8.0);
    for (int i = 0; i < 16; ++i) a.inv32[i] = (float)pow(500000.0, -(double)i / 16.0);
    a.ph_lo = 0; a.ph_hi = 0;
#if ONE_LAUNCH
    (void)hipMemsetAsync((unsigned char*)d_ws + WS_CTL, 0, WS_CTL_BYTES, stream);
    void* kargs[] = { &a };
    hipError_t e = hipLaunchCooperativeKernel((const void*)mega, dim3(grid), dim3(NTHR), kargs, LDS_BYTES, stream);
    if (e != hipSuccess) fprintf(stderr, "kernel_launch: cooperative launch failed: %s (grid %d)\n", hipGetErrorString(e), grid);
#else
    launch_phase<11>(a, 0, grid, stream);
    for (int l = 0; l < DEPTH; ++l) {
        launch_phase<0>(a, l, grid, stream);
        launch_phase<1>(a, l, grid, stream);
        launch_phase<2>(a, l, grid, stream);
        launch_phase<3>(a, l, grid, stream);
        launch_phase<4>(a, l, grid, stream);
        launch_phase<5>(a, l, grid, stream);
        launch_phase<6>(a, l, grid, stream);
        launch_phase<7>(a, l, grid, stream);
        launch_phase<8>(a, l, grid, stream);
    }
    launch_phase<12>(a, 0, grid, stream);
#endif
}
```

```cpp
#include <hip/hip_runtime.h>
#include <hip/hip_cooperative_groups.h>
#include <cstdio>
#include <cmath>
#include <cstdint>


namespace cg = cooperative_groups;

typedef __attribute__((ext_vector_type(8))) short bf16x8;
typedef __attribute__((ext_vector_type(4))) short bf16x4;
typedef __attribute__((ext_vector_type(16))) float f32x16;
typedef unsigned short u16;
typedef unsigned long long u64;

#define DI __device__ __forceinline__
#define MFMA32(a, b, c) __builtin_amdgcn_mfma_f32_32x32x16_bf16((a), (b), (c), 0, 0, 0)

constexpr int T_TOK = 32768, SEQ = 4096, NB = 8, DM = 1024, DEPTH = 2;
constexpr int NREF = 3184;
constexpr int NPAD = 3328;
constexpr int LDP = 2848;
constexpr int PC_Z = 0, PC_XBC = 256, PC_DSAQ = 1024, PC_DSAK = 1280, PC_IDXQ = 1344, PC_IDXK = 1856,
              PC_CQ = 1920, PC_CKV = 2176, PC_KR = 2304, PC_FOXQ = 2336, PC_FOXK = 2592;
constexpr int NC_DSAV = 2848, NC_FOXV = 2912, NC_SMALL = 3168;
constexpr float EPS = 1e-6f;
constexpr float LOG2E = 1.4426950408889634f;
constexpr int NTHR = 512;
constexpr int LDS_BYTES = 147456;

constexpr size_t al256(size_t x) { return (x + 255) & ~(size_t)255; }
constexpr size_t WS_CTL   = 0;
constexpr size_t WS_BAR   = 4096;
constexpr size_t WS_CTL_BYTES = 32768;
constexpr size_t WS_WIN   = 32768;
constexpr size_t WS_WUQ   = WS_WIN  + (size_t)2 * NPAD * 1024 * 2;
constexpr size_t WS_WUKV  = WS_WUQ  + (size_t)2 * 384 * 256 * 2;
constexpr size_t WS_WOUT  = WS_WUKV + (size_t)2 * 512 * 128 * 2;
constexpr size_t WS_WG    = WS_WOUT + (size_t)2 * 1024 * 1024 * 2;
constexpr size_t WS_WU    = WS_WG   + (size_t)32 * 256 * 1024 * 2;
constexpr size_t WS_WD    = WS_WU   + (size_t)32 * 256 * 1024 * 2;
constexpr size_t WS_TRIG  = WS_WD   + (size_t)32 * 256 * 1024 * 2;
constexpr size_t WS_ACT   = WS_TRIG + (size_t)T_TOK * 48 * 4;
constexpr size_t WS_PROJ  = WS_ACT  + (size_t)T_TOK * 1024 * 2;
constexpr size_t WS_SMALL = WS_PROJ + (size_t)T_TOK * LDP * 2;
constexpr size_t WS_MLAQ  = WS_SMALL + (size_t)T_TOK * 16 * 4;
constexpr size_t WS_MLAK  = WS_MLAQ + (size_t)T_TOK * 384 * 2;
constexpr size_t WS_MLAVT = WS_MLAK + (size_t)T_TOK * 384 * 2;
constexpr size_t WS_DSAVT = WS_MLAVT + (size_t)T_TOK * 256 * 2;
constexpr size_t WS_FOXVT = WS_DSAVT + (size_t)T_TOK * 64 * 2;
constexpr size_t WS_FLOG  = WS_FOXVT + (size_t)T_TOK * 256 * 2;
constexpr size_t WS_CS    = WS_FLOG + (size_t)T_TOK * 4 * 4;
constexpr size_t WS_CDEC  = WS_CS   + (size_t)8 * 32 * 4 * 64 * 128 * 4;
constexpr size_t WS_MASK  = WS_CDEC + 4096;
constexpr size_t WS_TOKW  = WS_MASK + (size_t)T_TOK * 64 * 8;
constexpr size_t WS_WRH   = WS_TOKW + (size_t)T_TOK * 2 * 4;
constexpr size_t WS_WRL   = WS_WRH + (size_t)2 * 64 * 1024 * 2;
constexpr size_t WS_KF    = WS_WRL + (size_t)2 * 64 * 1024 * 2;
constexpr size_t WS_END   = WS_KF + (size_t)T_TOK * 64 * 2;
constexpr size_t WS_LIST  = WS_PROJ;
constexpr size_t WS_HMID  = WS_PROJ + (size_t)64 * 32768 * 4;
constexpr size_t WS_YFFN  = WS_HMID + (size_t)T_TOK * 512 * 2;
static_assert(WS_YFFN + (size_t)T_TOK * 2048 * 2 <= WS_SMALL, "aliases must fit in PROJ");
static_assert(WS_END <= (size_t)512 * 1024 * 1024, "workspace budget");

struct Args {
    const float* in[25];
    float* out;
    unsigned char* ws;
    float inv16[8];
    float inv32[16];
    int ph_lo, ph_hi;
};

typedef const __attribute__((address_space(4))) Args KArgs;
struct Ctx { int tid, lane, wave; unsigned char* lds; };
__device__ __forceinline__ Ctx fresh_ctx(unsigned char* lds) {
    int t = threadIdx.x; asm volatile("" : "+v"(t));
    Ctx c; c.tid = t; c.lane = t & 63; c.wave = __builtin_amdgcn_readfirstlane(t >> 6); c.lds = lds; return c;
}

typedef __attribute__((ext_vector_type(2))) float f32x2;
typedef __attribute__((ext_vector_type(2))) __bf16 bf16x2_t;
DI u16 f2bf(float x) { return __builtin_bit_cast(u16, (__bf16)x); }
DI float bf2f(u16 h) { return __uint_as_float(((unsigned)h) << 16); }
DI unsigned pack2(float a, float b) { f32x2 v = {a, b}; return __builtin_bit_cast(unsigned, __builtin_convertvector(v, bf16x2_t)); }
DI float ex2(float x) { return __builtin_amdgcn_exp2f(x); }
DI float relu_raw(float x) { float r; asm("v_max_f32 %0, 0, %1" : "=v"(r) : "v"(x)); return r; }
DI float max3f(float a, float b, float c) { float r; asm("v_max3_f32 %0, %1, %2, %3" : "=v"(r) : "v"(a), "v"(b), "v"(c)); return r; }
DI float wsum(float v) { for (int o = 32; o >= 1; o >>= 1) v += __shfl_xor(v, o); return v; }
DI float wmaxf(float v) { for (int o = 32; o >= 1; o >>= 1) v = fmaxf(v, __shfl_xor(v, o)); return v; }
DI float wminf(float v) { for (int o = 32; o >= 1; o >>= 1) v = fminf(v, __shfl_xor(v, o)); return v; }
DI float siluf(float x) { return x / (1.f + __expf(-x)); }
DI float softplusf(float x) { return fmaxf(x, 0.f) + log1pf(__expf(-fabsf(x))); }
DI int crow(int reg, int h) { return (reg & 3) + 8 * (reg >> 2) + 4 * h; }
DI bf16x8 pack8(const f32x16& x, int s) {
    uint4 p;
    p.x = pack2(x[8 * s + 0], x[8 * s + 1]); p.y = pack2(x[8 * s + 2], x[8 * s + 3]);
    p.z = pack2(x[8 * s + 4], x[8 * s + 5]); p.w = pack2(x[8 * s + 6], x[8 * s + 7]);
    return __builtin_bit_cast(bf16x8, p);
}
DI f32x16 zero16() { f32x16 z; for (int i = 0; i < 16; ++i) z[i] = 0.f; return z; }

DI int ref_col(int n) {
    if (n < 1024) return n;
    if (n < 1280) return n - 1024 + 1028;
    if (n < 1344) return n - 1280 + 1284;
    if (n < 1856) return n - 1344 + 1412;
    if (n < 1920) return n - 1856 + 1924;
    if (n < 2176) return n - 1920 + 1996;
    if (n < 2304) return n - 2176 + 2252;
    if (n < 2336) return n - 2304 + 2380;
    if (n < 2592) return n - 2336 + 2412;
    if (n < 2848) return n - 2592 + 2668;
    if (n < 2912) return n - 2848 + 1348;
    if (n < 3168) return n - 2912 + 2924;
    if (n < 3172) return n - 3168 + 1024;
    if (n < 3180) return n - 3172 + 1988;
    if (n < 3184) return n - 3180 + 3180;
    return -1;
}

DI int bid() { int b = blockIdx.x; asm volatile("" : "+s"(b)); return b; }
DI int vblock() { const int G = gridDim.x, bx = bid(); return (G % 8 == 0) ? (bx % 8) * (G / 8) + bx / 8 : bx; }

constexpr int G_LDT = 72;
constexpr int G_AEL = 256 * G_LDT, G_BEL = 128 * G_LDT, G_STEL = G_AEL + G_BEL;
constexpr int G_LDS_BYTES = 2 * G_STEL * 2;

struct GP { const u16 *a0, *a1, *a2, *a3, *b0, *b1; };

template <bool PAIRED>
DI void gemm_core(const Ctx& c, int K, const GP& gp, f32x16 (&acc)[2][2]) {
    u16* S = (u16*)c.lds;
    const int r8 = c.tid >> 3, kc = c.tid & 7;
    const int wm = c.wave & 3, wn = c.wave >> 2, l31 = c.lane & 31, h = c.lane >> 5;
    const int nb0 = PAIRED ? wn * 32 : wn * 64, nb1 = PAIRED ? 64 + wn * 32 : wn * 64 + 32;
    uint4 ra0, ra1, ra2, ra3, rb0, rb1;
    uint4 sa0, sa1, sa2, sa3, sb0, sb1;
    const int nk = K >> 6;
#define G_LOAD(P, KOFF) do { \
        P##a0 = *(const uint4*)(gp.a0 + (KOFF) + kc * 8); P##a1 = *(const uint4*)(gp.a1 + (KOFF) + kc * 8); \
        P##a2 = *(const uint4*)(gp.a2 + (KOFF) + kc * 8); P##a3 = *(const uint4*)(gp.a3 + (KOFF) + kc * 8); \
        P##b0 = *(const uint4*)(gp.b0 + (KOFF) + kc * 8); P##b1 = *(const uint4*)(gp.b1 + (KOFF) + kc * 8); } while (0)
#define G_STORE(P, SP) do { u16* sp_ = (SP); \
        *(uint4*)(sp_ + (r8) * G_LDT + kc * 8) = P##a0; *(uint4*)(sp_ + (r8 + 64) * G_LDT + kc * 8) = P##a1; \
        *(uint4*)(sp_ + (r8 + 128) * G_LDT + kc * 8) = P##a2; *(uint4*)(sp_ + (r8 + 192) * G_LDT + kc * 8) = P##a3; \
        *(uint4*)(sp_ + G_AEL + (r8) * G_LDT + kc * 8) = P##b0; *(uint4*)(sp_ + G_AEL + (r8 + 64) * G_LDT + kc * 8) = P##b1; } while (0)
#define G_COMPUTE_KS(ST, KS0, KS1) do { \
        const u16* As = S + (ST) * G_STEL; const u16* Bs = As + G_AEL; \
        _Pragma("unroll") for (int ks = (KS0); ks < (KS1); ++ks) { \
            const bf16x8 a0 = *(const bf16x8*)(As + (wm * 64 + l31) * G_LDT + ks * 16 + h * 8); \
            const bf16x8 a1 = *(const bf16x8*)(As + (wm * 64 + 32 + l31) * G_LDT + ks * 16 + h * 8); \
            const bf16x8 b0 = *(const bf16x8*)(Bs + (nb0 + l31) * G_LDT + ks * 16 + h * 8); \
            const bf16x8 b1 = *(const bf16x8*)(Bs + (nb1 + l31) * G_LDT + ks * 16 + h * 8); \
            acc[0][0] = MFMA32(a0, b0, acc[0][0]); acc[0][1] = MFMA32(a0, b1, acc[0][1]); \
            acc[1][0] = MFMA32(a1, b0, acc[1][0]); acc[1][1] = MFMA32(a1, b1, acc[1][1]); } } while (0)
    G_LOAD(r, 0);
    G_STORE(r, S);
    if (nk > 1) G_LOAD(r, 64);
    __syncthreads();
    for (int kt = 0; kt < nk; kt += 2) {
        if (kt + 2 < nk) G_LOAD(s, (kt + 2) * 64);
        G_COMPUTE_KS(0, 0, 1);
        if (kt + 1 < nk) G_STORE(r, S + G_STEL);
        G_COMPUTE_KS(0, 1, 4);
        __syncthreads();
        if (kt + 1 >= nk) break;
        if (kt + 3 < nk) G_LOAD(r, (kt + 3) * 64);
        G_COMPUTE_KS(1, 0, 1);
        if (kt + 2 < nk) G_STORE(s, S);
        G_COMPUTE_KS(1, 1, 4);
        __syncthreads();
    }
#undef G_LOAD
#undef G_STORE
#undef G_COMPUTE_KS
}

typedef __attribute__((ext_vector_type(4))) float f32x4;
#define LAS3 __attribute__((address_space(3)))
constexpr int G2_HTB = 128 * 64 * 2;
constexpr int G2_LDS_BYTES = 8 * G2_HTB;
DI int g2_lds_byte(int r, int cc0) { const int st = (r >> 4) * 2 + (cc0 >> 5), rr = r & 15, cc = cc0 & 31, ob = rr * 64 + cc * 2; return st * 1024 + (ob ^ (((ob >> 9) & 1) << 5)); }
DI void g2_stage_rc(int b, int& R, int& C) { const int st = b / 1024, sb = b % 1024, swz = sb ^ (((sb >> 9) & 1) << 5); R = (st >> 1) * 16 + swz / 64; C = (st & 1) * 32 + (swz % 64) / 2; }

struct G2Ptrs { __amdgpu_buffer_rsrc_t ra, rb; unsigned va00, va01, va10, va11, vb0, vb1; unsigned sa, sb0, sb1; };
DI __amdgpu_buffer_rsrc_t g2_rsrc(const void* p) { return __builtin_amdgcn_make_buffer_rsrc((void*)p, 0, 0x7ffffff0, 0x00020000); }

template <class EPI>
DI void gemm256_unit(const Ctx& c, const G2Ptrs& g, int K, EPI&& epi) {
    LAS3 unsigned char* lds = (LAS3 unsigned char*)c.lds;
    const int wid = c.wave, lane = c.lane, wr = wid >> 2, wc = wid & 3, fr = lane & 15, fq = lane >> 4;
    const unsigned ldsw = (unsigned)wid * 1024u;
    const int aoff = g2_lds_byte(wr * 64 + fr, fq * 8), boff = g2_lds_byte(wc * 32 + fr, fq * 8);
#define G2_SA(b, h) (((b) * 2 + (h)) * G2_HTB)
#define G2_SB(b, h) ((4 + (b) * 2 + (h)) * G2_HTB)
#define G2_STAGE(bufoff, rs, v0, v1, so) do { \
        __builtin_amdgcn_raw_ptr_buffer_load_lds((rs), (LAS3 unsigned*)(lds + (bufoff) + ldsw), 16, (v0), (so), 0, 0); \
        __builtin_amdgcn_raw_ptr_buffer_load_lds((rs), (LAS3 unsigned*)(lds + (bufoff) + ldsw + 8192), 16, (v1), (so), 0, 0); } while (0)
#define G2_STA0(b, kt) G2_STAGE(G2_SA(b, 0), g.ra, g.va00, g.va01, g.sa + (unsigned)(kt) * 128u)
#define G2_STA1(b, kt) G2_STAGE(G2_SA(b, 1), g.ra, g.va10, g.va11, g.sa + (unsigned)(kt) * 128u)
#define G2_STB0(b, kt) G2_STAGE(G2_SB(b, 0), g.rb, g.vb0, g.vb1, g.sb0 + (unsigned)(kt) * 128u)
#define G2_STB1(b, kt) G2_STAGE(G2_SB(b, 1), g.rb, g.vb0, g.vb1, g.sb1 + (unsigned)(kt) * 128u)
#define G2_LDA(dst, b, h) do { _Pragma("unroll") for (int m = 0; m < 4; ++m) _Pragma("unroll") for (int k = 0; k < 2; ++k) dst[m][k] = *(const LAS3 bf16x8*)(lds + G2_SA(b, h) + aoff + m * 2048 + k * 1024); } while (0)
#define G2_LDB(dst, b, h) do { _Pragma("unroll") for (int n = 0; n < 2; ++n) _Pragma("unroll") for (int k = 0; k < 2; ++k) dst[n][k] = *(const LAS3 bf16x8*)(lds + G2_SB(b, h) + boff + n * 2048 + k * 1024); } while (0)
#define G2_MMA(ai, bj, At_, Bt_) do { __builtin_amdgcn_s_setprio(1); \
        _Pragma("unroll") for (int m = 0; m < 4; ++m) _Pragma("unroll") for (int n = 0; n < 2; ++n) _Pragma("unroll") for (int k = 0; k < 2; ++k) \
            acc[ai][bj][m][n] = __builtin_amdgcn_mfma_f32_16x16x32_bf16(Bt_[n][k], At_[m][k], acc[ai][bj][m][n], 0, 0, 0); \
        __builtin_amdgcn_s_setprio(0); } while (0)
#define G2_WAIT_V(n) asm volatile("s_waitcnt vmcnt(" #n ")" ::: "memory")
#define G2_WAIT_L(n) asm volatile("s_waitcnt lgkmcnt(" #n ")" ::: "memory")
#define G2_BAR __builtin_amdgcn_s_barrier()
#define G2_SCHED __builtin_amdgcn_sched_barrier(0)
    f32x4 acc[2][2][4][2];
#pragma unroll
    for (int i0 = 0; i0 < 2; ++i0)
#pragma unroll
        for (int i1 = 0; i1 < 2; ++i1)
#pragma unroll
            for (int i2 = 0; i2 < 4; ++i2)
#pragma unroll
                for (int i3 = 0; i3 < 2; ++i3) acc[i0][i1][i2][i3] = (f32x4){0.f, 0.f, 0.f, 0.f};
    bf16x8 At[4][2], B0[2][2], B1[2][2];
    int nt = K / 64; asm volatile("" : "+s"(nt));
    G2_STB0(0, 0); G2_STA0(0, 0); G2_STB1(0, 0); G2_STA1(0, 0);
    if (wr == 1) G2_BAR;
    G2_WAIT_V(4); G2_BAR;
    G2_STB0(1, 1); G2_STA0(1, 1); G2_STB1(1, 1);
    G2_WAIT_V(6); G2_BAR;
    for (int t = 0; t < nt - 2; t += 2) {
        G2_LDB(B0, 0, 0); G2_SCHED; G2_LDA(At, 0, 0); G2_STA1(1, t + 1);
        G2_WAIT_L(8); G2_BAR; G2_WAIT_L(0); G2_MMA(0, 0, At, B0); G2_BAR; G2_SCHED;
        G2_LDB(B1, 0, 1); G2_STB0(0, t + 2);
        G2_BAR; G2_WAIT_L(0); G2_MMA(0, 1, At, B1); G2_BAR;
        G2_LDA(At, 0, 1); G2_STA0(0, t + 2);
        G2_BAR; G2_WAIT_L(0); G2_MMA(1, 0, At, B0); G2_BAR; G2_SCHED;
        G2_STB1(0, t + 2);
        G2_WAIT_V(6); G2_BAR; G2_MMA(1, 1, At, B1); G2_BAR;
        G2_LDB(B0, 1, 0); G2_SCHED; G2_LDA(At, 1, 0); G2_STA1(0, t + 2);
        G2_WAIT_L(8); G2_BAR; G2_WAIT_L(0); G2_MMA(0, 0, At, B0); G2_BAR; G2_SCHED;
        G2_LDB(B1, 1, 1); G2_STB0(1, t + 3);
        G2_BAR; G2_WAIT_L(0); G2_MMA(0, 1, At, B1); G2_BAR;
        G2_LDA(At, 1, 1); G2_STA0(1, t + 3);
        G2_BAR; G2_WAIT_L(0); G2_MMA(1, 0, At, B0); G2_BAR; G2_SCHED;
        G2_STB1(1, t + 3);
        G2_WAIT_V(6); G2_BAR; G2_MMA(1, 1, At, B1); G2_BAR;
    }
    { G2_LDB(B0, 0, 0); G2_LDA(At, 0, 0); G2_STA1(1, nt - 1);
      G2_BAR; G2_WAIT_L(0); G2_MMA(0, 0, At, B0); G2_BAR;
      G2_LDB(B1, 0, 1); G2_BAR; G2_WAIT_L(0); G2_MMA(0, 1, At, B1); G2_BAR;
      G2_LDA(At, 0, 1); G2_WAIT_V(4); G2_BAR; G2_WAIT_L(0); G2_MMA(1, 0, At, B0); G2_MMA(1, 1, At, B1); G2_BAR; }
    { G2_LDB(B0, 1, 0); G2_LDA(At, 1, 0); G2_WAIT_V(2); G2_BAR; G2_WAIT_L(0); G2_MMA(0, 0, At, B0); G2_BAR;
      G2_LDB(B1, 1, 1); G2_WAIT_V(0); G2_BAR; G2_WAIT_L(0); G2_MMA(0, 1, At, B1); G2_BAR;
      G2_LDA(At, 1, 1); G2_BAR; G2_WAIT_L(0); G2_MMA(1, 0, At, B0); G2_MMA(1, 1, At, B1); G2_BAR; }
    if (wr == 0) G2_BAR;
    { int ln_ = threadIdx.x & 63; asm volatile("" : "+v"(ln_));
      epi(acc, wr, wc, ln_ & 15, ln_ >> 4); }
#undef G2_SA
#undef G2_SB
#undef G2_STAGE
#undef G2_STA0
#undef G2_STA1
#undef G2_STB0
#undef G2_STB1
#undef G2_LDA
#undef G2_LDB
#undef G2_MMA
#undef G2_WAIT_V
#undef G2_WAIT_L
#undef G2_BAR
#undef G2_SCHED
}

DI void xpose_tile(const Ctx& c, const float* in, int ld_in, int k0, int n0, int colmode, const float* kscale, u16* out, int ld_out) {
    float* tile = (float*)c.lds;
    if (!colmode) {
        const int j4 = (c.tid & 15) * 4, r0 = c.tid >> 4;
#pragma unroll
        for (int rr = 0; rr < 2; ++rr) {
            const int kk = r0 + 32 * rr;
            float4 v = *(const float4*)(in + (size_t)(k0 + kk) * ld_in + n0 + j4);
            if (kscale) { const float s = kscale[k0 + kk]; v.x *= s; v.y *= s; v.z *= s; v.w *= s; }
            *(float4*)(tile + kk * 68 + j4) = v;
        }
    } else {
        const int j = c.tid & 63, r0 = c.tid >> 6;
        const int rc = ref_col(n0 + j);
#pragma unroll
        for (int rr = 0; rr < 8; ++rr) {
            const int kk = r0 + 8 * rr;
            tile[kk * 68 + j] = (rc >= 0) ? in[(size_t)(k0 + kk) * ld_in + rc] : 0.f;
        }
    }
    __syncthreads();
    {
        const int jj = c.tid >> 3, k8 = (c.tid & 7) * 8;
        uint4 pk;
        pk.x = pack2(tile[(k8 + 0) * 68 + jj], tile[(k8 + 1) * 68 + jj]);
        pk.y = pack2(tile[(k8 + 2) * 68 + jj], tile[(k8 + 3) * 68 + jj]);
        pk.z = pack2(tile[(k8 + 4) * 68 + jj], tile[(k8 + 5) * 68 + jj]);
        pk.w = pack2(tile[(k8 + 6) * 68 + jj], tile[(k8 + 7) * 68 + jj]);
        *(uint4*)(out + (size_t)(n0 + jj) * ld_out + k0 + k8) = pk;
    }
    __syncthreads();
}

DI void phase_prep(const Ctx& c_in, KArgs& a) {
    const Ctx c = fresh_ctx(c_in.lds);
    unsigned char* ws = a.ws;
    const int n_win = 2 * 52 * 16;
    const int n_wuq = 2 * 6 * 4;
    const int n_wukv = 2 * 8 * 2;
    const int n_wout = 2 * 16 * 16;
    const int n_trig = T_TOK * 24 / NTHR;
    const int n_wr = 2 * 64 * 1024 / NTHR;
    const int total = n_win + n_wuq + n_wukv + n_wout + n_trig + n_wr;
    for (int it = bid(); it < total; it += gridDim.x) {
        int i = it;
        if (i < n_win) {
            const int l = i / 832, r = i % 832, nt = r / 16, kt = r % 16;
            xpose_tile(c, a.in[3] + (size_t)l * 1024 * NREF, NREF, kt * 64, nt * 64, 1, nullptr, (u16*)(ws + WS_WIN) + (size_t)l * NPAD * 1024, 1024);
            continue;
        }
        i -= n_win;
        if (i < n_wuq) {
            const int l = i / 24, r = i % 24, nt = r / 4, kt = r % 4;
            xpose_tile(c, a.in[11] + (size_t)l * 256 * 384, 384, kt * 64, nt * 64, 0, a.in[10] + l * 256, (u16*)(ws + WS_WUQ) + (size_t)l * 384 * 256, 256);
            continue;
        }
        i -= n_wuq;
        if (i < n_wukv) {
            const int l = i / 16, r = i % 16, nt = r / 2, kt = r % 2;
            xpose_tile(c, a.in[13] + (size_t)l * 128 * 512, 512, kt * 64, nt * 64, 0, a.in[12] + l * 128, (u16*)(ws + WS_WUKV) + (size_t)l * 512 * 128, 128);
            continue;
        }
        i -= n_wukv;
        if (i < n_wout) {
            const int l = i / 256, r = i % 256, nt = r / 16, kt = r % 16;
            xpose_tile(c, a.in[15] + (size_t)l * 1024 * 1024, 1024, kt * 64, nt * 64, 0, nullptr, (u16*)(ws + WS_WOUT) + (size_t)l * 1024 * 1024, 1024);
            continue;
        }
        i -= n_wout;
        if (i >= n_trig) {
            const int e = (i - n_trig) * NTHR + c.tid;
            const int l = e >> 16, n = (e >> 10) & 63, k = e & 1023;
            float v = 0.f;
            if (n < 4) v = a.in[17][((size_t)l * 1024 + k) * 4 + n];
            else if (n < 36) v = a.in[19][((size_t)l * 1024 + k) * 32 + (n - 4)];
            const u16 hi = f2bf(v);
            ((u16*)(ws + WS_WRH))[e] = hi;
            ((u16*)(ws + WS_WRL))[e] = f2bf(v - bf2f(hi));
            continue;
        }
        {
            const int e = i * NTHR + c.tid;
            const int t = e / 24, j = e % 24;
            const int pos = ((const int*)a.in[1])[t];
            const float inv = (j < 8) ? a.inv16[j] : a.inv32[j - 8];
            const float ang = (float)pos * inv;
            const double ad = (double)ang;
            const double r = ad - 6.283185307179586476925 * rint(ad * 0.15915494309189533577);
            const float rf = (float)r;
            const float cs = cosf(rf), sn = sinf(rf);
            float* trig = (float*)(ws + WS_TRIG) + (size_t)t * 48;
            if (j < 8) { trig[j] = cs; trig[8 + j] = sn; } else { trig[16 + (j - 8)] = cs; trig[32 + (j - 8)] = sn; }
        }
    }
}

DI void expert_conv_item(const Ctx& c, KArgs& a, int l, int it) {
    unsigned char* ws = a.ws;
    const int which = it / 512, r = it % 512, e = r / 16, grp = r % 16;
    const float* src; u16* dst; int ld_in, ld_out, k0[4], n0[4];
    if (which < 2) {
        src = a.in[21 + which] + ((size_t)l * 32 + e) * 1024 * 256; dst = (u16*)(ws + (which == 0 ? WS_WG : WS_WU)) + (size_t)e * 256 * 1024; ld_in = 256; ld_out = 1024;
#pragma unroll
        for (int i = 0; i < 4; ++i) { n0[i] = (grp >> 2) * 64; k0[i] = ((grp & 3) * 4 + i) * 64; }
    } else {
        src = a.in[23] + ((size_t)l * 32 + e) * 256 * 1024; dst = (u16*)(ws + WS_WD) + (size_t)e * 1024 * 256; ld_in = 1024; ld_out = 256;
#pragma unroll
        for (int i = 0; i < 4; ++i) { n0[i] = grp * 64; k0[i] = i * 64; }
    }
    float* tile = (float*)c.lds;
    const int j4 = (c.tid & 15) * 4, r0 = c.tid >> 4;
    float4 v[4][2];
#pragma unroll
    for (int i = 0; i < 4; ++i)
#pragma unroll
        for (int rr = 0; rr < 2; ++rr) v[i][rr] = *(const float4*)(src + (size_t)(k0[i] + r0 + 32 * rr) * ld_in + n0[i] + j4);
#pragma unroll
    for (int i = 0; i < 4; ++i)
#pragma unroll
        for (int rr = 0; rr < 2; ++rr) *(float4*)(tile + i * (64 * 68) + (r0 + 32 * rr) * 68 + j4) = v[i][rr];
    __syncthreads();
    const int jj = c.tid >> 3, k8 = (c.tid & 7) * 8;
#pragma unroll
    for (int i = 0; i < 4; ++i) {
        const float* tl = tile + i * (64 * 68);
        uint4 pk;
        pk.x = pack2(tl[(k8 + 0) * 68 + jj], tl[(k8 + 1) * 68 + jj]);
        pk.y = pack2(tl[(k8 + 2) * 68 + jj], tl[(k8 + 3) * 68 + jj]);
        pk.z = pack2(tl[(k8 + 4) * 68 + jj], tl[(k8 + 5) * 68 + jj]);
        pk.w = pack2(tl[(k8 + 6) * 68 + jj], tl[(k8 + 7) * 68 + jj]);
        *(uint4*)(dst + (size_t)(n0[i] + jj) * ld_out + k0[i] + k8) = pk;
    }
    __syncthreads();
}

DI void phase_norm_in(const Ctx& c_in, KArgs& a, int l) {
    const Ctx c = fresh_ctx(c_in.lds);
    unsigned char* ws = a.ws;
    const float* x = (l == 0) ? a.in[0] : a.out;
    const float* g = a.in[2] + l * 1024;
    u16* act = (u16*)(ws + WS_ACT);
    const int n_norm = T_TOK / 8;
    const int n_exp = 0;
    if (bid() == 0 && c.tid < 192) ((int*)(ws + WS_CTL))[c.tid] = 0;
    for (int it = bid(); it < n_norm + n_exp; it += gridDim.x) {
        if (false) {
        } else {
            const int t = (it - n_exp) * 8 + c.wave;
            const float* xr = x + (size_t)t * 1024;
            float v[16]; float ss = 0.f;
            if (l == 0) {
#pragma unroll
                for (int j = 0; j < 16; ++j) v[j] = xr[c.lane + 64 * j];
            } else {
                const u16* y0 = (const u16*)(ws + WS_YFFN) + (size_t)t * 2048;
#pragma unroll
                for (int j = 0; j < 16; ++j) { v[j] = xr[c.lane + 64 * j] + bf2f(y0[c.lane + 64 * j]) + bf2f(y0[1024 + c.lane + 64 * j]); a.out[(size_t)t * 1024 + c.lane + 64 * j] = v[j]; }
            }
#pragma unroll
            for (int j = 0; j < 16; ++j) ss += v[j] * v[j];
            ss = wsum(ss);
            const float rs = rsqrtf(ss * (1.f / 1024.f) + EPS);
#pragma unroll
            for (int j = 0; j < 16; ++j) act[(size_t)t * 1024 + c.lane + 64 * j] = f2bf(v[j] * rs * g[c.lane + 64 * j]);
        }
    }
}

DI void phase_inproj(const Ctx& c_in, KArgs& a, int l) {
    const Ctx c = fresh_ctx(c_in.lds);
    unsigned char* ws = a.ws;
    const u16* act = (const u16*)(ws + WS_ACT);
    const u16* w = (const u16*)(ws + WS_WIN) + (size_t)l * NPAD * 1024;
    u16* proj = (u16*)(ws + WS_PROJ);
    u16* dsavt = (u16*)(ws + WS_DSAVT);
    u16* foxvt = (u16*)(ws + WS_FOXVT);
    float* small = (float*)(ws + WS_SMALL);
    u16* mlak = (u16*)(ws + WS_MLAK);
    u16* kf = (u16*)(ws + WS_KF);
    const float* trig = (const float*)(ws + WS_TRIG);
    int R, C; g2_stage_rc(c.tid * 16, R, C);
    const int nunits = (T_TOK / 256) * 13;
    for (int u = vblock(); u < nunits; u += gridDim.x) {
        const int grp = u / 52, rr = u % 52;
        const int pm = grp * 4 + (rr & 3), pn = rr >> 2;
        G2Ptrs g;
        g.ra = g2_rsrc(act); g.rb = g2_rsrc(w);
        g.va00 = (unsigned)(R * 1024 + C) * 2u; g.va01 = g.va00 + 64 * 2048; g.va10 = g.va00 + 128 * 2048; g.va11 = g.va00 + 192 * 2048;
        g.vb0 = g.va00; g.vb1 = g.va01;
        g.sa = (unsigned)pm * (256u * 2048u); g.sb0 = (unsigned)pn * (256u * 2048u); g.sb1 = g.sb0 + 128u * 2048u;
        __syncthreads();
        gemm256_unit(c, g, 1024, [&](const f32x4 (&acc)[2][2][4][2], int wr, int wc, int fr, int fq) {
#pragma unroll
            for (int bj = 0; bj < 2; ++bj)
#pragma unroll
                for (int n = 0; n < 2; ++n) {
                    const int col0 = pn * 256 + bj * 128 + wc * 32 + n * 16;
                    if (col0 < LDP) {
                        const bool rope16 = (col0 >= PC_DSAQ) && (col0 < PC_CQ) && (((col0 - PC_DSAQ) & 63) == 0);
                        const bool kr0 = (col0 == PC_KR), kr1 = (col0 == PC_KR + 16);
                        const bool foxk = (col0 >= PC_FOXK);
                        const bool idxk = (col0 >= PC_IDXK) && (col0 < PC_IDXK + 64);
                        float kmx = 0.f;
#pragma unroll
                        for (int ai = 0; ai < 2; ++ai)
#pragma unroll
                            for (int m = 0; m < 4; ++m) {
                                const int row = pm * 256 + ai * 128 + wr * 64 + m * 16 + fr;
                                f32x4 v = acc[ai][bj][m][n];
                                if (rope16) {
                                    const float* tg = trig + (size_t)row * 48 + 4 * (fq & 1);
                                    const f32x4 cs = *(const f32x4*)tg, sn = *(const f32x4*)(tg + 8);
                                    f32x4 pv;
#pragma unroll
                                    for (int j = 0; j < 4; ++j) pv[j] = __shfl_xor(v[j], 32);
                                    v = (fq < 2) ? (v * cs - pv * sn) : (v * cs + pv * sn);
                                }
                                if (kr0) {
                                    const float* tg = trig + (size_t)row * 48 + 16 + 4 * fq;
                                    const f32x4 cs = *(const f32x4*)tg, sn = *(const f32x4*)(tg + 16);
                                    const f32x4 x2 = acc[ai][bj][m][1];
                                    const f32x4 o1 = v * cs - x2 * sn, o2 = x2 * cs + v * sn;
                                    uint2 p1, p2; p1.x = pack2(o1[0], o1[1]); p1.y = pack2(o1[2], o1[3]); p2.x = pack2(o2[0], o2[1]); p2.y = pack2(o2[2], o2[3]);
#pragma unroll
                                    for (int hd = 0; hd < 4; ++hd) {
                                        *(uint2*)(mlak + (size_t)row * 384 + hd * 96 + 64 + 4 * fq) = p1;
                                        *(uint2*)(mlak + (size_t)row * 384 + hd * 96 + 80 + 4 * fq) = p2;
                                    }
                                }
                                if (idxk) {
                                    uint2 pk; pk.x = pack2(v[0], v[1]); pk.y = pack2(v[2], v[3]);
                                    const int d0 = col0 - PC_IDXK + 4 * fq, bb = row >> 12, ss = row & 4095;
                                    *(uint2*)(kf + ((size_t)(((bb * 128 + (ss >> 5)) * 4 + (d0 >> 4)) * 64 + ((d0 >> 3) & 1) * 32 + (ss & 31))) * 8 + (d0 & 7)) = pk;
                                } else if (!kr0 && !kr1) {
                                    uint2 pk; pk.x = pack2(v[0], v[1]); pk.y = pack2(v[2], v[3]);
                                    *(uint2*)(proj + (size_t)row * LDP + col0 + 4 * fq) = pk;
                                    if (foxk) {
                                        const float b0 = bf2f((u16)(pk.x & 0xffff)), b1 = bf2f((u16)(pk.x >> 16)), b2 = bf2f((u16)(pk.y & 0xffff)), b3 = bf2f((u16)(pk.y >> 16));
                                        float ss = b0 * b0 + b1 * b1 + b2 * b2 + b3 * b3;
                                        ss += __shfl_xor(ss, 16); ss += __shfl_xor(ss, 32);
                                        kmx = fmaxf(kmx, ss);
                                    }
                                }
                            }
                        if (foxk) {
                            kmx = fmaxf(kmx, __shfl_xor(kmx, 1)); kmx = fmaxf(kmx, __shfl_xor(kmx, 2)); kmx = fmaxf(kmx, __shfl_xor(kmx, 4)); kmx = fmaxf(kmx, __shfl_xor(kmx, 8));
                            if (c.lane == 0) {
                                const int cc = col0 - PC_FOXK;
                                atomicMax((unsigned*)(ws + WS_CTL) + 64 + (((pm * 256) >> 12) * 4 + (cc >> 6)) * 4 + ((cc >> 4) & 3), __float_as_uint(kmx));
                            }
                        }
                    } else if (col0 < NC_SMALL) {
                        u16* vt = (col0 < NC_FOXV) ? dsavt + (size_t)(col0 - NC_DSAV + 4 * fq) * 4096 : foxvt + (size_t)(col0 - NC_FOXV + 4 * fq) * 4096;
                        const size_t bstride = (col0 < NC_FOXV) ? (size_t)64 * 4096 : (size_t)256 * 4096;
#pragma unroll
                        for (int ai = 0; ai < 2; ++ai)
#pragma unroll
                            for (int m = 0; m < 4; ++m) {
                                const int row = pm * 256 + ai * 128 + wr * 64 + m * 16 + fr;
                                u16* p = vt + (size_t)(row >> 12) * bstride + (row & 4095);
                                const f32x4 v = acc[ai][bj][m][n];
                                p[0] = f2bf(v[0]); p[4096] = f2bf(v[1]); p[2 * 4096] = f2bf(v[2]); p[3 * 4096] = f2bf(v[3]);
                            }
                    } else if (col0 == NC_SMALL) {
#pragma unroll
                        for (int ai = 0; ai < 2; ++ai)
#pragma unroll
                            for (int m = 0; m < 4; ++m) {
                                const int row = pm * 256 + ai * 128 + wr * 64 + m * 16 + fr;
                                *(f32x4*)(small + (size_t)row * 16 + 4 * fq) = acc[ai][bj][m][n];
                            }
                    }
                }
        });
    }
}

constexpr int SSD_LD = 136;
constexpr int SSD_TILE_B = 128 * SSD_LD * 2;
constexpr int SSD_OFF_DT = 3 * SSD_TILE_B;
constexpr int SSD_OFF_ACS = SSD_OFF_DT + 2048;
constexpr int SSD_OFF_SSQ = SSD_OFF_ACS + 2048;

DI void ssd_dt_acs(const Ctx& c, KArgs& a, int l, int tok0, float* dt_s, float* acs_s) {
    const float* small = (const float*)(a.ws + WS_SMALL);
    {
        const int t = c.tid >> 2, hd = c.tid & 3;
        const float raw = small[(size_t)(tok0 + t) * 16 + hd] + a.in[6][l * 4 + hd];
        dt_s[hd * 128 + t] = softplusf(raw);
    }
    __syncthreads();
    if (c.wave < 4) {
        const int hd = c.wave;
        const float av = -__expf(a.in[7][l * 4 + hd]);
        const float v0 = dt_s[hd * 128 + 2 * c.lane] * av, v1 = dt_s[hd * 128 + 2 * c.lane + 1] * av;
        const float s = v0 + v1;
        float inc = s;
#pragma unroll
        for (int o = 1; o < 64; o <<= 1) { const float tv = __shfl_up(inc, o); if (c.lane >= o) inc += tv; }
        const float ex = inc - s;
        acs_s[hd * 128 + 2 * c.lane] = ex + v0;
        acs_s[hd * 128 + 2 * c.lane + 1] = ex + v0 + v1;
    }
    __syncthreads();
}

DI float ssd_conv(const u16* proj, const float* cw, const float* cb, int b, int s, int xc) {
    float acc = cb[xc];
#pragma unroll
    for (int j = 0; j < 4; ++j) {
        const int sp = s - 3 + j;
        if (sp >= 0) acc += cw[j * 768 + xc] * bf2f(proj[(size_t)(b * 4096 + sp) * LDP + PC_XBC + xc]);
    }
    return siluf(acc);
}

template <bool TRANSPOSED>
DI void conv_stage_unit(const Ctx& c, const u16* proj, const float* cw, const float* cb, int b, int s0, int tseg, int xc0, u16* dst,
                        const float* dt_s, const float* acs_s, int head0) {
    const int ch = 2 * c.lane, xc = xc0 + ch;
    float w0[4], w1[4];
#pragma unroll
    for (int j = 0; j < 4; ++j) { w0[j] = cw[j * 768 + xc]; w1[j] = cw[j * 768 + xc + 1]; }
    const float bias0 = cb[xc], bias1 = cb[xc + 1];
    const u16* src = proj + (size_t)(b * 4096) * LDP + PC_XBC + xc;
    const int head = head0 + (ch >> 6);
#pragma unroll 1
    for (int half = 0; half < 2; ++half) {
        const int sb = s0 + tseg * 32 + half * 16 - 3;
        unsigned raw[19];
#pragma unroll
        for (int i = 0; i < 19; ++i) { const int sp = sb + i; raw[i] = (sp >= 0) ? *(const unsigned*)(src + (size_t)sp * LDP) : 0u; }
#pragma unroll
        for (int t = 0; t < 16; ++t) {
            float x0 = bias0, x1 = bias1;
#pragma unroll
            for (int j = 0; j < 4; ++j) { x0 += w0[j] * bf2f((u16)(raw[t + j] & 0xffff)); x1 += w1[j] * bf2f((u16)(raw[t + j] >> 16)); }
            x0 = siluf(x0); x1 = siluf(x1);
            const int tt = tseg * 32 + half * 16 + t;
            if (dt_s) { const float sc = dt_s[head * 128 + tt] * __expf(acs_s[head * 128 + 127] - acs_s[head * 128 + tt]); x0 *= sc; x1 *= sc; }
            if (TRANSPOSED) { dst[ch * SSD_LD + tt] = f2bf(x0); dst[(ch + 1) * SSD_LD + tt] = f2bf(x1); }
            else *(unsigned*)(dst + tt * SSD_LD + ch) = pack2(x0, x1);
        }
    }
}

DI void ssd_state_item(const Ctx& c_in, KArgs& a, int l, int item) {
    const Ctx c = fresh_ctx(c_in.lds);
    unsigned char* ws = a.ws;
    const u16* proj = (const u16*)(ws + WS_PROJ);
    const float* cw = a.in[4] + (size_t)l * 4 * 768;
    const float* cb = a.in[5] + (size_t)l * 768;
    float* cs = (float*)(ws + WS_CS);
    float* cdec = (float*)(ws + WS_CDEC);
    const int b = item >> 5, ch = item & 31, tok0 = b * 4096 + ch * 128, s0 = ch * 128;
    u16* XT = (u16*)c.lds;
    u16* BT = (u16*)(c.lds + SSD_TILE_B);
    float* dt_s = (float*)(c.lds + SSD_OFF_DT);
    float* acs_s = (float*)(c.lds + SSD_OFF_ACS);
    const int l31 = c.lane & 31, h = c.lane >> 5;
    ssd_dt_acs(c, a, l, tok0, dt_s, acs_s);
    if (c.tid < 4) cdec[(b * 32 + ch) * 4 + c.tid] = __expf(acs_s[c.tid * 128 + 127]);
    for (int g = 0; g < 2; ++g) {
        if (c.wave < 4) conv_stage_unit<true>(c, proj, cw, cb, b, s0, c.wave, 128 * g, XT, dt_s, acs_s, 2 * g);
        else conv_stage_unit<true>(c, proj, cw, cb, b, s0, c.wave - 4, 256 + 128 * g, BT, nullptr, nullptr, 0);
        __syncthreads();
        {
            const int hh = c.wave >> 2, pt = (c.wave >> 1) & 1, nh = c.wave & 1;
            f32x16 acc0 = zero16(), acc1 = zero16();
#pragma unroll
            for (int ks = 0; ks < 8; ++ks) {
                const bf16x8 af = *(const bf16x8*)(XT + (hh * 64 + pt * 32 + l31) * SSD_LD + ks * 16 + h * 8);
                const bf16x8 b0 = *(const bf16x8*)(BT + (nh * 64 + l31) * SSD_LD + ks * 16 + h * 8);
                const bf16x8 b1 = *(const bf16x8*)(BT + (nh * 64 + 32 + l31) * SSD_LD + ks * 16 + h * 8);
                acc0 = MFMA32(af, b0, acc0);
                acc1 = MFMA32(af, b1, acc1);
            }
            const int head = 2 * g + hh;
            float* dst = cs + ((size_t)((b * 32 + ch) * 4 + head) * 64) * 128;
#pragma unroll
            for (int r = 0; r < 16; ++r) {
                const int p = pt * 32 + crow(r, h);
                dst[p * 128 + nh * 64 + l31] = acc0[r];
                dst[p * 128 + nh * 64 + 32 + l31] = acc1[r];
            }
        }
        __syncthreads();
    }
}

DI void ssd_scan_item(const Ctx& c_in, KArgs& a, int item) {
    const Ctx c = fresh_ctx(c_in.lds);
    float* cs = (float*)(a.ws + WS_CS);
    const float* cdec = (const float*)(a.ws + WS_CDEC);
    const int idx = item * NTHR + c.tid;
    const int bh = idx >> 13, pn = idx & 8191, b = bh >> 2, hd = bh & 3;
    float v[32], dcy[32];
#pragma unroll
    for (int ch = 0; ch < 32; ++ch) {
        v[ch] = cs[((size_t)((b * 32 + ch) * 4 + hd)) * 8192 + pn];
        dcy[ch] = cdec[(b * 32 + ch) * 4 + hd];
    }
    float s = 0.f;
#pragma unroll
    for (int ch = 0; ch < 32; ++ch) {
        cs[((size_t)((b * 32 + ch) * 4 + hd)) * 8192 + pn] = s;
        s = s * dcy[ch] + v[ch];
    }
}

DI void ssd_out_item(const Ctx& c_in, KArgs& a, int l, int item) {
    const Ctx c = fresh_ctx(c_in.lds);
    unsigned char* ws = a.ws;
    const u16* proj = (const u16*)(ws + WS_PROJ);
    const float* cw = a.in[4] + (size_t)l * 4 * 768;
    const float* cb = a.in[5] + (size_t)l * 768;
    const float* prev = (const float*)(ws + WS_CS);
    u16* act = (u16*)(ws + WS_ACT);
    const int b = item >> 5, ch = item & 31, tok0 = b * 4096 + ch * 128, s0 = ch * 128;
    u16* XT = (u16*)c.lds;
    u16* BM = (u16*)(c.lds + SSD_TILE_B);
    u16* CM = (u16*)(c.lds + 2 * SSD_TILE_B);
    float* dt_s = (float*)(c.lds + SSD_OFF_DT);
    float* acs_s = (float*)(c.lds + SSD_OFF_ACS);
    float* ssq = (float*)(c.lds + SSD_OFF_SSQ);
    const int l31 = c.lane & 31, h = c.lane >> 5;
    ssd_dt_acs(c, a, l, tok0, dt_s, acs_s);
    f32x16 yreg[2][2];
    const int hh = c.wave >> 2, qt = c.wave & 3;
    const int q = qt * 32 + l31;
#pragma unroll
    for (int g = 0; g < 2; ++g) {
        for (int u = c.wave; u < 12; u += 8) {
            const int part = u >> 2, tseg = u & 3;
            if (part == 0) conv_stage_unit<true>(c, proj, cw, cb, b, s0, tseg, 128 * g, XT, nullptr, nullptr, 0);
            else if (part == 1) conv_stage_unit<false>(c, proj, cw, cb, b, s0, tseg, 256 + 128 * g, BM, nullptr, nullptr, 0);
            else conv_stage_unit<false>(c, proj, cw, cb, b, s0, tseg, 512 + 128 * g, CM, nullptr, nullptr, 0);
        }
        __syncthreads();
        {
            const int head = 2 * g + hh;
            const float acs_q = acs_s[head * 128 + q];
            bf16x8 cf[8];
#pragma unroll
            for (int ks = 0; ks < 8; ++ks) cf[ks] = *(const bf16x8*)(CM + q * SSD_LD + ks * 16 + h * 8);
            f32x16 yf0 = zero16(), yf1 = zero16();
            const float* pv = prev + ((size_t)((b * 32 + ch) * 4 + head) * 64) * 128;
#pragma unroll
            for (int ks = 0; ks < 8; ++ks) {
                {
                    const float* pr = pv + (size_t)l31 * 128 + ks * 16 + h * 8;
                    const float4 f0 = *(const float4*)pr, f1 = *(const float4*)(pr + 4);
                    const bf16x8 pa = __builtin_bit_cast(bf16x8, make_uint4(pack2(f0.x, f0.y), pack2(f0.z, f0.w), pack2(f1.x, f1.y), pack2(f1.z, f1.w)));
                    yf0 = MFMA32(pa, cf[ks], yf0);
                }
                {
                    const float* pr = pv + (size_t)(32 + l31) * 128 + ks * 16 + h * 8;
                    const float4 f0 = *(const float4*)pr, f1 = *(const float4*)(pr + 4);
                    const bf16x8 pa = __builtin_bit_cast(bf16x8, make_uint4(pack2(f0.x, f0.y), pack2(f0.z, f0.w), pack2(f1.x, f1.y), pack2(f1.z, f1.w)));
                    yf1 = MFMA32(pa, cf[ks], yf1);
                }
            }
            const float eq = __expf(acs_q);
            f32x16 yo0, yo1;
#pragma unroll
            for (int r = 0; r < 16; ++r) { yo0[r] = yf0[r] * eq; yo1[r] = yf1[r] * eq; }
            for (int kt = 0; kt <= qt; ++kt) {
                f32x16 gt = zero16();
#pragma unroll
                for (int ks = 0; ks < 8; ++ks) {
                    const bf16x8 bf = *(const bf16x8*)(BM + (kt * 32 + l31) * SSD_LD + ks * 16 + h * 8);
                    gt = MFMA32(bf, cf[ks], gt);
                }
#pragma unroll
                for (int r = 0; r < 16; ++r) {
                    const int k = kt * 32 + crow(r, h);
                    const float dec = __expf(fminf(acs_q - acs_s[head * 128 + k], 0.f)) * dt_s[head * 128 + k];
                    gt[r] = (k <= q) ? gt[r] * dec : 0.f;
                }
#pragma unroll
                for (int s2 = 0; s2 < 2; ++s2) {
                    const bf16x8 pb = pack8(gt, s2);
                    const int koff = kt * 32 + 16 * s2 + 4 * h;
                    {
                        const u16* xr = XT + (hh * 64 + l31) * SSD_LD + koff;
                        const uint2 lo = *(const uint2*)xr, hi = *(const uint2*)(xr + 8);
                        const bf16x8 xa = __builtin_bit_cast(bf16x8, make_uint4(lo.x, lo.y, hi.x, hi.y));
                        yo0 = MFMA32(xa, pb, yo0);
                    }
                    {
                        const u16* xr = XT + (hh * 64 + 32 + l31) * SSD_LD + koff;
                        const uint2 lo = *(const uint2*)xr, hi = *(const uint2*)(xr + 8);
                        const bf16x8 xa = __builtin_bit_cast(bf16x8, make_uint4(lo.x, lo.y, hi.x, hi.y));
                        yo1 = MFMA32(xa, pb, yo1);
                    }
                }
            }
            const float dsk = a.in[8][l * 4 + head];
            float part = 0.f;
#pragma unroll
            for (int pt = 0; pt < 2; ++pt) {
#pragma unroll
                for (int qd = 0; qd < 4; ++qd) {
                    const int p0 = pt * 32 + 8 * qd + 4 * h;
                    const uint2 zz = *(const uint2*)(proj + (size_t)(tok0 + q) * LDP + PC_Z + head * 64 + p0);
                    const float zf[4] = { bf2f((u16)(zz.x & 0xffff)), bf2f((u16)(zz.x >> 16)), bf2f((u16)(zz.y & 0xffff)), bf2f((u16)(zz.y >> 16)) };
#pragma unroll
                    for (int r3 = 0; r3 < 4; ++r3) {
                        const int r = 4 * qd + r3;
                        const float yo = pt ? yo1[r] : yo0[r];
                        const float xv = bf2f(XT[(hh * 64 + p0 + r3) * SSD_LD + q]);
                        const float y = (yo + dsk * xv) * siluf(zf[r3]);
                        yreg[g][pt][r] = y;
                        part += y * y;
                    }
                }
            }
            part += __shfl_xor(part, 32);
            if (h == 0) ssq[head * 128 + q] = part;
        }
        __syncthreads();
    }
    {
        const float rs = rsqrtf((ssq[q] + ssq[128 + q] + ssq[256 + q] + ssq[384 + q]) * (1.f / 256.f) + EPS);
        const float* nw = a.in[9] + l * 256;
#pragma unroll
        for (int g = 0; g < 2; ++g) {
            const int head = 2 * g + hh;
#pragma unroll
            for (int pt = 0; pt < 2; ++pt)
#pragma unroll
                for (int qd = 0; qd < 4; ++qd) {
                    const int p0 = pt * 32 + 8 * qd + 4 * h;
                    const float* w4 = nw + head * 64 + p0;
                    uint2 pk;
                    pk.x = pack2(yreg[g][pt][4 * qd] * rs * w4[0], yreg[g][pt][4 * qd + 1] * rs * w4[1]);
                    pk.y = pack2(yreg[g][pt][4 * qd + 2] * rs * w4[2], yreg[g][pt][4 * qd + 3] * rs * w4[3]);
                    *(uint2*)(act + (size_t)(tok0 + q) * 1024 + head * 64 + p0) = pk;
                }
        }
    }
    __syncthreads();
}

DI void token_post_item(const Ctx& c_in, KArgs& a, int l, int item) {
    const Ctx c = fresh_ctx(c_in.lds);
    unsigned char* ws = a.ws;
    u16* proj = (u16*)(ws + WS_PROJ);
    u16* mlak = (u16*)(ws + WS_MLAK);
    const float* trig = (const float*)(ws + WS_TRIG);
    const float* small = (const float*)(ws + WS_SMALL);
    float* flog = (float*)(ws + WS_FLOG);
    const int t = item * 8 + c.wave;
    u16* pr = proj + (size_t)t * LDP;
    const float* tg = trig + (size_t)t * 48;
#pragma unroll
    for (int r = 0; r < 2; ++r) {
        const int pid = c.lane + 64 * r;
        if (pid < 112) {
            int col, i;
            if (pid < 32)       { col = PC_DSAQ + (pid >> 3) * 64; i = pid & 7; }
            else if (pid < 40)  { col = PC_DSAK; i = pid - 32; }
            else if (pid < 104) { const int p = pid - 40; col = PC_IDXQ + (p >> 3) * 64; i = p & 7; }
            else                { col = PC_IDXK; i = pid - 104; }
            const float x1 = bf2f(pr[col + i]), x2 = bf2f(pr[col + 8 + i]);
            const float cs = tg[i], sn = tg[8 + i];
            pr[col + i] = f2bf(x1 * cs - x2 * sn);
            pr[col + 8 + i] = f2bf(x2 * cs + x1 * sn);
        } else {
            const int i = pid - 112;
            const float x1 = bf2f(pr[PC_KR + i]), x2 = bf2f(pr[PC_KR + 16 + i]);
            const float cs = tg[16 + i], sn = tg[32 + i];
            const u16 o1 = f2bf(x1 * cs - x2 * sn), o2 = f2bf(x2 * cs + x1 * sn);
#pragma unroll
            for (int hd = 0; hd < 4; ++hd) { mlak[(size_t)t * 384 + hd * 96 + 64 + i] = o1; mlak[(size_t)t * 384 + hd * 96 + 80 + i] = o2; }
        }
    }
    {
        const int hd = c.lane >> 4, d0 = (c.lane & 15) * 4;
        const uint2 kk = *(const uint2*)(pr + PC_FOXK + hd * 64 + d0);
        const float k0 = bf2f((u16)(kk.x & 0xffff)), k1 = bf2f((u16)(kk.x >> 16)), k2 = bf2f((u16)(kk.y & 0xffff)), k3 = bf2f((u16)(kk.y >> 16));
        float ss = k0 * k0 + k1 * k1 + k2 * k2 + k3 * k3;
        ss += __shfl_xor(ss, 1); ss += __shfl_xor(ss, 2); ss += __shfl_xor(ss, 4); ss += __shfl_xor(ss, 8);
        if ((c.lane & 15) == 0) {
            unsigned* km = (unsigned*)(ws + WS_CTL) + 64 + (t >> 12) * 4 + hd;
            const unsigned sb = __float_as_uint(ss);
            if (sb > __hip_atomic_load(km, __ATOMIC_RELAXED, __HIP_MEMORY_SCOPE_AGENT)) atomicMax(km, sb);
        }
    }
    if (c.lane < 4) {
        const float f = small[(size_t)t * 16 + 12 + c.lane] + a.in[14][l * 4 + c.lane];
        const float ls = fminf(f, 0.f) - log1pf(__expf(-fabsf(f)));
        const int b = t >> 12, s = t & 4095;
        flog[(size_t)(b * 4 + c.lane) * 4096 + s] = ls;
    }
}

DI void mla_up_item(const Ctx& c_in, KArgs& a, int l, int which, int item) {
    const Ctx c = fresh_ctx(c_in.lds);
    unsigned char* ws = a.ws;
    const u16* proj = (const u16*)(ws + WS_PROJ);
    const float* trig = (const float*)(ws + WS_TRIG);
    float* rs_s = (float*)(c.lds + G_LDS_BYTES);
    const int r8 = c.tid >> 3;
    const int wm = c.wave & 3, wn = c.wave >> 2, l31 = c.lane & 31, h = c.lane >> 5;
    const int K = which == 0 ? 256 : 128;
    const int pc = which == 0 ? PC_CQ : PC_CKV;
    const int ntn = which == 0 ? 3 : 4;
    const int mt = item / ntn, nt = item % ntn;
    const u16* w = which == 0 ? (const u16*)(ws + WS_WUQ) + (size_t)l * 384 * 256 : (const u16*)(ws + WS_WUKV) + (size_t)l * 512 * 128;
    {
        const int row = c.tid >> 1, half = c.tid & 1;
        const u16* p = proj + (size_t)(mt * 256 + row) * LDP + pc + half * (K / 2);
        float ss = 0.f;
        for (int i = 0; i < K / 2; i += 8) {
            const uint4 v = *(const uint4*)(p + i);
            const unsigned w4[4] = { v.x, v.y, v.z, v.w };
#pragma unroll
            for (int j = 0; j < 4; ++j) { const float f0 = bf2f((u16)(w4[j] & 0xffff)), f1 = bf2f((u16)(w4[j] >> 16)); ss += f0 * f0 + f1 * f1; }
        }
        ss += __shfl_xor(ss, 1);
        if (half == 0) rs_s[row] = rsqrtf(ss / (float)K + EPS);
    }
    __syncthreads();
    GP gp;
    gp.a0 = proj + (size_t)(mt * 256 + r8) * LDP + pc; gp.a1 = gp.a0 + 64 * LDP; gp.a2 = gp.a0 + 128 * LDP; gp.a3 = gp.a0 + 192 * LDP;
    gp.b0 = w + (size_t)(nt * 128 + r8) * K; gp.b1 = gp.b0 + 64 * K;
    f32x16 acc[2][2];
    acc[0][0] = zero16(); acc[0][1] = zero16(); acc[1][0] = zero16(); acc[1][1] = zero16();
    gemm_core<false>(c, K, gp, acc);
    u16* mlaq = (u16*)(ws + WS_MLAQ);
    u16* mlak = (u16*)(ws + WS_MLAK);
    u16* mlavt = (u16*)(ws + WS_MLAVT);
#pragma unroll
    for (int i = 0; i < 2; ++i)
#pragma unroll
        for (int j = 0; j < 2; ++j) {
            const int ml0 = wm * 64 + i * 32, m0 = mt * 256 + ml0, n0 = nt * 128 + wn * 64 + j * 32;
            const int n = n0 + l31;
            if (which == 0) {
                const bool rope = ((n0 >> 5) % 3) == 2;
#pragma unroll
                for (int r = 0; r < 16; ++r) {
                    const int ml = ml0 + crow(r, h), m = mt * 256 + ml;
                    float v = acc[i][j][r] * rs_s[ml];
                    if (rope) {
                        const float pv = __shfl_xor(v, 16);
                        const int ii = l31 & 15;
                        const float cs = trig[(size_t)m * 48 + 16 + ii], sn = trig[(size_t)m * 48 + 32 + ii];
                        v = (l31 < 16) ? (v * cs - pv * sn) : (v * cs + pv * sn);
                    }
                    mlaq[(size_t)m * 384 + n] = f2bf(v);
                }
            } else {
                const int head = n0 >> 7, wi = n0 & 127;
                if (wi < 64) {
#pragma unroll
                    for (int r = 0; r < 16; ++r) {
                        const int ml = ml0 + crow(r, h), m = mt * 256 + ml;
                        mlak[(size_t)m * 384 + head * 96 + wi + l31] = f2bf(acc[i][j][r] * rs_s[ml]);
                    }
                } else {
                    const int b = m0 >> 12, s0 = m0 & 4095, d = wi - 64 + l31;
                    u16* base = mlavt + ((size_t)(b * 4 + head) * 64 + d) * 4096 + s0;
#pragma unroll
                    for (int q = 0; q < 4; ++q) {
                        const int mlq = ml0 + 8 * q + 4 * h;
                        uint2 pk;
                        pk.x = pack2(acc[i][j][4 * q] * rs_s[mlq], acc[i][j][4 * q + 1] * rs_s[mlq + 1]);
                        pk.y = pack2(acc[i][j][4 * q + 2] * rs_s[mlq + 2], acc[i][j][4 * q + 3] * rs_s[mlq + 3]);
                        *(uint2*)(base + 8 * q + 4 * h) = pk;
                    }
                }
            }
        }
    __syncthreads();
}

constexpr int AT_LDV = 68;
template <int DQ, int MODE>
DI void attn_item(const Ctx& c_in, KArgs& a, int l, int b, int hd_in, int qb) {
    const Ctx c = fresh_ctx(c_in.lds);
    unsigned char* ws = a.ws;
    constexpr int LDK = DQ + 8;
    constexpr int K_EL = 64 * LDK, V_EL = 64 * AT_LDV, ST_EL = K_EL + V_EL;
    constexpr int NKS = DQ / 16;
    constexpr int KCH = DQ / 8;
    u16* S = (u16*)c.lds;
    float* fc_s = (float*)(c.lds + 2 * ST_EL * 2 + 64);
    const int l31 = c.lane & 31, h = c.lane >> 5;
    int hd, wq0, nkt;
    const u16 *Qp, *Kp, *Vp; int ldq, ldk, ocol;
    float scale;
    if (MODE == 0) {
        hd = hd_in;
        wq0 = qb * 256 + c.wave * 32; nkt = qb * 4 + 4;
        Qp = (const u16*)(ws + WS_MLAQ) + (size_t)b * 4096 * 384 + hd * 96; ldq = 384;
        Kp = (const u16*)(ws + WS_MLAK) + (size_t)b * 4096 * 384 + hd * 96; ldk = 384;
        Vp = (const u16*)(ws + WS_MLAVT) + (size_t)(b * 4 + hd) * 64 * 4096;
        ocol = 512 + hd * 64; scale = 0.10206207261596575f;
    } else if (MODE == 1) {
        hd = hd_in;
        wq0 = qb * 256 + c.wave * 32; nkt = qb * 4 + 4;
        Qp = (const u16*)(ws + WS_PROJ) + (size_t)b * 4096 * LDP + PC_FOXQ + hd * 64; ldq = LDP;
        Kp = (const u16*)(ws + WS_PROJ) + (size_t)b * 4096 * LDP + PC_FOXK + hd * 64; ldk = LDP;
        Vp = (const u16*)(ws + WS_FOXVT) + (size_t)(b * 4 + hd) * 64 * 4096;
        ocol = 768 + hd * 64; scale = 0.125f;
    } else {
        hd = c.wave & 3;
        wq0 = qb * 64 + (c.wave >> 2) * 32; nkt = qb + 1;
        Qp = (const u16*)(ws + WS_PROJ) + (size_t)b * 4096 * LDP + PC_DSAQ + hd * 64; ldq = LDP;
        Kp = (const u16*)(ws + WS_PROJ) + (size_t)b * 4096 * LDP + PC_DSAK; ldk = LDP;
        Vp = (const u16*)(ws + WS_DSAVT) + (size_t)b * 64 * 4096;
        ocol = 256 + hd * 64; scale = 0.125f;
    }
    const float sc2 = scale * LOG2E;
    const int q = wq0 + l31;
    bf16x8 qf[NKS];
#pragma unroll
    for (int ks = 0; ks < NKS; ++ks) qf[ks] = *(const bf16x8*)(Qp + (size_t)q * ldq + ks * 16 + h * 8);
    float fq = 0.f;
    if (MODE == 1) {
        const float* fsm = (const float*)(ws + WS_SMALL) + (size_t)b * 4096 * 16 + 12 + hd;
        const float fbias = a.in[14][l * 4 + hd];
        float* wtot = (float*)(c.lds + 2 * ST_EL * 2);
        const int nk = nkt * 64;
        float v[8]; float s = 0.f;
#pragma unroll
        for (int j = 0; j < 8; ++j) {
            const int idx = c.tid * 8 + j;
            float lf = 0.f;
            if (idx < nk) { const float f = fsm[(size_t)idx * 16] + fbias; lf = fminf(f, 0.f) - log1pf(__expf(-fabsf(f))); }
            v[j] = lf;
        }
#pragma unroll
        for (int j = 0; j < 8; ++j) { s += v[j]; v[j] = s; }
        float inc = s;
#pragma unroll
        for (int o = 1; o < 64; o <<= 1) { const float tv = __shfl_up(inc, o); if (c.lane >= o) inc += tv; }
        if (c.lane == 63) wtot[c.wave] = inc;
        __syncthreads();
        float base = inc - s;
        for (int w2 = 0; w2 < c.wave; ++w2) base += wtot[w2];
#pragma unroll
        for (int j = 0; j < 8; ++j) fc_s[c.tid * 8 + j] = (base + v[j]) * LOG2E;
        __syncthreads();
        fq = fc_s[q];
    }
    float sbound = 0.f;
    int* dflag = (int*)(c.lds + 2 * ST_EL * 2 + 64 + 4096 * 4);
    if (MODE == 1) {
        float qq = 0.f;
#pragma unroll
        for (int ks = 0; ks < NKS; ++ks)
#pragma unroll
            for (int j = 0; j < 8; ++j) { const float f = bf2f((u16)qf[ks][j]); qq += f * f; }
        qq += __shfl_xor(qq, 32);
        float kmax2 = 0.f;
#pragma unroll
        for (int f = 0; f < 4; ++f) kmax2 += __uint_as_float(__hip_atomic_load((const unsigned*)(ws + WS_CTL) + 64 + (b * 4 + hd) * 4 + f, __ATOMIC_RELAXED, __HIP_MEMORY_SCOPE_AGENT));
        sbound = sqrtf(qq * kmax2) * sc2 * 1.02f + 1.0f;
        if (c.tid < 16) dflag[c.tid] = 0;
    }
    bool wdone = false;
    const int krow0 = c.tid / KCH, kch0 = c.tid % KCH;
    const int c1 = c.tid + NTHR; const int krow1 = c1 / KCH, kch1 = c1 % KCH; const bool has1 = (KCH * 64 > NTHR) && (c1 < KCH * 64);
    const int vrow = c.tid >> 3, vch = c.tid & 7;
    struct KV { uint4 k0, k1, v; u64 mw; };
    KV sA, sB, sC;
    sA.k1 = sB.k1 = sC.k1 = make_uint4(0, 0, 0, 0); sA.mw = sB.mw = sC.mw = 0;
    const u64* mrow = (const u64*)(ws + WS_MASK) + (size_t)(b * 4096 + q) * 64;
    auto gload = [&](KV& s, int kt) {
        s.k0 = *(const uint4*)(Kp + (size_t)(kt * 64 + krow0) * ldk + kch0 * 8);
        if (has1) s.k1 = *(const uint4*)(Kp + (size_t)(kt * 64 + krow1) * ldk + kch1 * 8);
        s.v = *(const uint4*)(Vp + (size_t)vrow * 4096 + kt * 64 + vch * 8);
        if (MODE == 2) s.mw = mrow[kt];
    };
    auto sstore = [&](const KV& s, int st) {
        u16* Ks = S + st * ST_EL; u16* Vs = Ks + K_EL;
        *(uint4*)(Ks + krow0 * LDK + kch0 * 8) = s.k0;
        if (has1) *(uint4*)(Ks + krow1 * LDK + kch1 * 8) = s.k1;
        *(uint2*)(Vs + vrow * AT_LDV + vch * 8) = make_uint2(s.v.x, s.v.y);
        *(uint2*)(Vs + vrow * AT_LDV + vch * 8 + 4) = make_uint2(s.v.z, s.v.w);
    };
    f32x16 o0 = zero16(), o1 = zero16();
    float m_run = -1e30f, l_run = 0.f;
    auto tile_of = [&](int it) { return (MODE == 1) ? nkt - 1 - it : it; };
    bool stop = false;
    auto step = [&](int it, KV& cur, const KV& nxt) {
        const int kt = tile_of(it);
        const u64 mw_cur = cur.mw;
        if (it + 3 < nkt) gload(cur, tile_of(it + 3));
        if (kt * 64 <= wq0 + 31 && !wdone) {
            const u16* Ks = S + (it & 1) * ST_EL; const u16* Vs = Ks + K_EL;
            f32x16 s0 = zero16(), s1 = zero16();
#pragma unroll
            for (int ks = 0; ks < NKS; ++ks) {
                const bf16x8 k0 = *(const bf16x8*)(Ks + l31 * LDK + ks * 16 + h * 8);
                const bf16x8 k1 = *(const bf16x8*)(Ks + (32 + l31) * LDK + ks * 16 + h * 8);
                s0 = MFMA32(k0, qf[ks], s0);
                s1 = MFMA32(k1, qf[ks], s1);
            }
            const float scx = (MODE == 1) ? 1.0f : sc2;
            if (MODE == 1) {
#pragma unroll
                for (int g4 = 0; g4 < 4; ++g4) {
                    const float4 f0 = *(const float4*)(fc_s + kt * 64 + 8 * g4 + 4 * h);
                    const float4 f1 = *(const float4*)(fc_s + kt * 64 + 32 + 8 * g4 + 4 * h);
                    s0[4 * g4 + 0] = fmaf(s0[4 * g4 + 0], sc2, fq) - f0.x; s0[4 * g4 + 1] = fmaf(s0[4 * g4 + 1], sc2, fq) - f0.y;
                    s0[4 * g4 + 2] = fmaf(s0[4 * g4 + 2], sc2, fq) - f0.z; s0[4 * g4 + 3] = fmaf(s0[4 * g4 + 3], sc2, fq) - f0.w;
                    s1[4 * g4 + 0] = fmaf(s1[4 * g4 + 0], sc2, fq) - f1.x; s1[4 * g4 + 1] = fmaf(s1[4 * g4 + 1], sc2, fq) - f1.y;
                    s1[4 * g4 + 2] = fmaf(s1[4 * g4 + 2], sc2, fq) - f1.z; s1[4 * g4 + 3] = fmaf(s1[4 * g4 + 3], sc2, fq) - f1.w;
                }
            }
            if (MODE == 2) {
                const unsigned mlo = (unsigned)(mw_cur >> (4 * h)), mhi = (unsigned)(mw_cur >> (32 + 4 * h));
#pragma unroll
                for (int r = 0; r < 16; ++r) {
                    const int kr = (r & 3) + 8 * (r >> 2);
                    s0[r] = ((mlo >> kr) & 1u) ? s0[r] : -1e30f;
                    s1[r] = ((mhi >> kr) & 1u) ? s1[r] : -1e30f;
                }
            } else if (__builtin_amdgcn_readfirstlane(kt * 64 + 63 - wq0) > 0) {
                asm volatile("" ::: "memory");
                const int qrel = q - kt * 64 - 4 * h;
#pragma unroll
                for (int r = 0; r < 16; ++r) {
                    const int kr = (r & 3) + 8 * (r >> 2);
                    s0[r] = (kr <= qrel) ? s0[r] : -1e30f;
                    s1[r] = (kr + 32 <= qrel) ? s1[r] : -1e30f;
                }
            }
            asm volatile("s_nop 15\n\ts_nop 3" : "+v"(s0), "+v"(s1));
            float mx;
            {
                float t0 = max3f(s0[0], s0[1], s0[2]), t1 = max3f(s0[3], s0[4], s0[5]), t2 = max3f(s0[6], s0[7], s0[8]), t3 = max3f(s0[9], s0[10], s0[11]);
                float t4 = max3f(s0[12], s0[13], s0[14]), t5 = max3f(s0[15], s1[0], s1[1]), t6 = max3f(s1[2], s1[3], s1[4]), t7 = max3f(s1[5], s1[6], s1[7]);
                float t8 = max3f(s1[8], s1[9], s1[10]), t9 = max3f(s1[11], s1[12], s1[13]), t10 = max3f(s1[14], s1[15], t0);
                t1 = max3f(t1, t2, t3); t4 = max3f(t4, t5, t6); t7 = max3f(t7, t8, t9);
                mx = max3f(t1, t4, t7); mx = max3f(mx, t10, __shfl_xor(max3f(t1, t4, max3f(t7, t10, t10)), 32));
            }
            const float m_new = max3f(m_run, mx, mx);
            const float m_use = (MODE == 2) ? max3f(m_new, -1e20f, -1e20f) : m_new;
            const float alpha = ex2((m_run - m_new) * scx);
            const float nm = -m_use * scx;
            f32x2 rs2 = {0.f, 0.f};
            const f32x2 sc2v = {scx, scx}, nm2 = {nm, nm};
#pragma unroll
            for (int r = 0; r < 16; r += 2) {
                f32x2 xv = {s0[r], s0[r + 1]};
                xv = xv * sc2v + nm2;
                xv[0] = ex2(xv[0]); xv[1] = ex2(xv[1]);
                s0[r] = xv[0]; s0[r + 1] = xv[1];
                rs2 += xv;
                f32x2 yv = {s1[r], s1[r + 1]};
                yv = yv * sc2v + nm2;
                yv[0] = ex2(yv[0]); yv[1] = ex2(yv[1]);
                s1[r] = yv[0]; s1[r + 1] = yv[1];
                rs2 += yv;
            }
            float rsum = rs2[0] + rs2[1];
            rsum += __shfl_xor(rsum, 32);
            l_run = l_run * alpha + rsum; m_run = m_new;
            if (__any(alpha != 1.0f)) {
#pragma unroll
                for (int r = 0; r < 16; ++r) { o0[r] *= alpha; o1[r] *= alpha; }
            }
#pragma unroll
            for (int sub = 0; sub < 2; ++sub)
#pragma unroll
                for (int s2 = 0; s2 < 2; ++s2) {
                    const bf16x8 pb = pack8(sub ? s1 : s0, s2);
                    const int koff = sub * 32 + 16 * s2 + 4 * h;
                    {
                        const u16* vr = Vs + l31 * AT_LDV + koff;
                        const uint2 lo = *(const uint2*)vr, hi = *(const uint2*)(vr + 8);
                        o0 = MFMA32(__builtin_bit_cast(bf16x8, make_uint4(lo.x, lo.y, hi.x, hi.y)), pb, o0);
                    }
                    {
                        const u16* vr = Vs + (32 + l31) * AT_LDV + koff;
                        const uint2 lo = *(const uint2*)vr, hi = *(const uint2*)(vr + 8);
                        o1 = MFMA32(__builtin_bit_cast(bf16x8, make_uint4(lo.x, lo.y, hi.x, hi.y)), pb, o1);
                    }
                }
        }
        if (it + 1 < nkt) sstore(nxt, (it + 1) & 1);
        if (MODE == 1) {
            if (kt * 64 <= wq0 + 31 && !wdone && kt > 0) wdone = __all(sbound + (fq - fc_s[kt * 64 - 1]) < m_run - 40.f);
            if (c.lane == 0) dflag[(it & 1) * 8 + c.wave] = wdone ? 1 : 0;
        }
        __syncthreads();
        if (MODE == 1) {
            const int4 f0 = *(const int4*)(dflag + (it & 1) * 8), f1 = *(const int4*)(dflag + (it & 1) * 8 + 4);
            if ((f0.x & f0.y & f0.z & f0.w & f1.x & f1.y & f1.z & f1.w) != 0) stop = true;
        }
    };
    gload(sA, tile_of(0));
    if (nkt > 1) gload(sB, tile_of(1));
    if (nkt > 2) gload(sC, tile_of(2));
    sstore(sA, 0);
    __syncthreads();
    for (int it = 0; it < nkt; it += 3) {
        step(it, sA, sB); if (stop || it + 1 >= nkt) break;
        step(it + 1, sB, sC); if (stop || it + 2 >= nkt) break;
        step(it + 2, sC, sA); if (stop) break;
    }
    if (MODE == 1) __syncthreads();
    {
        const float inv = 1.f / l_run;
        u16* act = (u16*)(ws + WS_ACT) + (size_t)(b * 4096 + q) * 1024 + ocol;
#pragma unroll
        for (int qd = 0; qd < 4; ++qd) {
            uint2 pk;
            pk.x = pack2(o0[4 * qd] * inv, o0[4 * qd + 1] * inv); pk.y = pack2(o0[4 * qd + 2] * inv, o0[4 * qd + 3] * inv);
            *(uint2*)(act + 8 * qd + 4 * h) = pk;
            pk.x = pack2(o1[4 * qd] * inv, o1[4 * qd + 1] * inv); pk.y = pack2(o1[4 * qd + 2] * inv, o1[4 * qd + 3] * inv);
            *(uint2*)(act + 32 + 8 * qd + 4 * h) = pk;
        }
    }
}

constexpr int SC_LD = 4100;
DI void dsa_index_item(const Ctx& c_in, KArgs& a, int b, int s0) {
    const Ctx c = fresh_ctx(c_in.lds);
    unsigned char* ws = a.ws;
    const u16* proj = (const u16*)(ws + WS_PROJ);
    const float* small = (const float*)(ws + WS_SMALL);
    u64* mask = (u64*)(ws + WS_MASK);
    unsigned* SC = (unsigned*)c.lds;
    unsigned* HIST = (unsigned*)(c.lds + 8 * SC_LD * 4);
    unsigned* QMM = HIST + 8 * 272;
    const int l31 = c.lane & 31, h = c.lane >> 5;
    const int tok0 = b * 4096 + s0;
    const int ntile = ((s0 + 7) >> 5) + 1;
    const int npair = (ntile + 1) >> 1;
    if (c.tid < 16) QMM[c.tid] = (c.tid < 8) ? 0xffffffffu : 0u;
    const u16* kbase = (const u16*)(ws + WS_KF) + (size_t)b * 128 * 4 * 512 + c.lane * 8;
    bf16x8 kb[2][4], kn[2][4];
    if (c.wave < npair) {
#pragma unroll
        for (int tt = 0; tt < 2; ++tt)
#pragma unroll
            for (int ks = 0; ks < 4; ++ks) kb[tt][ks] = *(const bf16x8*)(kbase + (size_t)((2 * c.wave + tt) * 4 + ks) * 512);
    }
    bf16x8 qa[2][4];
    float wv[2][16];
#pragma unroll
    for (int rt = 0; rt < 2; ++rt) {
        const int r = rt * 32 + l31, ql = r >> 3, j = r & 7;
        const u16* p = proj + (size_t)(tok0 + ql) * LDP + PC_IDXQ + j * 64 + h * 8;
#pragma unroll
        for (int ks = 0; ks < 4; ++ks) qa[rt][ks] = *(const bf16x8*)(p + ks * 16);
#pragma unroll
        for (int g = 0; g < 4; ++g) {
            const float4 w4 = *(const float4*)(small + (size_t)(tok0 + g + 4 * rt) * 16 + 4 + 4 * h);
            wv[rt][4 * g + 0] = w4.x * 0.044194173824159216f; wv[rt][4 * g + 1] = w4.y * 0.044194173824159216f;
            wv[rt][4 * g + 2] = w4.z * 0.044194173824159216f; wv[rt][4 * g + 3] = w4.w * 0.044194173824159216f;
        }
    }
    unsigned kmin[4], kmax[4];
#pragma unroll
    for (int g = 0; g < 4; ++g) { kmin[g] = 0xffffffffu; kmax[g] = 0u; }
    __syncthreads();
    for (int kp = c.wave; kp < npair; kp += 8) {
        if (kp + 8 < npair) {
#pragma unroll
            for (int tt = 0; tt < 2; ++tt)
#pragma unroll
                for (int ks = 0; ks < 4; ++ks) kn[tt][ks] = *(const bf16x8*)(kbase + (size_t)((2 * (kp + 8) + tt) * 4 + ks) * 512);
        }
#pragma unroll
        for (int tt = 0; tt < 2; ++tt) {
            const int key = (2 * kp + tt) * 32 + l31;
            f32x16 a0 = zero16(), a1 = zero16();
#pragma unroll
            for (int ks = 0; ks < 4; ++ks) { a0 = MFMA32(qa[0][ks], kb[tt][ks], a0); a1 = MFMA32(qa[1][ks], kb[tt][ks], a1); }
            asm volatile("s_nop 15\n\ts_nop 3" : "+v"(a0), "+v"(a1));
#pragma unroll
            for (int g = 0; g < 4; ++g) {
                f32x2 p = {0.f, 0.f};
#pragma unroll
                for (int r3 = 0; r3 < 4; ++r3) {
                    const f32x2 rl = {relu_raw(a0[4 * g + r3]), relu_raw(a1[4 * g + r3])};
                    const f32x2 ww = {wv[0][4 * g + r3], wv[1][4 * g + r3]};
                    p += ww * rl;
                }
                const auto sw = __builtin_amdgcn_permlane32_swap(__float_as_uint(p[0]), __float_as_uint(p[1]), false, false);
                const float sc_ = __uint_as_float(sw[0]) + __uint_as_float(sw[1]);
                const unsigned bits = __float_as_uint(sc_ + 0.0f);
                unsigned k = bits ^ ((unsigned)((int)bits >> 31) | 0x80000000u);
                k = (key <= s0 + 4 * h + g) ? k : 0u;
                SC[(4 * h + g) * SC_LD + key] = k;
                kmax[g] = max(kmax[g], k); kmin[g] = min(kmin[g], k ? k : 0xffffffffu);
            }
        }
#pragma unroll
        for (int tt = 0; tt < 2; ++tt)
#pragma unroll
            for (int ks = 0; ks < 4; ++ks) kb[tt][ks] = kn[tt][ks];
    }
#pragma unroll
    for (int g = 0; g < 4; ++g) {
#pragma unroll
        for (int o = 16; o >= 1; o >>= 1) { kmin[g] = min(kmin[g], (unsigned)__shfl_xor((int)kmin[g], o)); kmax[g] = max(kmax[g], (unsigned)__shfl_xor((int)kmax[g], o)); }
        if (l31 == 0) { atomicMin(&QMM[4 * h + g], kmin[g]); atomicMax(&QMM[8 + 4 * h + g], kmax[g]); }
    }
    __syncthreads();
    {
        const int qi = __builtin_amdgcn_readfirstlane(s0 + c.wave), n = qi + 1;
        const unsigned* sc = SC + c.wave * SC_LD + c.lane;
        unsigned* hist = HIST + c.wave * 272;
        const int nit = (n + 63) >> 6;
        unsigned thr = 1u; int cut = 0x7fffffff;
        if (n > 256) {
            unsigned lo = (unsigned)__builtin_amdgcn_readfirstlane((int)QMM[c.wave]), hi = (unsigned)__builtin_amdgcn_readfirstlane((int)QMM[8 + c.wave]);
            const unsigned lo_full = lo, hi_full = hi;
            bool filtered = false;
            {
                const int m = (int)(32768.f / (float)n) + 6;
                if (m < 60) {
                    const int sidx = (c.lane * 13 + 5) % nit;
                    const unsigned smp = sc[sidx * 64];
                    int rank = 0;
#pragma unroll
                    for (int j = 0; j < 64; ++j) { const unsigned sj = (unsigned)__builtin_amdgcn_readlane((int)smp, j); rank += (sj > smp) ? 1 : 0; }
                    unsigned cand = (rank <= m - 1) ? smp : 0xffffffffu;
#pragma unroll
                    for (int o = 32; o >= 1; o >>= 1) cand = min(cand, (unsigned)__shfl_xor((int)cand, o));
                    const unsigned L = (unsigned)__builtin_amdgcn_readfirstlane((int)cand);
                    if (L > lo && L <= hi) { lo = L; filtered = true; }
                }
            }
            int kk = 256;
            for (int iter = 0; iter < 6; ++iter) {
                const unsigned width = hi - lo;
                const int shift = max(0, 24 - (int)__clz(width | 1u));
#pragma unroll
                for (int j = 0; j < 5; ++j) { const int idx = c.lane + 64 * j; if (idx < 272) hist[idx] = 0u; }
#pragma unroll 1
                for (int it0 = 0; it0 < nit; it0 += 8) {
                    unsigned kv[8];
#pragma unroll
                    for (int j = 0; j < 8; ++j) kv[j] = sc[(it0 + j) * 64];
#pragma unroll
                    for (int j = 0; j < 8; ++j) {
                        const unsigned d = kv[j] - lo;
                        if (it0 + j < nit && d <= width) atomicAdd(&hist[d >> shift], 1u);
                    }
                }
                const unsigned c0 = hist[4 * c.lane], c1 = hist[4 * c.lane + 1], c2 = hist[4 * c.lane + 2], c3 = hist[4 * c.lane + 3];
                const unsigned ls = c0 + c1 + c2 + c3;
                unsigned suf = ls;
#pragma unroll
                for (int o = 1; o < 64; o <<= 1) { const unsigned tv = __shfl_down(suf, o); if (c.lane + o < 64) suf += tv; }
                if (filtered) {
                    filtered = false;
                    if ((unsigned)__builtin_amdgcn_readfirstlane((int)suf) < (unsigned)kk) { lo = lo_full; hi = hi_full; continue; }
                }
                const unsigned above_lane = suf - ls;
                const bool mine = (suf >= (unsigned)kk) && (above_lane < (unsigned)kk);
                int bstar = 0; unsigned above = 0, cntb = 0;
                if (mine) {
                    unsigned run = above_lane;
                    if (run + c3 >= (unsigned)kk) { bstar = 4 * c.lane + 3; above = run; cntb = c3; }
                    else { run += c3;
                        if (run + c2 >= (unsigned)kk) { bstar = 4 * c.lane + 2; above = run; cntb = c2; }
                        else { run += c2;
                            if (run + c1 >= (unsigned)kk) { bstar = 4 * c.lane + 1; above = run; cntb = c1; }
                            else { run += c1; bstar = 4 * c.lane; above = run; cntb = c0; } } }
                }
                const u64 mm = __ballot(mine);
                const int src = __ffsll((long long)mm) - 1;
                bstar = __shfl(bstar, src); above = __shfl(above, src); cntb = __shfl(cntb, src);
                kk -= (int)above;
                const unsigned nlo = lo + ((unsigned)bstar << shift);
                const unsigned nhi = min(hi, nlo + ((1u << shift) - 1u));
                lo = nlo; hi = nhi; thr = lo;
                if ((int)cntb == kk) break;
                if (shift == 0) {
                    int need = kk;
                    for (int it = 0; it < nit; ++it) {
                        const unsigned k = sc[it * 64];
                        const bool e = (k == thr);
                        const u64 mk = __ballot(e); const int cn = __popcll(mk);
                        if (need <= cn) {
                            const u64 sel = __ballot(e && (__popcll(mk & ((1ull << c.lane) - 1ull)) == need - 1));
                            cut = it * 64 + (__ffsll((long long)sel) - 1);
                            break;
                        }
                        need -= cn;
                    }
                    break;
                }
            }
        }
        u64* mrow = mask + (size_t)(b * 4096 + qi) * 64;
        u64 myword = 0;
        const bool tie = (cut != 0x7fffffff);
#pragma unroll 1
        for (int it0 = 0; it0 < nit; it0 += 8) {
            unsigned kv[8];
#pragma unroll
            for (int j = 0; j < 8; ++j) kv[j] = sc[(it0 + j) * 64];
#pragma unroll
            for (int j = 0; j < 8; ++j) {
                const unsigned k = (it0 + j < nit) ? kv[j] : 0u;
                bool sel = (k >= thr);
                if (tie) sel = (k > thr) || (k == thr && ((it0 + j) * 64 + c.lane) <= cut);
                const u64 wd = __ballot(sel);
                if (c.lane == it0 + j) myword = wd;
            }
        }
        mrow[c.lane] = myword;
    }
    __syncthreads();
}

DI void phase_outproj(const Ctx& c_in, KArgs& a, int l) {
    const Ctx c = fresh_ctx(c_in.lds);
    unsigned char* ws = a.ws;
    const u16* act = (const u16*)(ws + WS_ACT);
    const u16* w = (const u16*)(ws + WS_WOUT) + (size_t)l * 1024 * 1024;
    const float* xin = (l == 0) ? a.in[0] : a.out;
    float* out = a.out;
    int R, C; g2_stage_rc(c.tid * 16, R, C);
    const int nunits = (T_TOK / 256) * 4;
    for (int u = vblock(); u < nunits; u += gridDim.x) {
        const int pm = (u >> 4) * 4 + (u & 3), pn = (u >> 2) & 3;
        G2Ptrs g;
        g.ra = g2_rsrc(act); g.rb = g2_rsrc(w);
        g.va00 = (unsigned)(R * 1024 + C) * 2u; g.va01 = g.va00 + 64 * 2048; g.va10 = g.va00 + 128 * 2048; g.va11 = g.va00 + 192 * 2048;
        g.vb0 = g.va00; g.vb1 = g.va01;
        g.sa = (unsigned)pm * (256u * 2048u); g.sb0 = (unsigned)pn * (256u * 2048u); g.sb1 = g.sb0 + 128u * 2048u;
        __syncthreads();
        gemm256_unit(c, g, 1024, [&](const f32x4 (&acc)[2][2][4][2], int wr, int wc, int fr, int fq) {
#pragma unroll
            for (int ai = 0; ai < 2; ++ai)
#pragma unroll
                for (int m = 0; m < 4; ++m) {
                    const size_t rowoff = (size_t)(pm * 256 + ai * 128 + wr * 64 + m * 16 + fr) * 1024 + pn * 256 + wc * 32 + 4 * fq;
#pragma unroll
                    for (int bj = 0; bj < 2; ++bj)
#pragma unroll
                        for (int n = 0; n < 2; ++n) {
                            const f32x4 xv = *(const f32x4*)(xin + rowoff + bj * 128 + n * 16);
                            *(f32x4*)(out + rowoff + bj * 128 + n * 16) = xv + acc[ai][bj][m][n];
                        }
                }
        });
    }
}

constexpr int RT_LD = 1032;
DI void phase_router(const Ctx& c_in, KArgs& a, int l) {
    const Ctx c = fresh_ctx(c_in.lds);
    unsigned char* ws = a.ws;
    const float* x = a.out;
    const float* g = a.in[16] + l * 1024;
    const float* brg = a.in[18] + l * 4;
    const float* bre = a.in[20] + l * 32;
    const u16* wrh = (const u16*)(ws + WS_WRH) + (size_t)l * 64 * 1024;
    const u16* wrl = (const u16*)(ws + WS_WRL) + (size_t)l * 64 * 1024;
    u16* act = (u16*)(ws + WS_ACT);
    int* cnt = (int*)(ws + WS_CTL);
    int* list = (int*)(ws + WS_LIST);
    float* tokw = (float*)(ws + WS_TOKW);
    u16* HI = (u16*)c.lds;
    u16* LO = HI + 32 * RT_LD;
    float* LG = (float*)(c.lds + 2 * 32 * RT_LD * 2);
    const int l31 = c.lane & 31, h = c.lane >> 5;
    for (int it = bid(); it < T_TOK / 32; it += gridDim.x) {
        const int t0 = it * 32;
#pragma unroll
        for (int tt = 0; tt < 4; ++tt) {
            const int tl = c.wave * 4 + tt, t = t0 + tl;
            const float* xr = x + (size_t)t * 1024 + c.lane * 4;
            float4 v[4]; float ss = 0.f;
#pragma unroll
            for (int j = 0; j < 4; ++j) { v[j] = *(const float4*)(xr + 256 * j); ss += v[j].x * v[j].x + v[j].y * v[j].y + v[j].z * v[j].z + v[j].w * v[j].w; }
            ss = wsum(ss);
            const float rs = rsqrtf(ss * (1.f / 1024.f) + EPS);
#pragma unroll
            for (int j = 0; j < 4; ++j) {
                const float4 gg = *(const float4*)(g + c.lane * 4 + 256 * j);
                const float h0 = v[j].x * rs * gg.x, h1 = v[j].y * rs * gg.y, h2 = v[j].z * rs * gg.z, h3 = v[j].w * rs * gg.w;
                const u16 b0 = f2bf(h0), b1 = f2bf(h1), b2 = f2bf(h2), b3 = f2bf(h3);
                const uint2 hp = make_uint2((unsigned)b0 | ((unsigned)b1 << 16), (unsigned)b2 | ((unsigned)b3 << 16));
                const uint2 lp = make_uint2(pack2(h0 - bf2f(b0), h1 - bf2f(b1)), pack2(h2 - bf2f(b2), h3 - bf2f(b3)));
                *(uint2*)(act + (size_t)t * 1024 + c.lane * 4 + 256 * j) = hp;
                *(uint2*)(HI + tl * RT_LD + c.lane * 4 + 256 * j) = hp;
                *(uint2*)(LO + tl * RT_LD + c.lane * 4 + 256 * j) = lp;
            }
        }
        __syncthreads();
        {
            const int k0 = c.wave * 128 + h * 8;
            f32x16 acc0 = zero16(), acc1 = zero16();
#pragma unroll
            for (int ks = 0; ks < 8; ++ks) {
                const int k = k0 + ks * 16;
                const bf16x8 ah = *(const bf16x8*)(HI + l31 * RT_LD + k);
                const bf16x8 al = *(const bf16x8*)(LO + l31 * RT_LD + k);
                const bf16x8 bh0 = *(const bf16x8*)(wrh + (size_t)l31 * 1024 + k);
                const bf16x8 bh1 = *(const bf16x8*)(wrh + (size_t)(32 + l31) * 1024 + k);
                const bf16x8 bl0 = *(const bf16x8*)(wrl + (size_t)l31 * 1024 + k);
                const bf16x8 bl1 = *(const bf16x8*)(wrl + (size_t)(32 + l31) * 1024 + k);
                acc0 = MFMA32(ah, bh0, acc0); acc0 = MFMA32(ah, bl0, acc0); acc0 = MFMA32(al, bh0, acc0);
                acc1 = MFMA32(ah, bh1, acc1); acc1 = MFMA32(ah, bl1, acc1); acc1 = MFMA32(al, bh1, acc1);
            }
            __syncthreads();
            float* PART = (float*)c.lds + c.wave * (32 * 37);
#pragma unroll
            for (int r = 0; r < 16; ++r) {
                PART[crow(r, h) * 37 + l31] = acc0[r];
                if (l31 < 4) PART[crow(r, h) * 37 + 32 + l31] = acc1[r];
            }
        }
        __syncthreads();
        for (int i = c.tid; i < 32 * 36; i += NTHR) {
            const int tk = i / 36, e = i % 36;
            float s = 0.f;
#pragma unroll
            for (int w2 = 0; w2 < 8; ++w2) s += ((const float*)c.lds)[w2 * (32 * 37) + tk * 37 + e];
            LG[tk * 65 + e] = s;
        }
        __syncthreads();
        int* lcnt = (int*)(LG + 32 * 65);
        if (c.tid < 64) lcnt[c.tid] = 0;
        __syncthreads();
        int myL1 = 0, myL2 = 0, r1 = 0, r2 = 0; float w1 = 0.f, w2 = 0.f;
        if (c.tid < 32) {
            const float* lg = LG + c.tid * 65;
            float gl[4];
#pragma unroll
            for (int e = 0; e < 4; ++e) gl[e] = lg[e] + brg[e];
            int gi = 0; float gm = gl[0];
#pragma unroll
            for (int e = 1; e < 4; ++e) if (gl[e] > gm) { gm = gl[e]; gi = e; }
            float den = 0.f;
#pragma unroll
            for (int e = 0; e < 4; ++e) den += __expf(gl[e] - gm);
            const float gp = 1.f / den;
            float el[8];
#pragma unroll
            for (int e = 0; e < 8; ++e) el[e] = lg[4 + gi * 8 + e] + bre[gi * 8 + e];
            int i1 = 0; float v1 = el[0];
#pragma unroll
            for (int e = 1; e < 8; ++e) if (el[e] > v1) { v1 = el[e]; i1 = e; }
            int i2 = 0; float v2 = -INFINITY;
#pragma unroll
            for (int e = 0; e < 8; ++e) if (e != i1 && el[e] > v2) { v2 = el[e]; i2 = e; }
            const float ex = __expf(v2 - v1);
            w1 = gp / (1.f + ex); w2 = gp * ex / (1.f + ex);
            myL1 = (gi * 8 + i1) * 2; myL2 = (gi * 8 + i2) * 2 + 1;
            r1 = atomicAdd(&lcnt[myL1], 1); r2 = atomicAdd(&lcnt[myL2], 1);
        }
        __syncthreads();
        if (c.tid < 64) { const int n = lcnt[c.tid]; lcnt[c.tid] = (n > 0) ? atomicAdd(&cnt[c.tid], n) : 0; }
        __syncthreads();
        if (c.tid < 32) {
            const int t = t0 + c.tid;
            list[(size_t)myL1 * 32768 + lcnt[myL1] + r1] = t;
            list[(size_t)myL2 * 32768 + lcnt[myL2] + r2] = t;
            tokw[t * 2] = w1; tokw[t * 2 + 1] = w2;
        }
        __syncthreads();
    }
}

DI int moe_setup(const Ctx& c, KArgs& a, int ntn, int kfilter, int* tstart  ) {
    const int* cnt = (const int*)(a.ws + WS_CTL);
    if (c.tid < 64) {
        const int L = c.tid;
        const int n = __hip_atomic_load(&cnt[L], __ATOMIC_RELAXED, __HIP_MEMORY_SCOPE_AGENT);
        const int mine = (kfilter < 0 || (L & 1) == kfilter) ? ((n + 255) >> 8) * ntn : 0;
        int inc = mine;
#pragma unroll
        for (int o = 1; o < 64; o <<= 1) { const int tv = __shfl_up(inc, o); if (L >= o) inc += tv; }
        tstart[L] = inc - mine;
        if (L == 63) tstart[64] = inc;
    }
    __syncthreads();
    return tstart[64];
}

constexpr int MOE_LDS_OFF = G2_LDS_BYTES;
DI void phase_moe_up(const Ctx& c_in, KArgs& a) {
    const Ctx c = fresh_ctx(c_in.lds);
    unsigned char* ws = a.ws;
    const u16* act = (const u16*)(ws + WS_ACT);
    const int* cnt = (const int*)(ws + WS_CTL);
    const int* list = (const int*)(ws + WS_LIST);
    const float* tokw = (const float*)(ws + WS_TOKW);
    u16* hmid = (u16*)(ws + WS_HMID);
    int* tstart = (int*)(c.lds + MOE_LDS_OFF);
    int* tok_s = (int*)(c.lds + MOE_LDS_OFF + 512);
    int R, C; g2_stage_rc(c.tid * 16, R, C);
    const int total = moe_setup(c, a, 2, -1, tstart);
    for (int tile = vblock(); tile < total; tile += gridDim.x) {
        int L = 0;
        for (int j = 0; j < 64; ++j) if (tstart[j + 1] <= tile) L = j + 1;
        const int rel = tile - tstart[L], mi = rel >> 1, nt = rel & 1;
        const int e = L >> 1, kr = L & 1;
        const int n = __hip_atomic_load(&cnt[L], __ATOMIC_RELAXED, __HIP_MEMORY_SCOPE_AGENT);
        __syncthreads();
        if (c.tid < 256) { const int r = mi * 256 + c.tid; tok_s[c.tid] = (r < n) ? list[(size_t)L * 32768 + r] : -1; }
        __syncthreads();
        G2Ptrs g;
        g.ra = g2_rsrc(act); g.rb = g2_rsrc(ws + WS_WG);
        { const int t0 = tok_s[R], t1 = tok_s[R + 64], t2 = tok_s[R + 128], t3 = tok_s[R + 192];
          g.va00 = (unsigned)((t0 < 0 ? 0 : t0) * 1024 + C) * 2u; g.va01 = (unsigned)((t1 < 0 ? 0 : t1) * 1024 + C) * 2u;
          g.va10 = (unsigned)((t2 < 0 ? 0 : t2) * 1024 + C) * 2u; g.va11 = (unsigned)((t3 < 0 ? 0 : t3) * 1024 + C) * 2u; }
        g.vb0 = (unsigned)(R * 1024 + C) * 2u; g.vb1 = g.vb0 + 64 * 2048;
        g.sa = 0u; g.sb0 = (unsigned)(e * 256 + nt * 128) * 2048u; g.sb1 = g.sb0 + (unsigned)(WS_WU - WS_WG);
        gemm256_unit(c, g, 1024, [&](const f32x4 (&acc)[2][2][4][2], int wr, int wc, int fr, int fq) {
#pragma unroll
            for (int ai = 0; ai < 2; ++ai)
#pragma unroll
                for (int m = 0; m < 4; ++m) {
                    const int tk = tok_s[ai * 128 + wr * 64 + m * 16 + fr];
                    if (tk >= 0) {
                        const float wgt = tokw[tk * 2 + kr];
                        u16* dst = hmid + ((size_t)tk * 2 + kr) * 256 + nt * 128 + wc * 32 + 4 * fq;
#pragma unroll
                        for (int n2 = 0; n2 < 2; ++n2) {
                            const f32x4 gv = acc[ai][0][m][n2], uv = acc[ai][1][m][n2];
                            uint2 pk;
                            pk.x = pack2(siluf(gv[0]) * uv[0] * wgt, siluf(gv[1]) * uv[1] * wgt);
                            pk.y = pack2(siluf(gv[2]) * uv[2] * wgt, siluf(gv[3]) * uv[3] * wgt);
                            *(uint2*)(dst + n2 * 16) = pk;
                        }
                    }
                }
        });
    }
}

DI void phase_moe_down(const Ctx& c_in, KArgs& a) {
    const Ctx c = fresh_ctx(c_in.lds);
    unsigned char* ws = a.ws;
    const int* cnt = (const int*)(ws + WS_CTL);
    const int* list = (const int*)(ws + WS_LIST);
    const u16* hmid = (const u16*)(ws + WS_HMID);
    u16* yffn = (u16*)(ws + WS_YFFN);
    int* tstart = (int*)(c.lds + MOE_LDS_OFF);
    int* tok_s = (int*)(c.lds + MOE_LDS_OFF + 512);
    int R, C; g2_stage_rc(c.tid * 16, R, C);
    const int total = moe_setup(c, a, 4, -1, tstart);
    for (int tile = vblock(); tile < total; tile += gridDim.x) {
        int L = 0;
        for (int j = 0; j < 64; ++j) if (tstart[j + 1] <= tile) L = j + 1;
        const int rel = tile - tstart[L], mi = rel >> 2, nt = rel & 3;
        const int e = L >> 1, kr = L & 1;
        const int n = __hip_atomic_load(&cnt[L], __ATOMIC_RELAXED, __HIP_MEMORY_SCOPE_AGENT);
        __syncthreads();
        if (c.tid < 256) { const int r = mi * 256 + c.tid; tok_s[c.tid] = (r < n) ? list[(size_t)L * 32768 + r] : -1; }
        __syncthreads();
        G2Ptrs g;
        g.ra = g2_rsrc(hmid); g.rb = g2_rsrc(ws + WS_WD);
        { const int t0 = tok_s[R], t1 = tok_s[R + 64], t2 = tok_s[R + 128], t3 = tok_s[R + 192];
          g.va00 = (unsigned)(((t0 < 0 ? 0 : t0) * 2 + kr) * 256 + C) * 2u; g.va01 = (unsigned)(((t1 < 0 ? 0 : t1) * 2 + kr) * 256 + C) * 2u;
          g.va10 = (unsigned)(((t2 < 0 ? 0 : t2) * 2 + kr) * 256 + C) * 2u; g.va11 = (unsigned)(((t3 < 0 ? 0 : t3) * 2 + kr) * 256 + C) * 2u; }
        g.vb0 = (unsigned)(R * 256 + C) * 2u; g.vb1 = g.vb0 + 64 * 512;
        g.sa = 0u; g.sb0 = (unsigned)(e * 1024 + nt * 256) * 512u; g.sb1 = g.sb0 + 128u * 512u;
        gemm256_unit(c, g, 256, [&](const f32x4 (&acc)[2][2][4][2], int wr, int wc, int fr, int fq) {
#pragma unroll
            for (int ai = 0; ai < 2; ++ai)
#pragma unroll
                for (int m = 0; m < 4; ++m) {
                    const int tk = tok_s[ai * 128 + wr * 64 + m * 16 + fr];
                    if (tk >= 0) {
                        u16* dst = yffn + ((size_t)tk * 2 + kr) * 1024 + nt * 256 + wc * 32 + 4 * fq;
#pragma unroll
                        for (int bj = 0; bj < 2; ++bj)
#pragma unroll
                            for (int n2 = 0; n2 < 2; ++n2) {
                                const f32x4 v = acc[ai][bj][m][n2];
                                uint2 pk; pk.x = pack2(v[0], v[1]); pk.y = pack2(v[2], v[3]);
                                *(uint2*)(dst + bj * 128 + n2 * 16) = pk;
                            }
                    }
                }
        });
    }
}

DI void phase_final(const Ctx& c_in, KArgs& a) {
    const Ctx c = fresh_ctx(c_in.lds);
    float* x = a.out;
    const float* g = a.in[24];
    for (int it = bid(); it < T_TOK / 8; it += gridDim.x) {
        const int t = it * 8 + c.wave;
        float* xr = x + (size_t)t * 1024;
        float v[16]; float ss = 0.f;
        const u16* y0 = (const u16*)(a.ws + WS_YFFN) + (size_t)t * 2048;
#pragma unroll
        for (int j = 0; j < 16; ++j) { v[j] = xr[c.lane + 64 * j] + bf2f(y0[c.lane + 64 * j]) + bf2f(y0[1024 + c.lane + 64 * j]); ss += v[j] * v[j]; }
        ss = wsum(ss);
        const float rs = rsqrtf(ss * (1.f / 1024.f) + EPS);
#pragma unroll
        for (int j = 0; j < 16; ++j) xr[c.lane + 64 * j] = v[j] * rs * g[c.lane + 64 * j];
    }
}

#define XB_TMO      128
#define XB_XCNT(j)  (256  + 64 * (j))
#define XB_XSUB(j)  (1280 + 64 * (j))
#define XB_XGEN(j)  (2304 + 64 * (j))
#define XB_TOP      3328
#define XB_TOPGEN   3392
#define XCD_BAR_WORDS 3456
#define XB_SPIN_CAP (1u << 22)
#define LAS __attribute__((address_space(3)))
DI unsigned xb_ld(unsigned* p)              { return __hip_atomic_load(p, __ATOMIC_RELAXED, __HIP_MEMORY_SCOPE_AGENT); }
DI unsigned xb_add(unsigned* p, unsigned v) { return __hip_atomic_fetch_add(p, v, __ATOMIC_RELAXED, __HIP_MEMORY_SCOPE_AGENT); }
DI unsigned xb_xcc_id() { return (unsigned)__builtin_amdgcn_s_getreg((3 << 11) | 20) & 0xFu; }
#define XB_SPIN(cond, bar) do { unsigned _sp = 0; while (cond) { __builtin_amdgcn_s_sleep(1); \
    if ((++_sp & 255u) == 0u) { if (xb_ld(&(bar)[XB_TMO])) break; if (_sp > XB_SPIN_CAP) { atomicAdd(&(bar)[XB_TMO], 1u); break; } } } } while (0)
struct XcdBarrier { unsigned* bar; unsigned x; volatile LAS unsigned* st; };
DI XcdBarrier xcd_barrier_post(unsigned* bar, volatile LAS unsigned* st) {
    XcdBarrier b; b.bar = bar; b.x = xb_xcc_id(); b.st = st;
    if (threadIdx.x == 0) (void)xb_add(&bar[XB_XCNT(b.x)], 1u);
    return b;
}
DI void xcd_barrier_complete(unsigned* bar, unsigned x, unsigned& nloc, unsigned& nx) {
    const unsigned G = gridDim.x * gridDim.y * gridDim.z;
    unsigned sum, cnt, mine, sp = 0u;
    for (;;) {
        sum = 0u; cnt = 0u; mine = 0u;
#pragma unroll
        for (unsigned j = 0; j < 16; ++j) { const unsigned cc = xb_ld(&bar[XB_XCNT(j)]); sum += cc; cnt += (cc > 0u) ? 1u : 0u; mine = (j == x) ? cc : mine; }
        if (sum == G) break;
        __builtin_amdgcn_s_sleep(1);
        if ((++sp & 255u) == 0u) { if (xb_ld(&bar[XB_TMO])) break; if (sp > XB_SPIN_CAP) { atomicAdd(&bar[XB_TMO], 1u); break; } }
    }
    nloc = mine > 0u ? mine : 1u; nx = cnt > 0u ? cnt : 1u;
}
DI void xcd_barrier(const XcdBarrier& b) {
    asm volatile("s_waitcnt vmcnt(0)" ::: "memory");
    __syncthreads();
    if (threadIdx.x == 0) {
        unsigned* bar = b.bar;
        __builtin_amdgcn_s_waitcnt(0);
        unsigned nloc = b.st[0], nx = b.st[1];
        if (nloc == 0u) { xcd_barrier_complete(bar, b.x, nloc, nx); b.st[0] = nloc; b.st[1] = nx; }
        const unsigned old = xb_add(&bar[XB_XSUB(b.x)], 1u);
        const unsigned gen = old / nloc;
        if (old + 1u == (gen + 1u) * nloc) {
            __builtin_amdgcn_fence(__ATOMIC_RELEASE, "agent");
            asm volatile("s_waitcnt vmcnt(0)" ::: "memory");
            const unsigned og = xb_add(&bar[XB_TOP], 1u);
            const unsigned tg = og / nx;
            if (og + 1u == (tg + 1u) * nx) xb_add(&bar[XB_TOPGEN], 1u);
            else XB_SPIN(xb_ld(&bar[XB_TOPGEN]) == tg, bar);
            __builtin_amdgcn_fence(__ATOMIC_ACQUIRE, "agent");
            xb_add(&bar[XB_XGEN(b.x)], 1u);
            asm volatile("s_waitcnt vmcnt(0)" ::: "memory");
        } else {
            XB_SPIN(xb_ld(&bar[XB_XGEN(b.x)]) == gen, bar);
            __builtin_amdgcn_fence(__ATOMIC_ACQUIRE, "agent");
            asm volatile("s_waitcnt vmcnt(0)" ::: "memory");
        }
    }
    __syncthreads();
}

template <int SP>
DI void run_phase(const Ctx& c, KArgs& a, int l) {
    if constexpr (SP == 11) phase_prep(c, a);
    else if constexpr (SP == 12) phase_final(c, a);
    else if constexpr (SP == 0) phase_norm_in(c, a, l);
    else if constexpr (SP == 1) phase_inproj(c, a, l);
    else if constexpr (SP == 2) {
        const int n_ssd = 256, n_q = 128 * 3, n_kv = 128 * 4;
        for (int it = bid(); it < n_ssd + n_q + n_kv; it += gridDim.x) {
            if (it < n_ssd) ssd_state_item(c, a, l, it);
            else if (it < n_ssd + n_q) mla_up_item(c, a, l, 0, it - n_ssd);
            else mla_up_item(c, a, l, 1, it - n_ssd - n_q);
        }
    }
    else if constexpr (SP == 3) { for (int it = bid(); it < 512; it += gridDim.x) ssd_scan_item(c, a, it); }
    else if constexpr (SP == 4) {
        int* ctr = (int*)(a.ws + WS_CTL) + 256 + l;
        volatile int* s_item = (volatile int*)(c.lds + LDS_BYTES - 32);
        for (;;) {
            __syncthreads();
            if (threadIdx.x == 0) *s_item = atomicAdd(ctr, 1);
            __syncthreads();
            const int it = *s_item;
            if (it >= 1024 + 512 + 256 + 768) break;
            if (it < 1024) {
                const int j = 15 - (it >> 6), r = it & 63;
                if (r >= 8 && r < 40) { const int rem = r - 8; attn_item<96, 0>(c, a, l, rem >> 2, rem & 3, j); }
                else {
                    const int sub = (r < 8) ? 3 : 2 - ((r - 40) >> 3);
                    const int b = r & 7, qb = 4 * j + sub;
                    for (int g8 = 0; g8 < 8; ++g8) dsa_index_item(c, a, b, qb * 64 + g8 * 8);
                    asm volatile("s_waitcnt vmcnt(0)" ::: "memory");
                    __syncthreads();
                    attn_item<64, 2>(c, a, l, b, 0, qb);
                }
            } else if (it < 1536) { const int i2 = it - 1024; attn_item<64, 1>(c, a, l, (i2 & 31) >> 2, i2 & 3, 15 - (i2 >> 5)); }
            else if (it < 1792) ssd_out_item(c, a, l, it - 1536);
            else { const Ctx cc = fresh_ctx(c.lds); expert_conv_item(cc, a, l, (it - 1792) * 2); expert_conv_item(cc, a, l, (it - 1792) * 2 + 1); }
        }
    }
    else if constexpr (SP == 5) phase_outproj(c, a, l);
    else if constexpr (SP == 6) phase_router(c, a, l);
    else if constexpr (SP == 7) phase_moe_up(c, a);
    else if constexpr (SP == 8) phase_moe_down(c, a);
}

#ifndef ONE_LAUNCH
#define ONE_LAUNCH 1
#endif

#if ONE_LAUNCH
__global__ void __launch_bounds__(NTHR) mega(Args a_unused) {
    extern __shared__ __attribute__((aligned(16))) unsigned char lds[];
    cg::grid_group grid = cg::this_grid();
    Ctx c; c.tid = threadIdx.x; c.lane = c.tid & 63; c.wave = 0; c.lds = lds;
    volatile LAS unsigned* st = (volatile LAS unsigned*)(lds + LDS_BYTES - 16);
    if (threadIdx.x == 0) { st[0] = 0u; st[1] = 0u; }
    __syncthreads();
    XcdBarrier bar = xcd_barrier_post((unsigned*)(a_unused.ws + WS_BAR), st);
#ifdef PROBE_SP
#define MEGA_PHASE(SPN, L) do { KArgs* kp_ = (KArgs*)__builtin_amdgcn_kernarg_segment_ptr(); asm volatile("" : "+s"(kp_)); \
        const unsigned long long pt0_ = __builtin_amdgcn_s_memrealtime(); run_phase<SPN>(c, *kp_, (L)); \
        if (SPN == PROBE_SP) { xcd_barrier(bar); const unsigned long long pt1_ = __builtin_amdgcn_s_memrealtime(); \
            while (__builtin_amdgcn_s_memrealtime() - pt1_ < (pt1_ - pt0_)) __builtin_amdgcn_s_sleep(8); } } while (0)
#else
#define MEGA_PHASE(SPN, L) do { KArgs* kp_ = (KArgs*)__builtin_amdgcn_kernarg_segment_ptr(); asm volatile("" : "+s"(kp_)); run_phase<SPN>(c, *kp_, (L)); } while (0)
#endif
    MEGA_PHASE(11, 0);
    grid.sync();
#pragma unroll 1
    for (int l = 0; l < DEPTH; ++l) {
        if (l > 0) xcd_barrier(bar);
        MEGA_PHASE(0, l); xcd_barrier(bar);
        MEGA_PHASE(1, l); xcd_barrier(bar);
        MEGA_PHASE(2, l); xcd_barrier(bar);
        MEGA_PHASE(3, l); xcd_barrier(bar);
        MEGA_PHASE(4, l); xcd_barrier(bar);
        MEGA_PHASE(5, l); xcd_barrier(bar);
        MEGA_PHASE(6, l); xcd_barrier(bar);
        MEGA_PHASE(7, l); xcd_barrier(bar);
        MEGA_PHASE(8, l);
    }
    xcd_barrier(bar);
    MEGA_PHASE(12, 0);
}
#else
template <int SP>
__global__ void __launch_bounds__(NTHR) kphase(Args a, int l) {
    extern __shared__ __attribute__((aligned(16))) unsigned char lds[];
    Ctx c; c.tid = threadIdx.x; c.lane = c.tid & 63; c.wave = __builtin_amdgcn_readfirstlane(c.tid >> 6); c.lds = lds;
    KArgs* kp = (KArgs*)__builtin_amdgcn_kernarg_segment_ptr();
    run_phase<SP>(c, *kp, l);
}
template <int SP>
static void launch_phase(const Args& a, int l, int grid, hipStream_t stream) {
    static bool attr_set = false;
    if (!attr_set) { (void)hipFuncSetAttribute((const void*)kphase<SP>, hipFuncAttributeMaxDynamicSharedMemorySize, LDS_BYTES); attr_set = true; }
    hipLaunchKernelGGL(kphase<SP>, dim3(grid), dim3(NTHR), LDS_BYTES, stream, a, l);
}
#endif

extern "C" void kernel_launch(void* const* d_in, const int* in_sizes, int n_in, void* d_out, int out_size, void* d_ws, size_t ws_size, hipStream_t stream) {
    static int grid = 0;
    if (grid == 0) {
        if (n_in != 25 || ws_size < WS_END) { fprintf(stderr, "kernel_launch: unexpected inputs (n_in %d, ws %zu, need %zu)\n", n_in, ws_size, (size_t)WS_END); grid = -1; return; }
        int dev = 0, cus = 0;
        (void)hipGetDevice(&dev);
        (void)hipDeviceGetAttribute(&cus, hipDeviceAttributeMultiprocessorCount, dev);
        if (cus <= 0) cus = 256;
#if ONE_LAUNCH
        int per_cu = 0;
        if (hipFuncSetAttribute((const void*)mega, hipFuncAttributeMaxDynamicSharedMemorySize, LDS_BYTES) != hipSuccess) { fprintf(stderr, "kernel_launch: hipFuncSetAttribute failed\n"); grid = -1; return; }
        if (hipOccupancyMaxActiveBlocksPerMultiprocessor(&per_cu, (const void*)mega, NTHR, LDS_BYTES) != hipSuccess || per_cu < 1) { fprintf(stderr, "kernel_launch: occupancy query says %d blocks per CU\n", per_cu); (void)hipGetLastError(); grid = -1; return; }
        grid = cus;
#else
        grid = cus;
#endif
    }
    if (grid < 0) return;
    Args a{};
    for (int i = 0; i < 25; ++i) a.in[i] = (const float*)d_in[i];
    a.out = (float*)d_out; a.ws = (unsigned char*)d_ws;
    for (int i = 0; i < 8; ++i) a.inv16[i] = (float)pow(500000.0, -(double)i / 8.0);
    for (int i = 0; i < 16; ++i) a.inv32[i] = (float)pow(500000.0, -(double)i / 16.0);
    a.ph_lo = 0; a.ph_hi = 0;
#if ONE_LAUNCH
    (void)hipMemsetAsync((unsigned char*)d_ws + WS_CTL, 0, WS_CTL_BYTES, stream);
    void* kargs[] = { &a };
    hipError_t e = hipLaunchCooperativeKernel((const void*)mega, dim3(grid), dim3(NTHR), kargs, LDS_BYTES, stream);
    if (e != hipSuccess) fprintf(stderr, "kernel_launch: cooperative launch failed: %s (grid %d)\n", hipGetErrorString(e), grid);
#else
    launch_phase<11>(a, 0, grid, stream);
    for (int l = 0; l < DEPTH; ++l) {
        launch_phase<0>(a, l, grid, stream);
        launch_phase<1>(a, l, grid, stream);
        launch_phase<2>(a, l, grid, stream);
        launch_phase<3>(a, l, grid, stream);
        launch_phase<4>(a, l, grid, stream);
        launch_phase<5>(a, l, grid, stream);
        launch_phase<6>(a, l, grid, stream);
        launch_phase<7>(a, l, grid, stream);
        launch_phase<8>(a, l, grid, stream);
    }
    launch_phase<12>(a, 0, grid, stream);
#endif
}
```

```cpp
#include <hip/hip_runtime.h>
#include <hip/hip_cooperative_groups.h>
#include <cstdio>
#include <cmath>
#include <cstdint>


namespace cg = cooperative_groups;

typedef __attribute__((ext_vector_type(8))) short bf16x8;
typedef __attribute__((ext_vector_type(4))) short bf16x4;
typedef __attribute__((ext_vector_type(16))) float f32x16;
typedef unsigned short u16;
typedef unsigned long long u64;

#define DI __device__ __forceinline__
#define MFMA32(a, b, c) __builtin_amdgcn_mfma_f32_32x32x16_bf16((a), (b), (c), 0, 0, 0)

constexpr int T_TOK = 32768, SEQ = 4096, NB = 8, DM = 1024, DEPTH = 2;
constexpr int NREF = 3184;
constexpr int NPAD = 3328;
constexpr int LDP = 2848;
constexpr int PC_Z = 0, PC_XBC = 256, PC_DSAQ = 1024, PC_CQ = 1280, PC_CKV = 1536, PC_DSAK = 1664, PC_IDXK = 1728, PC_IDXQ = 1792,
              PC_KR = 2304, PC_FOXQ = 2336, PC_FOXK = 2592;
constexpr int NC_DSAV = 2848, NC_FOXV = 2912, NC_SMALL = 3168;
constexpr float EPS = 1e-6f;
constexpr float LOG2E = 1.4426950408889634f;
constexpr int NTHR = 512;
constexpr int LDS_BYTES = 159744;

constexpr size_t al256(size_t x) { return (x + 255) & ~(size_t)255; }
constexpr size_t WS_CTL   = 0;
constexpr size_t WS_BAR   = 4096;
constexpr size_t WS_CTL_BYTES = 32768;
constexpr size_t WS_WIN   = 32768;
constexpr size_t WS_WUQ   = WS_WIN  + (size_t)2 * NPAD * 1024 * 2;
constexpr size_t WS_WUKV  = WS_WUQ  + (size_t)2 * 512 * 256 * 2;
constexpr size_t WS_WOUT  = WS_WUKV + (size_t)2 * 512 * 128 * 2;
constexpr size_t WS_WG    = WS_WOUT + (size_t)2 * 1024 * 1024 * 2;
constexpr size_t WS_WU    = WS_WG   + (size_t)32 * 256 * 1024 * 2;
constexpr size_t WS_WD    = WS_WU   + (size_t)32 * 256 * 1024 * 2;
constexpr size_t WS_TRIG  = WS_WD   + (size_t)32 * 256 * 1024 * 2;
constexpr size_t WS_ACT   = WS_TRIG + (size_t)T_TOK * 48 * 4;
constexpr size_t WS_PROJ  = WS_ACT  + (size_t)T_TOK * 1024 * 2;
constexpr size_t WS_SMALL = WS_PROJ + (size_t)T_TOK * LDP * 2;
constexpr size_t WS_MLAQ  = WS_SMALL + (size_t)T_TOK * 16 * 4;
constexpr size_t WS_MLAK  = WS_MLAQ + (size_t)T_TOK * 384 * 2;
constexpr size_t WS_MLAVT = WS_MLAK + (size_t)T_TOK * 384 * 2;
constexpr size_t WS_DSAVT = WS_MLAVT + (size_t)T_TOK * 256 * 2;
constexpr size_t WS_FOXVT = WS_DSAVT + (size_t)T_TOK * 64 * 2;
constexpr size_t WS_FLOG  = WS_FOXVT + (size_t)T_TOK * 256 * 2;
constexpr size_t WS_CS    = WS_FLOG + (size_t)T_TOK * 4 * 4;
constexpr size_t WS_CDEC  = WS_CS   + (size_t)8 * 32 * 4 * 64 * 128 * 4;
constexpr size_t WS_MASK  = WS_CDEC + 4096;
constexpr size_t WS_TOKW  = WS_MASK + (size_t)T_TOK * 64 * 8;
constexpr size_t WS_WRH   = WS_TOKW + (size_t)T_TOK * 2 * 4;
constexpr size_t WS_WRL   = WS_WRH + (size_t)2 * 64 * 1024 * 2;
constexpr size_t WS_KF    = WS_WRL + (size_t)2 * 64 * 1024 * 2;
constexpr size_t WS_RSQ   = WS_KF + (size_t)T_TOK * 64 * 2;
constexpr size_t WS_RSKV  = WS_RSQ + (size_t)T_TOK * 4;
constexpr size_t WS_END   = WS_RSKV + (size_t)T_TOK * 4;
constexpr size_t WS_LIST  = WS_PROJ;
constexpr size_t WS_HMID  = WS_PROJ + (size_t)64 * 32768 * 4;
constexpr size_t WS_YFFN  = WS_HMID + (size_t)T_TOK * 512 * 2;
static_assert(WS_YFFN + (size_t)T_TOK * 2048 * 2 <= WS_SMALL, "aliases must fit in PROJ");
static_assert(WS_END <= (size_t)512 * 1024 * 1024, "workspace budget");

struct Args {
    const float* in[25];
    float* out;
    unsigned char* ws;
    float inv16[8];
    float inv32[16];
    int ph_lo, ph_hi;
};

typedef const __attribute__((address_space(4))) Args KArgs;
struct Ctx { int tid, lane, wave; unsigned char* lds; };
__device__ __forceinline__ Ctx fresh_ctx(unsigned char* lds) {
    int t = threadIdx.x; asm volatile("" : "+v"(t));
    Ctx c; c.tid = t; c.lane = t & 63; c.wave = __builtin_amdgcn_readfirstlane(t >> 6); c.lds = lds; return c;
}

typedef __attribute__((ext_vector_type(2))) float f32x2;
typedef __attribute__((ext_vector_type(2))) __bf16 bf16x2_t;
DI u16 f2bf(float x) { return __builtin_bit_cast(u16, (__bf16)x); }
DI float bf2f(u16 h) { return __uint_as_float(((unsigned)h) << 16); }
DI unsigned pack2(float a, float b) { f32x2 v = {a, b}; return __builtin_bit_cast(unsigned, __builtin_convertvector(v, bf16x2_t)); }
DI float ex2(float x) { return __builtin_amdgcn_exp2f(x); }
DI float relu_raw(float x) { float r; asm("v_max_f32 %0, 0, %1" : "=v"(r) : "v"(x)); return r; }
DI float max3f(float a, float b, float c) { float r; asm("v_max3_f32 %0, %1, %2, %3" : "=v"(r) : "v"(a), "v"(b), "v"(c)); return r; }
DI float wsum(float v) { for (int o = 32; o >= 1; o >>= 1) v += __shfl_xor(v, o); return v; }
DI float wmaxf(float v) { for (int o = 32; o >= 1; o >>= 1) v = fmaxf(v, __shfl_xor(v, o)); return v; }
DI float wminf(float v) { for (int o = 32; o >= 1; o >>= 1) v = fminf(v, __shfl_xor(v, o)); return v; }
DI float siluf(float x) { return x / (1.f + __expf(-x)); }
DI float softplusf(float x) { return fmaxf(x, 0.f) + log1pf(__expf(-fabsf(x))); }
DI int crow(int reg, int h) { return (reg & 3) + 8 * (reg >> 2) + 4 * h; }
DI bf16x8 pack8(const f32x16& x, int s) {
    uint4 p;
    p.x = pack2(x[8 * s + 0], x[8 * s + 1]); p.y = pack2(x[8 * s + 2], x[8 * s + 3]);
    p.z = pack2(x[8 * s + 4], x[8 * s + 5]); p.w = pack2(x[8 * s + 6], x[8 * s + 7]);
    return __builtin_bit_cast(bf16x8, p);
}
DI f32x16 zero16() { f32x16 z; for (int i = 0; i < 16; ++i) z[i] = 0.f; return z; }

DI int ref_col(int n) {
    if (n < 1024) return n;
    if (n < 1280) return n - 1024 + 1028;
    if (n < 1536) return n - 1280 + 1996;
    if (n < 1664) return n - 1536 + 2252;
    if (n < 1728) return n - 1664 + 1284;
    if (n < 1792) return n - 1728 + 1924;
    if (n < 2304) return n - 1792 + 1412;
    if (n < 2336) return n - 2304 + 2380;
    if (n < 2592) return n - 2336 + 2412;
    if (n < 2848) return n - 2592 + 2668;
    if (n < 2912) return n - 2848 + 1348;
    if (n < 3168) return n - 2912 + 2924;
    if (n < 3172) return n - 3168 + 1024;
    if (n < 3180) return n - 3172 + 1988;
    if (n < 3184) return n - 3180 + 3180;
    return -1;
}

DI int bid() { int b = blockIdx.x; asm volatile("" : "+s"(b)); return b; }
DI int vblock() { const int G = gridDim.x, bx = bid(); return (G % 8 == 0) ? (bx % 8) * (G / 8) + bx / 8 : bx; }

constexpr int G_LDT = 72;
constexpr int G_AEL = 256 * G_LDT, G_BEL = 128 * G_LDT, G_STEL = G_AEL + G_BEL;
constexpr int G_LDS_BYTES = 2 * G_STEL * 2;

struct GP { const u16 *a0, *a1, *a2, *a3, *b0, *b1; };

template <bool PAIRED>
DI void gemm_core(const Ctx& c, int K, const GP& gp, f32x16 (&acc)[2][2]) {
    u16* S = (u16*)c.lds;
    const int r8 = c.tid >> 3, kc = c.tid & 7;
    const int wm = c.wave & 3, wn = c.wave >> 2, l31 = c.lane & 31, h = c.lane >> 5;
    const int nb0 = PAIRED ? wn * 32 : wn * 64, nb1 = PAIRED ? 64 + wn * 32 : wn * 64 + 32;
    uint4 ra0, ra1, ra2, ra3, rb0, rb1;
    uint4 sa0, sa1, sa2, sa3, sb0, sb1;
    const int nk = K >> 6;
#define G_LOAD(P, KOFF) do { \
        P##a0 = *(const uint4*)(gp.a0 + (KOFF) + kc * 8); P##a1 = *(const uint4*)(gp.a1 + (KOFF) + kc * 8); \
        P##a2 = *(const uint4*)(gp.a2 + (KOFF) + kc * 8); P##a3 = *(const uint4*)(gp.a3 + (KOFF) + kc * 8); \
        P##b0 = *(const uint4*)(gp.b0 + (KOFF) + kc * 8); P##b1 = *(const uint4*)(gp.b1 + (KOFF) + kc * 8); } while (0)
#define G_STORE(P, SP) do { u16* sp_ = (SP); \
        *(uint4*)(sp_ + (r8) * G_LDT + kc * 8) = P##a0; *(uint4*)(sp_ + (r8 + 64) * G_LDT + kc * 8) = P##a1; \
        *(uint4*)(sp_ + (r8 + 128) * G_LDT + kc * 8) = P##a2; *(uint4*)(sp_ + (r8 + 192) * G_LDT + kc * 8) = P##a3; \
        *(uint4*)(sp_ + G_AEL + (r8) * G_LDT + kc * 8) = P##b0; *(uint4*)(sp_ + G_AEL + (r8 + 64) * G_LDT + kc * 8) = P##b1; } while (0)
#define G_COMPUTE_KS(ST, KS0, KS1) do { \
        const u16* As = S + (ST) * G_STEL; const u16* Bs = As + G_AEL; \
        _Pragma("unroll") for (int ks = (KS0); ks < (KS1); ++ks) { \
            const bf16x8 a0 = *(const bf16x8*)(As + (wm * 64 + l31) * G_LDT + ks * 16 + h * 8); \
            const bf16x8 a1 = *(const bf16x8*)(As + (wm * 64 + 32 + l31) * G_LDT + ks * 16 + h * 8); \
            const bf16x8 b0 = *(const bf16x8*)(Bs + (nb0 + l31) * G_LDT + ks * 16 + h * 8); \
            const bf16x8 b1 = *(const bf16x8*)(Bs + (nb1 + l31) * G_LDT + ks * 16 + h * 8); \
            acc[0][0] = MFMA32(a0, b0, acc[0][0]); acc[0][1] = MFMA32(a0, b1, acc[0][1]); \
            acc[1][0] = MFMA32(a1, b0, acc[1][0]); acc[1][1] = MFMA32(a1, b1, acc[1][1]); } } while (0)
    G_LOAD(r, 0);
    G_STORE(r, S);
    if (nk > 1) G_LOAD(r, 64);
    __syncthreads();
    for (int kt = 0; kt < nk; kt += 2) {
        if (kt + 2 < nk) G_LOAD(s, (kt + 2) * 64);
        G_COMPUTE_KS(0, 0, 1);
        if (kt + 1 < nk) G_STORE(r, S + G_STEL);
        G_COMPUTE_KS(0, 1, 4);
        __syncthreads();
        if (kt + 1 >= nk) break;
        if (kt + 3 < nk) G_LOAD(r, (kt + 3) * 64);
        G_COMPUTE_KS(1, 0, 1);
        if (kt + 2 < nk) G_STORE(s, S);
        G_COMPUTE_KS(1, 1, 4);
        __syncthreads();
    }
#undef G_LOAD
#undef G_STORE
#undef G_COMPUTE_KS
}

typedef __attribute__((ext_vector_type(4))) float f32x4;
#define LAS3 __attribute__((address_space(3)))
constexpr int G2_HTB = 128 * 64 * 2;
constexpr int G2_LDS_BYTES = 8 * G2_HTB;
DI int g2_lds_byte(int r, int cc0) { const int st = (r >> 4) * 2 + (cc0 >> 5), rr = r & 15, cc = cc0 & 31, ob = rr * 64 + cc * 2; return st * 1024 + (ob ^ (((ob >> 9) & 1) << 5)); }
DI void g2_stage_rc(int b, int& R, int& C) { const int st = b / 1024, sb = b % 1024, swz = sb ^ (((sb >> 9) & 1) << 5); R = (st >> 1) * 16 + swz / 64; C = (st & 1) * 32 + (swz % 64) / 2; }

struct G2Ptrs { __amdgpu_buffer_rsrc_t ra, rb; unsigned va00, va01, va10, va11, vb0, vb1; unsigned sa, sb0, sb1; };
DI __amdgpu_buffer_rsrc_t g2_rsrc(const void* p) { return __builtin_amdgcn_make_buffer_rsrc((void*)p, 0, 0x7ffffff0, 0x00020000); }

template <class EPI>
DI void gemm256_unit(const Ctx& c, const G2Ptrs& g, int K, EPI&& epi) {
    LAS3 unsigned char* lds = (LAS3 unsigned char*)c.lds;
    const int wid = c.wave, lane = c.lane, wr = wid >> 2, wc = wid & 3, fr = lane & 15, fq = lane >> 4;
    const unsigned ldsw = (unsigned)wid * 1024u;
    const int aoff = g2_lds_byte(wr * 64 + fr, fq * 8), boff = g2_lds_byte(wc * 32 + fr, fq * 8);
#define G2_SA(b, h) (((b) * 2 + (h)) * G2_HTB)
#define G2_SB(b, h) ((4 + (b) * 2 + (h)) * G2_HTB)
#define G2_STAGE(bufoff, rs, v0, v1, so) do { \
        __builtin_amdgcn_raw_ptr_buffer_load_lds((rs), (LAS3 unsigned*)(lds + (bufoff) + ldsw), 16, (v0), (so), 0, 0); \
        __builtin_amdgcn_raw_ptr_buffer_load_lds((rs), (LAS3 unsigned*)(lds + (bufoff) + ldsw + 8192), 16, (v1), (so), 0, 0); } while (0)
#define G2_STA0(b, kt) G2_STAGE(G2_SA(b, 0), g.ra, g.va00, g.va01, g.sa + (unsigned)(kt) * 128u)
#define G2_STA1(b, kt) G2_STAGE(G2_SA(b, 1), g.ra, g.va10, g.va11, g.sa + (unsigned)(kt) * 128u)
#define G2_STB0(b, kt) G2_STAGE(G2_SB(b, 0), g.rb, g.vb0, g.vb1, g.sb0 + (unsigned)(kt) * 128u)
#define G2_STB1(b, kt) G2_STAGE(G2_SB(b, 1), g.rb, g.vb0, g.vb1, g.sb1 + (unsigned)(kt) * 128u)
#define G2_LDA(dst, b, h) do { _Pragma("unroll") for (int m = 0; m < 4; ++m) _Pragma("unroll") for (int k = 0; k < 2; ++k) dst[m][k] = *(const LAS3 bf16x8*)(lds + G2_SA(b, h) + aoff + m * 2048 + k * 1024); } while (0)
#define G2_LDB(dst, b, h) do { _Pragma("unroll") for (int n = 0; n < 2; ++n) _Pragma("unroll") for (int k = 0; k < 2; ++k) dst[n][k] = *(const LAS3 bf16x8*)(lds + G2_SB(b, h) + boff + n * 2048 + k * 1024); } while (0)
#define G2_MMA(ai, bj, At_, Bt_) do { __builtin_amdgcn_s_setprio(1); \
        _Pragma("unroll") for (int m = 0; m < 4; ++m) _Pragma("unroll") for (int n = 0; n < 2; ++n) _Pragma("unroll") for (int k = 0; k < 2; ++k) \
            acc[ai][bj][m][n] = __builtin_amdgcn_mfma_f32_16x16x32_bf16(Bt_[n][k], At_[m][k], acc[ai][bj][m][n], 0, 0, 0); \
        __builtin_amdgcn_s_setprio(0); } while (0)
#define G2_WAIT_V(n) asm volatile("s_waitcnt vmcnt(" #n ")" ::: "memory")
#define G2_WAIT_L(n) asm volatile("s_waitcnt lgkmcnt(" #n ")" ::: "memory")
#define G2_BAR __builtin_amdgcn_s_barrier()
#define G2_SCHED __builtin_amdgcn_sched_barrier(0)
    f32x4 acc[2][2][4][2];
#pragma unroll
    for (int i0 = 0; i0 < 2; ++i0)
#pragma unroll
        for (int i1 = 0; i1 < 2; ++i1)
#pragma unroll
            for (int i2 = 0; i2 < 4; ++i2)
#pragma unroll
                for (int i3 = 0; i3 < 2; ++i3) acc[i0][i1][i2][i3] = (f32x4){0.f, 0.f, 0.f, 0.f};
    bf16x8 At[4][2], B0[2][2], B1[2][2];
    int nt = K / 64; asm volatile("" : "+s"(nt));
    G2_STB0(0, 0); G2_STA0(0, 0); G2_STB1(0, 0); G2_STA1(0, 0);
    if (wr == 1) G2_BAR;
    G2_WAIT_V(4); G2_BAR;
    G2_STB0(1, 1); G2_STA0(1, 1); G2_STB1(1, 1);
    G2_WAIT_V(6); G2_BAR;
    for (int t = 0; t < nt - 2; t += 2) {
        G2_LDB(B0, 0, 0); G2_SCHED; G2_LDA(At, 0, 0); G2_STA1(1, t + 1);
        G2_WAIT_L(8); G2_BAR; G2_WAIT_L(0); G2_MMA(0, 0, At, B0); G2_BAR; G2_SCHED;
        G2_LDB(B1, 0, 1); G2_STB0(0, t + 2);
        G2_BAR; G2_WAIT_L(0); G2_MMA(0, 1, At, B1); G2_BAR;
        G2_LDA(At, 0, 1); G2_STA0(0, t + 2);
        G2_BAR; G2_WAIT_L(0); G2_MMA(1, 0, At, B0); G2_BAR; G2_SCHED;
        G2_STB1(0, t + 2);
        G2_WAIT_V(6); G2_BAR; G2_MMA(1, 1, At, B1); G2_BAR;
        G2_LDB(B0, 1, 0); G2_SCHED; G2_LDA(At, 1, 0); G2_STA1(0, t + 2);
        G2_WAIT_L(8); G2_BAR; G2_WAIT_L(0); G2_MMA(0, 0, At, B0); G2_BAR; G2_SCHED;
        G2_LDB(B1, 1, 1); G2_STB0(1, t + 3);
        G2_BAR; G2_WAIT_L(0); G2_MMA(0, 1, At, B1); G2_BAR;
        G2_LDA(At, 1, 1); G2_STA0(1, t + 3);
        G2_BAR; G2_WAIT_L(0); G2_MMA(1, 0, At, B0); G2_BAR; G2_SCHED;
        G2_STB1(1, t + 3);
        G2_WAIT_V(6); G2_BAR; G2_MMA(1, 1, At, B1); G2_BAR;
    }
    { G2_LDB(B0, 0, 0); G2_LDA(At, 0, 0); G2_STA1(1, nt - 1);
      G2_BAR; G2_WAIT_L(0); G2_MMA(0, 0, At, B0); G2_BAR;
      G2_LDB(B1, 0, 1); G2_BAR; G2_WAIT_L(0); G2_MMA(0, 1, At, B1); G2_BAR;
      G2_LDA(At, 0, 1); G2_WAIT_V(4); G2_BAR; G2_WAIT_L(0); G2_MMA(1, 0, At, B0); G2_MMA(1, 1, At, B1); G2_BAR; }
    { G2_LDB(B0, 1, 0); G2_LDA(At, 1, 0); G2_WAIT_V(2); G2_BAR; G2_WAIT_L(0); G2_MMA(0, 0, At, B0); G2_BAR;
      G2_LDB(B1, 1, 1); G2_WAIT_V(0); G2_BAR; G2_WAIT_L(0); G2_MMA(0, 1, At, B1); G2_BAR;
      G2_LDA(At, 1, 1); G2_BAR; G2_WAIT_L(0); G2_MMA(1, 0, At, B0); G2_MMA(1, 1, At, B1); G2_BAR; }
    if (wr == 0) G2_BAR;
    { int ln_ = threadIdx.x & 63; asm volatile("" : "+v"(ln_));
      epi(acc, wr, wc, ln_ & 15, ln_ >> 4); }
#undef G2_SA
#undef G2_SB
#undef G2_STAGE
#undef G2_STA0
#undef G2_STA1
#undef G2_STB0
#undef G2_STB1
#undef G2_LDA
#undef G2_LDB
#undef G2_MMA
#undef G2_WAIT_V
#undef G2_WAIT_L
#undef G2_BAR
#undef G2_SCHED
}

DI void xpose_tile(const Ctx& c, const float* in, int ld_in, int k0, int n0, int colmode, const float* kscale, u16* out, int ld_out) {
    float* tile = (float*)c.lds;
    if (!colmode) {
        const int j4 = (c.tid & 15) * 4, r0 = c.tid >> 4;
#pragma unroll
        for (int rr = 0; rr < 2; ++rr) {
            const int kk = r0 + 32 * rr;
            float4 v = *(const float4*)(in + (size_t)(k0 + kk) * ld_in + n0 + j4);
            if (kscale) { const float s = kscale[k0 + kk]; v.x *= s; v.y *= s; v.z *= s; v.w *= s; }
            *(float4*)(tile + kk * 68 + j4) = v;
        }
    } else {
        const int j = c.tid & 63, r0 = c.tid >> 6;
        const int rc = ref_col(n0 + j);
#pragma unroll
        for (int rr = 0; rr < 8; ++rr) {
            const int kk = r0 + 8 * rr;
            tile[kk * 68 + j] = (rc >= 0) ? in[(size_t)(k0 + kk) * ld_in + rc] : 0.f;
        }
    }
    __syncthreads();
    {
        const int jj = c.tid >> 3, k8 = (c.tid & 7) * 8;
        uint4 pk;
        pk.x = pack2(tile[(k8 + 0) * 68 + jj], tile[(k8 + 1) * 68 + jj]);
        pk.y = pack2(tile[(k8 + 2) * 68 + jj], tile[(k8 + 3) * 68 + jj]);
        pk.z = pack2(tile[(k8 + 4) * 68 + jj], tile[(k8 + 5) * 68 + jj]);
        pk.w = pack2(tile[(k8 + 6) * 68 + jj], tile[(k8 + 7) * 68 + jj]);
        *(uint4*)(out + (size_t)(n0 + jj) * ld_out + k0 + k8) = pk;
    }
    __syncthreads();
}

DI void phase_prep(const Ctx& c_in, KArgs& a) {
    const Ctx c = fresh_ctx(c_in.lds);
    unsigned char* ws = a.ws;
    const int n_win = 2 * 52 * 16;
    const int n_wuq = 2 * 8 * 4;
    const int n_wukv = 2 * 8 * 2;
    const int n_wout = 2 * 16 * 16;
    const int n_trig = T_TOK * 24 / NTHR;
    const int n_wr = 2 * 64 * 1024 / NTHR;
    const int total = n_win + n_wuq + n_wukv + n_wout + n_trig + n_wr;
    for (int it = bid(); it < total; it += gridDim.x) {
        int i = it;
        if (i < n_win) {
            const int l = i / 832, r = i % 832, nt = r / 16, kt = r % 16;
            xpose_tile(c, a.in[3] + (size_t)l * 1024 * NREF, NREF, kt * 64, nt * 64, 1, nullptr, (u16*)(ws + WS_WIN) + (size_t)l * NPAD * 1024, 1024);
            continue;
        }
        i -= n_win;
        if (i < n_wuq) {
            const int l = i / 32, r = i % 32, nt = r / 4, kt = r % 4;
            u16* dst = (u16*)(ws + WS_WUQ) + (size_t)l * 512 * 256;
            if (nt < 6) xpose_tile(c, a.in[11] + (size_t)l * 256 * 384, 384, kt * 64, nt * 64, 0, a.in[10] + l * 256, dst, 256);
            else { const int jj = c.tid >> 3, k8 = (c.tid & 7) * 8; *(uint4*)(dst + (size_t)(nt * 64 + jj) * 256 + kt * 64 + k8) = make_uint4(0, 0, 0, 0); }
            continue;
        }
        i -= n_wuq;
        if (i < n_wukv) {
            const int l = i / 16, r = i % 16, nt = r / 2, kt = r % 2;
            xpose_tile(c, a.in[13] + (size_t)l * 128 * 512, 512, kt * 64, nt * 64, 0, a.in[12] + l * 128, (u16*)(ws + WS_WUKV) + (size_t)l * 512 * 128, 128);
            continue;
        }
        i -= n_wukv;
        if (i < n_wout) {
            const int l = i / 256, r = i % 256, nt = r / 16, kt = r % 16;
            xpose_tile(c, a.in[15] + (size_t)l * 1024 * 1024, 1024, kt * 64, nt * 64, 0, nullptr, (u16*)(ws + WS_WOUT) + (size_t)l * 1024 * 1024, 1024);
            continue;
        }
        i -= n_wout;
        if (i >= n_trig) {
            const int e = (i - n_trig) * NTHR + c.tid;
            const int l = e >> 16, n = (e >> 10) & 63, k = e & 1023;
            float v = 0.f;
            if (n < 4) v = a.in[17][((size_t)l * 1024 + k) * 4 + n];
            else if (n < 36) v = a.in[19][((size_t)l * 1024 + k) * 32 + (n - 4)];
            const u16 hi = f2bf(v);
            ((u16*)(ws + WS_WRH))[e] = hi;
            ((u16*)(ws + WS_WRL))[e] = f2bf(v - bf2f(hi));
            continue;
        }
        {
            const int e = i * NTHR + c.tid;
            const int t = e / 24, j = e % 24;
            const int pos = ((const int*)a.in[1])[t];
            const float inv = (j < 8) ? a.inv16[j] : a.inv32[j - 8];
            const float ang = (float)pos * inv;
            const double ad = (double)ang;
            const double r = ad - 6.283185307179586476925 * rint(ad * 0.15915494309189533577);
            const float rf = (float)r;
            const float cs = cosf(rf), sn = sinf(rf);
            float* trig = (float*)(ws + WS_TRIG) + (size_t)t * 48;
            if (j < 8) { trig[j] = cs; trig[8 + j] = sn; } else { trig[16 + (j - 8)] = cs; trig[32 + (j - 8)] = sn; }
        }
    }
}

DI void expert_conv_item(const Ctx& c, KArgs& a, int l, int it) {
    unsigned char* ws = a.ws;
    const int which = it / 512, r = it % 512, e = r / 16, grp = r % 16;
    const float* src; u16* dst; int ld_in, ld_out, k0[4], n0[4];
    if (which < 2) {
        src = a.in[21 + which] + ((size_t)l * 32 + e) * 1024 * 256; dst = (u16*)(ws + (which == 0 ? WS_WG : WS_WU)) + (size_t)e * 256 * 1024; ld_in = 256; ld_out = 1024;
#pragma unroll
        for (int i = 0; i < 4; ++i) { n0[i] = (grp >> 2) * 64; k0[i] = ((grp & 3) * 4 + i) * 64; }
    } else {
        src = a.in[23] + ((size_t)l * 32 + e) * 256 * 1024; dst = (u16*)(ws + WS_WD) + (size_t)e * 1024 * 256; ld_in = 1024; ld_out = 256;
#pragma unroll
        for (int i = 0; i < 4; ++i) { n0[i] = grp * 64; k0[i] = i * 64; }
    }
    float* tile = (float*)c.lds;
    const int j4 = (c.tid & 15) * 4, r0 = c.tid >> 4;
    float4 v[4][2];
#pragma unroll
    for (int i = 0; i < 4; ++i)
#pragma unroll
        for (int rr = 0; rr < 2; ++rr) v[i][rr] = *(const float4*)(src + (size_t)(k0[i] + r0 + 32 * rr) * ld_in + n0[i] + j4);
#pragma unroll
    for (int i = 0; i < 4; ++i)
#pragma unroll
        for (int rr = 0; rr < 2; ++rr) *(float4*)(tile + i * (64 * 68) + (r0 + 32 * rr) * 68 + j4) = v[i][rr];
    __syncthreads();
    const int jj = c.tid >> 3, k8 = (c.tid & 7) * 8;
#pragma unroll
    for (int i = 0; i < 4; ++i) {
        const float* tl = tile + i * (64 * 68);
        uint4 pk;
        pk.x = pack2(tl[(k8 + 0) * 68 + jj], tl[(k8 + 1) * 68 + jj]);
        pk.y = pack2(tl[(k8 + 2) * 68 + jj], tl[(k8 + 3) * 68 + jj]);
        pk.z = pack2(tl[(k8 + 4) * 68 + jj], tl[(k8 + 5) * 68 + jj]);
        pk.w = pack2(tl[(k8 + 6) * 68 + jj], tl[(k8 + 7) * 68 + jj]);
        *(uint4*)(dst + (size_t)(n0[i] + jj) * ld_out + k0[i] + k8) = pk;
    }
    __syncthreads();
}

DI void phase_norm_in(const Ctx& c_in, KArgs& a, int l) {
    const Ctx c = fresh_ctx(c_in.lds);
    unsigned char* ws = a.ws;
    const float* x = (l == 0) ? a.in[0] : a.out;
    const float* g = a.in[2] + l * 1024;
    u16* act = (u16*)(ws + WS_ACT);
    const int n_norm = T_TOK / 8;
    const int n_exp = 0;
    if (bid() == 0 && c.tid < 192) ((int*)(ws + WS_CTL))[c.tid] = 0;
    for (int it = bid(); it < n_norm + n_exp; it += gridDim.x) {
        if (false) {
        } else {
            const int t = (it - n_exp) * 8 + c.wave;
            const float* xr = x + (size_t)t * 1024;
            float v[16]; float ss = 0.f;
            if (l == 0) {
#pragma unroll
                for (int j = 0; j < 16; ++j) v[j] = xr[c.lane + 64 * j];
            } else {
                const u16* y0 = (const u16*)(ws + WS_YFFN) + (size_t)t * 2048;
#pragma unroll
                for (int j = 0; j < 16; ++j) { v[j] = xr[c.lane + 64 * j] + bf2f(y0[c.lane + 64 * j]) + bf2f(y0[1024 + c.lane + 64 * j]); a.out[(size_t)t * 1024 + c.lane + 64 * j] = v[j]; }
            }
#pragma unroll
            for (int j = 0; j < 16; ++j) ss += v[j] * v[j];
            ss = wsum(ss);
            const float rs = rsqrtf(ss * (1.f / 1024.f) + EPS);
#pragma unroll
            for (int j = 0; j < 16; ++j) act[(size_t)t * 1024 + c.lane + 64 * j] = f2bf(v[j] * rs * g[c.lane + 64 * j]);
        }
    }
}

DI void phase_inproj(const Ctx& c_in, KArgs& a, int l) {
    const Ctx c = fresh_ctx(c_in.lds);
    unsigned char* ws = a.ws;
    const u16* act = (const u16*)(ws + WS_ACT);
    const u16* w = (const u16*)(ws + WS_WIN) + (size_t)l * NPAD * 1024;
    u16* proj = (u16*)(ws + WS_PROJ);
    u16* dsavt = (u16*)(ws + WS_DSAVT);
    u16* foxvt = (u16*)(ws + WS_FOXVT);
    float* small = (float*)(ws + WS_SMALL);
    u16* mlak = (u16*)(ws + WS_MLAK);
    u16* kf = (u16*)(ws + WS_KF);
    const float* trig = (const float*)(ws + WS_TRIG);
    int R, C; g2_stage_rc(c.tid * 16, R, C);
    const int nunits = (T_TOK / 256) * 13;
    for (int u = vblock(); u < nunits; u += gridDim.x) {
        const int grp = u / 52, rr = u % 52;
        const int pm = grp * 4 + (rr & 3), pn = rr >> 2;
        G2Ptrs g;
        g.ra = g2_rsrc(act); g.rb = g2_rsrc(w);
        g.va00 = (unsigned)(R * 1024 + C) * 2u; g.va01 = g.va00 + 64 * 2048; g.va10 = g.va00 + 128 * 2048; g.va11 = g.va00 + 192 * 2048;
        g.vb0 = g.va00; g.vb1 = g.va01;
        g.sa = (unsigned)pm * (256u * 2048u); g.sb0 = (unsigned)pn * (256u * 2048u); g.sb1 = g.sb0 + 128u * 2048u;
        __syncthreads();
        gemm256_unit(c, g, 1024, [&](const f32x4 (&acc)[2][2][4][2], int wr, int wc, int fr, int fq) {
#pragma unroll
            for (int bj = 0; bj < 2; ++bj)
#pragma unroll
                for (int n = 0; n < 2; ++n) {
                    const int col0 = pn * 256 + bj * 128 + wc * 32 + n * 16;
                    if (col0 < LDP) {
                        const bool rope16 = ((col0 >= PC_DSAQ && col0 < PC_CQ) || (col0 >= PC_DSAK && col0 < PC_KR)) && ((col0 & 63) == 0);
                        const bool kr0 = (col0 == PC_KR), kr1 = (col0 == PC_KR + 16);
                        const bool foxk = (col0 >= PC_FOXK);
                        const bool idxk = (col0 >= PC_IDXK) && (col0 < PC_IDXK + 64);
                        float kmx = 0.f;
#pragma unroll
                        for (int ai = 0; ai < 2; ++ai)
#pragma unroll
                            for (int m = 0; m < 4; ++m) {
                                const int row = pm * 256 + ai * 128 + wr * 64 + m * 16 + fr;
                                f32x4 v = acc[ai][bj][m][n];
                                if (rope16) {
                                    const float* tg = trig + (size_t)row * 48 + 4 * (fq & 1);
                                    const f32x4 cs = *(const f32x4*)tg, sn = *(const f32x4*)(tg + 8);
                                    f32x4 pv;
#pragma unroll
                                    for (int j = 0; j < 4; ++j) pv[j] = __shfl_xor(v[j], 32);
                                    v = (fq < 2) ? (v * cs - pv * sn) : (v * cs + pv * sn);
                                }
                                if (kr0) {
                                    const float* tg = trig + (size_t)row * 48 + 16 + 4 * fq;
                                    const f32x4 cs = *(const f32x4*)tg, sn = *(const f32x4*)(tg + 16);
                                    const f32x4 x2 = acc[ai][bj][m][1];
                                    const f32x4 o1 = v * cs - x2 * sn, o2 = x2 * cs + v * sn;
                                    uint2 p1, p2; p1.x = pack2(o1[0], o1[1]); p1.y = pack2(o1[2], o1[3]); p2.x = pack2(o2[0], o2[1]); p2.y = pack2(o2[2], o2[3]);
#pragma unroll
                                    for (int hd = 0; hd < 4; ++hd) {
                                        *(uint2*)(mlak + (size_t)row * 384 + hd * 96 + 64 + 4 * fq) = p1;
                                        *(uint2*)(mlak + (size_t)row * 384 + hd * 96 + 80 + 4 * fq) = p2;
                                    }
                                }
                                if (idxk) {
                                    uint2 pk; pk.x = pack2(v[0], v[1]); pk.y = pack2(v[2], v[3]);
                                    const int d0 = col0 - PC_IDXK + 4 * fq, bb = row >> 12, ss = row & 4095;
                                    *(uint2*)(kf + ((size_t)(((bb * 128 + (ss >> 5)) * 4 + (d0 >> 4)) * 64 + ((d0 >> 3) & 1) * 32 + (ss & 31))) * 8 + (d0 & 7)) = pk;
                                } else if (!kr0 && !kr1) {
                                    uint2 pk; pk.x = pack2(v[0], v[1]); pk.y = pack2(v[2], v[3]);
                                    *(uint2*)(proj + (size_t)row * LDP + col0 + 4 * fq) = pk;
                                    if (foxk) {
                                        const float b0 = bf2f((u16)(pk.x & 0xffff)), b1 = bf2f((u16)(pk.x >> 16)), b2 = bf2f((u16)(pk.y & 0xffff)), b3 = bf2f((u16)(pk.y >> 16));
                                        float ss = b0 * b0 + b1 * b1 + b2 * b2 + b3 * b3;
                                        ss += __shfl_xor(ss, 16); ss += __shfl_xor(ss, 32);
                                        kmx = fmaxf(kmx, ss);
                                    }
                                }
                            }
                        if (foxk) {
                            kmx = fmaxf(kmx, __shfl_xor(kmx, 1)); kmx = fmaxf(kmx, __shfl_xor(kmx, 2)); kmx = fmaxf(kmx, __shfl_xor(kmx, 4)); kmx = fmaxf(kmx, __shfl_xor(kmx, 8));
                            if (c.lane == 0) {
                                const int cc = col0 - PC_FOXK;
                                atomicMax((unsigned*)(ws + WS_CTL) + 64 + (((pm * 256) >> 12) * 4 + (cc >> 6)) * 4 + ((cc >> 4) & 3), __float_as_uint(kmx));
                            }
                        }
                    } else if (col0 < NC_SMALL) {
                        u16* vt = (col0 < NC_FOXV) ? dsavt + (size_t)(col0 - NC_DSAV + 4 * fq) * 4096 : foxvt + (size_t)(col0 - NC_FOXV + 4 * fq) * 4096;
                        const size_t bstride = (col0 < NC_FOXV) ? (size_t)64 * 4096 : (size_t)256 * 4096;
#pragma unroll
                        for (int ai = 0; ai < 2; ++ai)
#pragma unroll
                            for (int m = 0; m < 4; ++m) {
                                const int row = pm * 256 + ai * 128 + wr * 64 + m * 16 + fr;
                                u16* p = vt + (size_t)(row >> 12) * bstride + (row & 4095);
                                const f32x4 v = acc[ai][bj][m][n];
                                p[0] = f2bf(v[0]); p[4096] = f2bf(v[1]); p[2 * 4096] = f2bf(v[2]); p[3 * 4096] = f2bf(v[3]);
                            }
                    } else if (col0 == NC_SMALL) {
#pragma unroll
                        for (int ai = 0; ai < 2; ++ai)
#pragma unroll
                            for (int m = 0; m < 4; ++m) {
                                const int row = pm * 256 + ai * 128 + wr * 64 + m * 16 + fr;
                                *(f32x4*)(small + (size_t)row * 16 + 4 * fq) = acc[ai][bj][m][n];
                            }
                    }
                }
            if (pn == 5 || pn == 6) {
                float* part = (float*)c.lds;
#pragma unroll
                for (int ai = 0; ai < 2; ++ai)
#pragma unroll
                    for (int m = 0; m < 4; ++m) {
                        float ss = 0.f;
#pragma unroll
                        for (int bj = 0; bj < 2; ++bj)
#pragma unroll
                            for (int n = 0; n < 2; ++n) if (pn == 5 || bj == 0) {
                                const f32x4 v = acc[ai][bj][m][n];
#pragma unroll
                                for (int j = 0; j < 4; ++j) { const float bq = bf2f(f2bf(v[j])); ss += bq * bq; }
                            }
                        ss += __shfl_xor(ss, 16); ss += __shfl_xor(ss, 32);
                        if (fq == 0) part[(ai * 128 + wr * 64 + m * 16 + fr) * 4 + wc] = ss;
                    }
                __syncthreads();
                if (c.tid < 256) {
                    const float4 p4 = *(const float4*)(part + c.tid * 4);
                    const float s = p4.x + p4.y + p4.z + p4.w;
                    if (pn == 5) ((float*)(ws + WS_RSQ))[pm * 256 + c.tid] = rsqrtf(s * (1.f / 256.f) + EPS);
                    else ((float*)(ws + WS_RSKV))[pm * 256 + c.tid] = rsqrtf(s * (1.f / 128.f) + EPS);
                }
            }
        });
    }
}

constexpr int SSD_LD = 136;
constexpr int SSD_TILE_B = 128 * SSD_LD * 2;
constexpr int SSD_OFF_DT = 3 * SSD_TILE_B;
constexpr int SSD_OFF_ACS = SSD_OFF_DT + 2048;
constexpr int SSD_OFF_SSQ = SSD_OFF_ACS + 2048;

DI void ssd_dt_acs(const Ctx& c, KArgs& a, int l, int tok0, float* dt_s, float* acs_s) {
    const float* small = (const float*)(a.ws + WS_SMALL);
    {
        const int t = c.tid >> 2, hd = c.tid & 3;
        const float raw = small[(size_t)(tok0 + t) * 16 + hd] + a.in[6][l * 4 + hd];
        dt_s[hd * 128 + t] = softplusf(raw);
    }
    __syncthreads();
    if (c.wave < 4) {
        const int hd = c.wave;
        const float av = -__expf(a.in[7][l * 4 + hd]);
        const float v0 = dt_s[hd * 128 + 2 * c.lane] * av, v1 = dt_s[hd * 128 + 2 * c.lane + 1] * av;
        const float s = v0 + v1;
        float inc = s;
#pragma unroll
        for (int o = 1; o < 64; o <<= 1) { const float tv = __shfl_up(inc, o); if (c.lane >= o) inc += tv; }
        const float ex = inc - s;
        acs_s[hd * 128 + 2 * c.lane] = ex + v0;
        acs_s[hd * 128 + 2 * c.lane + 1] = ex + v0 + v1;
    }
    __syncthreads();
}

DI float ssd_conv(const u16* proj, const float* cw, const float* cb, int b, int s, int xc) {
    float acc = cb[xc];
#pragma unroll
    for (int j = 0; j < 4; ++j) {
        const int sp = s - 3 + j;
        if (sp >= 0) acc += cw[j * 768 + xc] * bf2f(proj[(size_t)(b * 4096 + sp) * LDP + PC_XBC + xc]);
    }
    return siluf(acc);
}

template <bool TRANSPOSED>
DI void conv_stage_unit(const Ctx& c, const u16* proj, const float* cw, const float* cb, int b, int s0, int tseg, int xc0, u16* dst,
                        const float* dt_s, const float* acs_s, int head0) {
    const int ch = 2 * c.lane, xc = xc0 + ch;
    float w0[4], w1[4];
#pragma unroll
    for (int j = 0; j < 4; ++j) { w0[j] = cw[j * 768 + xc]; w1[j] = cw[j * 768 + xc + 1]; }
    const float bias0 = cb[xc], bias1 = cb[xc + 1];
    const u16* src = proj + (size_t)(b * 4096) * LDP + PC_XBC + xc;
    const int head = head0 + (ch >> 6);
#pragma unroll 1
    for (int half = 0; half < 2; ++half) {
        const int sb = s0 + tseg * 32 + half * 16 - 3;
        unsigned raw[19];
#pragma unroll
        for (int i = 0; i < 19; ++i) { const int sp = sb + i; raw[i] = (sp >= 0) ? *(const unsigned*)(src + (size_t)sp * LDP) : 0u; }
#pragma unroll
        for (int t = 0; t < 16; ++t) {
            float x0 = bias0, x1 = bias1;
#pragma unroll
            for (int j = 0; j < 4; ++j) { x0 += w0[j] * bf2f((u16)(raw[t + j] & 0xffff)); x1 += w1[j] * bf2f((u16)(raw[t + j] >> 16)); }
            x0 = siluf(x0); x1 = siluf(x1);
            const int tt = tseg * 32 + half * 16 + t;
            if (dt_s) { const float sc = dt_s[head * 128 + tt] * __expf(acs_s[head * 128 + 127] - acs_s[head * 128 + tt]); x0 *= sc; x1 *= sc; }
            if (TRANSPOSED) { dst[ch * SSD_LD + tt] = f2bf(x0); dst[(ch + 1) * SSD_LD + tt] = f2bf(x1); }
            else *(unsigned*)(dst + tt * SSD_LD + ch) = pack2(x0, x1);
        }
    }
}

DI void ssd_state_item(const Ctx& c_in, KArgs& a, int l, int item) {
    const Ctx c = fresh_ctx(c_in.lds);
    unsigned char* ws = a.ws;
    const u16* proj = (const u16*)(ws + WS_PROJ);
    const float* cw = a.in[4] + (size_t)l * 4 * 768;
    const float* cb = a.in[5] + (size_t)l * 768;
    float* cs = (float*)(ws + WS_CS);
    float* cdec = (float*)(ws + WS_CDEC);
    const int b = item >> 5, ch = item & 31, tok0 = b * 4096 + ch * 128, s0 = ch * 128;
    u16* XT = (u16*)c.lds;
    u16* BT = (u16*)(c.lds + SSD_TILE_B);
    float* dt_s = (float*)(c.lds + SSD_OFF_DT);
    float* acs_s = (float*)(c.lds + SSD_OFF_ACS);
    const int l31 = c.lane & 31, h = c.lane >> 5;
    ssd_dt_acs(c, a, l, tok0, dt_s, acs_s);
    if (c.tid < 4) cdec[(b * 32 + ch) * 4 + c.tid] = __expf(acs_s[c.tid * 128 + 127]);
    for (int g = 0; g < 2; ++g) {
        if (c.wave < 4) conv_stage_unit<true>(c, proj, cw, cb, b, s0, c.wave, 128 * g, XT, dt_s, acs_s, 2 * g);
        else conv_stage_unit<true>(c, proj, cw, cb, b, s0, c.wave - 4, 256 + 128 * g, BT, nullptr, nullptr, 0);
        __syncthreads();
        {
            const int hh = c.wave >> 2, pt = (c.wave >> 1) & 1, nh = c.wave & 1;
            f32x16 acc0 = zero16(), acc1 = zero16();
#pragma unroll
            for (int ks = 0; ks < 8; ++ks) {
                const bf16x8 af = *(const bf16x8*)(XT + (hh * 64 + pt * 32 + l31) * SSD_LD + ks * 16 + h * 8);
                const bf16x8 b0 = *(const bf16x8*)(BT + (nh * 64 + l31) * SSD_LD + ks * 16 + h * 8);
                const bf16x8 b1 = *(const bf16x8*)(BT + (nh * 64 + 32 + l31) * SSD_LD + ks * 16 + h * 8);
                acc0 = MFMA32(af, b0, acc0);
                acc1 = MFMA32(af, b1, acc1);
            }
            const int head = 2 * g + hh;
            float* dst = cs + ((size_t)((b * 32 + ch) * 4 + head) * 64) * 128;
#pragma unroll
            for (int r = 0; r < 16; ++r) {
                const int p = pt * 32 + crow(r, h);
                dst[p * 128 + nh * 64 + l31] = acc0[r];
                dst[p * 128 + nh * 64 + 32 + l31] = acc1[r];
            }
        }
        __syncthreads();
    }
}

DI void ssd_scan_item(const Ctx& c_in, KArgs& a, int item) {
    const Ctx c = fresh_ctx(c_in.lds);
    float* cs = (float*)(a.ws + WS_CS);
    const float* cdec = (const float*)(a.ws + WS_CDEC);
    const int idx = item * NTHR + c.tid;
    const int bh = idx >> 13, pn = idx & 8191, b = bh >> 2, hd = bh & 3;
    float v[32], dcy[32];
#pragma unroll
    for (int ch = 0; ch < 32; ++ch) {
        v[ch] = cs[((size_t)((b * 32 + ch) * 4 + hd)) * 8192 + pn];
        dcy[ch] = cdec[(b * 32 + ch) * 4 + hd];
    }
    float s = 0.f;
#pragma unroll
    for (int ch = 0; ch < 32; ++ch) {
        cs[((size_t)((b * 32 + ch) * 4 + hd)) * 8192 + pn] = s;
        s = s * dcy[ch] + v[ch];
    }
}

DI void ssd_out_item(const Ctx& c_in, KArgs& a, int l, int item) {
    const Ctx c = fresh_ctx(c_in.lds);
    unsigned char* ws = a.ws;
    const u16* proj = (const u16*)(ws + WS_PROJ);
    const float* cw = a.in[4] + (size_t)l * 4 * 768;
    const float* cb = a.in[5] + (size_t)l * 768;
    const float* prev = (const float*)(ws + WS_CS);
    u16* act = (u16*)(ws + WS_ACT);
    const int b = item >> 5, ch = item & 31, tok0 = b * 4096 + ch * 128, s0 = ch * 128;
    u16* XT = (u16*)c.lds;
    u16* BM = (u16*)(c.lds + SSD_TILE_B);
    u16* CM = (u16*)(c.lds + 2 * SSD_TILE_B);
    float* dt_s = (float*)(c.lds + SSD_OFF_DT);
    float* acs_s = (float*)(c.lds + SSD_OFF_ACS);
    float* ssq = (float*)(c.lds + SSD_OFF_SSQ);
    const int l31 = c.lane & 31, h = c.lane >> 5;
    ssd_dt_acs(c, a, l, tok0, dt_s, acs_s);
    f32x16 yreg[2][2];
    const int hh = c.wave >> 2, qt = c.wave & 3;
    const int q = qt * 32 + l31;
#pragma unroll
    for (int g = 0; g < 2; ++g) {
        for (int u = c.wave; u < 12; u += 8) {
            const int part = u >> 2, tseg = u & 3;
            if (part == 0) conv_stage_unit<true>(c, proj, cw, cb, b, s0, tseg, 128 * g, XT, nullptr, nullptr, 0);
            else if (part == 1) conv_stage_unit<false>(c, proj, cw, cb, b, s0, tseg, 256 + 128 * g, BM, nullptr, nullptr, 0);
            else conv_stage_unit<false>(c, proj, cw, cb, b, s0, tseg, 512 + 128 * g, CM, nullptr, nullptr, 0);
        }
        __syncthreads();
        {
            const int head = 2 * g + hh;
            const float acs_q = acs_s[head * 128 + q];
            bf16x8 cf[8];
#pragma unroll
            for (int ks = 0; ks < 8; ++ks) cf[ks] = *(const bf16x8*)(CM + q * SSD_LD + ks * 16 + h * 8);
            f32x16 yf0 = zero16(), yf1 = zero16();
            const float* pv = prev + ((size_t)((b * 32 + ch) * 4 + head) * 64) * 128;
#pragma unroll
            for (int ks = 0; ks < 8; ++ks) {
                {
                    const float* pr = pv + (size_t)l31 * 128 + ks * 16 + h * 8;
                    const float4 f0 = *(const float4*)pr, f1 = *(const float4*)(pr + 4);
                    const bf16x8 pa = __builtin_bit_cast(bf16x8, make_uint4(pack2(f0.x, f0.y), pack2(f0.z, f0.w), pack2(f1.x, f1.y), pack2(f1.z, f1.w)));
                    yf0 = MFMA32(pa, cf[ks], yf0);
                }
                {
                    const float* pr = pv + (size_t)(32 + l31) * 128 + ks * 16 + h * 8;
                    const float4 f0 = *(const float4*)pr, f1 = *(const float4*)(pr + 4);
                    const bf16x8 pa = __builtin_bit_cast(bf16x8, make_uint4(pack2(f0.x, f0.y), pack2(f0.z, f0.w), pack2(f1.x, f1.y), pack2(f1.z, f1.w)));
                    yf1 = MFMA32(pa, cf[ks], yf1);
                }
            }
            const float eq = __expf(acs_q);
            f32x16 yo0, yo1;
#pragma unroll
            for (int r = 0; r < 16; ++r) { yo0[r] = yf0[r] * eq; yo1[r] = yf1[r] * eq; }
            for (int kt = 0; kt <= qt; ++kt) {
                f32x16 gt = zero16();
#pragma unroll
                for (int ks = 0; ks < 8; ++ks) {
                    const bf16x8 bf = *(const bf16x8*)(BM + (kt * 32 + l31) * SSD_LD + ks * 16 + h * 8);
                    gt = MFMA32(bf, cf[ks], gt);
                }
#pragma unroll
                for (int r = 0; r < 16; ++r) {
                    const int k = kt * 32 + crow(r, h);
                    const float dec = __expf(fminf(acs_q - acs_s[head * 128 + k], 0.f)) * dt_s[head * 128 + k];
                    gt[r] = (k <= q) ? gt[r] * dec : 0.f;
                }
#pragma unroll
                for (int s2 = 0; s2 < 2; ++s2) {
                    const bf16x8 pb = pack8(gt, s2);
                    const int koff = kt * 32 + 16 * s2 + 4 * h;
                    {
                        const u16* xr = XT + (hh * 64 + l31) * SSD_LD + koff;
                        const uint2 lo = *(const uint2*)xr, hi = *(const uint2*)(xr + 8);
                        const bf16x8 xa = __builtin_bit_cast(bf16x8, make_uint4(lo.x, lo.y, hi.x, hi.y));
                        yo0 = MFMA32(xa, pb, yo0);
                    }
                    {
                        const u16* xr = XT + (hh * 64 + 32 + l31) * SSD_LD + koff;
                        const uint2 lo = *(const uint2*)xr, hi = *(const uint2*)(xr + 8);
                        const bf16x8 xa = __builtin_bit_cast(bf16x8, make_uint4(lo.x, lo.y, hi.x, hi.y));
                        yo1 = MFMA32(xa, pb, yo1);
                    }
                }
            }
            const float dsk = a.in[8][l * 4 + head];
            float part = 0.f;
#pragma unroll
            for (int pt = 0; pt < 2; ++pt) {
#pragma unroll
                for (int qd = 0; qd < 4; ++qd) {
                    const int p0 = pt * 32 + 8 * qd + 4 * h;
                    const uint2 zz = *(const uint2*)(proj + (size_t)(tok0 + q) * LDP + PC_Z + head * 64 + p0);
                    const float zf[4] = { bf2f((u16)(zz.x & 0xffff)), bf2f((u16)(zz.x >> 16)), bf2f((u16)(zz.y & 0xffff)), bf2f((u16)(zz.y >> 16)) };
#pragma unroll
                    for (int r3 = 0; r3 < 4; ++r3) {
                        const int r = 4 * qd + r3;
                        const float yo = pt ? yo1[r] : yo0[r];
                        const float xv = bf2f(XT[(hh * 64 + p0 + r3) * SSD_LD + q]);
                        const float y = (yo + dsk * xv) * siluf(zf[r3]);
                        yreg[g][pt][r] = y;
                        part += y * y;
                    }
                }
            }
            part += __shfl_xor(part, 32);
            if (h == 0) ssq[head * 128 + q] = part;
        }
        __syncthreads();
    }
    {
        const float rs = rsqrtf((ssq[q] + ssq[128 + q] + ssq[256 + q] + ssq[384 + q]) * (1.f / 256.f) + EPS);
        const float* nw = a.in[9] + l * 256;
#pragma unroll
        for (int g = 0; g < 2; ++g) {
            const int head = 2 * g + hh;
#pragma unroll
            for (int pt = 0; pt < 2; ++pt)
#pragma unroll
                for (int qd = 0; qd < 4; ++qd) {
                    const int p0 = pt * 32 + 8 * qd + 4 * h;
                    const float* w4 = nw + head * 64 + p0;
                    uint2 pk;
                    pk.x = pack2(yreg[g][pt][4 * qd] * rs * w4[0], yreg[g][pt][4 * qd + 1] * rs * w4[1]);
                    pk.y = pack2(yreg[g][pt][4 * qd + 2] * rs * w4[2], yreg[g][pt][4 * qd + 3] * rs * w4[3]);
                    *(uint2*)(act + (size_t)(tok0 + q) * 1024 + head * 64 + p0) = pk;
                }
        }
    }
    __syncthreads();
}

DI void mla_up_item(const Ctx& c_in, KArgs& a, int l, int which, int item) {
    const Ctx c = fresh_ctx(c_in.lds);
    unsigned char* ws = a.ws;
    const u16* proj = (const u16*)(ws + WS_PROJ);
    const float* trig = (const float*)(ws + WS_TRIG);
    float* rs_s = (float*)(c.lds + G_LDS_BYTES);
    const int r8 = c.tid >> 3;
    const int wm = c.wave & 3, wn = c.wave >> 2, l31 = c.lane & 31, h = c.lane >> 5;
    const int K = which == 0 ? 256 : 128;
    const int pc = which == 0 ? PC_CQ : PC_CKV;
    const int ntn = which == 0 ? 3 : 4;
    const int mt = item / ntn, nt = item % ntn;
    const u16* w = which == 0 ? (const u16*)(ws + WS_WUQ) + (size_t)l * 384 * 256 : (const u16*)(ws + WS_WUKV) + (size_t)l * 512 * 128;
    {
        const int row = c.tid >> 1, half = c.tid & 1;
        const u16* p = proj + (size_t)(mt * 256 + row) * LDP + pc + half * (K / 2);
        float ss = 0.f;
        for (int i = 0; i < K / 2; i += 8) {
            const uint4 v = *(const uint4*)(p + i);
            const unsigned w4[4] = { v.x, v.y, v.z, v.w };
#pragma unroll
            for (int j = 0; j < 4; ++j) { const float f0 = bf2f((u16)(w4[j] & 0xffff)), f1 = bf2f((u16)(w4[j] >> 16)); ss += f0 * f0 + f1 * f1; }
        }
        ss += __shfl_xor(ss, 1);
        if (half == 0) rs_s[row] = rsqrtf(ss / (float)K + EPS);
    }
    __syncthreads();
    GP gp;
    gp.a0 = proj + (size_t)(mt * 256 + r8) * LDP + pc; gp.a1 = gp.a0 + 64 * LDP; gp.a2 = gp.a0 + 128 * LDP; gp.a3 = gp.a0 + 192 * LDP;
    gp.b0 = w + (size_t)(nt * 128 + r8) * K; gp.b1 = gp.b0 + 64 * K;
    f32x16 acc[2][2];
    acc[0][0] = zero16(); acc[0][1] = zero16(); acc[1][0] = zero16(); acc[1][1] = zero16();
    gemm_core<false>(c, K, gp, acc);
    u16* mlaq = (u16*)(ws + WS_MLAQ);
    u16* mlak = (u16*)(ws + WS_MLAK);
    u16* mlavt = (u16*)(ws + WS_MLAVT);
#pragma unroll
    for (int i = 0; i < 2; ++i)
#pragma unroll
        for (int j = 0; j < 2; ++j) {
            const int ml0 = wm * 64 + i * 32, m0 = mt * 256 + ml0, n0 = nt * 128 + wn * 64 + j * 32;
            const int n = n0 + l31;
            if (which == 0) {
                const bool rope = ((n0 >> 5) % 3) == 2;
#pragma unroll
                for (int r = 0; r < 16; ++r) {
                    const int ml = ml0 + crow(r, h), m = mt * 256 + ml;
                    float v = acc[i][j][r] * rs_s[ml];
                    if (rope) {
                        const float pv = __shfl_xor(v, 16);
                        const int ii = l31 & 15;
                        const float cs = trig[(size_t)m * 48 + 16 + ii], sn = trig[(size_t)m * 48 + 32 + ii];
                        v = (l31 < 16) ? (v * cs - pv * sn) : (v * cs + pv * sn);
                    }
                    mlaq[(size_t)m * 384 + n] = f2bf(v);
                }
            } else {
                const int head = n0 >> 7, wi = n0 & 127;
                if (wi < 64) {
#pragma unroll
                    for (int r = 0; r < 16; ++r) {
                        const int ml = ml0 + crow(r, h), m = mt * 256 + ml;
                        mlak[(size_t)m * 384 + head * 96 + wi + l31] = f2bf(acc[i][j][r] * rs_s[ml]);
                    }
                } else {
                    const int b = m0 >> 12, s0 = m0 & 4095, d = wi - 64 + l31;
                    u16* base = mlavt + ((size_t)(b * 4 + head) * 64 + d) * 4096 + s0;
#pragma unroll
                    for (int q = 0; q < 4; ++q) {
                        const int mlq = ml0 + 8 * q + 4 * h;
                        uint2 pk;
                        pk.x = pack2(acc[i][j][4 * q] * rs_s[mlq], acc[i][j][4 * q + 1] * rs_s[mlq + 1]);
                        pk.y = pack2(acc[i][j][4 * q + 2] * rs_s[mlq + 2], acc[i][j][4 * q + 3] * rs_s[mlq + 3]);
                        *(uint2*)(base + 8 * q + 4 * h) = pk;
                    }
                }
            }
        }
    __syncthreads();
}

DI void mla_up_unit(const Ctx& c_in, KArgs& a, int l, int which, int unit) {
    const Ctx c = fresh_ctx(c_in.lds);
    unsigned char* ws = a.ws;
    const u16* proj = (const u16*)(ws + WS_PROJ);
    const float* trig = (const float*)(ws + WS_TRIG);
    u16* mlaq = (u16*)(ws + WS_MLAQ);
    u16* mlak = (u16*)(ws + WS_MLAK);
    u16* mlavt = (u16*)(ws + WS_MLAVT);
    int R, C; g2_stage_rc(c.tid * 16, R, C);
    const int pm = unit >> 1, pn = unit & 1;
    G2Ptrs g;
    g.ra = g2_rsrc(proj);
    g.va00 = (unsigned)(R * LDP + (which == 0 ? PC_CQ : PC_CKV) + C) * 2u; g.va01 = g.va00 + 64 * LDP * 2; g.va10 = g.va00 + 128 * LDP * 2; g.va11 = g.va00 + 192 * LDP * 2;
    g.sa = (unsigned)pm * (256u * LDP * 2u);
    __syncthreads();
    if (which == 0) {
        g.rb = g2_rsrc((const u16*)(ws + WS_WUQ) + (size_t)l * 512 * 256);
        g.vb0 = (unsigned)(R * 256 + C) * 2u; g.vb1 = g.vb0 + 64 * 512; g.sb0 = (unsigned)pn * (256u * 512u); g.sb1 = g.sb0 + 128u * 512u;
        const float* rsq = (const float*)(ws + WS_RSQ);
        gemm256_unit(c, g, 256, [&](const f32x4 (&acc)[2][2][4][2], int wr, int wc, int fr, int fq) {
#pragma unroll
            for (int ai = 0; ai < 2; ++ai)
#pragma unroll
                for (int m = 0; m < 4; ++m) {
                    const int row = pm * 256 + ai * 128 + wr * 64 + m * 16 + fr;
                    const float rs = rsq[row];
#pragma unroll
                    for (int bj = 0; bj < 2; ++bj) {
                        const int c32 = pn * 256 + bj * 128 + wc * 32;
                        if (c32 < 384) {
                            f32x4 v0 = acc[ai][bj][m][0] * rs, v1 = acc[ai][bj][m][1] * rs;
                            if ((c32 % 96) == 64) {
                                const float* tg = trig + (size_t)row * 48 + 16 + 4 * fq;
                                const f32x4 cs = *(const f32x4*)tg, sn = *(const f32x4*)(tg + 16);
                                const f32x4 o1 = v0 * cs - v1 * sn, o2 = v1 * cs + v0 * sn;
                                v0 = o1; v1 = o2;
                            }
                            uint2 p0, p1; p0.x = pack2(v0[0], v0[1]); p0.y = pack2(v0[2], v0[3]); p1.x = pack2(v1[0], v1[1]); p1.y = pack2(v1[2], v1[3]);
                            *(uint2*)(mlaq + (size_t)row * 384 + c32 + 4 * fq) = p0;
                            *(uint2*)(mlaq + (size_t)row * 384 + c32 + 16 + 4 * fq) = p1;
                        }
                    }
                }
        });
    } else {
        g.rb = g2_rsrc((const u16*)(ws + WS_WUKV) + (size_t)l * 512 * 128);
        g.vb0 = (unsigned)(R * 128 + C) * 2u; g.vb1 = g.vb0 + 64 * 256; g.sb0 = (unsigned)pn * (256u * 256u); g.sb1 = g.sb0 + 128u * 256u;
        const float* rskv = (const float*)(ws + WS_RSKV);
        gemm256_unit(c, g, 128, [&](const f32x4 (&acc)[2][2][4][2], int wr, int wc, int fr, int fq) {
#pragma unroll
            for (int ai = 0; ai < 2; ++ai)
#pragma unroll
                for (int m = 0; m < 4; ++m) {
                    const int row = pm * 256 + ai * 128 + wr * 64 + m * 16 + fr;
                    const float rs = rskv[row];
#pragma unroll
                    for (int bj = 0; bj < 2; ++bj) {
                        const int head = pn * 2 + bj, c32 = wc * 32;
#pragma unroll
                        for (int n = 0; n < 2; ++n) {
                            const f32x4 v = acc[ai][bj][m][n] * rs;
                            if (c32 < 64) {
                                uint2 pk; pk.x = pack2(v[0], v[1]); pk.y = pack2(v[2], v[3]);
                                *(uint2*)(mlak + (size_t)row * 384 + head * 96 + c32 + n * 16 + 4 * fq) = pk;
                            } else {
                                u16* p = mlavt + ((size_t)((row >> 12) * 4 + head) * 64 + (c32 - 64 + n * 16 + 4 * fq)) * 4096 + (row & 4095);
                                p[0] = f2bf(v[0]); p[4096] = f2bf(v[1]); p[2 * 4096] = f2bf(v[2]); p[3 * 4096] = f2bf(v[3]);
                            }
                        }
                    }
                }
        });
    }
}

constexpr int AT_LDV = 68;
template <int DQ, int MODE>
DI void attn_item(const Ctx& c_in, KArgs& a, int l, int b, int hd_in, int qb) {
    const Ctx c = fresh_ctx(c_in.lds);
    unsigned char* ws = a.ws;
    constexpr int LDK = DQ + 8;
    constexpr int K_EL = 64 * LDK, V_EL = 64 * AT_LDV, ST_EL = K_EL + V_EL;
    constexpr int NKS = DQ / 16;
    constexpr int KCH = DQ / 8;
    u16* S = (u16*)c.lds;
    float* fc_s = (float*)(c.lds + 2 * ST_EL * 2 + 64);
    const int l31 = c.lane & 31, h = c.lane >> 5;
    int hd, wq0, nkt;
    const u16 *Qp, *Kp, *Vp; int ldq, ldk, ocol;
    float scale;
    if (MODE == 0) {
        hd = hd_in;
        wq0 = qb * 256 + c.wave * 32; nkt = qb * 4 + 4;
        Qp = (const u16*)(ws + WS_MLAQ) + (size_t)b * 4096 * 384 + hd * 96; ldq = 384;
        Kp = (const u16*)(ws + WS_MLAK) + (size_t)b * 4096 * 384 + hd * 96; ldk = 384;
        Vp = (const u16*)(ws + WS_MLAVT) + (size_t)(b * 4 + hd) * 64 * 4096;
        ocol = 512 + hd * 64; scale = 0.10206207261596575f;
    } else if (MODE == 1) {
        hd = hd_in;
        wq0 = qb * 256 + c.wave * 32; nkt = qb * 4 + 4;
        Qp = (const u16*)(ws + WS_PROJ) + (size_t)b * 4096 * LDP + PC_FOXQ + hd * 64; ldq = LDP;
        Kp = (const u16*)(ws + WS_PROJ) + (size_t)b * 4096 * LDP + PC_FOXK + hd * 64; ldk = LDP;
        Vp = (const u16*)(ws + WS_FOXVT) + (size_t)(b * 4 + hd) * 64 * 4096;
        ocol = 768 + hd * 64; scale = 0.125f;
    } else {
        hd = c.wave & 3;
        wq0 = qb * 64 + (c.wave >> 2) * 32; nkt = qb + 1;
        Qp = (const u16*)(ws + WS_PROJ) + (size_t)b * 4096 * LDP + PC_DSAQ + hd * 64; ldq = LDP;
        Kp = (const u16*)(ws + WS_PROJ) + (size_t)b * 4096 * LDP + PC_DSAK; ldk = LDP;
        Vp = (const u16*)(ws + WS_DSAVT) + (size_t)b * 64 * 4096;
        ocol = 256 + hd * 64; scale = 0.125f;
    }
    const float sc2 = scale * LOG2E;
    const int q = wq0 + l31;
    bf16x8 qf[NKS];
#pragma unroll
    for (int ks = 0; ks < NKS; ++ks) qf[ks] = *(const bf16x8*)(Qp + (size_t)q * ldq + ks * 16 + h * 8);
    float fq = 0.f;
    if (MODE == 1) {
        const float* fsm = (const float*)(ws + WS_SMALL) + (size_t)b * 4096 * 16 + 12 + hd;
        const float fbias = a.in[14][l * 4 + hd];
        float* wtot = (float*)(c.lds + 2 * ST_EL * 2);
        const int nk = nkt * 64;
        float v[8]; float s = 0.f;
#pragma unroll
        for (int j = 0; j < 8; ++j) {
            const int idx = c.tid * 8 + j;
            float lf = 0.f;
            if (idx < nk) { const float f = fsm[(size_t)idx * 16] + fbias; lf = fminf(f, 0.f) - log1pf(__expf(-fabsf(f))); }
            v[j] = lf;
        }
#pragma unroll
        for (int j = 0; j < 8; ++j) { s += v[j]; v[j] = s; }
        float inc = s;
#pragma unroll
        for (int o = 1; o < 64; o <<= 1) { const float tv = __shfl_up(inc, o); if (c.lane >= o) inc += tv; }
        if (c.lane == 63) wtot[c.wave] = inc;
        __syncthreads();
        float base = inc - s;
        for (int w2 = 0; w2 < c.wave; ++w2) base += wtot[w2];
#pragma unroll
        for (int j = 0; j < 8; ++j) fc_s[c.tid * 8 + j] = (base + v[j]) * LOG2E;
        __syncthreads();
        fq = fc_s[q];
    }
    float sbound = 0.f;
    int* dflag = (int*)(c.lds + 2 * ST_EL * 2 + 64 + 4096 * 4);
    if (MODE == 1) {
        float qq = 0.f;
#pragma unroll
        for (int ks = 0; ks < NKS; ++ks)
#pragma unroll
            for (int j = 0; j < 8; ++j) { const float f = bf2f((u16)qf[ks][j]); qq += f * f; }
        qq += __shfl_xor(qq, 32);
        float kmax2 = 0.f;
#pragma unroll
        for (int f = 0; f < 4; ++f) kmax2 += __uint_as_float(__hip_atomic_load((const unsigned*)(ws + WS_CTL) + 64 + (b * 4 + hd) * 4 + f, __ATOMIC_RELAXED, __HIP_MEMORY_SCOPE_AGENT));
        sbound = sqrtf(qq * kmax2) * sc2 * 1.02f + 1.0f;
        if (c.tid < 16) dflag[c.tid] = 0;
    }
    bool wdone = false;
    const int krow0 = c.tid / KCH, kch0 = c.tid % KCH;
    const int c1 = c.tid + NTHR; const int krow1 = c1 / KCH, kch1 = c1 % KCH; const bool has1 = (KCH * 64 > NTHR) && (c1 < KCH * 64);
    const int vrow = c.tid >> 3, vch = c.tid & 7;
    struct KV { uint4 k0, k1, v; u64 mw; };
    KV sA, sB, sC;
    sA.k1 = sB.k1 = sC.k1 = make_uint4(0, 0, 0, 0); sA.mw = sB.mw = sC.mw = 0;
    const u64* mrow = (const u64*)(ws + WS_MASK) + (size_t)(b * 4096 + q) * 64;
    auto gload = [&](KV& s, int kt) {
        s.k0 = *(const uint4*)(Kp + (size_t)(kt * 64 + krow0) * ldk + kch0 * 8);
        if (has1) s.k1 = *(const uint4*)(Kp + (size_t)(kt * 64 + krow1) * ldk + kch1 * 8);
        s.v = *(const uint4*)(Vp + (size_t)vrow * 4096 + kt * 64 + vch * 8);
        if (MODE == 2) s.mw = mrow[kt];
    };
    auto sstore = [&](const KV& s, int st) {
        u16* Ks = S + st * ST_EL; u16* Vs = Ks + K_EL;
        *(uint4*)(Ks + krow0 * LDK + kch0 * 8) = s.k0;
        if (has1) *(uint4*)(Ks + krow1 * LDK + kch1 * 8) = s.k1;
        *(uint2*)(Vs + vrow * AT_LDV + vch * 8) = make_uint2(s.v.x, s.v.y);
        *(uint2*)(Vs + vrow * AT_LDV + vch * 8 + 4) = make_uint2(s.v.z, s.v.w);
    };
    f32x16 o0 = zero16(), o1 = zero16();
    float m_run = -1e30f, l_run = 0.f;
    auto tile_of = [&](int it) { return (MODE == 1) ? nkt - 1 - it : it; };
    bool stop = false;
    auto step = [&](int it, KV& cur, const KV& nxt) {
        const int kt = tile_of(it);
        const u64 mw_cur = cur.mw;
        if (it + 3 < nkt) gload(cur, tile_of(it + 3));
        if (kt * 64 <= wq0 + 31 && !wdone) {
            const u16* Ks = S + (it & 1) * ST_EL; const u16* Vs = Ks + K_EL;
            f32x16 s0 = zero16(), s1 = zero16();
#pragma unroll
            for (int ks = 0; ks < NKS; ++ks) {
                const bf16x8 k0 = *(const bf16x8*)(Ks + l31 * LDK + ks * 16 + h * 8);
                const bf16x8 k1 = *(const bf16x8*)(Ks + (32 + l31) * LDK + ks * 16 + h * 8);
                s0 = MFMA32(k0, qf[ks], s0);
                s1 = MFMA32(k1, qf[ks], s1);
            }
            const float scx = (MODE == 1) ? 1.0f : sc2;
            if (MODE == 1) {
#pragma unroll
                for (int g4 = 0; g4 < 4; ++g4) {
                    const float4 f0 = *(const float4*)(fc_s + kt * 64 + 8 * g4 + 4 * h);
                    const float4 f1 = *(const float4*)(fc_s + kt * 64 + 32 + 8 * g4 + 4 * h);
                    s0[4 * g4 + 0] = fmaf(s0[4 * g4 + 0], sc2, fq) - f0.x; s0[4 * g4 + 1] = fmaf(s0[4 * g4 + 1], sc2, fq) - f0.y;
                    s0[4 * g4 + 2] = fmaf(s0[4 * g4 + 2], sc2, fq) - f0.z; s0[4 * g4 + 3] = fmaf(s0[4 * g4 + 3], sc2, fq) - f0.w;
                    s1[4 * g4 + 0] = fmaf(s1[4 * g4 + 0], sc2, fq) - f1.x; s1[4 * g4 + 1] = fmaf(s1[4 * g4 + 1], sc2, fq) - f1.y;
                    s1[4 * g4 + 2] = fmaf(s1[4 * g4 + 2], sc2, fq) - f1.z; s1[4 * g4 + 3] = fmaf(s1[4 * g4 + 3], sc2, fq) - f1.w;
                }
            }
            if (MODE == 2) {
                const unsigned mlo = (unsigned)(mw_cur >> (4 * h)), mhi = (unsigned)(mw_cur >> (32 + 4 * h));
#pragma unroll
                for (int r = 0; r < 16; ++r) {
                    const int kr = (r & 3) + 8 * (r >> 2);
                    s0[r] = ((mlo >> kr) & 1u) ? s0[r] : -1e30f;
                    s1[r] = ((mhi >> kr) & 1u) ? s1[r] : -1e30f;
                }
            } else if (__builtin_amdgcn_readfirstlane(kt * 64 + 63 - wq0) > 0) {
                asm volatile("" ::: "memory");
                const int qrel = q - kt * 64 - 4 * h;
#pragma unroll
                for (int r = 0; r < 16; ++r) {
                    const int kr = (r & 3) + 8 * (r >> 2);
                    s0[r] = (kr <= qrel) ? s0[r] : -1e30f;
                    s1[r] = (kr + 32 <= qrel) ? s1[r] : -1e30f;
                }
            }
            asm volatile("s_nop 15\n\ts_nop 3" : "+v"(s0), "+v"(s1));
            float mx;
            {
                float t0 = max3f(s0[0], s0[1], s0[2]), t1 = max3f(s0[3], s0[4], s0[5]), t2 = max3f(s0[6], s0[7], s0[8]), t3 = max3f(s0[9], s0[10], s0[11]);
                float t4 = max3f(s0[12], s0[13], s0[14]), t5 = max3f(s0[15], s1[0], s1[1]), t6 = max3f(s1[2], s1[3], s1[4]), t7 = max3f(s1[5], s1[6], s1[7]);
                float t8 = max3f(s1[8], s1[9], s1[10]), t9 = max3f(s1[11], s1[12], s1[13]), t10 = max3f(s1[14], s1[15], t0);
                t1 = max3f(t1, t2, t3); t4 = max3f(t4, t5, t6); t7 = max3f(t7, t8, t9);
                mx = max3f(t1, t4, t7); mx = max3f(mx, t10, __shfl_xor(max3f(t1, t4, max3f(t7, t10, t10)), 32));
            }
            const float m_new = max3f(m_run, mx, mx);
            const float m_use = (MODE == 2) ? max3f(m_new, -1e20f, -1e20f) : m_new;
            const float alpha = ex2((m_run - m_new) * scx);
            const float nm = -m_use * scx;
            f32x2 rs2 = {0.f, 0.f};
            const f32x2 sc2v = {scx, scx}, nm2 = {nm, nm};
#pragma unroll
            for (int r = 0; r < 16; r += 2) {
                f32x2 xv = {s0[r], s0[r + 1]};
                xv = xv * sc2v + nm2;
                xv[0] = ex2(xv[0]); xv[1] = ex2(xv[1]);
                s0[r] = xv[0]; s0[r + 1] = xv[1];
                rs2 += xv;
                f32x2 yv = {s1[r], s1[r + 1]};
                yv = yv * sc2v + nm2;
                yv[0] = ex2(yv[0]); yv[1] = ex2(yv[1]);
                s1[r] = yv[0]; s1[r + 1] = yv[1];
                rs2 += yv;
            }
            float rsum = rs2[0] + rs2[1];
            rsum += __shfl_xor(rsum, 32);
            l_run = l_run * alpha + rsum; m_run = m_new;
            if (__any(alpha != 1.0f)) {
#pragma unroll
                for (int r = 0; r < 16; ++r) { o0[r] *= alpha; o1[r] *= alpha; }
            }
#pragma unroll
            for (int sub = 0; sub < 2; ++sub)
#pragma unroll
                for (int s2 = 0; s2 < 2; ++s2) {
                    const bf16x8 pb = pack8(sub ? s1 : s0, s2);
                    const int koff = sub * 32 + 16 * s2 + 4 * h;
                    {
                        const u16* vr = Vs + l31 * AT_LDV + koff;
                        const uint2 lo = *(const uint2*)vr, hi = *(const uint2*)(vr + 8);
                        o0 = MFMA32(__builtin_bit_cast(bf16x8, make_uint4(lo.x, lo.y, hi.x, hi.y)), pb, o0);
                    }
                    {
                        const u16* vr = Vs + (32 + l31) * AT_LDV + koff;
                        const uint2 lo = *(const uint2*)vr, hi = *(const uint2*)(vr + 8);
                        o1 = MFMA32(__builtin_bit_cast(bf16x8, make_uint4(lo.x, lo.y, hi.x, hi.y)), pb, o1);
                    }
                }
        }
        if (it + 1 < nkt) sstore(nxt, (it + 1) & 1);
        if (MODE == 1) {
            if (kt * 64 <= wq0 + 31 && !wdone && kt > 0) wdone = __all(sbound + (fq - fc_s[kt * 64 - 1]) < m_run - 40.f);
            if (c.lane == 0) dflag[(it & 1) * 8 + c.wave] = wdone ? 1 : 0;
        }
        __syncthreads();
        if (MODE == 1) {
            const int4 f0 = *(const int4*)(dflag + (it & 1) * 8), f1 = *(const int4*)(dflag + (it & 1) * 8 + 4);
            if ((f0.x & f0.y & f0.z & f0.w & f1.x & f1.y & f1.z & f1.w) != 0) stop = true;
        }
    };
    gload(sA, tile_of(0));
    if (nkt > 1) gload(sB, tile_of(1));
    if (nkt > 2) gload(sC, tile_of(2));
    sstore(sA, 0);
    __syncthreads();
    for (int it = 0; it < nkt; it += 3) {
        step(it, sA, sB); if (stop || it + 1 >= nkt) break;
        step(it + 1, sB, sC); if (stop || it + 2 >= nkt) break;
        step(it + 2, sC, sA); if (stop) break;
    }
    if (MODE == 1) __syncthreads();
    {
        const float inv = 1.f / l_run;
        u16* act = (u16*)(ws + WS_ACT) + (size_t)(b * 4096 + q) * 1024 + ocol;
#pragma unroll
        for (int qd = 0; qd < 4; ++qd) {
            uint2 pk;
            pk.x = pack2(o0[4 * qd] * inv, o0[4 * qd + 1] * inv); pk.y = pack2(o0[4 * qd + 2] * inv, o0[4 * qd + 3] * inv);
            *(uint2*)(act + 8 * qd + 4 * h) = pk;
            pk.x = pack2(o1[4 * qd] * inv, o1[4 * qd + 1] * inv); pk.y = pack2(o1[4 * qd + 2] * inv, o1[4 * qd + 3] * inv);
            *(uint2*)(act + 32 + 8 * qd + 4 * h) = pk;
        }
    }
}

constexpr int SC_LD = 4100;
struct DsaPref { uint4 q; float w; bf16x8 kb[2][4]; };
DI void dsa_prefetch(const Ctx& c, KArgs& a, int b, int s0, DsaPref& pf) {
    const u16* proj = (const u16*)(a.ws + WS_PROJ);
    const float* small = (const float*)(a.ws + WS_SMALL);
    const int tok0 = b * 4096 + s0;
    const int npair = ((((s0 + 7) >> 5) + 1) + 1) >> 1;
    const u16* kbase = (const u16*)(a.ws + WS_KF) + (size_t)b * 128 * 4 * 512 + c.lane * 8;
    if (c.wave < npair) {
#pragma unroll
        for (int tt = 0; tt < 2; ++tt)
#pragma unroll
            for (int ks = 0; ks < 4; ++ks) pf.kb[tt][ks] = *(const bf16x8*)(kbase + (size_t)((2 * c.wave + tt) * 4 + ks) * 512);
    }
    {
        const int r = c.tid >> 3;
        pf.q = *(const uint4*)(proj + (size_t)(tok0 + (r >> 3)) * LDP + PC_IDXQ + (r & 7) * 64 + (c.tid & 7) * 8);
    }
    pf.w = (c.tid < 64) ? small[(size_t)(tok0 + (c.tid >> 3)) * 16 + 4 + (c.tid & 7)] * 0.044194173824159216f : 0.f;
}
DI void dsa_index_item(const Ctx& c_in, KArgs& a, int b, int s0, DsaPref& pf, bool last) {
    const Ctx c = fresh_ctx(c_in.lds);
    unsigned char* ws = a.ws;
    const u16* proj = (const u16*)(ws + WS_PROJ);
    const float* small = (const float*)(ws + WS_SMALL);
    u64* mask = (u64*)(ws + WS_MASK);
    unsigned* SC = (unsigned*)c.lds;
    unsigned* HIST = (unsigned*)(c.lds + 8 * SC_LD * 4);
    unsigned* QMM = HIST + 8 * 272;
    const int l31 = c.lane & 31, h = c.lane >> 5;
    const int tok0 = b * 4096 + s0;
    const int ntile = ((s0 + 7) >> 5) + 1;
    const int npair = (ntile + 1) >> 1;
    u16* QA_s = (u16*)(QMM + 16);
    float* W_s = (float*)(QA_s + 64 * 72);
    if (c.tid < 16) QMM[c.tid] = (c.tid < 8) ? 0xffffffffu : 0u;
    *(uint4*)(QA_s + (c.tid >> 3) * 72 + (c.tid & 7) * 8) = pf.q;
    if (c.tid < 64) W_s[c.tid] = pf.w;
    const u16* kbase = (const u16*)(ws + WS_KF) + (size_t)b * 128 * 4 * 512 + c.lane * 8;
    bf16x8 kb[2][4], kn[2][4];
#pragma unroll
    for (int tt = 0; tt < 2; ++tt)
#pragma unroll
        for (int ks = 0; ks < 4; ++ks) kb[tt][ks] = pf.kb[tt][ks];
    __syncthreads();
    bf16x8 qa[2][4];
    float wv[2][16];
#pragma unroll
    for (int rt = 0; rt < 2; ++rt) {
#pragma unroll
        for (int ks = 0; ks < 4; ++ks) qa[rt][ks] = *(const bf16x8*)(QA_s + (rt * 32 + l31) * 72 + ks * 16 + h * 8);
#pragma unroll
        for (int g = 0; g < 4; ++g) {
            const float4 w4 = *(const float4*)(W_s + (g + 4 * rt) * 8 + 4 * h);
            wv[rt][4 * g + 0] = w4.x; wv[rt][4 * g + 1] = w4.y; wv[rt][4 * g + 2] = w4.z; wv[rt][4 * g + 3] = w4.w;
        }
    }
    unsigned kmin[4], kmax[4];
#pragma unroll
    for (int g = 0; g < 4; ++g) { kmin[g] = 0xffffffffu; kmax[g] = 0u; }
    for (int kp = c.wave; kp < npair; kp += 8) {
        if (kp + 8 < npair) {
#pragma unroll
            for (int tt = 0; tt < 2; ++tt)
#pragma unroll
                for (int ks = 0; ks < 4; ++ks) kn[tt][ks] = *(const bf16x8*)(kbase + (size_t)((2 * (kp + 8) + tt) * 4 + ks) * 512);
        }
#pragma unroll
        for (int tt = 0; tt < 2; ++tt) {
            const int key = (2 * kp + tt) * 32 + l31;
            f32x16 a0 = zero16(), a1 = zero16();
#pragma unroll
            for (int ks = 0; ks < 4; ++ks) { a0 = MFMA32(qa[0][ks], kb[tt][ks], a0); a1 = MFMA32(qa[1][ks], kb[tt][ks], a1); }
            asm volatile("s_nop 15\n\ts_nop 3" : "+v"(a0), "+v"(a1));
#pragma unroll
            for (int g = 0; g < 4; ++g) {
                f32x2 p = {0.f, 0.f};
#pragma unroll
                for (int r3 = 0; r3 < 4; ++r3) {
                    const f32x2 rl = {relu_raw(a0[4 * g + r3]), relu_raw(a1[4 * g + r3])};
                    const f32x2 ww = {wv[0][4 * g + r3], wv[1][4 * g + r3]};
                    p += ww * rl;
                }
                const auto sw = __builtin_amdgcn_permlane32_swap(__float_as_uint(p[0]), __float_as_uint(p[1]), false, false);
                const float sc_ = __uint_as_float(sw[0]) + __uint_as_float(sw[1]);
                const unsigned bits = __float_as_uint(sc_ + 0.0f);
                unsigned k = bits ^ ((unsigned)((int)bits >> 31) | 0x80000000u);
                k = (key <= s0 + 4 * h + g) ? k : 0u;
                SC[(4 * h + g) * SC_LD + key] = k;
                kmax[g] = max(kmax[g], k); kmin[g] = min(kmin[g], k ? k : 0xffffffffu);
            }
        }
#pragma unroll
        for (int tt = 0; tt < 2; ++tt)
#pragma unroll
            for (int ks = 0; ks < 4; ++ks) kb[tt][ks] = kn[tt][ks];
    }
#pragma unroll
    for (int g = 0; g < 4; ++g) {
#pragma unroll
        for (int o = 16; o >= 1; o >>= 1) { kmin[g] = min(kmin[g], (unsigned)__shfl_xor((int)kmin[g], o)); kmax[g] = max(kmax[g], (unsigned)__shfl_xor((int)kmax[g], o)); }
        if (l31 == 0) { atomicMin(&QMM[4 * h + g], kmin[g]); atomicMax(&QMM[8 + 4 * h + g], kmax[g]); }
    }
    if (!last) dsa_prefetch(c, a, b, s0 + 8, pf);
    __syncthreads();
    {
        const int qi = __builtin_amdgcn_readfirstlane(s0 + c.wave), n = qi + 1;
        const unsigned* sc = SC + c.wave * SC_LD + c.lane;
        unsigned* hist = HIST + c.wave * 272;
        const int nit = (n + 63) >> 6;
        unsigned thr = 1u; int cut = 0x7fffffff;
        if (n > 256) {
            unsigned lo = (unsigned)__builtin_amdgcn_readfirstlane((int)QMM[c.wave]), hi = (unsigned)__builtin_amdgcn_readfirstlane((int)QMM[8 + c.wave]);
            const unsigned lo_full = lo, hi_full = hi;
            bool filtered = false;
            {
                const int m = (int)(32768.f / (float)n) + 6;
                if (m < 60) {
                    const int sidx = (c.lane * 13 + 5) % nit;
                    const unsigned smp = sc[sidx * 64];
                    int rank = 0;
#pragma unroll
                    for (int j = 0; j < 64; ++j) { const unsigned sj = (unsigned)__builtin_amdgcn_readlane((int)smp, j); rank += (sj > smp) ? 1 : 0; }
                    unsigned cand = (rank <= m - 1) ? smp : 0xffffffffu;
#pragma unroll
                    for (int o = 32; o >= 1; o >>= 1) cand = min(cand, (unsigned)__shfl_xor((int)cand, o));
                    const unsigned L = (unsigned)__builtin_amdgcn_readfirstlane((int)cand);
                    if (L > lo && L <= hi) { lo = L; filtered = true; }
                }
            }
            int kk = 256;
            for (int iter = 0; iter < 6; ++iter) {
                const unsigned width = hi - lo;
                const int shift = max(0, 24 - (int)__clz(width | 1u));
#pragma unroll
                for (int j = 0; j < 5; ++j) { const int idx = c.lane + 64 * j; if (idx < 272) hist[idx] = 0u; }
#pragma unroll 1
                for (int it0 = 0; it0 < nit; it0 += 8) {
                    unsigned kv[8];
#pragma unroll
                    for (int j = 0; j < 8; ++j) kv[j] = sc[(it0 + j) * 64];
#pragma unroll
                    for (int j = 0; j < 8; ++j) {
                        const unsigned d = kv[j] - lo;
                        if (it0 + j < nit && d <= width) atomicAdd(&hist[d >> shift], 1u);
                    }
                }
                const unsigned c0 = hist[4 * c.lane], c1 = hist[4 * c.lane + 1], c2 = hist[4 * c.lane + 2], c3 = hist[4 * c.lane + 3];
                const unsigned ls = c0 + c1 + c2 + c3;
                unsigned suf = ls;
#pragma unroll
                for (int o = 1; o < 64; o <<= 1) { const unsigned tv = __shfl_down(suf, o); if (c.lane + o < 64) suf += tv; }
                if (filtered) {
                    filtered = false;
                    if ((unsigned)__builtin_amdgcn_readfirstlane((int)suf) < (unsigned)kk) { lo = lo_full; hi = hi_full; continue; }
                }
                const unsigned above_lane = suf - ls;
                const bool mine = (suf >= (unsigned)kk) && (above_lane < (unsigned)kk);
                int bstar = 0; unsigned above = 0, cntb = 0;
                if (mine) {
                    unsigned run = above_lane;
                    if (run + c3 >= (unsigned)kk) { bstar = 4 * c.lane + 3; above = run; cntb = c3; }
                    else { run += c3;
                        if (run + c2 >= (unsigned)kk) { bstar = 4 * c.lane + 2; above = run; cntb = c2; }
                        else { run += c2;
                            if (run + c1 >= (unsigned)kk) { bstar = 4 * c.lane + 1; above = run; cntb = c1; }
                            else { run += c1; bstar = 4 * c.lane; above = run; cntb = c0; } } }
                }
                const u64 mm = __ballot(mine);
                const int src = __ffsll((long long)mm) - 1;
                bstar = __shfl(bstar, src); above = __shfl(above, src); cntb = __shfl(cntb, src);
                kk -= (int)above;
                const unsigned nlo = lo + ((unsigned)bstar << shift);
                const unsigned nhi = min(hi, nlo + ((1u << shift) - 1u));
                lo = nlo; hi = nhi; thr = lo;
                if ((int)cntb == kk) break;
                if (shift == 0) {
                    int need = kk;
                    for (int it = 0; it < nit; ++it) {
                        const unsigned k = sc[it * 64];
                        const bool e = (k == thr);
                        const u64 mk = __ballot(e); const int cn = __popcll(mk);
                        if (need <= cn) {
                            const u64 sel = __ballot(e && (__popcll(mk & ((1ull << c.lane) - 1ull)) == need - 1));
                            cut = it * 64 + (__ffsll((long long)sel) - 1);
                            break;
                        }
                        need -= cn;
                    }
                    break;
                }
            }
        }
        u64* mrow = mask + (size_t)(b * 4096 + qi) * 64;
        u64 myword = 0;
        const bool tie = (cut != 0x7fffffff);
#pragma unroll 1
        for (int it0 = 0; it0 < nit; it0 += 8) {
            unsigned kv[8];
#pragma unroll
            for (int j = 0; j < 8; ++j) kv[j] = sc[(it0 + j) * 64];
#pragma unroll
            for (int j = 0; j < 8; ++j) {
                const unsigned k = (it0 + j < nit) ? kv[j] : 0u;
                bool sel = (k >= thr);
                if (tie) sel = (k > thr) || (k == thr && ((it0 + j) * 64 + c.lane) <= cut);
                const u64 wd = __ballot(sel);
                if (c.lane == it0 + j) myword = wd;
            }
        }
        mrow[c.lane] = myword;
    }
    __syncthreads();
}

DI void phase_outproj(const Ctx& c_in, KArgs& a, int l) {
    const Ctx c = fresh_ctx(c_in.lds);
    unsigned char* ws = a.ws;
    const u16* act = (const u16*)(ws + WS_ACT);
    const u16* w = (const u16*)(ws + WS_WOUT) + (size_t)l * 1024 * 1024;
    const float* xin = (l == 0) ? a.in[0] : a.out;
    float* out = a.out;
    int R, C; g2_stage_rc(c.tid * 16, R, C);
    const int nunits = (T_TOK / 256) * 4;
    for (int u = vblock(); u < nunits; u += gridDim.x) {
        const int pm = (u >> 4) * 4 + (u & 3), pn = (u >> 2) & 3;
        G2Ptrs g;
        g.ra = g2_rsrc(act); g.rb = g2_rsrc(w);
        g.va00 = (unsigned)(R * 1024 + C) * 2u; g.va01 = g.va00 + 64 * 2048; g.va10 = g.va00 + 128 * 2048; g.va11 = g.va00 + 192 * 2048;
        g.vb0 = g.va00; g.vb1 = g.va01;
        g.sa = (unsigned)pm * (256u * 2048u); g.sb0 = (unsigned)pn * (256u * 2048u); g.sb1 = g.sb0 + 128u * 2048u;
        __syncthreads();
        gemm256_unit(c, g, 1024, [&](const f32x4 (&acc)[2][2][4][2], int wr, int wc, int fr, int fq) {
#pragma unroll
            for (int ai = 0; ai < 2; ++ai)
#pragma unroll
                for (int m = 0; m < 4; ++m) {
                    const size_t rowoff = (size_t)(pm * 256 + ai * 128 + wr * 64 + m * 16 + fr) * 1024 + pn * 256 + wc * 32 + 4 * fq;
#pragma unroll
                    for (int bj = 0; bj < 2; ++bj)
#pragma unroll
                        for (int n = 0; n < 2; ++n) {
                            const f32x4 xv = *(const f32x4*)(xin + rowoff + bj * 128 + n * 16);
                            *(f32x4*)(out + rowoff + bj * 128 + n * 16) = xv + acc[ai][bj][m][n];
                        }
                }
        });
    }
}

constexpr int RT_LD = 1032;
DI void phase_router(const Ctx& c_in, KArgs& a, int l) {
    const Ctx c = fresh_ctx(c_in.lds);
    unsigned char* ws = a.ws;
    const float* x = a.out;
    const float* g = a.in[16] + l * 1024;
    const float* brg = a.in[18] + l * 4;
    const float* bre = a.in[20] + l * 32;
    const u16* wrh = (const u16*)(ws + WS_WRH) + (size_t)l * 64 * 1024;
    const u16* wrl = (const u16*)(ws + WS_WRL) + (size_t)l * 64 * 1024;
    u16* act = (u16*)(ws + WS_ACT);
    int* cnt = (int*)(ws + WS_CTL);
    int* list = (int*)(ws + WS_LIST);
    float* tokw = (float*)(ws + WS_TOKW);
    u16* HI = (u16*)c.lds;
    u16* LO = HI + 32 * RT_LD;
    float* LG = (float*)(c.lds + 2 * 32 * RT_LD * 2);
    const int l31 = c.lane & 31, h = c.lane >> 5;
    for (int it = bid(); it < T_TOK / 32; it += gridDim.x) {
        const int t0 = it * 32;
#pragma unroll
        for (int tt = 0; tt < 4; ++tt) {
            const int tl = c.wave * 4 + tt, t = t0 + tl;
            const float* xr = x + (size_t)t * 1024 + c.lane * 4;
            float4 v[4]; float ss = 0.f;
#pragma unroll
            for (int j = 0; j < 4; ++j) { v[j] = *(const float4*)(xr + 256 * j); ss += v[j].x * v[j].x + v[j].y * v[j].y + v[j].z * v[j].z + v[j].w * v[j].w; }
            ss = wsum(ss);
            const float rs = rsqrtf(ss * (1.f / 1024.f) + EPS);
#pragma unroll
            for (int j = 0; j < 4; ++j) {
                const float4 gg = *(const float4*)(g + c.lane * 4 + 256 * j);
                const float h0 = v[j].x * rs * gg.x, h1 = v[j].y * rs * gg.y, h2 = v[j].z * rs * gg.z, h3 = v[j].w * rs * gg.w;
                const u16 b0 = f2bf(h0), b1 = f2bf(h1), b2 = f2bf(h2), b3 = f2bf(h3);
                const uint2 hp = make_uint2((unsigned)b0 | ((unsigned)b1 << 16), (unsigned)b2 | ((unsigned)b3 << 16));
                const uint2 lp = make_uint2(pack2(h0 - bf2f(b0), h1 - bf2f(b1)), pack2(h2 - bf2f(b2), h3 - bf2f(b3)));
                *(uint2*)(act + (size_t)t * 1024 + c.lane * 4 + 256 * j) = hp;
                *(uint2*)(HI + tl * RT_LD + c.lane * 4 + 256 * j) = hp;
                *(uint2*)(LO + tl * RT_LD + c.lane * 4 + 256 * j) = lp;
            }
        }
        __syncthreads();
        {
            const int k0 = c.wave * 128 + h * 8;
            f32x16 acc0 = zero16(), acc1 = zero16();
#pragma unroll
            for (int ks = 0; ks < 8; ++ks) {
                const int k = k0 + ks * 16;
                const bf16x8 ah = *(const bf16x8*)(HI + l31 * RT_LD + k);
                const bf16x8 al = *(const bf16x8*)(LO + l31 * RT_LD + k);
                const bf16x8 bh0 = *(const bf16x8*)(wrh + (size_t)l31 * 1024 + k);
                const bf16x8 bh1 = *(const bf16x8*)(wrh + (size_t)(32 + l31) * 1024 + k);
                const bf16x8 bl0 = *(const bf16x8*)(wrl + (size_t)l31 * 1024 + k);
                const bf16x8 bl1 = *(const bf16x8*)(wrl + (size_t)(32 + l31) * 1024 + k);
                acc0 = MFMA32(ah, bh0, acc0); acc0 = MFMA32(ah, bl0, acc0); acc0 = MFMA32(al, bh0, acc0);
                acc1 = MFMA32(ah, bh1, acc1); acc1 = MFMA32(ah, bl1, acc1); acc1 = MFMA32(al, bh1, acc1);
            }
            __syncthreads();
            float* PART = (float*)c.lds + c.wave * (32 * 37);
#pragma unroll
            for (int r = 0; r < 16; ++r) {
                PART[crow(r, h) * 37 + l31] = acc0[r];
                if (l31 < 4) PART[crow(r, h) * 37 + 32 + l31] = acc1[r];
            }
        }
        __syncthreads();
        for (int i = c.tid; i < 32 * 36; i += NTHR) {
            const int tk = i / 36, e = i % 36;
            float s = 0.f;
#pragma unroll
            for (int w2 = 0; w2 < 8; ++w2) s += ((const float*)c.lds)[w2 * (32 * 37) + tk * 37 + e];
            LG[tk * 65 + e] = s;
        }
        __syncthreads();
        int* lcnt = (int*)(LG + 32 * 65);
        if (c.tid < 64) lcnt[c.tid] = 0;
        __syncthreads();
        int myL1 = 0, myL2 = 0, r1 = 0, r2 = 0; float w1 = 0.f, w2 = 0.f;
        if (c.tid < 32) {
            const float* lg = LG + c.tid * 65;
            float gl[4];
#pragma unroll
            for (int e = 0; e < 4; ++e) gl[e] = lg[e] + brg[e];
            int gi = 0; float gm = gl[0];
#pragma unroll
            for (int e = 1; e < 4; ++e) if (gl[e] > gm) { gm = gl[e]; gi = e; }
            float den = 0.f;
#pragma unroll
            for (int e = 0; e < 4; ++e) den += __expf(gl[e] - gm);
            const float gp = 1.f / den;
            float el[8];
#pragma unroll
            for (int e = 0; e < 8; ++e) el[e] = lg[4 + gi * 8 + e] + bre[gi * 8 + e];
            int i1 = 0; float v1 = el[0];
#pragma unroll
            for (int e = 1; e < 8; ++e) if (el[e] > v1) { v1 = el[e]; i1 = e; }
            int i2 = 0; float v2 = -INFINITY;
#pragma unroll
            for (int e = 0; e < 8; ++e) if (e != i1 && el[e] > v2) { v2 = el[e]; i2 = e; }
            const float ex = __expf(v2 - v1);
            w1 = gp / (1.f + ex); w2 = gp * ex / (1.f + ex);
            myL1 = (gi * 8 + i1) * 2; myL2 = (gi * 8 + i2) * 2 + 1;
            r1 = atomicAdd(&lcnt[myL1], 1); r2 = atomicAdd(&lcnt[myL2], 1);
        }
        __syncthreads();
        if (c.tid < 64) { const int n = lcnt[c.tid]; lcnt[c.tid] = (n > 0) ? atomicAdd(&cnt[c.tid], n) : 0; }
        __syncthreads();
        if (c.tid < 32) {
            const int t = t0 + c.tid;
            list[(size_t)myL1 * 32768 + lcnt[myL1] + r1] = t;
            list[(size_t)myL2 * 32768 + lcnt[myL2] + r2] = t;
            tokw[t * 2] = w1; tokw[t * 2 + 1] = w2;
        }
        __syncthreads();
    }
}

DI int moe_setup(const Ctx& c, KArgs& a, int ntn, int kfilter, int* tstart  ) {
    const int* cnt = (const int*)(a.ws + WS_CTL);
    if (c.tid < 64) {
        const int L = c.tid;
        const int n = __hip_atomic_load(&cnt[L], __ATOMIC_RELAXED, __HIP_MEMORY_SCOPE_AGENT);
        const int mine = (kfilter < 0 || (L & 1) == kfilter) ? ((n + 255) >> 8) * ntn : 0;
        int inc = mine;
#pragma unroll
        for (int o = 1; o < 64; o <<= 1) { const int tv = __shfl_up(inc, o); if (L >= o) inc += tv; }
        tstart[L] = inc - mine;
        if (L == 63) tstart[64] = inc;
    }
    __syncthreads();
    return tstart[64];
}

constexpr int MOE_LDS_OFF = G2_LDS_BYTES;
DI void phase_moe_up(const Ctx& c_in, KArgs& a) {
    const Ctx c = fresh_ctx(c_in.lds);
    unsigned char* ws = a.ws;
    const u16* act = (const u16*)(ws + WS_ACT);
    const int* cnt = (const int*)(ws + WS_CTL);
    const int* list = (const int*)(ws + WS_LIST);
    const float* tokw = (const float*)(ws + WS_TOKW);
    u16* hmid = (u16*)(ws + WS_HMID);
    int* tstart = (int*)(c.lds + MOE_LDS_OFF);
    int* tok_s = (int*)(c.lds + MOE_LDS_OFF + 512);
    int R, C; g2_stage_rc(c.tid * 16, R, C);
    const int total = moe_setup(c, a, 2, -1, tstart);
    for (int tile = vblock(); tile < total; tile += gridDim.x) {
        int L = 0;
        for (int j = 0; j < 64; ++j) if (tstart[j + 1] <= tile) L = j + 1;
        const int rel = tile - tstart[L], mi = rel >> 1, nt = rel & 1;
        const int e = L >> 1, kr = L & 1;
        const int n = __hip_atomic_load(&cnt[L], __ATOMIC_RELAXED, __HIP_MEMORY_SCOPE_AGENT);
        __syncthreads();
        if (c.tid < 256) { const int r = mi * 256 + c.tid; tok_s[c.tid] = (r < n) ? list[(size_t)L * 32768 + r] : -1; }
        __syncthreads();
        G2Ptrs g;
        g.ra = g2_rsrc(act); g.rb = g2_rsrc(ws + WS_WG);
        { const int t0 = tok_s[R], t1 = tok_s[R + 64], t2 = tok_s[R + 128], t3 = tok_s[R + 192];
          g.va00 = (unsigned)((t0 < 0 ? 0 : t0) * 1024 + C) * 2u; g.va01 = (unsigned)((t1 < 0 ? 0 : t1) * 1024 + C) * 2u;
          g.va10 = (unsigned)((t2 < 0 ? 0 : t2) * 1024 + C) * 2u; g.va11 = (unsigned)((t3 < 0 ? 0 : t3) * 1024 + C) * 2u; }
        g.vb0 = (unsigned)(R * 1024 + C) * 2u; g.vb1 = g.vb0 + 64 * 2048;
        g.sa = 0u; g.sb0 = (unsigned)(e * 256 + nt * 128) * 2048u; g.sb1 = g.sb0 + (unsigned)(WS_WU - WS_WG);
        gemm256_unit(c, g, 1024, [&](const f32x4 (&acc)[2][2][4][2], int wr, int wc, int fr, int fq) {
#pragma unroll
            for (int ai = 0; ai < 2; ++ai)
#pragma unroll
                for (int m = 0; m < 4; ++m) {
                    const int tk = tok_s[ai * 128 + wr * 64 + m * 16 + fr];
                    if (tk >= 0) {
                        const float wgt = tokw[tk * 2 + kr];
                        u16* dst = hmid + ((size_t)tk * 2 + kr) * 256 + nt * 128 + wc * 32 + 4 * fq;
#pragma unroll
                        for (int n2 = 0; n2 < 2; ++n2) {
                            const f32x4 gv = acc[ai][0][m][n2], uv = acc[ai][1][m][n2];
                            uint2 pk;
                            pk.x = pack2(siluf(gv[0]) * uv[0] * wgt, siluf(gv[1]) * uv[1] * wgt);
                            pk.y = pack2(siluf(gv[2]) * uv[2] * wgt, siluf(gv[3]) * uv[3] * wgt);
                            *(uint2*)(dst + n2 * 16) = pk;
                        }
                    }
                }
        });
    }
}

DI void phase_moe_down(const Ctx& c_in, KArgs& a) {
    const Ctx c = fresh_ctx(c_in.lds);
    unsigned char* ws = a.ws;
    const int* cnt = (const int*)(ws + WS_CTL);
    const int* list = (const int*)(ws + WS_LIST);
    const u16* hmid = (const u16*)(ws + WS_HMID);
    u16* yffn = (u16*)(ws + WS_YFFN);
    int* tstart = (int*)(c.lds + MOE_LDS_OFF);
    int* tok_s = (int*)(c.lds + MOE_LDS_OFF + 512);
    int R, C; g2_stage_rc(c.tid * 16, R, C);
    const int total = moe_setup(c, a, 4, -1, tstart);
    for (int tile = vblock(); tile < total; tile += gridDim.x) {
        int L = 0;
        for (int j = 0; j < 64; ++j) if (tstart[j + 1] <= tile) L = j + 1;
        const int rel = tile - tstart[L], mi = rel >> 2, nt = rel & 3;
        const int e = L >> 1, kr = L & 1;
        const int n = __hip_atomic_load(&cnt[L], __ATOMIC_RELAXED, __HIP_MEMORY_SCOPE_AGENT);
        __syncthreads();
        if (c.tid < 256) { const int r = mi * 256 + c.tid; tok_s[c.tid] = (r < n) ? list[(size_t)L * 32768 + r] : -1; }
        __syncthreads();
        G2Ptrs g;
        g.ra = g2_rsrc(hmid); g.rb = g2_rsrc(ws + WS_WD);
        { const int t0 = tok_s[R], t1 = tok_s[R + 64], t2 = tok_s[R + 128], t3 = tok_s[R + 192];
          g.va00 = (unsigned)(((t0 < 0 ? 0 : t0) * 2 + kr) * 256 + C) * 2u; g.va01 = (unsigned)(((t1 < 0 ? 0 : t1) * 2 + kr) * 256 + C) * 2u;
          g.va10 = (unsigned)(((t2 < 0 ? 0 : t2) * 2 + kr) * 256 + C) * 2u; g.va11 = (unsigned)(((t3 < 0 ? 0 : t3) * 2 + kr) * 256 + C) * 2u; }
        g.vb0 = (unsigned)(R * 256 + C) * 2u; g.vb1 = g.vb0 + 64 * 512;
        g.sa = 0u; g.sb0 = (unsigned)(e * 1024 + nt * 256) * 512u; g.sb1 = g.sb0 + 128u * 512u;
        gemm256_unit(c, g, 256, [&](const f32x4 (&acc)[2][2][4][2], int wr, int wc, int fr, int fq) {
#pragma unroll
            for (int ai = 0; ai < 2; ++ai)
#pragma unroll
                for (int m = 0; m < 4; ++m) {
                    const int tk = tok_s[ai * 128 + wr * 64 + m * 16 + fr];
                    if (tk >= 0) {
                        u16* dst = yffn + ((size_t)tk * 2 + kr) * 1024 + nt * 256 + wc * 32 + 4 * fq;
#pragma unroll
                        for (int bj = 0; bj < 2; ++bj)
#pragma unroll
                            for (int n2 = 0; n2 < 2; ++n2) {
                                const f32x4 v = acc[ai][bj][m][n2];
                                uint2 pk; pk.x = pack2(v[0], v[1]); pk.y = pack2(v[2], v[3]);
                                *(uint2*)(dst + bj * 128 + n2 * 16) = pk;
                            }
                    }
                }
        });
    }
}

DI void phase_final(const Ctx& c_in, KArgs& a) {
    const Ctx c = fresh_ctx(c_in.lds);
    float* x = a.out;
    const float* g = a.in[24];
    for (int it = bid(); it < T_TOK / 8; it += gridDim.x) {
        const int t = it * 8 + c.wave;
        float* xr = x + (size_t)t * 1024;
        float v[16]; float ss = 0.f;
        const u16* y0 = (const u16*)(a.ws + WS_YFFN) + (size_t)t * 2048;
#pragma unroll
        for (int j = 0; j < 16; ++j) { v[j] = xr[c.lane + 64 * j] + bf2f(y0[c.lane + 64 * j]) + bf2f(y0[1024 + c.lane + 64 * j]); ss += v[j] * v[j]; }
        ss = wsum(ss);
        const float rs = rsqrtf(ss * (1.f / 1024.f) + EPS);
#pragma unroll
        for (int j = 0; j < 16; ++j) xr[c.lane + 64 * j] = v[j] * rs * g[c.lane + 64 * j];
    }
}

#define XB_TMO      128
#define XB_XCNT(j)  (256  + 64 * (j))
#define XB_XSUB(j)  (1280 + 64 * (j))
#define XB_XGEN(j)  (2304 + 64 * (j))
#define XB_TOP      3328
#define XB_TOPGEN   3392
#define XCD_BAR_WORDS 3456
#define XB_SPIN_CAP (1u << 22)
#define LAS __attribute__((address_space(3)))
DI unsigned xb_ld(unsigned* p)              { return __hip_atomic_load(p, __ATOMIC_RELAXED, __HIP_MEMORY_SCOPE_AGENT); }
DI unsigned xb_add(unsigned* p, unsigned v) { return __hip_atomic_fetch_add(p, v, __ATOMIC_RELAXED, __HIP_MEMORY_SCOPE_AGENT); }
DI unsigned xb_xcc_id() { return (unsigned)__builtin_amdgcn_s_getreg((3 << 11) | 20) & 0xFu; }
#define XB_SPIN(cond, bar) do { unsigned _sp = 0; while (cond) { __builtin_amdgcn_s_sleep(1); \
    if ((++_sp & 255u) == 0u) { if (xb_ld(&(bar)[XB_TMO])) break; if (_sp > XB_SPIN_CAP) { atomicAdd(&(bar)[XB_TMO], 1u); break; } } } } while (0)
struct XcdBarrier { unsigned* bar; unsigned x; volatile LAS unsigned* st; };
DI XcdBarrier xcd_barrier_post(unsigned* bar, volatile LAS unsigned* st) {
    XcdBarrier b; b.bar = bar; b.x = xb_xcc_id(); b.st = st;
    if (threadIdx.x == 0) (void)xb_add(&bar[XB_XCNT(b.x)], 1u);
    return b;
}
DI void xcd_barrier_complete(unsigned* bar, unsigned x, unsigned& nloc, unsigned& nx) {
    const unsigned G = gridDim.x * gridDim.y * gridDim.z;
    unsigned sum, cnt, mine, sp = 0u;
    for (;;) {
        sum = 0u; cnt = 0u; mine = 0u;
#pragma unroll
        for (unsigned j = 0; j < 16; ++j) { const unsigned cc = xb_ld(&bar[XB_XCNT(j)]); sum += cc; cnt += (cc > 0u) ? 1u : 0u; mine = (j == x) ? cc : mine; }
        if (sum == G) break;
        __builtin_amdgcn_s_sleep(1);
        if ((++sp & 255u) == 0u) { if (xb_ld(&bar[XB_TMO])) break; if (sp > XB_SPIN_CAP) { atomicAdd(&bar[XB_TMO], 1u); break; } }
    }
    nloc = mine > 0u ? mine : 1u; nx = cnt > 0u ? cnt : 1u;
}
DI void xcd_barrier(const XcdBarrier& b) {
    asm volatile("s_waitcnt vmcnt(0)" ::: "memory");
    __syncthreads();
    if (threadIdx.x == 0) {
        unsigned* bar = b.bar;
        __builtin_amdgcn_s_waitcnt(0);
        unsigned nloc = b.st[0], nx = b.st[1];
        if (nloc == 0u) { xcd_barrier_complete(bar, b.x, nloc, nx); b.st[0] = nloc; b.st[1] = nx; }
        const unsigned old = xb_add(&bar[XB_XSUB(b.x)], 1u);
        const unsigned gen = old / nloc;
        if (old + 1u == (gen + 1u) * nloc) {
            __builtin_amdgcn_fence(__ATOMIC_RELEASE, "agent");
            asm volatile("s_waitcnt vmcnt(0)" ::: "memory");
            const unsigned og = xb_add(&bar[XB_TOP], 1u);
            const unsigned tg = og / nx;
            if (og + 1u == (tg + 1u) * nx) xb_add(&bar[XB_TOPGEN], 1u);
            else XB_SPIN(xb_ld(&bar[XB_TOPGEN]) == tg, bar);
            __builtin_amdgcn_fence(__ATOMIC_ACQUIRE, "agent");
            xb_add(&bar[XB_XGEN(b.x)], 1u);
            asm volatile("s_waitcnt vmcnt(0)" ::: "memory");
        } else {
            XB_SPIN(xb_ld(&bar[XB_XGEN(b.x)]) == gen, bar);
            __builtin_amdgcn_fence(__ATOMIC_ACQUIRE, "agent");
            asm volatile("s_waitcnt vmcnt(0)" ::: "memory");
        }
    }
    __syncthreads();
}

template <int SP>
DI void run_phase(const Ctx& c, KArgs& a, int l) {
    if constexpr (SP == 11) phase_prep(c, a);
    else if constexpr (SP == 12) phase_final(c, a);
    else if constexpr (SP == 0) phase_norm_in(c, a, l);
    else if constexpr (SP == 1) phase_inproj(c, a, l);
    else if constexpr (SP == 2) {
        const int n_ssd = 256, n_q = 256, n_kv = 256;
        for (int it = bid(); it < n_ssd + n_q + n_kv; it += gridDim.x) {
            if (it < n_ssd) ssd_state_item(c, a, l, it);
            else if (it < n_ssd + n_q) mla_up_unit(c, a, l, 0, it - n_ssd);
            else mla_up_unit(c, a, l, 1, it - n_ssd - n_q);
        }
    }
    else if constexpr (SP == 3) { for (int it = bid(); it < 512; it += gridDim.x) ssd_scan_item(c, a, it); }
    else if constexpr (SP == 4) {
        int* ctr = (int*)(a.ws + WS_CTL) + 256 + l;
        volatile int* s_item = (volatile int*)(c.lds + LDS_BYTES - 32);
        for (;;) {
            __syncthreads();
            if (threadIdx.x == 0) *s_item = atomicAdd(ctr, 1);
            __syncthreads();
            const int it = *s_item;
            if (it >= 1024 + 512 + 256 + 768) break;
            if (it < 1024) {
                const int j = 15 - (it >> 6), r = it & 63;
                if (r >= 8 && r < 40) { const int rem = r - 8; attn_item<96, 0>(c, a, l, rem >> 2, rem & 3, j); }
                else {
                    const int sub = (r < 8) ? 3 : 2 - ((r - 40) >> 3);
                    const int b = r & 7, qb = 4 * j + sub;
                    { DsaPref pf; dsa_prefetch(fresh_ctx(c.lds), a, b, qb * 64, pf);
                      for (int g8 = 0; g8 < 8; ++g8) dsa_index_item(c, a, b, qb * 64 + g8 * 8, pf, g8 == 7); }
                    asm volatile("s_waitcnt vmcnt(0)" ::: "memory");
                    __syncthreads();
                    attn_item<64, 2>(c, a, l, b, 0, qb);
                }
            } else if (it < 1536) { const int i2 = it - 1024; attn_item<64, 1>(c, a, l, (i2 & 31) >> 2, i2 & 3, 15 - (i2 >> 5)); }
            else if (it < 1792) ssd_out_item(c, a, l, it - 1536);
            else { const Ctx cc = fresh_ctx(c.lds); expert_conv_item(cc, a, l, (it - 1792) * 2); expert_conv_item(cc, a, l, (it - 1792) * 2 + 1); }
        }
    }
    else if constexpr (SP == 5) phase_outproj(c, a, l);
    else if constexpr (SP == 6) phase_router(c, a, l);
    else if constexpr (SP == 7) phase_moe_up(c, a);
    else if constexpr (SP == 8) phase_moe_down(c, a);
}

#ifndef ONE_LAUNCH
#define ONE_LAUNCH 1
#endif

#if ONE_LAUNCH
__global__ void __launch_bounds__(NTHR) mega(Args a_unused) {
    extern __shared__ __attribute__((aligned(16))) unsigned char lds[];
    cg::grid_group grid = cg::this_grid();
    Ctx c; c.tid = threadIdx.x; c.lane = c.tid & 63; c.wave = 0; c.lds = lds;
    volatile LAS unsigned* st = (volatile LAS unsigned*)(lds + LDS_BYTES - 16);
    if (threadIdx.x == 0) { st[0] = 0u; st[1] = 0u; }
    __syncthreads();
    XcdBarrier bar = xcd_barrier_post((unsigned*)(a_unused.ws + WS_BAR), st);
#ifdef PROBE_SP
#define MEGA_PHASE(SPN, L) do { KArgs* kp_ = (KArgs*)__builtin_amdgcn_kernarg_segment_ptr(); asm volatile("" : "+s"(kp_)); \
        const unsigned long long pt0_ = __builtin_amdgcn_s_memrealtime(); run_phase<SPN>(c, *kp_, (L)); \
        if (SPN == PROBE_SP) { xcd_barrier(bar); const unsigned long long pt1_ = __builtin_amdgcn_s_memrealtime(); \
            while (__builtin_amdgcn_s_memrealtime() - pt1_ < (pt1_ - pt0_)) __builtin_amdgcn_s_sleep(8); } } while (0)
#else
#define MEGA_PHASE(SPN, L) do { KArgs* kp_ = (KArgs*)__builtin_amdgcn_kernarg_segment_ptr(); asm volatile("" : "+s"(kp_)); run_phase<SPN>(c, *kp_, (L)); } while (0)
#endif
    MEGA_PHASE(11, 0);
    grid.sync();
#pragma unroll 1
    for (int l = 0; l < DEPTH; ++l) {
        if (l > 0) xcd_barrier(bar);
        MEGA_PHASE(0, l); xcd_barrier(bar);
        MEGA_PHASE(1, l); xcd_barrier(bar);
        MEGA_PHASE(2, l); xcd_barrier(bar);
        MEGA_PHASE(3, l); xcd_barrier(bar);
        MEGA_PHASE(4, l); xcd_barrier(bar);
        MEGA_PHASE(5, l); xcd_barrier(bar);
        MEGA_PHASE(6, l); xcd_barrier(bar);
        MEGA_PHASE(7, l); xcd_barrier(bar);
        MEGA_PHASE(8, l);
    }
    xcd_barrier(bar);
    MEGA_PHASE(12, 0);
}
#else
template <int SP>
__global__ void __launch_bounds__(NTHR) kphase(Args a, int l) {
    extern __shared__ __attribute__((aligned(16))) unsigned char lds[];
    Ctx c; c.tid = threadIdx.x; c.lane = c.tid & 63; c.wave = __builtin_amdgcn_readfirstlane(c.tid >> 6); c.lds = lds;
    KArgs* kp = (KArgs*)__builtin_amdgcn_kernarg_segment_ptr();
    run_phase<SP>(c, *kp, l);
}
template <int SP>
static void launch_phase(const Args& a, int l, int grid, hipStream_t stream) {
    static bool attr_set = false;
    if (!attr_set) { (void)hipFuncSetAttribute((const void*)kphase<SP>, hipFuncAttributeMaxDynamicSharedMemorySize, LDS_BYTES); attr_set = true; }
    hipLaunchKernelGGL(kphase<SP>, dim3(grid), dim3(NTHR), LDS_BYTES, stream, a, l);
}
#endif

extern "C" void kernel_launch(void* const* d_in, const int* in_sizes, int n_in, void* d_out, int out_size, void* d_ws, size_t ws_size, hipStream_t stream) {
    static int grid = 0;
    if (grid == 0) {
        if (n_in != 25 || ws_size < WS_END) { fprintf(stderr, "kernel_launch: unexpected inputs (n_in %d, ws %zu, need %zu)\n", n_in, ws_size, (size_t)WS_END); grid = -1; return; }
        int dev = 0, cus = 0;
        (void)hipGetDevice(&dev);
        (void)hipDeviceGetAttribute(&cus, hipDeviceAttributeMultiprocessorCount, dev);
        if (cus <= 0) cus = 256;
#if ONE_LAUNCH
        int per_cu = 0;
        if (hipFuncSetAttribute((const void*)mega, hipFuncAttributeMaxDynamicSharedMemorySize, LDS_BYTES) != hipSuccess) { fprintf(stderr, "kernel_launch: hipFuncSetAttribute failed\n"); grid = -1; return; }
        if (hipOccupancyMaxActiveBlocksPerMultiprocessor(&per_cu, (const void*)mega, NTHR, LDS_BYTES) != hipSuccess || per_cu < 1) { fprintf(stderr, "kernel_launch: occupancy query says %d blocks per CU\n", per_cu); (void)hipGetLastError(); grid = -1; return; }
        grid = cus;
#else
        grid = cus;
#endif
    }
    if (grid < 0) return;
    Args a{};
    for (int i = 0; i < 25; ++i) a.in[i] = (const float*)d_in[i];
    a.out = (float*)d_out; a.ws = (unsigned char*)d_ws;
    for (int i = 0; i < 8; ++i) a.inv16[i] = (float)pow(500000.0, -(double)i / 8.0);
    for (int i = 0; i < 16; ++i) a.inv32[i] = (float)pow(500000.0, -(double)i / 16.0);
    a.ph_lo = 0; a.ph_hi = 0;
#if ONE_LAUNCH
    (void)hipMemsetAsync((unsigned char*)d_ws + WS_CTL, 0, WS_CTL_BYTES, stream);
    void* kargs[] = { &a };
    hipError_t e = hipLaunchCooperativeKernel((const void*)mega, dim3(grid), dim3(NTHR), kargs, LDS_BYTES, stream);
    if (e != hipSuccess) fprintf(stderr, "kernel_launch: cooperative launch failed: %s (grid %d)\n", hipGetErrorString(e), grid);
#else
    launch_phase<11>(a, 0, grid, stream);
    for (int l = 0; l < DEPTH; ++l) {
        launch_phase<0>(a, l, grid, stream);
        launch_phase<1>(a, l, grid, stream);
        launch_phase<2>(a, l, grid, stream);
        launch_phase<3>(a, l, grid, stream);
        launch_phase<4>(a, l, grid, stream);
        launch_phase<5>(a, l, grid, stream);
        launch_phase<6>(a, l, grid, stream);
        launch_phase<7>(a, l, grid, stream);
        launch_phase<8>(a, l, grid, stream);
    }
    launch_phase<12>(a, 0, grid, stream);
#endif
}
```

```cpp
#include <hip/hip_runtime.h>
#include <hip/hip_cooperative_groups.h>
#include <cstdio>
#include <cmath>
#include <cstdint>


namespace cg = cooperative_groups;

typedef __attribute__((ext_vector_type(8))) short bf16x8;
typedef __attribute__((ext_vector_type(4))) short bf16x4;
typedef __attribute__((ext_vector_type(16))) float f32x16;
typedef unsigned short u16;
typedef unsigned long long u64;

#define DI __device__ __forceinline__
#define MFMA32(a, b, c) __builtin_amdgcn_mfma_f32_32x32x16_bf16((a), (b), (c), 0, 0, 0)

constexpr int T_TOK = 32768, SEQ = 4096, NB = 8, DM = 1024, DEPTH = 2;
constexpr int NREF = 3184;
constexpr int NPAD = 3328;
constexpr int LDP = 2848;
constexpr int PC_Z = 0, PC_XBC = 256, PC_DSAQ = 1024, PC_CQ = 1280, PC_CKV = 1536, PC_DSAK = 1664, PC_IDXK = 1728, PC_IDXQ = 1792,
              PC_KR = 2304, PC_FOXQ = 2336, PC_FOXK = 2592;
constexpr int NC_DSAV = 2848, NC_FOXV = 2912, NC_SMALL = 3168;
constexpr float EPS = 1e-6f;
constexpr float LOG2E = 1.4426950408889634f;
constexpr int NTHR = 512;
constexpr int LDS_BYTES = 159744;

constexpr size_t al256(size_t x) { return (x + 255) & ~(size_t)255; }
constexpr size_t WS_CTL   = 0;
constexpr size_t WS_BAR   = 4096;
constexpr size_t WS_CTL_BYTES = 32768;
constexpr size_t WS_WIN   = 32768;
constexpr size_t WS_WUQ   = WS_WIN  + (size_t)2 * NPAD * 1024 * 2;
constexpr size_t WS_WUKV  = WS_WUQ  + (size_t)2 * 512 * 256 * 2;
constexpr size_t WS_WOUT  = WS_WUKV + (size_t)2 * 512 * 128 * 2;
constexpr size_t WS_WG    = WS_WOUT + (size_t)2 * 1024 * 1024 * 2;
constexpr size_t WS_WU    = WS_WG   + (size_t)32 * 256 * 1024 * 2;
constexpr size_t WS_WD    = WS_WU   + (size_t)32 * 256 * 1024 * 2;
constexpr size_t WS_TRIG  = WS_WD   + (size_t)32 * 256 * 1024 * 2;
constexpr size_t WS_ACT   = WS_TRIG + (size_t)T_TOK * 48 * 4;
constexpr size_t WS_PROJ  = WS_ACT  + (size_t)T_TOK * 1024 * 2;
constexpr size_t WS_SMALL = WS_PROJ + (size_t)T_TOK * LDP * 2;
constexpr size_t WS_MLAQ  = WS_SMALL + (size_t)T_TOK * 16 * 4;
constexpr size_t WS_MLAK  = WS_MLAQ + (size_t)T_TOK * 384 * 2;
constexpr size_t WS_MLAVT = WS_MLAK + (size_t)T_TOK * 384 * 2;
constexpr size_t WS_DSAVT = WS_MLAVT + (size_t)T_TOK * 256 * 2;
constexpr size_t WS_FOXVT = WS_DSAVT + (size_t)T_TOK * 64 * 2;
constexpr size_t WS_FLOG  = WS_FOXVT + (size_t)T_TOK * 256 * 2;
constexpr size_t WS_CS    = WS_FLOG + (size_t)T_TOK * 4 * 4;
constexpr size_t WS_CDEC  = WS_CS   + (size_t)8 * 32 * 4 * 64 * 128 * 4;
constexpr size_t WS_MASK  = WS_CDEC + 4096;
constexpr size_t WS_TOKW  = WS_MASK + (size_t)T_TOK * 64 * 8;
constexpr size_t WS_WRH   = WS_TOKW + (size_t)T_TOK * 2 * 4;
constexpr size_t WS_WRL   = WS_WRH + (size_t)2 * 64 * 1024 * 2;
constexpr size_t WS_KF    = WS_WRL + (size_t)2 * 64 * 1024 * 2;
constexpr size_t WS_RSQ   = WS_KF + (size_t)T_TOK * 64 * 2;
constexpr size_t WS_RSKV  = WS_RSQ + (size_t)T_TOK * 4;
constexpr size_t WS_END   = WS_RSKV + (size_t)T_TOK * 4;
constexpr size_t WS_LIST  = WS_PROJ;
constexpr size_t WS_HMID  = WS_PROJ + (size_t)64 * 32768 * 4;
constexpr size_t WS_YFFN  = WS_HMID + (size_t)T_TOK * 512 * 2;
static_assert(WS_YFFN + (size_t)T_TOK * 2048 * 2 <= WS_SMALL, "aliases must fit in PROJ");
static_assert(WS_END <= (size_t)512 * 1024 * 1024, "workspace budget");

struct Args {
    const float* in[25];
    float* out;
    unsigned char* ws;
    float inv16[8];
    float inv32[16];
    int ph_lo, ph_hi;
};

typedef const __attribute__((address_space(4))) Args KArgs;
struct Ctx { int tid, lane, wave; unsigned char* lds; };
__device__ __forceinline__ Ctx fresh_ctx(unsigned char* lds) {
    int t = threadIdx.x; asm volatile("" : "+v"(t));
    Ctx c; c.tid = t; c.lane = t & 63; c.wave = __builtin_amdgcn_readfirstlane(t >> 6); c.lds = lds; return c;
}

typedef __attribute__((ext_vector_type(2))) float f32x2;
typedef __attribute__((ext_vector_type(2))) __bf16 bf16x2_t;
DI u16 f2bf(float x) { return __builtin_bit_cast(u16, (__bf16)x); }
DI float bf2f(u16 h) { return __uint_as_float(((unsigned)h) << 16); }
DI unsigned pack2(float a, float b) { f32x2 v = {a, b}; return __builtin_bit_cast(unsigned, __builtin_convertvector(v, bf16x2_t)); }
DI float ex2(float x) { return __builtin_amdgcn_exp2f(x); }
DI float relu_raw(float x) { float r; asm("v_max_f32 %0, 0, %1" : "=v"(r) : "v"(x)); return r; }
DI float max3f(float a, float b, float c) { float r; asm("v_max3_f32 %0, %1, %2, %3" : "=v"(r) : "v"(a), "v"(b), "v"(c)); return r; }
DI float wsum(float v) { for (int o = 32; o >= 1; o >>= 1) v += __shfl_xor(v, o); return v; }
DI float wmaxf(float v) { for (int o = 32; o >= 1; o >>= 1) v = fmaxf(v, __shfl_xor(v, o)); return v; }
DI float wminf(float v) { for (int o = 32; o >= 1; o >>= 1) v = fminf(v, __shfl_xor(v, o)); return v; }
DI float siluf(float x) { return x / (1.f + __expf(-x)); }
DI float softplusf(float x) { return fmaxf(x, 0.f) + log1pf(__expf(-fabsf(x))); }
DI int crow(int reg, int h) { return (reg & 3) + 8 * (reg >> 2) + 4 * h; }
DI bf16x8 pack8(const f32x16& x, int s) {
    uint4 p;
    p.x = pack2(x[8 * s + 0], x[8 * s + 1]); p.y = pack2(x[8 * s + 2], x[8 * s + 3]);
    p.z = pack2(x[8 * s + 4], x[8 * s + 5]); p.w = pack2(x[8 * s + 6], x[8 * s + 7]);
    return __builtin_bit_cast(bf16x8, p);
}
DI f32x16 zero16() { f32x16 z; for (int i = 0; i < 16; ++i) z[i] = 0.f; return z; }

DI int ref_col(int n) {
    if (n < 1024) return n;
    if (n < 1280) return n - 1024 + 1028;
    if (n < 1536) return n - 1280 + 1996;
    if (n < 1664) return n - 1536 + 2252;
    if (n < 1728) return n - 1664 + 1284;
    if (n < 1792) return n - 1728 + 1924;
    if (n < 2304) return n - 1792 + 1412;
    if (n < 2336) return n - 2304 + 2380;
    if (n < 2592) return n - 2336 + 2412;
    if (n < 2848) return n - 2592 + 2668;
    if (n < 2912) return n - 2848 + 1348;
    if (n < 3168) return n - 2912 + 2924;
    if (n < 3172) return n - 3168 + 1024;
    if (n < 3180) return n - 3172 + 1988;
    if (n < 3184) return n - 3180 + 3180;
    return -1;
}

DI int bid() { int b = blockIdx.x; asm volatile("" : "+s"(b)); return b; }
DI int vblock() { const int G = gridDim.x, bx = bid(); return (G % 8 == 0) ? (bx % 8) * (G / 8) + bx / 8 : bx; }

constexpr int G_LDT = 72;
constexpr int G_AEL = 256 * G_LDT, G_BEL = 128 * G_LDT, G_STEL = G_AEL + G_BEL;
constexpr int G_LDS_BYTES = 2 * G_STEL * 2;

struct GP { const u16 *a0, *a1, *a2, *a3, *b0, *b1; };

template <bool PAIRED>
DI void gemm_core(const Ctx& c, int K, const GP& gp, f32x16 (&acc)[2][2]) {
    u16* S = (u16*)c.lds;
    const int r8 = c.tid >> 3, kc = c.tid & 7;
    const int wm = c.wave & 3, wn = c.wave >> 2, l31 = c.lane & 31, h = c.lane >> 5;
    const int nb0 = PAIRED ? wn * 32 : wn * 64, nb1 = PAIRED ? 64 + wn * 32 : wn * 64 + 32;
    uint4 ra0, ra1, ra2, ra3, rb0, rb1;
    uint4 sa0, sa1, sa2, sa3, sb0, sb1;
    const int nk = K >> 6;
#define G_LOAD(P, KOFF) do { \
        P##a0 = *(const uint4*)(gp.a0 + (KOFF) + kc * 8); P##a1 = *(const uint4*)(gp.a1 + (KOFF) + kc * 8); \
        P##a2 = *(const uint4*)(gp.a2 + (KOFF) + kc * 8); P##a3 = *(const uint4*)(gp.a3 + (KOFF) + kc * 8); \
        P##b0 = *(const uint4*)(gp.b0 + (KOFF) + kc * 8); P##b1 = *(const uint4*)(gp.b1 + (KOFF) + kc * 8); } while (0)
#define G_STORE(P, SP) do { u16* sp_ = (SP); \
        *(uint4*)(sp_ + (r8) * G_LDT + kc * 8) = P##a0; *(uint4*)(sp_ + (r8 + 64) * G_LDT + kc * 8) = P##a1; \
        *(uint4*)(sp_ + (r8 + 128) * G_LDT + kc * 8) = P##a2; *(uint4*)(sp_ + (r8 + 192) * G_LDT + kc * 8) = P##a3; \
        *(uint4*)(sp_ + G_AEL + (r8) * G_LDT + kc * 8) = P##b0; *(uint4*)(sp_ + G_AEL + (r8 + 64) * G_LDT + kc * 8) = P##b1; } while (0)
#define G_COMPUTE_KS(ST, KS0, KS1) do { \
        const u16* As = S + (ST) * G_STEL; const u16* Bs = As + G_AEL; \
        _Pragma("unroll") for (int ks = (KS0); ks < (KS1); ++ks) { \
            const bf16x8 a0 = *(const bf16x8*)(As + (wm * 64 + l31) * G_LDT + ks * 16 + h * 8); \
            const bf16x8 a1 = *(const bf16x8*)(As + (wm * 64 + 32 + l31) * G_LDT + ks * 16 + h * 8); \
            const bf16x8 b0 = *(const bf16x8*)(Bs + (nb0 + l31) * G_LDT + ks * 16 + h * 8); \
            const bf16x8 b1 = *(const bf16x8*)(Bs + (nb1 + l31) * G_LDT + ks * 16 + h * 8); \
            acc[0][0] = MFMA32(a0, b0, acc[0][0]); acc[0][1] = MFMA32(a0, b1, acc[0][1]); \
            acc[1][0] = MFMA32(a1, b0, acc[1][0]); acc[1][1] = MFMA32(a1, b1, acc[1][1]); } } while (0)
    G_LOAD(r, 0);
    G_STORE(r, S);
    if (nk > 1) G_LOAD(r, 64);
    __syncthreads();
    for (int kt = 0; kt < nk; kt += 2) {
        if (kt + 2 < nk) G_LOAD(s, (kt + 2) * 64);
        G_COMPUTE_KS(0, 0, 1);
        if (kt + 1 < nk) G_STORE(r, S + G_STEL);
        G_COMPUTE_KS(0, 1, 4);
        __syncthreads();
        if (kt + 1 >= nk) break;
        if (kt + 3 < nk) G_LOAD(r, (kt + 3) * 64);
        G_COMPUTE_KS(1, 0, 1);
        if (kt + 2 < nk) G_STORE(s, S);
        G_COMPUTE_KS(1, 1, 4);
        __syncthreads();
    }
#undef G_LOAD
#undef G_STORE
#undef G_COMPUTE_KS
}

typedef __attribute__((ext_vector_type(4))) float f32x4;
#define LAS3 __attribute__((address_space(3)))
constexpr int G2_HTB = 128 * 64 * 2;
constexpr int G2_LDS_BYTES = 8 * G2_HTB;
DI int g2_lds_byte(int r, int cc0) { const int st = (r >> 4) * 2 + (cc0 >> 5), rr = r & 15, cc = cc0 & 31, ob = rr * 64 + cc * 2; return st * 1024 + (ob ^ (((ob >> 9) & 1) << 5)); }
DI void g2_stage_rc(int b, int& R, int& C) { const int st = b / 1024, sb = b % 1024, swz = sb ^ (((sb >> 9) & 1) << 5); R = (st >> 1) * 16 + swz / 64; C = (st & 1) * 32 + (swz % 64) / 2; }

struct G2Ptrs { __amdgpu_buffer_rsrc_t ra, rb; unsigned va00, va01, va10, va11, vb0, vb1; unsigned sa, sb0, sb1; };
DI __amdgpu_buffer_rsrc_t g2_rsrc(const void* p) { return __builtin_amdgcn_make_buffer_rsrc((void*)p, 0, 0x7ffffff0, 0x00020000); }

template <class EPI>
DI void gemm256_unit(const Ctx& c, const G2Ptrs& g, int K, EPI&& epi) {
    LAS3 unsigned char* lds = (LAS3 unsigned char*)c.lds;
    const int wid = c.wave, lane = c.lane, wr = wid >> 2, wc = wid & 3, fr = lane & 15, fq = lane >> 4;
    const unsigned ldsw = (unsigned)wid * 1024u;
    const int aoff = g2_lds_byte(wr * 64 + fr, fq * 8), boff = g2_lds_byte(wc * 32 + fr, fq * 8);
#define G2_SA(b, h) (((b) * 2 + (h)) * G2_HTB)
#define G2_SB(b, h) ((4 + (b) * 2 + (h)) * G2_HTB)
#define G2_STAGE(bufoff, rs, v0, v1, so) do { \
        __builtin_amdgcn_raw_ptr_buffer_load_lds((rs), (LAS3 unsigned*)(lds + (bufoff) + ldsw), 16, (v0), (so), 0, 0); \
        __builtin_amdgcn_raw_ptr_buffer_load_lds((rs), (LAS3 unsigned*)(lds + (bufoff) + ldsw + 8192), 16, (v1), (so), 0, 0); } while (0)
#define G2_STA0(b, kt) G2_STAGE(G2_SA(b, 0), g.ra, g.va00, g.va01, g.sa + (unsigned)(kt) * 128u)
#define G2_STA1(b, kt) G2_STAGE(G2_SA(b, 1), g.ra, g.va10, g.va11, g.sa + (unsigned)(kt) * 128u)
#define G2_STB0(b, kt) G2_STAGE(G2_SB(b, 0), g.rb, g.vb0, g.vb1, g.sb0 + (unsigned)(kt) * 128u)
#define G2_STB1(b, kt) G2_STAGE(G2_SB(b, 1), g.rb, g.vb0, g.vb1, g.sb1 + (unsigned)(kt) * 128u)
#define G2_LDA(dst, b, h) do { _Pragma("unroll") for (int m = 0; m < 4; ++m) _Pragma("unroll") for (int k = 0; k < 2; ++k) dst[m][k] = *(const LAS3 bf16x8*)(lds + G2_SA(b, h) + aoff + m * 2048 + k * 1024); } while (0)
#define G2_LDB(dst, b, h) do { _Pragma("unroll") for (int n = 0; n < 2; ++n) _Pragma("unroll") for (int k = 0; k < 2; ++k) dst[n][k] = *(const LAS3 bf16x8*)(lds + G2_SB(b, h) + boff + n * 2048 + k * 1024); } while (0)
#define G2_MMA(ai, bj, At_, Bt_) do { __builtin_amdgcn_s_setprio(1); \
        _Pragma("unroll") for (int m = 0; m < 4; ++m) _Pragma("unroll") for (int n = 0; n < 2; ++n) _Pragma("unroll") for (int k = 0; k < 2; ++k) \
            acc[ai][bj][m][n] = __builtin_amdgcn_mfma_f32_16x16x32_bf16(Bt_[n][k], At_[m][k], acc[ai][bj][m][n], 0, 0, 0); \
        __builtin_amdgcn_s_setprio(0); } while (0)
#define G2_WAIT_V(n) asm volatile("s_waitcnt vmcnt(" #n ")" ::: "memory")
#define G2_WAIT_L(n) asm volatile("s_waitcnt lgkmcnt(" #n ")" ::: "memory")
#define G2_BAR __builtin_amdgcn_s_barrier()
#define G2_SCHED __builtin_amdgcn_sched_barrier(0)
    f32x4 acc[2][2][4][2];
#pragma unroll
    for (int i0 = 0; i0 < 2; ++i0)
#pragma unroll
        for (int i1 = 0; i1 < 2; ++i1)
#pragma unroll
            for (int i2 = 0; i2 < 4; ++i2)
#pragma unroll
                for (int i3 = 0; i3 < 2; ++i3) acc[i0][i1][i2][i3] = (f32x4){0.f, 0.f, 0.f, 0.f};
    bf16x8 At[4][2], B0[2][2], B1[2][2];
    int nt = K / 64; asm volatile("" : "+s"(nt));
    G2_STB0(0, 0); G2_STA0(0, 0); G2_STB1(0, 0); G2_STA1(0, 0);
    if (wr == 1) G2_BAR;
    G2_WAIT_V(4); G2_BAR;
    G2_STB0(1, 1); G2_STA0(1, 1); G2_STB1(1, 1);
    G2_WAIT_V(6); G2_BAR;
    for (int t = 0; t < nt - 2; t += 2) {
        G2_LDB(B0, 0, 0); G2_SCHED; G2_LDA(At, 0, 0); G2_STA1(1, t + 1);
        G2_WAIT_L(8); G2_BAR; G2_WAIT_L(0); G2_MMA(0, 0, At, B0); G2_BAR; G2_SCHED;
        G2_LDB(B1, 0, 1); G2_STB0(0, t + 2);
        G2_BAR; G2_WAIT_L(0); G2_MMA(0, 1, At, B1); G2_BAR;
        G2_LDA(At, 0, 1); G2_STA0(0, t + 2);
        G2_BAR; G2_WAIT_L(0); G2_MMA(1, 0, At, B0); G2_BAR; G2_SCHED;
        G2_STB1(0, t + 2);
        G2_WAIT_V(6); G2_BAR; G2_MMA(1, 1, At, B1); G2_BAR;
        G2_LDB(B0, 1, 0); G2_SCHED; G2_LDA(At, 1, 0); G2_STA1(0, t + 2);
        G2_WAIT_L(8); G2_BAR; G2_WAIT_L(0); G2_MMA(0, 0, At, B0); G2_BAR; G2_SCHED;
        G2_LDB(B1, 1, 1); G2_STB0(1, t + 3);
        G2_BAR; G2_WAIT_L(0); G2_MMA(0, 1, At, B1); G2_BAR;
        G2_LDA(At, 1, 1); G2_STA0(1, t + 3);
        G2_BAR; G2_WAIT_L(0); G2_MMA(1, 0, At, B0); G2_BAR; G2_SCHED;
        G2_STB1(1, t + 3);
        G2_WAIT_V(6); G2_BAR; G2_MMA(1, 1, At, B1); G2_BAR;
    }
    { G2_LDB(B0, 0, 0); G2_LDA(At, 0, 0); G2_STA1(1, nt - 1);
      G2_BAR; G2_WAIT_L(0); G2_MMA(0, 0, At, B0); G2_BAR;
      G2_LDB(B1, 0, 1); G2_BAR; G2_WAIT_L(0); G2_MMA(0, 1, At, B1); G2_BAR;
      G2_LDA(At, 0, 1); G2_WAIT_V(4); G2_BAR; G2_WAIT_L(0); G2_MMA(1, 0, At, B0); G2_MMA(1, 1, At, B1); G2_BAR; }
    { G2_LDB(B0, 1, 0); G2_LDA(At, 1, 0); G2_WAIT_V(2); G2_BAR; G2_WAIT_L(0); G2_MMA(0, 0, At, B0); G2_BAR;
      G2_LDB(B1, 1, 1); G2_WAIT_V(0); G2_BAR; G2_WAIT_L(0); G2_MMA(0, 1, At, B1); G2_BAR;
      G2_LDA(At, 1, 1); G2_BAR; G2_WAIT_L(0); G2_MMA(1, 0, At, B0); G2_MMA(1, 1, At, B1); G2_BAR; }
    if (wr == 0) G2_BAR;
    { int ln_ = threadIdx.x & 63; asm volatile("" : "+v"(ln_));
      epi(acc, wr, wc, ln_ & 15, ln_ >> 4); }
#undef G2_SA
#undef G2_SB
#undef G2_STAGE
#undef G2_STA0
#undef G2_STA1
#undef G2_STB0
#undef G2_STB1
#undef G2_LDA
#undef G2_LDB
#undef G2_MMA
#undef G2_WAIT_V
#undef G2_WAIT_L
#undef G2_BAR
#undef G2_SCHED
}

DI void xpose_tile(const Ctx& c, const float* in, int ld_in, int k0, int n0, int colmode, const float* kscale, u16* out, int ld_out) {
    float* tile = (float*)c.lds;
    {
        const int j4 = (c.tid & 15) * 4, r0 = c.tid >> 4;
        const int rc = colmode ? ref_col(n0 + j4) : n0 + j4;
#pragma unroll
        for (int rr = 0; rr < 2; ++rr) {
            const int kk = r0 + 32 * rr;
            float4 v = make_float4(0.f, 0.f, 0.f, 0.f);
            if (rc >= 0) v = *(const float4*)(in + (size_t)(k0 + kk) * ld_in + rc);
            if (kscale) { const float s = kscale[k0 + kk]; v.x *= s; v.y *= s; v.z *= s; v.w *= s; }
            *(float4*)(tile + kk * 68 + j4) = v;
        }
    }
    __syncthreads();
    {
        const int jj = c.tid >> 3, k8 = (c.tid & 7) * 8;
        uint4 pk;
        pk.x = pack2(tile[(k8 + 0) * 68 + jj], tile[(k8 + 1) * 68 + jj]);
        pk.y = pack2(tile[(k8 + 2) * 68 + jj], tile[(k8 + 3) * 68 + jj]);
        pk.z = pack2(tile[(k8 + 4) * 68 + jj], tile[(k8 + 5) * 68 + jj]);
        pk.w = pack2(tile[(k8 + 6) * 68 + jj], tile[(k8 + 7) * 68 + jj]);
        *(uint4*)(out + (size_t)(n0 + jj) * ld_out + k0 + k8) = pk;
    }
    __syncthreads();
}

DI void phase_prep(const Ctx& c_in, KArgs& a) {
    const Ctx c = fresh_ctx(c_in.lds);
    unsigned char* ws = a.ws;
    const int n_win = 2 * 52 * 16;
    const int n_wuq = 2 * 8 * 4;
    const int n_wukv = 2 * 8 * 2;
    const int n_wout = 2 * 16 * 16;
    const int n_trig = T_TOK * 24 / NTHR;
    const int n_wr = 2 * 64 * 1024 / NTHR;
    const int total = n_win + n_wuq + n_wukv + n_wout + n_trig + n_wr;
    for (int it = bid(); it < total; it += gridDim.x) {
        int i = it;
        if (i < n_win) {
            const int l = i / 832, r = i % 832, nt = r / 16, kt = r % 16;
            xpose_tile(c, a.in[3] + (size_t)l * 1024 * NREF, NREF, kt * 64, nt * 64, 1, nullptr, (u16*)(ws + WS_WIN) + (size_t)l * NPAD * 1024, 1024);
            continue;
        }
        i -= n_win;
        if (i < n_wuq) {
            const int l = i / 32, r = i % 32, nt = r / 4, kt = r % 4;
            u16* dst = (u16*)(ws + WS_WUQ) + (size_t)l * 512 * 256;
            if (nt < 6) xpose_tile(c, a.in[11] + (size_t)l * 256 * 384, 384, kt * 64, nt * 64, 0, a.in[10] + l * 256, dst, 256);
            else { const int jj = c.tid >> 3, k8 = (c.tid & 7) * 8; *(uint4*)(dst + (size_t)(nt * 64 + jj) * 256 + kt * 64 + k8) = make_uint4(0, 0, 0, 0); }
            continue;
        }
        i -= n_wuq;
        if (i < n_wukv) {
            const int l = i / 16, r = i % 16, nt = r / 2, kt = r % 2;
            xpose_tile(c, a.in[13] + (size_t)l * 128 * 512, 512, kt * 64, nt * 64, 0, a.in[12] + l * 128, (u16*)(ws + WS_WUKV) + (size_t)l * 512 * 128, 128);
            continue;
        }
        i -= n_wukv;
        if (i < n_wout) {
            const int l = i / 256, r = i % 256, nt = r / 16, kt = r % 16;
            xpose_tile(c, a.in[15] + (size_t)l * 1024 * 1024, 1024, kt * 64, nt * 64, 0, nullptr, (u16*)(ws + WS_WOUT) + (size_t)l * 1024 * 1024, 1024);
            continue;
        }
        i -= n_wout;
        if (i >= n_trig) {
            const int e = (i - n_trig) * NTHR + c.tid;
            const int l = e >> 16, n = (e >> 10) & 63, k = e & 1023;
            float v = 0.f;
            if (n < 4) v = a.in[17][((size_t)l * 1024 + k) * 4 + n];
            else if (n < 36) v = a.in[19][((size_t)l * 1024 + k) * 32 + (n - 4)];
            const u16 hi = f2bf(v);
            ((u16*)(ws + WS_WRH))[e] = hi;
            ((u16*)(ws + WS_WRL))[e] = f2bf(v - bf2f(hi));
            continue;
        }
        {
            const int e = i * NTHR + c.tid;
            const int t = e / 24, j = e % 24;
            const int pos = ((const int*)a.in[1])[t];
            const float inv = (j < 8) ? a.inv16[j] : a.inv32[j - 8];
            const float ang = (float)pos * inv;
            const double ad = (double)ang;
            const double r = ad - 6.283185307179586476925 * rint(ad * 0.15915494309189533577);
            const float rf = (float)r;
            const float cs = cosf(rf), sn = sinf(rf);
            float* trig = (float*)(ws + WS_TRIG) + (size_t)t * 48;
            if (j < 8) { trig[j] = cs; trig[8 + j] = sn; } else { trig[16 + (j - 8)] = cs; trig[32 + (j - 8)] = sn; }
        }
    }
}

DI void expert_conv_item(const Ctx& c, KArgs& a, int l, int it) {
    unsigned char* ws = a.ws;
    const int which = it / 512, r = it % 512, e = r / 16, grp = r % 16;
    const float* src; u16* dst; int ld_in, ld_out, k0[4], n0[4];
    if (which < 2) {
        src = a.in[21 + which] + ((size_t)l * 32 + e) * 1024 * 256; dst = (u16*)(ws + (which == 0 ? WS_WG : WS_WU)) + (size_t)e * 256 * 1024; ld_in = 256; ld_out = 1024;
#pragma unroll
        for (int i = 0; i < 4; ++i) { n0[i] = (grp >> 2) * 64; k0[i] = ((grp & 3) * 4 + i) * 64; }
    } else {
        src = a.in[23] + ((size_t)l * 32 + e) * 256 * 1024; dst = (u16*)(ws + WS_WD) + (size_t)e * 1024 * 256; ld_in = 1024; ld_out = 256;
#pragma unroll
        for (int i = 0; i < 4; ++i) { n0[i] = grp * 64; k0[i] = i * 64; }
    }
    float* tile = (float*)c.lds;
    const int j4 = (c.tid & 15) * 4, r0 = c.tid >> 4;
    float4 v[4][2];
#pragma unroll
    for (int i = 0; i < 4; ++i)
#pragma unroll
        for (int rr = 0; rr < 2; ++rr) v[i][rr] = *(const float4*)(src + (size_t)(k0[i] + r0 + 32 * rr) * ld_in + n0[i] + j4);
#pragma unroll
    for (int i = 0; i < 4; ++i)
#pragma unroll
        for (int rr = 0; rr < 2; ++rr) *(float4*)(tile + i * (64 * 68) + (r0 + 32 * rr) * 68 + j4) = v[i][rr];
    __syncthreads();
    const int jj = c.tid >> 3, k8 = (c.tid & 7) * 8;
#pragma unroll
    for (int i = 0; i < 4; ++i) {
        const float* tl = tile + i * (64 * 68);
        uint4 pk;
        pk.x = pack2(tl[(k8 + 0) * 68 + jj], tl[(k8 + 1) * 68 + jj]);
        pk.y = pack2(tl[(k8 + 2) * 68 + jj], tl[(k8 + 3) * 68 + jj]);
        pk.z = pack2(tl[(k8 + 4) * 68 + jj], tl[(k8 + 5) * 68 + jj]);
        pk.w = pack2(tl[(k8 + 6) * 68 + jj], tl[(k8 + 7) * 68 + jj]);
        *(uint4*)(dst + (size_t)(n0[i] + jj) * ld_out + k0[i] + k8) = pk;
    }
    __syncthreads();
}

DI void phase_norm_in(const Ctx& c_in, KArgs& a, int l) {
    const Ctx c = fresh_ctx(c_in.lds);
    unsigned char* ws = a.ws;
    const float* x = (l == 0) ? a.in[0] : a.out;
    const float* g = a.in[2] + l * 1024;
    u16* act = (u16*)(ws + WS_ACT);
    if (bid() == 0 && c.tid < 192) ((int*)(ws + WS_CTL))[c.tid] = 0;
    for (int it = bid(); it < T_TOK / 16; it += gridDim.x) {
#pragma unroll
        for (int tt = 0; tt < 2; ++tt) {
            const int t = it * 16 + c.wave * 2 + tt;
            const float* xr = x + (size_t)t * 1024 + c.lane * 4;
            float4 v[4];
#pragma unroll
            for (int j = 0; j < 4; ++j) v[j] = *(const float4*)(xr + 256 * j);
            if (l != 0) {
                const u16* y0 = (const u16*)(ws + WS_YFFN) + (size_t)t * 2048 + c.lane * 4;
#pragma unroll
                for (int j = 0; j < 4; ++j) {
                    const uint2 ya = *(const uint2*)(y0 + 256 * j), yb = *(const uint2*)(y0 + 1024 + 256 * j);
                    v[j].x += bf2f((u16)(ya.x & 0xffff)) + bf2f((u16)(yb.x & 0xffff)); v[j].y += bf2f((u16)(ya.x >> 16)) + bf2f((u16)(yb.x >> 16));
                    v[j].z += bf2f((u16)(ya.y & 0xffff)) + bf2f((u16)(yb.y & 0xffff)); v[j].w += bf2f((u16)(ya.y >> 16)) + bf2f((u16)(yb.y >> 16));
                    *(float4*)(a.out + (size_t)t * 1024 + c.lane * 4 + 256 * j) = v[j];
                }
            }
            float ss = 0.f;
#pragma unroll
            for (int j = 0; j < 4; ++j) ss += v[j].x * v[j].x + v[j].y * v[j].y + v[j].z * v[j].z + v[j].w * v[j].w;
            ss = wsum(ss);
            const float rs = rsqrtf(ss * (1.f / 1024.f) + EPS);
#pragma unroll
            for (int j = 0; j < 4; ++j) {
                const float4 gg = *(const float4*)(g + c.lane * 4 + 256 * j);
                uint2 pk; pk.x = pack2(v[j].x * rs * gg.x, v[j].y * rs * gg.y); pk.y = pack2(v[j].z * rs * gg.z, v[j].w * rs * gg.w);
                *(uint2*)(act + (size_t)t * 1024 + c.lane * 4 + 256 * j) = pk;
            }
        }
    }
}

DI void phase_inproj(const Ctx& c_in, KArgs& a, int l) {
    const Ctx c = fresh_ctx(c_in.lds);
    unsigned char* ws = a.ws;
    const u16* act = (const u16*)(ws + WS_ACT);
    const u16* w = (const u16*)(ws + WS_WIN) + (size_t)l * NPAD * 1024;
    u16* proj = (u16*)(ws + WS_PROJ);
    u16* dsavt = (u16*)(ws + WS_DSAVT);
    u16* foxvt = (u16*)(ws + WS_FOXVT);
    float* small = (float*)(ws + WS_SMALL);
    u16* mlak = (u16*)(ws + WS_MLAK);
    u16* kf = (u16*)(ws + WS_KF);
    const float* trig = (const float*)(ws + WS_TRIG);
    int R, C; g2_stage_rc(c.tid * 16, R, C);
    const int nunits = (T_TOK / 256) * 13;
    for (int u = vblock(); u < nunits; u += gridDim.x) {
        const int grp = u / 52, rr = u % 52;
        const int pm = grp * 4 + (rr & 3), pn = rr >> 2;
        G2Ptrs g;
        g.ra = g2_rsrc(act); g.rb = g2_rsrc(w);
        g.va00 = (unsigned)(R * 1024 + C) * 2u; g.va01 = g.va00 + 64 * 2048; g.va10 = g.va00 + 128 * 2048; g.va11 = g.va00 + 192 * 2048;
        g.vb0 = g.va00; g.vb1 = g.va01;
        g.sa = (unsigned)pm * (256u * 2048u); g.sb0 = (unsigned)pn * (256u * 2048u); g.sb1 = g.sb0 + 128u * 2048u;
        __syncthreads();
        gemm256_unit(c, g, 1024, [&](const f32x4 (&acc)[2][2][4][2], int wr, int wc, int fr, int fq) {
#pragma unroll
            for (int bj = 0; bj < 2; ++bj)
#pragma unroll
                for (int n = 0; n < 2; ++n) {
                    const int col0 = pn * 256 + bj * 128 + wc * 32 + n * 16;
                    if (col0 < LDP) {
                        const bool rope16 = ((col0 >= PC_DSAQ && col0 < PC_CQ) || (col0 >= PC_DSAK && col0 < PC_KR)) && ((col0 & 63) == 0);
                        const bool kr0 = (col0 == PC_KR), kr1 = (col0 == PC_KR + 16);
                        const bool foxk = (col0 >= PC_FOXK);
                        const bool idxk = (col0 >= PC_IDXK) && (col0 < PC_IDXK + 64);
                        float kmx = 0.f;
#pragma unroll
                        for (int ai = 0; ai < 2; ++ai)
#pragma unroll
                            for (int m = 0; m < 4; ++m) {
                                const int row = pm * 256 + ai * 128 + wr * 64 + m * 16 + fr;
                                f32x4 v = acc[ai][bj][m][n];
                                if (rope16) {
                                    const float* tg = trig + (size_t)row * 48 + 4 * (fq & 1);
                                    const f32x4 cs = *(const f32x4*)tg, sn = *(const f32x4*)(tg + 8);
                                    f32x4 pv;
#pragma unroll
                                    for (int j = 0; j < 4; ++j) pv[j] = __shfl_xor(v[j], 32);
                                    v = (fq < 2) ? (v * cs - pv * sn) : (v * cs + pv * sn);
                                }
                                if (kr0) {
                                    const float* tg = trig + (size_t)row * 48 + 16 + 4 * fq;
                                    const f32x4 cs = *(const f32x4*)tg, sn = *(const f32x4*)(tg + 16);
                                    const f32x4 x2 = acc[ai][bj][m][1];
                                    const f32x4 o1 = v * cs - x2 * sn, o2 = x2 * cs + v * sn;
                                    uint2 p1, p2; p1.x = pack2(o1[0], o1[1]); p1.y = pack2(o1[2], o1[3]); p2.x = pack2(o2[0], o2[1]); p2.y = pack2(o2[2], o2[3]);
#pragma unroll
                                    for (int hd = 0; hd < 4; ++hd) {
                                        *(uint2*)(mlak + (size_t)row * 384 + hd * 96 + 64 + 4 * fq) = p1;
                                        *(uint2*)(mlak + (size_t)row * 384 + hd * 96 + 80 + 4 * fq) = p2;
                                    }
                                }
                                if (idxk) {
                                    uint2 pk; pk.x = pack2(v[0], v[1]); pk.y = pack2(v[2], v[3]);
                                    const int d0 = col0 - PC_IDXK + 4 * fq, bb = row >> 12, ss = row & 4095;
                                    *(uint2*)(kf + ((size_t)(((bb * 128 + (ss >> 5)) * 4 + (d0 >> 4)) * 64 + ((d0 >> 3) & 1) * 32 + (ss & 31))) * 8 + (d0 & 7)) = pk;
                                } else if (!kr0 && !kr1) {
                                    uint2 pk; pk.x = pack2(v[0], v[1]); pk.y = pack2(v[2], v[3]);
                                    *(uint2*)(proj + (size_t)row * LDP + col0 + 4 * fq) = pk;
                                    if (foxk) {
                                        const float b0 = bf2f((u16)(pk.x & 0xffff)), b1 = bf2f((u16)(pk.x >> 16)), b2 = bf2f((u16)(pk.y & 0xffff)), b3 = bf2f((u16)(pk.y >> 16));
                                        float ss = b0 * b0 + b1 * b1 + b2 * b2 + b3 * b3;
                                        ss += __shfl_xor(ss, 16); ss += __shfl_xor(ss, 32);
                                        kmx = fmaxf(kmx, ss);
                                    }
                                }
                            }
                        if (foxk) {
                            kmx = fmaxf(kmx, __shfl_xor(kmx, 1)); kmx = fmaxf(kmx, __shfl_xor(kmx, 2)); kmx = fmaxf(kmx, __shfl_xor(kmx, 4)); kmx = fmaxf(kmx, __shfl_xor(kmx, 8));
                            if (c.lane == 0) {
                                const int cc = col0 - PC_FOXK;
                                atomicMax((unsigned*)(ws + WS_CTL) + 64 + (((pm * 256) >> 12) * 4 + (cc >> 6)) * 4 + ((cc >> 4) & 3), __float_as_uint(kmx));
                            }
                        }
                    } else if (col0 < NC_SMALL) {
                        u16* vt = (col0 < NC_FOXV) ? dsavt + (size_t)(col0 - NC_DSAV + 4 * fq) * 4096 : foxvt + (size_t)(col0 - NC_FOXV + 4 * fq) * 4096;
                        const size_t bstride = (col0 < NC_FOXV) ? (size_t)64 * 4096 : (size_t)256 * 4096;
#pragma unroll
                        for (int ai = 0; ai < 2; ++ai)
#pragma unroll
                            for (int m = 0; m < 4; ++m) {
                                const int row = pm * 256 + ai * 128 + wr * 64 + m * 16 + fr;
                                u16* p = vt + (size_t)(row >> 12) * bstride + (row & 4095);
                                const f32x4 v = acc[ai][bj][m][n];
                                p[0] = f2bf(v[0]); p[4096] = f2bf(v[1]); p[2 * 4096] = f2bf(v[2]); p[3 * 4096] = f2bf(v[3]);
                            }
                    } else if (col0 == NC_SMALL) {
#pragma unroll
                        for (int ai = 0; ai < 2; ++ai)
#pragma unroll
                            for (int m = 0; m < 4; ++m) {
                                const int row = pm * 256 + ai * 128 + wr * 64 + m * 16 + fr;
                                *(f32x4*)(small + (size_t)row * 16 + 4 * fq) = acc[ai][bj][m][n];
                            }
                    }
                }
            if (pn == 5 || pn == 6) {
                float* part = (float*)c.lds;
#pragma unroll
                for (int ai = 0; ai < 2; ++ai)
#pragma unroll
                    for (int m = 0; m < 4; ++m) {
                        float ss = 0.f;
#pragma unroll
                        for (int bj = 0; bj < 2; ++bj)
#pragma unroll
                            for (int n = 0; n < 2; ++n) if (pn == 5 || bj == 0) {
                                const f32x4 v = acc[ai][bj][m][n];
#pragma unroll
                                for (int j = 0; j < 4; ++j) { const float bq = bf2f(f2bf(v[j])); ss += bq * bq; }
                            }
                        ss += __shfl_xor(ss, 16); ss += __shfl_xor(ss, 32);
                        if (fq == 0) part[(ai * 128 + wr * 64 + m * 16 + fr) * 4 + wc] = ss;
                    }
                __syncthreads();
                if (c.tid < 256) {
                    const float4 p4 = *(const float4*)(part + c.tid * 4);
                    const float s = p4.x + p4.y + p4.z + p4.w;
                    if (pn == 5) ((float*)(ws + WS_RSQ))[pm * 256 + c.tid] = rsqrtf(s * (1.f / 256.f) + EPS);
                    else ((float*)(ws + WS_RSKV))[pm * 256 + c.tid] = rsqrtf(s * (1.f / 128.f) + EPS);
                }
            }
        });
    }
}

constexpr int SSD_LD = 136;
constexpr int SSD_TILE_B = 128 * SSD_LD * 2;
constexpr int SSD_OFF_DT = 3 * SSD_TILE_B;
constexpr int SSD_OFF_ACS = SSD_OFF_DT + 2048;
constexpr int SSD_OFF_SSQ = SSD_OFF_ACS + 2048;

DI void ssd_dt_acs(const Ctx& c, KArgs& a, int l, int tok0, float* dt_s, float* acs_s) {
    const float* small = (const float*)(a.ws + WS_SMALL);
    {
        const int t = c.tid >> 2, hd = c.tid & 3;
        const float raw = small[(size_t)(tok0 + t) * 16 + hd] + a.in[6][l * 4 + hd];
        dt_s[hd * 128 + t] = softplusf(raw);
    }
    __syncthreads();
    if (c.wave < 4) {
        const int hd = c.wave;
        const float av = -__expf(a.in[7][l * 4 + hd]);
        const float v0 = dt_s[hd * 128 + 2 * c.lane] * av, v1 = dt_s[hd * 128 + 2 * c.lane + 1] * av;
        const float s = v0 + v1;
        float inc = s;
#pragma unroll
        for (int o = 1; o < 64; o <<= 1) { const float tv = __shfl_up(inc, o); if (c.lane >= o) inc += tv; }
        const float ex = inc - s;
        acs_s[hd * 128 + 2 * c.lane] = ex + v0;
        acs_s[hd * 128 + 2 * c.lane + 1] = ex + v0 + v1;
    }
    __syncthreads();
}

DI float ssd_conv(const u16* proj, const float* cw, const float* cb, int b, int s, int xc) {
    float acc = cb[xc];
#pragma unroll
    for (int j = 0; j < 4; ++j) {
        const int sp = s - 3 + j;
        if (sp >= 0) acc += cw[j * 768 + xc] * bf2f(proj[(size_t)(b * 4096 + sp) * LDP + PC_XBC + xc]);
    }
    return siluf(acc);
}

template <bool TRANSPOSED>
DI void conv_stage_unit(const Ctx& c, const u16* proj, const float* cw, const float* cb, int b, int s0, int tseg, int xc0, u16* dst,
                        const float* dt_s, const float* acs_s, int head0) {
    const int ch = 2 * c.lane, xc = xc0 + ch;
    float w0[4], w1[4];
#pragma unroll
    for (int j = 0; j < 4; ++j) { w0[j] = cw[j * 768 + xc]; w1[j] = cw[j * 768 + xc + 1]; }
    const float bias0 = cb[xc], bias1 = cb[xc + 1];
    const u16* src = proj + (size_t)(b * 4096) * LDP + PC_XBC + xc;
    const int head = head0 + (ch >> 6);
#pragma unroll 1
    for (int half = 0; half < 2; ++half) {
        const int sb = s0 + tseg * 32 + half * 16 - 3;
        unsigned raw[19];
#pragma unroll
        for (int i = 0; i < 19; ++i) { const int sp = sb + i; raw[i] = (sp >= 0) ? *(const unsigned*)(src + (size_t)sp * LDP) : 0u; }
#pragma unroll
        for (int t = 0; t < 16; ++t) {
            float x0 = bias0, x1 = bias1;
#pragma unroll
            for (int j = 0; j < 4; ++j) { x0 += w0[j] * bf2f((u16)(raw[t + j] & 0xffff)); x1 += w1[j] * bf2f((u16)(raw[t + j] >> 16)); }
            x0 = siluf(x0); x1 = siluf(x1);
            const int tt = tseg * 32 + half * 16 + t;
            if (dt_s) { const float sc = dt_s[head * 128 + tt] * __expf(acs_s[head * 128 + 127] - acs_s[head * 128 + tt]); x0 *= sc; x1 *= sc; }
            if (TRANSPOSED) { dst[ch * SSD_LD + tt] = f2bf(x0); dst[(ch + 1) * SSD_LD + tt] = f2bf(x1); }
            else *(unsigned*)(dst + tt * SSD_LD + ch) = pack2(x0, x1);
        }
    }
}

DI void ssd_state_item(const Ctx& c_in, KArgs& a, int l, int item) {
    const Ctx c = fresh_ctx(c_in.lds);
    unsigned char* ws = a.ws;
    const u16* proj = (const u16*)(ws + WS_PROJ);
    const float* cw = a.in[4] + (size_t)l * 4 * 768;
    const float* cb = a.in[5] + (size_t)l * 768;
    float* cs = (float*)(ws + WS_CS);
    float* cdec = (float*)(ws + WS_CDEC);
    const int b = item >> 5, ch = item & 31, tok0 = b * 4096 + ch * 128, s0 = ch * 128;
    u16* XT = (u16*)c.lds;
    u16* BT = (u16*)(c.lds + SSD_TILE_B);
    float* dt_s = (float*)(c.lds + SSD_OFF_DT);
    float* acs_s = (float*)(c.lds + SSD_OFF_ACS);
    const int l31 = c.lane & 31, h = c.lane >> 5;
    ssd_dt_acs(c, a, l, tok0, dt_s, acs_s);
    if (c.tid < 4) cdec[(b * 32 + ch) * 4 + c.tid] = __expf(acs_s[c.tid * 128 + 127]);
    for (int g = 0; g < 2; ++g) {
        if (c.wave < 4) conv_stage_unit<true>(c, proj, cw, cb, b, s0, c.wave, 128 * g, XT, dt_s, acs_s, 2 * g);
        else conv_stage_unit<true>(c, proj, cw, cb, b, s0, c.wave - 4, 256 + 128 * g, BT, nullptr, nullptr, 0);
        __syncthreads();
        {
            const int hh = c.wave >> 2, pt = (c.wave >> 1) & 1, nh = c.wave & 1;
            f32x16 acc0 = zero16(), acc1 = zero16();
#pragma unroll
            for (int ks = 0; ks < 8; ++ks) {
                const bf16x8 af = *(const bf16x8*)(XT + (hh * 64 + pt * 32 + l31) * SSD_LD + ks * 16 + h * 8);
                const bf16x8 b0 = *(const bf16x8*)(BT + (nh * 64 + l31) * SSD_LD + ks * 16 + h * 8);
                const bf16x8 b1 = *(const bf16x8*)(BT + (nh * 64 + 32 + l31) * SSD_LD + ks * 16 + h * 8);
                acc0 = MFMA32(af, b0, acc0);
                acc1 = MFMA32(af, b1, acc1);
            }
            const int head = 2 * g + hh;
            float* dst = cs + ((size_t)((b * 32 + ch) * 4 + head) * 64) * 128;
#pragma unroll
            for (int r = 0; r < 16; ++r) {
                const int p = pt * 32 + crow(r, h);
                dst[p * 128 + nh * 64 + l31] = acc0[r];
                dst[p * 128 + nh * 64 + 32 + l31] = acc1[r];
            }
        }
        __syncthreads();
    }
}

DI void ssd_scan_item(const Ctx& c_in, KArgs& a, int item) {
    const Ctx c = fresh_ctx(c_in.lds);
    float* cs = (float*)(a.ws + WS_CS);
    const float* cdec = (const float*)(a.ws + WS_CDEC);
    const int idx = item * NTHR + c.tid;
    const int bh = idx >> 13, pn = idx & 8191, b = bh >> 2, hd = bh & 3;
    float v[32], dcy[32];
#pragma unroll
    for (int ch = 0; ch < 32; ++ch) {
        v[ch] = cs[((size_t)((b * 32 + ch) * 4 + hd)) * 8192 + pn];
        dcy[ch] = cdec[(b * 32 + ch) * 4 + hd];
    }
    float s = 0.f;
#pragma unroll
    for (int ch = 0; ch < 32; ++ch) {
        cs[((size_t)((b * 32 + ch) * 4 + hd)) * 8192 + pn] = s;
        s = s * dcy[ch] + v[ch];
    }
}

DI void ssd_out_item(const Ctx& c_in, KArgs& a, int l, int item) {
    const Ctx c = fresh_ctx(c_in.lds);
    unsigned char* ws = a.ws;
    const u16* proj = (const u16*)(ws + WS_PROJ);
    const float* cw = a.in[4] + (size_t)l * 4 * 768;
    const float* cb = a.in[5] + (size_t)l * 768;
    const float* prev = (const float*)(ws + WS_CS);
    u16* act = (u16*)(ws + WS_ACT);
    const int b = item >> 5, ch = item & 31, tok0 = b * 4096 + ch * 128, s0 = ch * 128;
    u16* XT = (u16*)c.lds;
    u16* BM = (u16*)(c.lds + SSD_TILE_B);
    u16* CM = (u16*)(c.lds + 2 * SSD_TILE_B);
    float* dt_s = (float*)(c.lds + SSD_OFF_DT);
    float* acs_s = (float*)(c.lds + SSD_OFF_ACS);
    float* ssq = (float*)(c.lds + SSD_OFF_SSQ);
    const int l31 = c.lane & 31, h = c.lane >> 5;
    ssd_dt_acs(c, a, l, tok0, dt_s, acs_s);
    f32x16 yreg[2][2];
    const int hh = c.wave >> 2, qt = c.wave & 3;
    const int q = qt * 32 + l31;
#pragma unroll
    for (int g = 0; g < 2; ++g) {
        for (int u = c.wave; u < 12; u += 8) {
            const int part = u >> 2, tseg = u & 3;
            if (part == 0) conv_stage_unit<true>(c, proj, cw, cb, b, s0, tseg, 128 * g, XT, nullptr, nullptr, 0);
            else if (part == 1) conv_stage_unit<false>(c, proj, cw, cb, b, s0, tseg, 256 + 128 * g, BM, nullptr, nullptr, 0);
            else conv_stage_unit<false>(c, proj, cw, cb, b, s0, tseg, 512 + 128 * g, CM, nullptr, nullptr, 0);
        }
        __syncthreads();
        {
            const int head = 2 * g + hh;
            const float acs_q = acs_s[head * 128 + q];
            bf16x8 cf[8];
#pragma unroll
            for (int ks = 0; ks < 8; ++ks) cf[ks] = *(const bf16x8*)(CM + q * SSD_LD + ks * 16 + h * 8);
            f32x16 yf0 = zero16(), yf1 = zero16();
            const float* pv = prev + ((size_t)((b * 32 + ch) * 4 + head) * 64) * 128;
#pragma unroll
            for (int ks = 0; ks < 8; ++ks) {
                {
                    const float* pr = pv + (size_t)l31 * 128 + ks * 16 + h * 8;
                    const float4 f0 = *(const float4*)pr, f1 = *(const float4*)(pr + 4);
                    const bf16x8 pa = __builtin_bit_cast(bf16x8, make_uint4(pack2(f0.x, f0.y), pack2(f0.z, f0.w), pack2(f1.x, f1.y), pack2(f1.z, f1.w)));
                    yf0 = MFMA32(pa, cf[ks], yf0);
                }
                {
                    const float* pr = pv + (size_t)(32 + l31) * 128 + ks * 16 + h * 8;
                    const float4 f0 = *(const float4*)pr, f1 = *(const float4*)(pr + 4);
                    const bf16x8 pa = __builtin_bit_cast(bf16x8, make_uint4(pack2(f0.x, f0.y), pack2(f0.z, f0.w), pack2(f1.x, f1.y), pack2(f1.z, f1.w)));
                    yf1 = MFMA32(pa, cf[ks], yf1);
                }
            }
            const float eq = __expf(acs_q);
            f32x16 yo0, yo1;
#pragma unroll
            for (int r = 0; r < 16; ++r) { yo0[r] = yf0[r] * eq; yo1[r] = yf1[r] * eq; }
            for (int kt = 0; kt <= qt; ++kt) {
                f32x16 gt = zero16();
#pragma unroll
                for (int ks = 0; ks < 8; ++ks) {
                    const bf16x8 bf = *(const bf16x8*)(BM + (kt * 32 + l31) * SSD_LD + ks * 16 + h * 8);
                    gt = MFMA32(bf, cf[ks], gt);
                }
#pragma unroll
                for (int r = 0; r < 16; ++r) {
                    const int k = kt * 32 + crow(r, h);
                    const float dec = __expf(fminf(acs_q - acs_s[head * 128 + k], 0.f)) * dt_s[head * 128 + k];
                    gt[r] = (k <= q) ? gt[r] * dec : 0.f;
                }
#pragma unroll
                for (int s2 = 0; s2 < 2; ++s2) {
                    const bf16x8 pb = pack8(gt, s2);
                    const int koff = kt * 32 + 16 * s2 + 4 * h;
                    {
                        const u16* xr = XT + (hh * 64 + l31) * SSD_LD + koff;
                        const uint2 lo = *(const uint2*)xr, hi = *(const uint2*)(xr + 8);
                        const bf16x8 xa = __builtin_bit_cast(bf16x8, make_uint4(lo.x, lo.y, hi.x, hi.y));
                        yo0 = MFMA32(xa, pb, yo0);
                    }
                    {
                        const u16* xr = XT + (hh * 64 + 32 + l31) * SSD_LD + koff;
                        const uint2 lo = *(const uint2*)xr, hi = *(const uint2*)(xr + 8);
                        const bf16x8 xa = __builtin_bit_cast(bf16x8, make_uint4(lo.x, lo.y, hi.x, hi.y));
                        yo1 = MFMA32(xa, pb, yo1);
                    }
                }
            }
            const float dsk = a.in[8][l * 4 + head];
            float part = 0.f;
#pragma unroll
            for (int pt = 0; pt < 2; ++pt) {
#pragma unroll
                for (int qd = 0; qd < 4; ++qd) {
                    const int p0 = pt * 32 + 8 * qd + 4 * h;
                    const uint2 zz = *(const uint2*)(proj + (size_t)(tok0 + q) * LDP + PC_Z + head * 64 + p0);
                    const float zf[4] = { bf2f((u16)(zz.x & 0xffff)), bf2f((u16)(zz.x >> 16)), bf2f((u16)(zz.y & 0xffff)), bf2f((u16)(zz.y >> 16)) };
#pragma unroll
                    for (int r3 = 0; r3 < 4; ++r3) {
                        const int r = 4 * qd + r3;
                        const float yo = pt ? yo1[r] : yo0[r];
                        const float xv = bf2f(XT[(hh * 64 + p0 + r3) * SSD_LD + q]);
                        const float y = (yo + dsk * xv) * siluf(zf[r3]);
                        yreg[g][pt][r] = y;
                        part += y * y;
                    }
                }
            }
            part += __shfl_xor(part, 32);
            if (h == 0) ssq[head * 128 + q] = part;
        }
        __syncthreads();
    }
    {
        const float rs = rsqrtf((ssq[q] + ssq[128 + q] + ssq[256 + q] + ssq[384 + q]) * (1.f / 256.f) + EPS);
        const float* nw = a.in[9] + l * 256;
#pragma unroll
        for (int g = 0; g < 2; ++g) {
            const int head = 2 * g + hh;
#pragma unroll
            for (int pt = 0; pt < 2; ++pt)
#pragma unroll
                for (int qd = 0; qd < 4; ++qd) {
                    const int p0 = pt * 32 + 8 * qd + 4 * h;
                    const float* w4 = nw + head * 64 + p0;
                    uint2 pk;
                    pk.x = pack2(yreg[g][pt][4 * qd] * rs * w4[0], yreg[g][pt][4 * qd + 1] * rs * w4[1]);
                    pk.y = pack2(yreg[g][pt][4 * qd + 2] * rs * w4[2], yreg[g][pt][4 * qd + 3] * rs * w4[3]);
                    *(uint2*)(act + (size_t)(tok0 + q) * 1024 + head * 64 + p0) = pk;
                }
        }
    }
    __syncthreads();
}

DI void mla_up_item(const Ctx& c_in, KArgs& a, int l, int which, int item) {
    const Ctx c = fresh_ctx(c_in.lds);
    unsigned char* ws = a.ws;
    const u16* proj = (const u16*)(ws + WS_PROJ);
    const float* trig = (const float*)(ws + WS_TRIG);
    float* rs_s = (float*)(c.lds + G_LDS_BYTES);
    const int r8 = c.tid >> 3;
    const int wm = c.wave & 3, wn = c.wave >> 2, l31 = c.lane & 31, h = c.lane >> 5;
    const int K = which == 0 ? 256 : 128;
    const int pc = which == 0 ? PC_CQ : PC_CKV;
    const int ntn = which == 0 ? 3 : 4;
    const int mt = item / ntn, nt = item % ntn;
    const u16* w = which == 0 ? (const u16*)(ws + WS_WUQ) + (size_t)l * 384 * 256 : (const u16*)(ws + WS_WUKV) + (size_t)l * 512 * 128;
    {
        const int row = c.tid >> 1, half = c.tid & 1;
        const u16* p = proj + (size_t)(mt * 256 + row) * LDP + pc + half * (K / 2);
        float ss = 0.f;
        for (int i = 0; i < K / 2; i += 8) {
            const uint4 v = *(const uint4*)(p + i);
            const unsigned w4[4] = { v.x, v.y, v.z, v.w };
#pragma unroll
            for (int j = 0; j < 4; ++j) { const float f0 = bf2f((u16)(w4[j] & 0xffff)), f1 = bf2f((u16)(w4[j] >> 16)); ss += f0 * f0 + f1 * f1; }
        }
        ss += __shfl_xor(ss, 1);
        if (half == 0) rs_s[row] = rsqrtf(ss / (float)K + EPS);
    }
    __syncthreads();
    GP gp;
    gp.a0 = proj + (size_t)(mt * 256 + r8) * LDP + pc; gp.a1 = gp.a0 + 64 * LDP; gp.a2 = gp.a0 + 128 * LDP; gp.a3 = gp.a0 + 192 * LDP;
    gp.b0 = w + (size_t)(nt * 128 + r8) * K; gp.b1 = gp.b0 + 64 * K;
    f32x16 acc[2][2];
    acc[0][0] = zero16(); acc[0][1] = zero16(); acc[1][0] = zero16(); acc[1][1] = zero16();
    gemm_core<false>(c, K, gp, acc);
    u16* mlaq = (u16*)(ws + WS_MLAQ);
    u16* mlak = (u16*)(ws + WS_MLAK);
    u16* mlavt = (u16*)(ws + WS_MLAVT);
#pragma unroll
    for (int i = 0; i < 2; ++i)
#pragma unroll
        for (int j = 0; j < 2; ++j) {
            const int ml0 = wm * 64 + i * 32, m0 = mt * 256 + ml0, n0 = nt * 128 + wn * 64 + j * 32;
            const int n = n0 + l31;
            if (which == 0) {
                const bool rope = ((n0 >> 5) % 3) == 2;
#pragma unroll
                for (int r = 0; r < 16; ++r) {
                    const int ml = ml0 + crow(r, h), m = mt * 256 + ml;
                    float v = acc[i][j][r] * rs_s[ml];
                    if (rope) {
                        const float pv = __shfl_xor(v, 16);
                        const int ii = l31 & 15;
                        const float cs = trig[(size_t)m * 48 + 16 + ii], sn = trig[(size_t)m * 48 + 32 + ii];
                        v = (l31 < 16) ? (v * cs - pv * sn) : (v * cs + pv * sn);
                    }
                    mlaq[(size_t)m * 384 + n] = f2bf(v);
                }
            } else {
                const int head = n0 >> 7, wi = n0 & 127;
                if (wi < 64) {
#pragma unroll
                    for (int r = 0; r < 16; ++r) {
                        const int ml = ml0 + crow(r, h), m = mt * 256 + ml;
                        mlak[(size_t)m * 384 + head * 96 + wi + l31] = f2bf(acc[i][j][r] * rs_s[ml]);
                    }
                } else {
                    const int b = m0 >> 12, s0 = m0 & 4095, d = wi - 64 + l31;
                    u16* base = mlavt + ((size_t)(b * 4 + head) * 64 + d) * 4096 + s0;
#pragma unroll
                    for (int q = 0; q < 4; ++q) {
                        const int mlq = ml0 + 8 * q + 4 * h;
                        uint2 pk;
                        pk.x = pack2(acc[i][j][4 * q] * rs_s[mlq], acc[i][j][4 * q + 1] * rs_s[mlq + 1]);
                        pk.y = pack2(acc[i][j][4 * q + 2] * rs_s[mlq + 2], acc[i][j][4 * q + 3] * rs_s[mlq + 3]);
                        *(uint2*)(base + 8 * q + 4 * h) = pk;
                    }
                }
            }
        }
    __syncthreads();
}

DI void mla_up_unit(const Ctx& c_in, KArgs& a, int l, int which, int unit) {
    const Ctx c = fresh_ctx(c_in.lds);
    unsigned char* ws = a.ws;
    const u16* proj = (const u16*)(ws + WS_PROJ);
    const float* trig = (const float*)(ws + WS_TRIG);
    u16* mlaq = (u16*)(ws + WS_MLAQ);
    u16* mlak = (u16*)(ws + WS_MLAK);
    u16* mlavt = (u16*)(ws + WS_MLAVT);
    int R, C; g2_stage_rc(c.tid * 16, R, C);
    const int pm = unit >> 1, pn = unit & 1;
    G2Ptrs g;
    g.ra = g2_rsrc(proj);
    g.va00 = (unsigned)(R * LDP + (which == 0 ? PC_CQ : PC_CKV) + C) * 2u; g.va01 = g.va00 + 64 * LDP * 2; g.va10 = g.va00 + 128 * LDP * 2; g.va11 = g.va00 + 192 * LDP * 2;
    g.sa = (unsigned)pm * (256u * LDP * 2u);
    __syncthreads();
    if (which == 0) {
        g.rb = g2_rsrc((const u16*)(ws + WS_WUQ) + (size_t)l * 512 * 256);
        g.vb0 = (unsigned)(R * 256 + C) * 2u; g.vb1 = g.vb0 + 64 * 512; g.sb0 = (unsigned)pn * (256u * 512u); g.sb1 = g.sb0 + 128u * 512u;
        const float* rsq = (const float*)(ws + WS_RSQ);
        gemm256_unit(c, g, 256, [&](const f32x4 (&acc)[2][2][4][2], int wr, int wc, int fr, int fq) {
#pragma unroll
            for (int ai = 0; ai < 2; ++ai)
#pragma unroll
                for (int m = 0; m < 4; ++m) {
                    const int row = pm * 256 + ai * 128 + wr * 64 + m * 16 + fr;
                    const float rs = rsq[row];
#pragma unroll
                    for (int bj = 0; bj < 2; ++bj) {
                        const int c32 = pn * 256 + bj * 128 + wc * 32;
                        if (c32 < 384) {
                            f32x4 v0 = acc[ai][bj][m][0] * rs, v1 = acc[ai][bj][m][1] * rs;
                            if ((c32 % 96) == 64) {
                                const float* tg = trig + (size_t)row * 48 + 16 + 4 * fq;
                                const f32x4 cs = *(const f32x4*)tg, sn = *(const f32x4*)(tg + 16);
                                const f32x4 o1 = v0 * cs - v1 * sn, o2 = v1 * cs + v0 * sn;
                                v0 = o1; v1 = o2;
                            }
                            uint2 p0, p1; p0.x = pack2(v0[0], v0[1]); p0.y = pack2(v0[2], v0[3]); p1.x = pack2(v1[0], v1[1]); p1.y = pack2(v1[2], v1[3]);
                            *(uint2*)(mlaq + (size_t)row * 384 + c32 + 4 * fq) = p0;
                            *(uint2*)(mlaq + (size_t)row * 384 + c32 + 16 + 4 * fq) = p1;
                        }
                    }
                }
        });
    } else {
        g.rb = g2_rsrc((const u16*)(ws + WS_WUKV) + (size_t)l * 512 * 128);
        g.vb0 = (unsigned)(R * 128 + C) * 2u; g.vb1 = g.vb0 + 64 * 256; g.sb0 = (unsigned)pn * (256u * 256u); g.sb1 = g.sb0 + 128u * 256u;
        const float* rskv = (const float*)(ws + WS_RSKV);
        gemm256_unit(c, g, 128, [&](const f32x4 (&acc)[2][2][4][2], int wr, int wc, int fr, int fq) {
#pragma unroll
            for (int ai = 0; ai < 2; ++ai)
#pragma unroll
                for (int m = 0; m < 4; ++m) {
                    const int row = pm * 256 + ai * 128 + wr * 64 + m * 16 + fr;
                    const float rs = rskv[row];
#pragma unroll
                    for (int bj = 0; bj < 2; ++bj) {
                        const int head = pn * 2 + bj, c32 = wc * 32;
#pragma unroll
                        for (int n = 0; n < 2; ++n) {
                            const f32x4 v = acc[ai][bj][m][n] * rs;
                            if (c32 < 64) {
                                uint2 pk; pk.x = pack2(v[0], v[1]); pk.y = pack2(v[2], v[3]);
                                *(uint2*)(mlak + (size_t)row * 384 + head * 96 + c32 + n * 16 + 4 * fq) = pk;
                            } else {
                                u16* p = mlavt + ((size_t)((row >> 12) * 4 + head) * 64 + (c32 - 64 + n * 16 + 4 * fq)) * 4096 + (row & 4095);
                                p[0] = f2bf(v[0]); p[4096] = f2bf(v[1]); p[2 * 4096] = f2bf(v[2]); p[3 * 4096] = f2bf(v[3]);
                            }
                        }
                    }
                }
        });
    }
}

constexpr int AT_LDV = 68;
template <int DQ, int MODE>
DI void attn_item(const Ctx& c_in, KArgs& a, int l, int b, int hd_in, int qb) {
    const Ctx c = fresh_ctx(c_in.lds);
    unsigned char* ws = a.ws;
    constexpr int LDK = DQ + 8;
    constexpr int K_EL = 64 * LDK, V_EL = 64 * AT_LDV, ST_EL = K_EL + V_EL;
    constexpr int NKS = DQ / 16;
    constexpr int KCH = DQ / 8;
    u16* S = (u16*)c.lds;
    float* fc_s = (float*)(c.lds + 2 * ST_EL * 2 + 64);
    const int l31 = c.lane & 31, h = c.lane >> 5;
    int hd, wq0, nkt;
    const u16 *Qp, *Kp, *Vp; int ldq, ldk, ocol;
    float scale;
    if (MODE == 0) {
        hd = hd_in;
        wq0 = qb * 256 + c.wave * 32; nkt = qb * 4 + 4;
        Qp = (const u16*)(ws + WS_MLAQ) + (size_t)b * 4096 * 384 + hd * 96; ldq = 384;
        Kp = (const u16*)(ws + WS_MLAK) + (size_t)b * 4096 * 384 + hd * 96; ldk = 384;
        Vp = (const u16*)(ws + WS_MLAVT) + (size_t)(b * 4 + hd) * 64 * 4096;
        ocol = 512 + hd * 64; scale = 0.10206207261596575f;
    } else if (MODE == 1) {
        hd = hd_in;
        wq0 = qb * 256 + c.wave * 32; nkt = qb * 4 + 4;
        Qp = (const u16*)(ws + WS_PROJ) + (size_t)b * 4096 * LDP + PC_FOXQ + hd * 64; ldq = LDP;
        Kp = (const u16*)(ws + WS_PROJ) + (size_t)b * 4096 * LDP + PC_FOXK + hd * 64; ldk = LDP;
        Vp = (const u16*)(ws + WS_FOXVT) + (size_t)(b * 4 + hd) * 64 * 4096;
        ocol = 768 + hd * 64; scale = 0.125f;
    } else {
        hd = c.wave & 3;
        wq0 = qb * 64 + (c.wave >> 2) * 32; nkt = qb + 1;
        Qp = (const u16*)(ws + WS_PROJ) + (size_t)b * 4096 * LDP + PC_DSAQ + hd * 64; ldq = LDP;
        Kp = (const u16*)(ws + WS_PROJ) + (size_t)b * 4096 * LDP + PC_DSAK; ldk = LDP;
        Vp = (const u16*)(ws + WS_DSAVT) + (size_t)b * 64 * 4096;
        ocol = 256 + hd * 64; scale = 0.125f;
    }
    const float sc2 = scale * LOG2E;
    const int q = wq0 + l31;
    bf16x8 qf[NKS];
#pragma unroll
    for (int ks = 0; ks < NKS; ++ks) qf[ks] = *(const bf16x8*)(Qp + (size_t)q * ldq + ks * 16 + h * 8);
    float fq = 0.f;
    if (MODE == 1) {
        const float* fsm = (const float*)(ws + WS_SMALL) + (size_t)b * 4096 * 16 + 12 + hd;
        const float fbias = a.in[14][l * 4 + hd];
        float* wtot = (float*)(c.lds + 2 * ST_EL * 2);
        const int nk = nkt * 64;
        float v[8]; float s = 0.f;
#pragma unroll
        for (int j = 0; j < 8; ++j) {
            const int idx = c.tid * 8 + j;
            float lf = 0.f;
            if (idx < nk) { const float f = fsm[(size_t)idx * 16] + fbias; lf = fminf(f, 0.f) - log1pf(__expf(-fabsf(f))); }
            v[j] = lf;
        }
#pragma unroll
        for (int j = 0; j < 8; ++j) { s += v[j]; v[j] = s; }
        float inc = s;
#pragma unroll
        for (int o = 1; o < 64; o <<= 1) { const float tv = __shfl_up(inc, o); if (c.lane >= o) inc += tv; }
        if (c.lane == 63) wtot[c.wave] = inc;
        __syncthreads();
        float base = inc - s;
        for (int w2 = 0; w2 < c.wave; ++w2) base += wtot[w2];
#pragma unroll
        for (int j = 0; j < 8; ++j) fc_s[c.tid * 8 + j] = (base + v[j]) * LOG2E;
        __syncthreads();
        fq = fc_s[q];
    }
    float sbound = 0.f;
    int* dflag = (int*)(c.lds + 2 * ST_EL * 2 + 64 + 4096 * 4);
    if (MODE == 1) {
        float qq = 0.f;
#pragma unroll
        for (int ks = 0; ks < NKS; ++ks)
#pragma unroll
            for (int j = 0; j < 8; ++j) { const float f = bf2f((u16)qf[ks][j]); qq += f * f; }
        qq += __shfl_xor(qq, 32);
        float kmax2 = 0.f;
#pragma unroll
        for (int f = 0; f < 4; ++f) kmax2 += __uint_as_float(__hip_atomic_load((const unsigned*)(ws + WS_CTL) + 64 + (b * 4 + hd) * 4 + f, __ATOMIC_RELAXED, __HIP_MEMORY_SCOPE_AGENT));
        sbound = sqrtf(qq * kmax2) * sc2 * 1.02f + 1.0f;
        if (c.tid < 16) dflag[c.tid] = 0;
    }
    bool wdone = false;
    const int krow0 = c.tid / KCH, kch0 = c.tid % KCH;
    const int c1 = c.tid + NTHR; const int krow1 = c1 / KCH, kch1 = c1 % KCH; const bool has1 = (KCH * 64 > NTHR) && (c1 < KCH * 64);
    const int vrow = c.tid >> 3, vch = c.tid & 7;
    struct KV { uint4 k0, k1, v; u64 mw; };
    KV sA, sB, sC;
    sA.k1 = sB.k1 = sC.k1 = make_uint4(0, 0, 0, 0); sA.mw = sB.mw = sC.mw = 0;
    const u64* mrow = (const u64*)(ws + WS_MASK) + (size_t)(b * 4096 + q) * 64;
    auto gload = [&](KV& s, int kt) {
        s.k0 = *(const uint4*)(Kp + (size_t)(kt * 64 + krow0) * ldk + kch0 * 8);
        if (has1) s.k1 = *(const uint4*)(Kp + (size_t)(kt * 64 + krow1) * ldk + kch1 * 8);
        s.v = *(const uint4*)(Vp + (size_t)vrow * 4096 + kt * 64 + vch * 8);
        if (MODE == 2) s.mw = mrow[kt];
    };
    auto sstore = [&](const KV& s, int st) {
        u16* Ks = S + st * ST_EL; u16* Vs = Ks + K_EL;
        *(uint4*)(Ks + krow0 * LDK + kch0 * 8) = s.k0;
        if (has1) *(uint4*)(Ks + krow1 * LDK + kch1 * 8) = s.k1;
        *(uint2*)(Vs + vrow * AT_LDV + vch * 8) = make_uint2(s.v.x, s.v.y);
        *(uint2*)(Vs + vrow * AT_LDV + vch * 8 + 4) = make_uint2(s.v.z, s.v.w);
    };
    f32x16 o0 = zero16(), o1 = zero16();
    float m_run = -1e30f, l_run = 0.f;
    auto tile_of = [&](int it) { return (MODE == 1) ? nkt - 1 - it : it; };
    bool stop = false;
    auto step = [&](int it, KV& cur, const KV& nxt) {
        const int kt = tile_of(it);
        const u64 mw_cur = cur.mw;
        if (it + 3 < nkt) gload(cur, tile_of(it + 3));
        if (kt * 64 <= wq0 + 31 && !wdone) {
            const u16* Ks = S + (it & 1) * ST_EL; const u16* Vs = Ks + K_EL;
            f32x16 s0 = zero16(), s1 = zero16();
#pragma unroll
            for (int ks = 0; ks < NKS; ++ks) {
                const bf16x8 k0 = *(const bf16x8*)(Ks + l31 * LDK + ks * 16 + h * 8);
                const bf16x8 k1 = *(const bf16x8*)(Ks + (32 + l31) * LDK + ks * 16 + h * 8);
                s0 = MFMA32(k0, qf[ks], s0);
                s1 = MFMA32(k1, qf[ks], s1);
            }
            const float scx = (MODE == 1) ? 1.0f : sc2;
            if (MODE == 1) {
#pragma unroll
                for (int g4 = 0; g4 < 4; ++g4) {
                    const float4 f0 = *(const float4*)(fc_s + kt * 64 + 8 * g4 + 4 * h);
                    const float4 f1 = *(const float4*)(fc_s + kt * 64 + 32 + 8 * g4 + 4 * h);
                    s0[4 * g4 + 0] = fmaf(s0[4 * g4 + 0], sc2, fq) - f0.x; s0[4 * g4 + 1] = fmaf(s0[4 * g4 + 1], sc2, fq) - f0.y;
                    s0[4 * g4 + 2] = fmaf(s0[4 * g4 + 2], sc2, fq) - f0.z; s0[4 * g4 + 3] = fmaf(s0[4 * g4 + 3], sc2, fq) - f0.w;
                    s1[4 * g4 + 0] = fmaf(s1[4 * g4 + 0], sc2, fq) - f1.x; s1[4 * g4 + 1] = fmaf(s1[4 * g4 + 1], sc2, fq) - f1.y;
                    s1[4 * g4 + 2] = fmaf(s1[4 * g4 + 2], sc2, fq) - f1.z; s1[4 * g4 + 3] = fmaf(s1[4 * g4 + 3], sc2, fq) - f1.w;
                }
            }
            if (MODE == 2) {
                const unsigned mlo = (unsigned)(mw_cur >> (4 * h)), mhi = (unsigned)(mw_cur >> (32 + 4 * h));
#pragma unroll
                for (int r = 0; r < 16; ++r) {
                    const int kr = (r & 3) + 8 * (r >> 2);
                    s0[r] = ((mlo >> kr) & 1u) ? s0[r] : -1e30f;
                    s1[r] = ((mhi >> kr) & 1u) ? s1[r] : -1e30f;
                }
            } else if (__builtin_amdgcn_readfirstlane(kt * 64 + 63 - wq0) > 0) {
                asm volatile("" ::: "memory");
                const int qrel = q - kt * 64 - 4 * h;
#pragma unroll
                for (int r = 0; r < 16; ++r) {
                    const int kr = (r & 3) + 8 * (r >> 2);
                    s0[r] = (kr <= qrel) ? s0[r] : -1e30f;
                    s1[r] = (kr + 32 <= qrel) ? s1[r] : -1e30f;
                }
            }
            asm volatile("s_nop 15\n\ts_nop 3" : "+v"(s0), "+v"(s1));
            float mx;
            {
                float t0 = max3f(s0[0], s0[1], s0[2]), t1 = max3f(s0[3], s0[4], s0[5]), t2 = max3f(s0[6], s0[7], s0[8]), t3 = max3f(s0[9], s0[10], s0[11]);
                float t4 = max3f(s0[12], s0[13], s0[14]), t5 = max3f(s0[15], s1[0], s1[1]), t6 = max3f(s1[2], s1[3], s1[4]), t7 = max3f(s1[5], s1[6], s1[7]);
                float t8 = max3f(s1[8], s1[9], s1[10]), t9 = max3f(s1[11], s1[12], s1[13]), t10 = max3f(s1[14], s1[15], t0);
                t1 = max3f(t1, t2, t3); t4 = max3f(t4, t5, t6); t7 = max3f(t7, t8, t9);
                mx = max3f(t1, t4, t7); mx = max3f(mx, t10, __shfl_xor(max3f(t1, t4, max3f(t7, t10, t10)), 32));
            }
            const float m_new = max3f(m_run, mx, mx);
            const float m_use = (MODE == 2) ? max3f(m_new, -1e20f, -1e20f) : m_new;
            const float alpha = ex2((m_run - m_new) * scx);
            const float nm = -m_use * scx;
            f32x2 rs2 = {0.f, 0.f};
            const f32x2 sc2v = {scx, scx}, nm2 = {nm, nm};
#pragma unroll
            for (int r = 0; r < 16; r += 2) {
                f32x2 xv = {s0[r], s0[r + 1]};
                xv = xv * sc2v + nm2;
                xv[0] = ex2(xv[0]); xv[1] = ex2(xv[1]);
                s0[r] = xv[0]; s0[r + 1] = xv[1];
                rs2 += xv;
                f32x2 yv = {s1[r], s1[r + 1]};
                yv = yv * sc2v + nm2;
                yv[0] = ex2(yv[0]); yv[1] = ex2(yv[1]);
                s1[r] = yv[0]; s1[r + 1] = yv[1];
                rs2 += yv;
            }
            float rsum = rs2[0] + rs2[1];
            rsum += __shfl_xor(rsum, 32);
            l_run = l_run * alpha + rsum; m_run = m_new;
            if (__any(alpha != 1.0f)) {
#pragma unroll
                for (int r = 0; r < 16; ++r) { o0[r] *= alpha; o1[r] *= alpha; }
            }
#pragma unroll
            for (int sub = 0; sub < 2; ++sub)
#pragma unroll
                for (int s2 = 0; s2 < 2; ++s2) {
                    const bf16x8 pb = pack8(sub ? s1 : s0, s2);
                    const int koff = sub * 32 + 16 * s2 + 4 * h;
                    {
                        const u16* vr = Vs + l31 * AT_LDV + koff;
                        const uint2 lo = *(const uint2*)vr, hi = *(const uint2*)(vr + 8);
                        o0 = MFMA32(__builtin_bit_cast(bf16x8, make_uint4(lo.x, lo.y, hi.x, hi.y)), pb, o0);
                    }
                    {
                        const u16* vr = Vs + (32 + l31) * AT_LDV + koff;
                        const uint2 lo = *(const uint2*)vr, hi = *(const uint2*)(vr + 8);
                        o1 = MFMA32(__builtin_bit_cast(bf16x8, make_uint4(lo.x, lo.y, hi.x, hi.y)), pb, o1);
                    }
                }
        }
        if (it + 1 < nkt) sstore(nxt, (it + 1) & 1);
        if (MODE == 1) {
            if (kt * 64 <= wq0 + 31 && !wdone && kt > 0) wdone = __all(sbound + (fq - fc_s[kt * 64 - 1]) < m_run - 40.f);
            if (c.lane == 0) dflag[(it & 1) * 8 + c.wave] = wdone ? 1 : 0;
        }
        __syncthreads();
        if (MODE == 1) {
            const int4 f0 = *(const int4*)(dflag + (it & 1) * 8), f1 = *(const int4*)(dflag + (it & 1) * 8 + 4);
            if ((f0.x & f0.y & f0.z & f0.w & f1.x & f1.y & f1.z & f1.w) != 0) stop = true;
        }
    };
    gload(sA, tile_of(0));
    if (nkt > 1) gload(sB, tile_of(1));
    if (nkt > 2) gload(sC, tile_of(2));
    sstore(sA, 0);
    __syncthreads();
    for (int it = 0; it < nkt; it += 3) {
        step(it, sA, sB); if (stop || it + 1 >= nkt) break;
        step(it + 1, sB, sC); if (stop || it + 2 >= nkt) break;
        step(it + 2, sC, sA); if (stop) break;
    }
    if (MODE == 1) __syncthreads();
    {
        const float inv = 1.f / l_run;
        u16* act = (u16*)(ws + WS_ACT) + (size_t)(b * 4096 + q) * 1024 + ocol;
#pragma unroll
        for (int qd = 0; qd < 4; ++qd) {
            uint2 pk;
            pk.x = pack2(o0[4 * qd] * inv, o0[4 * qd + 1] * inv); pk.y = pack2(o0[4 * qd + 2] * inv, o0[4 * qd + 3] * inv);
            *(uint2*)(act + 8 * qd + 4 * h) = pk;
            pk.x = pack2(o1[4 * qd] * inv, o1[4 * qd + 1] * inv); pk.y = pack2(o1[4 * qd + 2] * inv, o1[4 * qd + 3] * inv);
            *(uint2*)(act + 32 + 8 * qd + 4 * h) = pk;
        }
    }
}

constexpr int SC_LD = 4100;
struct DsaPref { uint4 q; float w; bf16x8 kb[2][4]; };
DI void dsa_prefetch(const Ctx& c, KArgs& a, int b, int s0, DsaPref& pf) {
    const u16* proj = (const u16*)(a.ws + WS_PROJ);
    const float* small = (const float*)(a.ws + WS_SMALL);
    const int tok0 = b * 4096 + s0;
    const int npair = ((((s0 + 7) >> 5) + 1) + 1) >> 1;
    const u16* kbase = (const u16*)(a.ws + WS_KF) + (size_t)b * 128 * 4 * 512 + c.lane * 8;
    if (c.wave < npair) {
#pragma unroll
        for (int tt = 0; tt < 2; ++tt)
#pragma unroll
            for (int ks = 0; ks < 4; ++ks) pf.kb[tt][ks] = *(const bf16x8*)(kbase + (size_t)((2 * c.wave + tt) * 4 + ks) * 512);
    }
    {
        const int r = c.tid >> 3;
        pf.q = *(const uint4*)(proj + (size_t)(tok0 + (r >> 3)) * LDP + PC_IDXQ + (r & 7) * 64 + (c.tid & 7) * 8);
    }
    pf.w = (c.tid < 64) ? small[(size_t)(tok0 + (c.tid >> 3)) * 16 + 4 + (c.tid & 7)] * 0.044194173824159216f : 0.f;
}
DI void dsa_index_item(const Ctx& c_in, KArgs& a, int b, int s0, DsaPref& pf, bool last) {
    const Ctx c = fresh_ctx(c_in.lds);
    unsigned char* ws = a.ws;
    const u16* proj = (const u16*)(ws + WS_PROJ);
    const float* small = (const float*)(ws + WS_SMALL);
    u64* mask = (u64*)(ws + WS_MASK);
    unsigned* SC = (unsigned*)c.lds;
    unsigned* HIST = (unsigned*)(c.lds + 8 * SC_LD * 4);
    unsigned* QMM = HIST + 8 * 272;
    const int l31 = c.lane & 31, h = c.lane >> 5;
    const int tok0 = b * 4096 + s0;
    const int ntile = ((s0 + 7) >> 5) + 1;
    const int npair = (ntile + 1) >> 1;
    u16* QA_s = (u16*)(QMM + 16);
    float* W_s = (float*)(QA_s + 64 * 72);
    if (c.tid < 16) QMM[c.tid] = (c.tid < 8) ? 0xffffffffu : 0u;
    *(uint4*)(QA_s + (c.tid >> 3) * 72 + (c.tid & 7) * 8) = pf.q;
    if (c.tid < 64) W_s[c.tid] = pf.w;
    const u16* kbase = (const u16*)(ws + WS_KF) + (size_t)b * 128 * 4 * 512 + c.lane * 8;
    bf16x8 kb[2][4], kn[2][4];
#pragma unroll
    for (int tt = 0; tt < 2; ++tt)
#pragma unroll
        for (int ks = 0; ks < 4; ++ks) kb[tt][ks] = pf.kb[tt][ks];
    __syncthreads();
    bf16x8 qa[2][4];
    float wv[2][16];
#pragma unroll
    for (int rt = 0; rt < 2; ++rt) {
#pragma unroll
        for (int ks = 0; ks < 4; ++ks) qa[rt][ks] = *(const bf16x8*)(QA_s + (rt * 32 + l31) * 72 + ks * 16 + h * 8);
#pragma unroll
        for (int g = 0; g < 4; ++g) {
            const float4 w4 = *(const float4*)(W_s + (g + 4 * rt) * 8 + 4 * h);
            wv[rt][4 * g + 0] = w4.x; wv[rt][4 * g + 1] = w4.y; wv[rt][4 * g + 2] = w4.z; wv[rt][4 * g + 3] = w4.w;
        }
    }
    unsigned kmin[4], kmax[4];
#pragma unroll
    for (int g = 0; g < 4; ++g) { kmin[g] = 0xffffffffu; kmax[g] = 0u; }
    for (int kp = c.wave; kp < npair; kp += 8) {
        if (kp + 8 < npair) {
#pragma unroll
            for (int tt = 0; tt < 2; ++tt)
#pragma unroll
                for (int ks = 0; ks < 4; ++ks) kn[tt][ks] = *(const bf16x8*)(kbase + (size_t)((2 * (kp + 8) + tt) * 4 + ks) * 512);
        }
#pragma unroll
        for (int tt = 0; tt < 2; ++tt) {
            const int key = (2 * kp + tt) * 32 + l31;
            f32x16 a0 = zero16(), a1 = zero16();
#pragma unroll
            for (int ks = 0; ks < 4; ++ks) { a0 = MFMA32(qa[0][ks], kb[tt][ks], a0); a1 = MFMA32(qa[1][ks], kb[tt][ks], a1); }
            asm volatile("s_nop 15\n\ts_nop 3" : "+v"(a0), "+v"(a1));
#pragma unroll
            for (int g = 0; g < 4; ++g) {
                f32x2 p = {0.f, 0.f};
#pragma unroll
                for (int r3 = 0; r3 < 4; ++r3) {
                    const f32x2 rl = {relu_raw(a0[4 * g + r3]), relu_raw(a1[4 * g + r3])};
                    const f32x2 ww = {wv[0][4 * g + r3], wv[1][4 * g + r3]};
                    p += ww * rl;
                }
                const auto sw = __builtin_amdgcn_permlane32_swap(__float_as_uint(p[0]), __float_as_uint(p[1]), false, false);
                const float sc_ = __uint_as_float(sw[0]) + __uint_as_float(sw[1]);
                const unsigned bits = __float_as_uint(sc_ + 0.0f);
                unsigned k = bits ^ ((unsigned)((int)bits >> 31) | 0x80000000u);
                k = (key <= s0 + 4 * h + g) ? k : 0u;
                SC[(4 * h + g) * SC_LD + key] = k;
                kmax[g] = max(kmax[g], k); kmin[g] = min(kmin[g], k ? k : 0xffffffffu);
            }
        }
#pragma unroll
        for (int tt = 0; tt < 2; ++tt)
#pragma unroll
            for (int ks = 0; ks < 4; ++ks) kb[tt][ks] = kn[tt][ks];
    }
#pragma unroll
    for (int g = 0; g < 4; ++g) {
#pragma unroll
        for (int o = 16; o >= 1; o >>= 1) { kmin[g] = min(kmin[g], (unsigned)__shfl_xor((int)kmin[g], o)); kmax[g] = max(kmax[g], (unsigned)__shfl_xor((int)kmax[g], o)); }
        if (l31 == 0) { atomicMin(&QMM[4 * h + g], kmin[g]); atomicMax(&QMM[8 + 4 * h + g], kmax[g]); }
    }
    if (!last) dsa_prefetch(c, a, b, s0 + 8, pf);
    __syncthreads();
    {
        const int qi = __builtin_amdgcn_readfirstlane(s0 + c.wave), n = qi + 1;
        const unsigned* sc = SC + c.wave * SC_LD + c.lane;
        unsigned* hist = HIST + c.wave * 272;
        const int nit = (n + 63) >> 6;
        {
            unsigned* scw = SC + c.wave * SC_LD + c.lane;
            for (int it = nit; it < ((nit + 7) & ~7); ++it) scw[it * 64] = 0u;
        }
        unsigned thr = 1u; int cut = 0x7fffffff;
        if (n > 256) {
            unsigned lo = (unsigned)__builtin_amdgcn_readfirstlane((int)QMM[c.wave]), hi = (unsigned)__builtin_amdgcn_readfirstlane((int)QMM[8 + c.wave]);
            const unsigned lo_full = lo, hi_full = hi;
            bool filtered = false;
            {
                const int m = (int)(32768.f / (float)n) + 6;
                if (m < 60) {
                    const int sidx = (c.lane * 13 + 5) % nit;
                    const unsigned smp = sc[sidx * 64];
                    int rank = 0;
#pragma unroll
                    for (int j = 0; j < 64; ++j) { const unsigned sj = (unsigned)__builtin_amdgcn_readlane((int)smp, j); rank += (sj > smp) ? 1 : 0; }
                    unsigned cand = (rank <= m - 1) ? smp : 0xffffffffu;
#pragma unroll
                    for (int o = 32; o >= 1; o >>= 1) cand = min(cand, (unsigned)__shfl_xor((int)cand, o));
                    const unsigned L = (unsigned)__builtin_amdgcn_readfirstlane((int)cand);
                    if (L > lo && L <= hi) { lo = L; filtered = true; }
                }
            }
            int kk = 256;
            for (int iter = 0; iter < 6; ++iter) {
                const unsigned width = hi - lo;
                const int shift = max(0, 24 - (int)__clz(width | 1u));
#pragma unroll
                for (int j = 0; j < 5; ++j) { const int idx = c.lane + 64 * j; if (idx < 272) hist[idx] = 0u; }
#pragma unroll 1
                for (int it0 = 0; it0 < nit; it0 += 8) {
                    unsigned kv[8];
#pragma unroll
                    for (int j = 0; j < 8; ++j) kv[j] = sc[(it0 + j) * 64];
#pragma unroll
                    for (int j = 0; j < 8; ++j) {
                        const unsigned d = kv[j] - lo;
                        if (d <= width) atomicAdd(&hist[d >> shift], 1u);
                    }
                }
                const unsigned c0 = hist[4 * c.lane], c1 = hist[4 * c.lane + 1], c2 = hist[4 * c.lane + 2], c3 = hist[4 * c.lane + 3];
                const unsigned ls = c0 + c1 + c2 + c3;
                unsigned suf = ls;
#pragma unroll
                for (int o = 1; o < 64; o <<= 1) { const unsigned tv = __shfl_down(suf, o); if (c.lane + o < 64) suf += tv; }
                if (filtered) {
                    filtered = false;
                    if ((unsigned)__builtin_amdgcn_readfirstlane((int)suf) < (unsigned)kk) { lo = lo_full; hi = hi_full; continue; }
                }
                const unsigned above_lane = suf - ls;
                const bool mine = (suf >= (unsigned)kk) && (above_lane < (unsigned)kk);
                int bstar = 0; unsigned above = 0, cntb = 0;
                if (mine) {
                    unsigned run = above_lane;
                    if (run + c3 >= (unsigned)kk) { bstar = 4 * c.lane + 3; above = run; cntb = c3; }
                    else { run += c3;
                        if (run + c2 >= (unsigned)kk) { bstar = 4 * c.lane + 2; above = run; cntb = c2; }
                        else { run += c2;
                            if (run + c1 >= (unsigned)kk) { bstar = 4 * c.lane + 1; above = run; cntb = c1; }
                            else { run += c1; bstar = 4 * c.lane; above = run; cntb = c0; } } }
                }
                const u64 mm = __ballot(mine);
                const int src = __ffsll((long long)mm) - 1;
                bstar = __shfl(bstar, src); above = __shfl(above, src); cntb = __shfl(cntb, src);
                kk -= (int)above;
                const unsigned nlo = lo + ((unsigned)bstar << shift);
                const unsigned nhi = min(hi, nlo + ((1u << shift) - 1u));
                lo = nlo; hi = nhi; thr = lo;
                if ((int)cntb == kk) break;
                if (shift == 0) {
                    int need = kk;
                    for (int it = 0; it < nit; ++it) {
                        const unsigned k = sc[it * 64];
                        const bool e = (k == thr);
                        const u64 mk = __ballot(e); const int cn = __popcll(mk);
                        if (need <= cn) {
                            const u64 sel = __ballot(e && (__popcll(mk & ((1ull << c.lane) - 1ull)) == need - 1));
                            cut = it * 64 + (__ffsll((long long)sel) - 1);
                            break;
                        }
                        need -= cn;
                    }
                    break;
                }
            }
        }
        u64* mrow = mask + (size_t)(b * 4096 + qi) * 64;
        const bool tie = (cut != 0x7fffffff);
#pragma unroll 1
        for (int it0 = 0; it0 < 64; it0 += 8) {
            u64 wsel = 0;
            if (it0 < nit) {
                unsigned kv[8];
#pragma unroll
                for (int j = 0; j < 8; ++j) kv[j] = sc[(it0 + j) * 64];
#pragma unroll
                for (int j = 0; j < 8; ++j) {
                    const unsigned k = kv[j];
                    bool sel = (k >= thr);
                    if (tie) sel = (k > thr) || (k == thr && ((it0 + j) * 64 + c.lane) <= cut);
                    const u64 wd = __ballot(sel);
                    wsel = (c.lane == j) ? wd : wsel;
                }
            }
            if (c.lane < 8) mrow[it0 + c.lane] = wsel;
        }
    }
    __syncthreads();
}

DI void phase_outproj(const Ctx& c_in, KArgs& a, int l) {
    const Ctx c = fresh_ctx(c_in.lds);
    unsigned char* ws = a.ws;
    const u16* act = (const u16*)(ws + WS_ACT);
    const u16* w = (const u16*)(ws + WS_WOUT) + (size_t)l * 1024 * 1024;
    const float* xin = (l == 0) ? a.in[0] : a.out;
    float* out = a.out;
    int R, C; g2_stage_rc(c.tid * 16, R, C);
    const int nunits = (T_TOK / 256) * 4;
    for (int u = vblock(); u < nunits; u += gridDim.x) {
        const int pm = (u >> 4) * 4 + (u & 3), pn = (u >> 2) & 3;
        G2Ptrs g;
        g.ra = g2_rsrc(act); g.rb = g2_rsrc(w);
        g.va00 = (unsigned)(R * 1024 + C) * 2u; g.va01 = g.va00 + 64 * 2048; g.va10 = g.va00 + 128 * 2048; g.va11 = g.va00 + 192 * 2048;
        g.vb0 = g.va00; g.vb1 = g.va01;
        g.sa = (unsigned)pm * (256u * 2048u); g.sb0 = (unsigned)pn * (256u * 2048u); g.sb1 = g.sb0 + 128u * 2048u;
        __syncthreads();
        gemm256_unit(c, g, 1024, [&](const f32x4 (&acc)[2][2][4][2], int wr, int wc, int fr, int fq) {
#pragma unroll
            for (int ai = 0; ai < 2; ++ai)
#pragma unroll
                for (int m = 0; m < 4; ++m) {
                    const size_t rowoff = (size_t)(pm * 256 + ai * 128 + wr * 64 + m * 16 + fr) * 1024 + pn * 256 + wc * 32 + 4 * fq;
#pragma unroll
                    for (int bj = 0; bj < 2; ++bj)
#pragma unroll
                        for (int n = 0; n < 2; ++n) {
                            const f32x4 xv = *(const f32x4*)(xin + rowoff + bj * 128 + n * 16);
                            *(f32x4*)(out + rowoff + bj * 128 + n * 16) = xv + acc[ai][bj][m][n];
                        }
                }
        });
    }
}

constexpr int RT_LD = 1032;
DI void phase_router(const Ctx& c_in, KArgs& a, int l) {
    const Ctx c = fresh_ctx(c_in.lds);
    unsigned char* ws = a.ws;
    const float* x = a.out;
    const float* g = a.in[16] + l * 1024;
    const float* brg = a.in[18] + l * 4;
    const float* bre = a.in[20] + l * 32;
    const u16* wrh = (const u16*)(ws + WS_WRH) + (size_t)l * 64 * 1024;
    const u16* wrl = (const u16*)(ws + WS_WRL) + (size_t)l * 64 * 1024;
    u16* act = (u16*)(ws + WS_ACT);
    int* cnt = (int*)(ws + WS_CTL);
    int* list = (int*)(ws + WS_LIST);
    float* tokw = (float*)(ws + WS_TOKW);
    u16* HI = (u16*)c.lds;
    u16* LO = HI + 32 * RT_LD;
    float* LG = (float*)(c.lds + 2 * 32 * RT_LD * 2);
    const int l31 = c.lane & 31, h = c.lane >> 5;
    for (int it = bid(); it < T_TOK / 32; it += gridDim.x) {
        const int t0 = it * 32;
#pragma unroll
        for (int tt = 0; tt < 4; ++tt) {
            const int tl = c.wave * 4 + tt, t = t0 + tl;
            const float* xr = x + (size_t)t * 1024 + c.lane * 4;
            float4 v[4]; float ss = 0.f;
#pragma unroll
            for (int j = 0; j < 4; ++j) { v[j] = *(const float4*)(xr + 256 * j); ss += v[j].x * v[j].x + v[j].y * v[j].y + v[j].z * v[j].z + v[j].w * v[j].w; }
            ss = wsum(ss);
            const float rs = rsqrtf(ss * (1.f / 1024.f) + EPS);
#pragma unroll
            for (int j = 0; j < 4; ++j) {
                const float4 gg = *(const float4*)(g + c.lane * 4 + 256 * j);
                const float h0 = v[j].x * rs * gg.x, h1 = v[j].y * rs * gg.y, h2 = v[j].z * rs * gg.z, h3 = v[j].w * rs * gg.w;
                const u16 b0 = f2bf(h0), b1 = f2bf(h1), b2 = f2bf(h2), b3 = f2bf(h3);
                const uint2 hp = make_uint2((unsigned)b0 | ((unsigned)b1 << 16), (unsigned)b2 | ((unsigned)b3 << 16));
                const uint2 lp = make_uint2(pack2(h0 - bf2f(b0), h1 - bf2f(b1)), pack2(h2 - bf2f(b2), h3 - bf2f(b3)));
                *(uint2*)(act + (size_t)t * 1024 + c.lane * 4 + 256 * j) = hp;
                *(uint2*)(HI + tl * RT_LD + c.lane * 4 + 256 * j) = hp;
                *(uint2*)(LO + tl * RT_LD + c.lane * 4 + 256 * j) = lp;
            }
        }
        __syncthreads();
        {
            const int k0 = c.wave * 128 + h * 8;
            f32x16 acc0 = zero16(), acc1 = zero16();
#pragma unroll
            for (int ks = 0; ks < 8; ++ks) {
                const int k = k0 + ks * 16;
                const bf16x8 ah = *(const bf16x8*)(HI + l31 * RT_LD + k);
                const bf16x8 al = *(const bf16x8*)(LO + l31 * RT_LD + k);
                const bf16x8 bh0 = *(const bf16x8*)(wrh + (size_t)l31 * 1024 + k);
                const bf16x8 bh1 = *(const bf16x8*)(wrh + (size_t)(32 + l31) * 1024 + k);
                const bf16x8 bl0 = *(const bf16x8*)(wrl + (size_t)l31 * 1024 + k);
                const bf16x8 bl1 = *(const bf16x8*)(wrl + (size_t)(32 + l31) * 1024 + k);
                acc0 = MFMA32(ah, bh0, acc0); acc0 = MFMA32(ah, bl0, acc0); acc0 = MFMA32(al, bh0, acc0);
                acc1 = MFMA32(ah, bh1, acc1); acc1 = MFMA32(ah, bl1, acc1); acc1 = MFMA32(al, bh1, acc1);
            }
            __syncthreads();
            float* PART = (float*)c.lds + c.wave * (32 * 37);
#pragma unroll
            for (int r = 0; r < 16; ++r) {
                PART[crow(r, h) * 37 + l31] = acc0[r];
                if (l31 < 4) PART[crow(r, h) * 37 + 32 + l31] = acc1[r];
            }
        }
        __syncthreads();
        for (int i = c.tid; i < 32 * 36; i += NTHR) {
            const int tk = i / 36, e = i % 36;
            float s = 0.f;
#pragma unroll
            for (int w2 = 0; w2 < 8; ++w2) s += ((const float*)c.lds)[w2 * (32 * 37) + tk * 37 + e];
            LG[tk * 65 + e] = s;
        }
        __syncthreads();
        int* lcnt = (int*)(LG + 32 * 65);
        if (c.tid < 64) lcnt[c.tid] = 0;
        __syncthreads();
        int myL1 = 0, myL2 = 0, r1 = 0, r2 = 0; float w1 = 0.f, w2 = 0.f;
        if (c.tid < 32) {
            const float* lg = LG + c.tid * 65;
            float gl[4];
#pragma unroll
            for (int e = 0; e < 4; ++e) gl[e] = lg[e] + brg[e];
            int gi = 0; float gm = gl[0];
#pragma unroll
            for (int e = 1; e < 4; ++e) if (gl[e] > gm) { gm = gl[e]; gi = e; }
            float den = 0.f;
#pragma unroll
            for (int e = 0; e < 4; ++e) den += __expf(gl[e] - gm);
            const float gp = 1.f / den;
            float el[8];
#pragma unroll
            for (int e = 0; e < 8; ++e) el[e] = lg[4 + gi * 8 + e] + bre[gi * 8 + e];
            int i1 = 0; float v1 = el[0];
#pragma unroll
            for (int e = 1; e < 8; ++e) if (el[e] > v1) { v1 = el[e]; i1 = e; }
            int i2 = 0; float v2 = -INFINITY;
#pragma unroll
            for (int e = 0; e < 8; ++e) if (e != i1 && el[e] > v2) { v2 = el[e]; i2 = e; }
            const float ex = __expf(v2 - v1);
            w1 = gp / (1.f + ex); w2 = gp * ex / (1.f + ex);
            myL1 = (gi * 8 + i1) * 2; myL2 = (gi * 8 + i2) * 2 + 1;
            r1 = atomicAdd(&lcnt[myL1], 1); r2 = atomicAdd(&lcnt[myL2], 1);
        }
        __syncthreads();
        if (c.tid < 64) { const int n = lcnt[c.tid]; lcnt[c.tid] = (n > 0) ? atomicAdd(&cnt[c.tid], n) : 0; }
        __syncthreads();
        if (c.tid < 32) {
            const int t = t0 + c.tid;
            list[(size_t)myL1 * 32768 + lcnt[myL1] + r1] = t;
            list[(size_t)myL2 * 32768 + lcnt[myL2] + r2] = t;
            tokw[t * 2] = w1; tokw[t * 2 + 1] = w2;
        }
        __syncthreads();
    }
}

DI int moe_setup(const Ctx& c, KArgs& a, int ntn, int kfilter, int* tstart  ) {
    const int* cnt = (const int*)(a.ws + WS_CTL);
    if (c.tid < 64) {
        const int L = c.tid;
        const int n = __hip_atomic_load(&cnt[L], __ATOMIC_RELAXED, __HIP_MEMORY_SCOPE_AGENT);
        const int mine = (kfilter < 0 || (L & 1) == kfilter) ? ((n + 255) >> 8) * ntn : 0;
        int inc = mine;
#pragma unroll
        for (int o = 1; o < 64; o <<= 1) { const int tv = __shfl_up(inc, o); if (L >= o) inc += tv; }
        tstart[L] = inc - mine;
        if (L == 63) tstart[64] = inc;
    }
    __syncthreads();
    return tstart[64];
}

constexpr int MOE_LDS_OFF = G2_LDS_BYTES;
DI void phase_moe_up(const Ctx& c_in, KArgs& a) {
    const Ctx c = fresh_ctx(c_in.lds);
    unsigned char* ws = a.ws;
    const u16* act = (const u16*)(ws + WS_ACT);
    const int* cnt = (const int*)(ws + WS_CTL);
    const int* list = (const int*)(ws + WS_LIST);
    const float* tokw = (const float*)(ws + WS_TOKW);
    u16* hmid = (u16*)(ws + WS_HMID);
    int* tstart = (int*)(c.lds + MOE_LDS_OFF);
    int* tok_s = (int*)(c.lds + MOE_LDS_OFF + 512);
    int R, C; g2_stage_rc(c.tid * 16, R, C);
    const int total = moe_setup(c, a, 2, -1, tstart);
    for (int tile = vblock(); tile < total; tile += gridDim.x) {
        int L = 0;
        for (int j = 0; j < 64; ++j) if (tstart[j + 1] <= tile) L = j + 1;
        const int rel = tile - tstart[L], mi = rel >> 1, nt = rel & 1;
        const int e = L >> 1, kr = L & 1;
        const int n = __hip_atomic_load(&cnt[L], __ATOMIC_RELAXED, __HIP_MEMORY_SCOPE_AGENT);
        __syncthreads();
        if (c.tid < 256) { const int r = mi * 256 + c.tid; tok_s[c.tid] = (r < n) ? list[(size_t)L * 32768 + r] : -1; }
        __syncthreads();
        G2Ptrs g;
        g.ra = g2_rsrc(act); g.rb = g2_rsrc(ws + WS_WG);
        { const int t0 = tok_s[R], t1 = tok_s[R + 64], t2 = tok_s[R + 128], t3 = tok_s[R + 192];
          g.va00 = (unsigned)((t0 < 0 ? 0 : t0) * 1024 + C) * 2u; g.va01 = (unsigned)((t1 < 0 ? 0 : t1) * 1024 + C) * 2u;
          g.va10 = (unsigned)((t2 < 0 ? 0 : t2) * 1024 + C) * 2u; g.va11 = (unsigned)((t3 < 0 ? 0 : t3) * 1024 + C) * 2u; }
        g.vb0 = (unsigned)(R * 1024 + C) * 2u; g.vb1 = g.vb0 + 64 * 2048;
        g.sa = 0u; g.sb0 = (unsigned)(e * 256 + nt * 128) * 2048u; g.sb1 = g.sb0 + (unsigned)(WS_WU - WS_WG);
        gemm256_unit(c, g, 1024, [&](const f32x4 (&acc)[2][2][4][2], int wr, int wc, int fr, int fq) {
#pragma unroll
            for (int ai = 0; ai < 2; ++ai)
#pragma unroll
                for (int m = 0; m < 4; ++m) {
                    const int tk = tok_s[ai * 128 + wr * 64 + m * 16 + fr];
                    if (tk >= 0) {
                        const float wgt = tokw[tk * 2 + kr];
                        u16* dst = hmid + ((size_t)tk * 2 + kr) * 256 + nt * 128 + wc * 32 + 4 * fq;
#pragma unroll
                        for (int n2 = 0; n2 < 2; ++n2) {
                            const f32x4 gv = acc[ai][0][m][n2], uv = acc[ai][1][m][n2];
                            uint2 pk;
                            pk.x = pack2(siluf(gv[0]) * uv[0] * wgt, siluf(gv[1]) * uv[1] * wgt);
                            pk.y = pack2(siluf(gv[2]) * uv[2] * wgt, siluf(gv[3]) * uv[3] * wgt);
                            *(uint2*)(dst + n2 * 16) = pk;
                        }
                    }
                }
        });
    }
}

DI void phase_moe_down(const Ctx& c_in, KArgs& a) {
    const Ctx c = fresh_ctx(c_in.lds);
    unsigned char* ws = a.ws;
    const int* cnt = (const int*)(ws + WS_CTL);
    const int* list = (const int*)(ws + WS_LIST);
    const u16* hmid = (const u16*)(ws + WS_HMID);
    u16* yffn = (u16*)(ws + WS_YFFN);
    int* tstart = (int*)(c.lds + MOE_LDS_OFF);
    int* tok_s = (int*)(c.lds + MOE_LDS_OFF + 512);
    int R, C; g2_stage_rc(c.tid * 16, R, C);
    const int total = moe_setup(c, a, 4, -1, tstart);
    for (int tile = vblock(); tile < total; tile += gridDim.x) {
        int L = 0;
        for (int j = 0; j < 64; ++j) if (tstart[j + 1] <= tile) L = j + 1;
        const int rel = tile - tstart[L], mi = rel >> 2, nt = rel & 3;
        const int e = L >> 1, kr = L & 1;
        const int n = __hip_atomic_load(&cnt[L], __ATOMIC_RELAXED, __HIP_MEMORY_SCOPE_AGENT);
        __syncthreads();
        if (c.tid < 256) { const int r = mi * 256 + c.tid; tok_s[c.tid] = (r < n) ? list[(size_t)L * 32768 + r] : -1; }
        __syncthreads();
        G2Ptrs g;
        g.ra = g2_rsrc(hmid); g.rb = g2_rsrc(ws + WS_WD);
        { const int t0 = tok_s[R], t1 = tok_s[R + 64], t2 = tok_s[R + 128], t3 = tok_s[R + 192];
          g.va00 = (unsigned)(((t0 < 0 ? 0 : t0) * 2 + kr) * 256 + C) * 2u; g.va01 = (unsigned)(((t1 < 0 ? 0 : t1) * 2 + kr) * 256 + C) * 2u;
          g.va10 = (unsigned)(((t2 < 0 ? 0 : t2) * 2 + kr) * 256 + C) * 2u; g.va11 = (unsigned)(((t3 < 0 ? 0 : t3) * 2 + kr) * 256 + C) * 2u; }
        g.vb0 = (unsigned)(R * 256 + C) * 2u; g.vb1 = g.vb0 + 64 * 512;
        g.sa = 0u; g.sb0 = (unsigned)(e * 1024 + nt * 256) * 512u; g.sb1 = g.sb0 + 128u * 512u;
        gemm256_unit(c, g, 256, [&](const f32x4 (&acc)[2][2][4][2], int wr, int wc, int fr, int fq) {
#pragma unroll
            for (int ai = 0; ai < 2; ++ai)
#pragma unroll
                for (int m = 0; m < 4; ++m) {
                    const int tk = tok_s[ai * 128 + wr * 64 + m * 16 + fr];
                    if (tk >= 0) {
                        u16* dst = yffn + ((size_t)tk * 2 + kr) * 1024 + nt * 256 + wc * 32 + 4 * fq;
#pragma unroll
                        for (int bj = 0; bj < 2; ++bj)
#pragma unroll
                            for (int n2 = 0; n2 < 2; ++n2) {
                                const f32x4 v = acc[ai][bj][m][n2];
                                uint2 pk; pk.x = pack2(v[0], v[1]); pk.y = pack2(v[2], v[3]);
                                *(uint2*)(dst + bj * 128 + n2 * 16) = pk;
                            }
                    }
                }
        });
    }
}

DI void phase_final(const Ctx& c_in, KArgs& a) {
    const Ctx c = fresh_ctx(c_in.lds);
    float* x = a.out;
    const float* g = a.in[24];
    for (int it = bid(); it < T_TOK / 16; it += gridDim.x) {
#pragma unroll
        for (int tt = 0; tt < 2; ++tt) {
            const int t = it * 16 + c.wave * 2 + tt;
            float* xr = x + (size_t)t * 1024 + c.lane * 4;
            const u16* y0 = (const u16*)(a.ws + WS_YFFN) + (size_t)t * 2048 + c.lane * 4;
            float4 v[4]; float ss = 0.f;
#pragma unroll
            for (int j = 0; j < 4; ++j) {
                v[j] = *(const float4*)(xr + 256 * j);
                const uint2 ya = *(const uint2*)(y0 + 256 * j), yb = *(const uint2*)(y0 + 1024 + 256 * j);
                v[j].x += bf2f((u16)(ya.x & 0xffff)) + bf2f((u16)(yb.x & 0xffff)); v[j].y += bf2f((u16)(ya.x >> 16)) + bf2f((u16)(yb.x >> 16));
                v[j].z += bf2f((u16)(ya.y & 0xffff)) + bf2f((u16)(yb.y & 0xffff)); v[j].w += bf2f((u16)(ya.y >> 16)) + bf2f((u16)(yb.y >> 16));
                ss += v[j].x * v[j].x + v[j].y * v[j].y + v[j].z * v[j].z + v[j].w * v[j].w;
            }
            ss = wsum(ss);
            const float rs = rsqrtf(ss * (1.f / 1024.f) + EPS);
#pragma unroll
            for (int j = 0; j < 4; ++j) {
                const float4 gg = *(const float4*)(g + c.lane * 4 + 256 * j);
                *(float4*)(xr + 256 * j) = make_float4(v[j].x * rs * gg.x, v[j].y * rs * gg.y, v[j].z * rs * gg.z, v[j].w * rs * gg.w);
            }
        }
    }
}

#define XB_TMO      128
#define XB_XCNT(j)  (256  + 64 * (j))
#define XB_XSUB(j)  (1280 + 64 * (j))
#define XB_XGEN(j)  (2304 + 64 * (j))
#define XB_TOP      3328
#define XB_TOPGEN   3392
#define XCD_BAR_WORDS 3456
#define XB_SPIN_CAP (1u << 22)
#define LAS __attribute__((address_space(3)))
DI unsigned xb_ld(unsigned* p)              { return __hip_atomic_load(p, __ATOMIC_RELAXED, __HIP_MEMORY_SCOPE_AGENT); }
DI unsigned xb_add(unsigned* p, unsigned v) { return __hip_atomic_fetch_add(p, v, __ATOMIC_RELAXED, __HIP_MEMORY_SCOPE_AGENT); }
DI unsigned xb_xcc_id() { return (unsigned)__builtin_amdgcn_s_getreg((3 << 11) | 20) & 0xFu; }
#define XB_SPIN(cond, bar) do { unsigned _sp = 0; while (cond) { __builtin_amdgcn_s_sleep(1); \
    if ((++_sp & 255u) == 0u) { if (xb_ld(&(bar)[XB_TMO])) break; if (_sp > XB_SPIN_CAP) { atomicAdd(&(bar)[XB_TMO], 1u); break; } } } } while (0)
struct XcdBarrier { unsigned* bar; unsigned x; volatile LAS unsigned* st; };
DI XcdBarrier xcd_barrier_post(unsigned* bar, volatile LAS unsigned* st) {
    XcdBarrier b; b.bar = bar; b.x = xb_xcc_id(); b.st = st;
    if (threadIdx.x == 0) (void)xb_add(&bar[XB_XCNT(b.x)], 1u);
    return b;
}
DI void xcd_barrier_complete(unsigned* bar, unsigned x, unsigned& nloc, unsigned& nx) {
    const unsigned G = gridDim.x * gridDim.y * gridDim.z;
    unsigned sum, cnt, mine, sp = 0u;
    for (;;) {
        sum = 0u; cnt = 0u; mine = 0u;
#pragma unroll
        for (unsigned j = 0; j < 16; ++j) { const unsigned cc = xb_ld(&bar[XB_XCNT(j)]); sum += cc; cnt += (cc > 0u) ? 1u : 0u; mine = (j == x) ? cc : mine; }
        if (sum == G) break;
        __builtin_amdgcn_s_sleep(1);
        if ((++sp & 255u) == 0u) { if (xb_ld(&bar[XB_TMO])) break; if (sp > XB_SPIN_CAP) { atomicAdd(&bar[XB_TMO], 1u); break; } }
    }
    nloc = mine > 0u ? mine : 1u; nx = cnt > 0u ? cnt : 1u;
}
DI void xcd_barrier(const XcdBarrier& b) {
    asm volatile("s_waitcnt vmcnt(0)" ::: "memory");
    __syncthreads();
    if (threadIdx.x == 0) {
        unsigned* bar = b.bar;
        __builtin_amdgcn_s_waitcnt(0);
        unsigned nloc = b.st[0], nx = b.st[1];
        if (nloc == 0u) { xcd_barrier_complete(bar, b.x, nloc, nx); b.st[0] = nloc; b.st[1] = nx; }
        const unsigned old = xb_add(&bar[XB_XSUB(b.x)], 1u);
        const unsigned gen = old / nloc;
        if (old + 1u == (gen + 1u) * nloc) {
            __builtin_amdgcn_fence(__ATOMIC_RELEASE, "agent");
            asm volatile("s_waitcnt vmcnt(0)" ::: "memory");
            const unsigned og = xb_add(&bar[XB_TOP], 1u);
            const unsigned tg = og / nx;
            if (og + 1u == (tg + 1u) * nx) xb_add(&bar[XB_TOPGEN], 1u);
            else XB_SPIN(xb_ld(&bar[XB_TOPGEN]) == tg, bar);
            __builtin_amdgcn_fence(__ATOMIC_ACQUIRE, "agent");
            xb_add(&bar[XB_XGEN(b.x)], 1u);
            asm volatile("s_waitcnt vmcnt(0)" ::: "memory");
        } else {
            XB_SPIN(xb_ld(&bar[XB_XGEN(b.x)]) == gen, bar);
            __builtin_amdgcn_fence(__ATOMIC_ACQUIRE, "agent");
            asm volatile("s_waitcnt vmcnt(0)" ::: "memory");
        }
    }
    __syncthreads();
}

template <int SP>
DI void run_phase(const Ctx& c, KArgs& a, int l) {
    if constexpr (SP == 11) phase_prep(c, a);
    else if constexpr (SP == 12) phase_final(c, a);
    else if constexpr (SP == 0) phase_norm_in(c, a, l);
    else if constexpr (SP == 1) phase_inproj(c, a, l);
    else if constexpr (SP == 2) {
        const int n_ssd = 256, n_q = 256, n_kv = 256;
        for (int it = bid(); it < n_ssd + n_q + n_kv; it += gridDim.x) {
            if (it < n_ssd) ssd_state_item(c, a, l, it);
            else if (it < n_ssd + n_q) mla_up_unit(c, a, l, 0, it - n_ssd);
            else mla_up_unit(c, a, l, 1, it - n_ssd - n_q);
        }
    }
    else if constexpr (SP == 3) { for (int it = bid(); it < 512; it += gridDim.x) ssd_scan_item(c, a, it); }
    else if constexpr (SP == 4) {
        int* ctr = (int*)(a.ws + WS_CTL) + 256 + l;
        volatile int* s_item = (volatile int*)(c.lds + LDS_BYTES - 32);
        for (;;) {
            __syncthreads();
            if (threadIdx.x == 0) *s_item = atomicAdd(ctr, 1);
            __syncthreads();
            const int it = *s_item;
            if (it >= 1024 + 512 + 256 + 768) break;
            if (it < 1024) {
                const int j = 15 - (it >> 6), r = it & 63;
                if (r >= 8 && r < 40) { const int rem = r - 8; attn_item<96, 0>(c, a, l, rem >> 2, rem & 3, j); }
                else {
                    const int sub = (r < 8) ? 3 : 2 - ((r - 40) >> 3);
                    const int b = r & 7, qb = 4 * j + sub;
                    { DsaPref pf; dsa_prefetch(fresh_ctx(c.lds), a, b, qb * 64, pf);
                      for (int g8 = 0; g8 < 8; ++g8) dsa_index_item(c, a, b, qb * 64 + g8 * 8, pf, g8 == 7); }
                    asm volatile("s_waitcnt vmcnt(0)" ::: "memory");
                    __syncthreads();
                    attn_item<64, 2>(c, a, l, b, 0, qb);
                }
            } else if (it < 1536) { const int i2 = it - 1024; attn_item<64, 1>(c, a, l, (i2 & 31) >> 2, i2 & 3, 15 - (i2 >> 5)); }
            else if (it < 1792) ssd_out_item(c, a, l, it - 1536);
            else { const Ctx cc = fresh_ctx(c.lds); expert_conv_item(cc, a, l, (it - 1792) * 2); expert_conv_item(cc, a, l, (it - 1792) * 2 + 1); }
        }
    }
    else if constexpr (SP == 5) phase_outproj(c, a, l);
    else if constexpr (SP == 6) phase_router(c, a, l);
    else if constexpr (SP == 7) phase_moe_up(c, a);
    else if constexpr (SP == 8) phase_moe_down(c, a);
}

#ifndef ONE_LAUNCH
#define ONE_LAUNCH 1
#endif

#if ONE_LAUNCH
__global__ void __launch_bounds__(NTHR) mega(Args a_unused) {
    extern __shared__ __attribute__((aligned(16))) unsigned char lds[];
    cg::grid_group grid = cg::this_grid();
    Ctx c; c.tid = threadIdx.x; c.lane = c.tid & 63; c.wave = 0; c.lds = lds;
    volatile LAS unsigned* st = (volatile LAS unsigned*)(lds + LDS_BYTES - 16);
    if (threadIdx.x == 0) { st[0] = 0u; st[1] = 0u; }
    __syncthreads();
    XcdBarrier bar = xcd_barrier_post((unsigned*)(a_unused.ws + WS_BAR), st);
#ifdef PROBE_SP
#define MEGA_PHASE(SPN, L) do { KArgs* kp_ = (KArgs*)__builtin_amdgcn_kernarg_segment_ptr(); asm volatile("" : "+s"(kp_)); \
        const unsigned long long pt0_ = __builtin_amdgcn_s_memrealtime(); run_phase<SPN>(c, *kp_, (L)); \
        if (SPN == PROBE_SP) { xcd_barrier(bar); const unsigned long long pt1_ = __builtin_amdgcn_s_memrealtime(); \
            while (__builtin_amdgcn_s_memrealtime() - pt1_ < (pt1_ - pt0_)) __builtin_amdgcn_s_sleep(8); } } while (0)
#else
#define MEGA_PHASE(SPN, L) do { KArgs* kp_ = (KArgs*)__builtin_amdgcn_kernarg_segment_ptr(); asm volatile("" : "+s"(kp_)); run_phase<SPN>(c, *kp_, (L)); } while (0)
#endif
    MEGA_PHASE(11, 0);
    grid.sync();
#pragma unroll 1
    for (int l = 0; l < DEPTH; ++l) {
        if (l > 0) xcd_barrier(bar);
        MEGA_PHASE(0, l); xcd_barrier(bar);
        MEGA_PHASE(1, l); xcd_barrier(bar);
        MEGA_PHASE(2, l); xcd_barrier(bar);
        MEGA_PHASE(3, l); xcd_barrier(bar);
        MEGA_PHASE(4, l); xcd_barrier(bar);
        MEGA_PHASE(5, l); xcd_barrier(bar);
        MEGA_PHASE(6, l); xcd_barrier(bar);
        MEGA_PHASE(7, l); xcd_barrier(bar);
        MEGA_PHASE(8, l);
    }
    xcd_barrier(bar);
    MEGA_PHASE(12, 0);
}
#else
template <int SP>
__global__ void __launch_bounds__(NTHR) kphase(Args a, int l) {
    extern __shared__ __attribute__((aligned(16))) unsigned char lds[];
    Ctx c; c.tid = threadIdx.x; c.lane = c.tid & 63; c.wave = __builtin_amdgcn_readfirstlane(c.tid >> 6); c.lds = lds;
    KArgs* kp = (KArgs*)__builtin_amdgcn_kernarg_segment_ptr();
    run_phase<SP>(c, *kp, l);
}
template <int SP>
static void launch_phase(const Args& a, int l, int grid, hipStream_t stream) {
    static bool attr_set = false;
    if (!attr_set) { (void)hipFuncSetAttribute((const void*)kphase<SP>, hipFuncAttributeMaxDynamicSharedMemorySize, LDS_BYTES); attr_set = true; }
    hipLaunchKernelGGL(kphase<SP>, dim3(grid), dim3(NTHR), LDS_BYTES, stream, a, l);
}
#endif

extern "C" void kernel_launch(void* const* d_in, const int* in_sizes, int n_in, void* d_out, int out_size, void* d_ws, size_t ws_size, hipStream_t stream) {
    static int grid = 0;
    if (grid == 0) {
        if (n_in != 25 || ws_size < WS_END) { fprintf(stderr, "kernel_launch: unexpected inputs (n_in %d, ws %zu, need %zu)\n", n_in, ws_size, (size_t)WS_END); grid = -1; return; }
        int dev = 0, cus = 0;
        (void)hipGetDevice(&dev);
        (void)hipDeviceGetAttribute(&cus, hipDeviceAttributeMultiprocessorCount, dev);
        if (cus <= 0) cus = 256;
#if ONE_LAUNCH
        int per_cu = 0;
        if (hipFuncSetAttribute((const void*)mega, hipFuncAttributeMaxDynamicSharedMemorySize, LDS_BYTES) != hipSuccess) { fprintf(stderr, "kernel_launch: hipFuncSetAttribute failed\n"); grid = -1; return; }
        if (hipOccupancyMaxActiveBlocksPerMultiprocessor(&per_cu, (const void*)mega, NTHR, LDS_BYTES) != hipSuccess || per_cu < 1) { fprintf(stderr, "kernel_launch: occupancy query says %d blocks per CU\n", per_cu); (void)hipGetLastError(); grid = -1; return; }
        grid = cus;
#else
        grid = cus;
#endif
    }
    if (grid < 0) return;
    Args a{};
    for (int i = 0; i < 25; ++i) a.in[i] = (const float*)d_in[i];
    a.out = (float*)d_out; a.ws = (unsigned char*)d_ws;
    for (int i = 0; i < 8; ++i) a.inv16[i] = (float)pow(500000.0, -(double)i / 8.0);
    for (int i = 0; i < 16; ++i) a.inv32[i] = (float)pow(500000.0, -(double)i / 16.0);
    a.ph_lo = 0; a.ph_hi = 0;
#if ONE_LAUNCH
    (void)hipMemsetAsync((unsigned char*)d_ws + WS_CTL, 0, WS_CTL_BYTES, stream);
    void* kargs[] = { &a };
    hipError_t e = hipLaunchCooperativeKernel((const void*)mega, dim3(grid), dim3(NTHR), kargs, LDS_BYTES, stream);
    if (e != hipSuccess) fprintf(stderr, "kernel_launch: cooperative launch failed: %s (grid %d)\n", hipGetErrorString(e), grid);
#else
    launch_phase<11>(a, 0, grid, stream);
    for (int l = 0; l < DEPTH; ++l) {
        launch_phase<0>(a, l, grid, stream);
        launch_phase<1>(a, l, grid, stream);
        launch_phase<2>(a, l, grid, stream);
        launch_phase<3>(a, l, grid, stream);
        launch_phase<4>(a, l, grid, stream);
        launch_phase<5>(a, l, grid, stream);
        launch_phase<6>(a, l, grid, stream);
        launch_phase<7>(a, l, grid, stream);
        launch_phase<8>(a, l, grid, stream);
    }
    launch_phase<12>(a, 0, grid, stream);
#endif
}
```

```cpp
#include <hip/hip_runtime.h>
#include <hip/hip_cooperative_groups.h>
#include <cstdio>
#include <cmath>
#include <cstdint>


namespace cg = cooperative_groups;

typedef __attribute__((ext_vector_type(8))) short bf16x8;
typedef __attribute__((ext_vector_type(4))) short bf16x4;
typedef __attribute__((ext_vector_type(16))) float f32x16;
typedef unsigned short u16;
typedef unsigned long long u64;

#define DI __device__ __forceinline__
#define MFMA32(a, b, c) __builtin_amdgcn_mfma_f32_32x32x16_bf16((a), (b), (c), 0, 0, 0)

constexpr int T_TOK = 32768, SEQ = 4096, NB = 8, DM = 1024, DEPTH = 2;
constexpr int NREF = 3184;
constexpr int NPAD = 3328;
constexpr int LDP = 2848;
constexpr int PC_Z = 0, PC_XBC = 256, PC_DSAQ = 1024, PC_CQ = 1280, PC_CKV = 1536, PC_DSAK = 1664, PC_IDXK = 1728, PC_IDXQ = 1792,
              PC_KR = 2304, PC_FOXQ = 2336, PC_FOXK = 2592;
constexpr int NC_DSAV = 2848, NC_FOXV = 2912, NC_SMALL = 3168;
constexpr float EPS = 1e-6f;
constexpr float LOG2E = 1.4426950408889634f;
constexpr int NTHR = 512;
constexpr int LDS_BYTES = 159744;

constexpr size_t al256(size_t x) { return (x + 255) & ~(size_t)255; }
constexpr size_t WS_CTL   = 0;
constexpr size_t WS_BAR   = 4096;
constexpr size_t WS_CTL_BYTES = 32768;
constexpr size_t WS_WIN   = 32768;
constexpr size_t WS_WUQ   = WS_WIN  + (size_t)2 * NPAD * 1024 * 2;
constexpr size_t WS_WUKV  = WS_WUQ  + (size_t)2 * 512 * 256 * 2;
constexpr size_t WS_WOUT  = WS_WUKV + (size_t)2 * 512 * 128 * 2;
constexpr size_t WS_WG    = WS_WOUT + (size_t)2 * 1024 * 1024 * 2;
constexpr size_t WS_WU    = WS_WG   + (size_t)32 * 256 * 1024 * 2;
constexpr size_t WS_WD    = WS_WU   + (size_t)32 * 256 * 1024 * 2;
constexpr size_t WS_TRIG  = WS_WD   + (size_t)32 * 256 * 1024 * 2;
constexpr size_t WS_ACT   = WS_TRIG + (size_t)T_TOK * 48 * 4;
constexpr size_t WS_PROJ  = WS_ACT  + (size_t)T_TOK * 1024 * 2;
constexpr size_t WS_SMALL = WS_PROJ + (size_t)T_TOK * LDP * 2;
constexpr size_t WS_MLAQ  = WS_SMALL + (size_t)T_TOK * 16 * 4;
constexpr size_t WS_MLAK  = WS_MLAQ + (size_t)T_TOK * 384 * 2;
constexpr size_t WS_MLAVT = WS_MLAK + (size_t)T_TOK * 384 * 2;
constexpr size_t WS_DSAVT = WS_MLAVT + (size_t)T_TOK * 256 * 2;
constexpr size_t WS_FOXVT = WS_DSAVT + (size_t)T_TOK * 64 * 2;
constexpr size_t WS_FLOG  = WS_FOXVT + (size_t)T_TOK * 256 * 2;
constexpr size_t WS_CDEC  = WS_FLOG + (size_t)T_TOK * 4 * 4;
constexpr size_t WS_MASK  = WS_CDEC + 4096;
constexpr size_t WS_TOKW  = WS_MASK + (size_t)T_TOK * 64 * 8;
constexpr size_t WS_WRH   = WS_TOKW + (size_t)T_TOK * 2 * 4;
constexpr size_t WS_WRL   = WS_WRH + (size_t)2 * 64 * 1024 * 2;
constexpr size_t WS_KF    = WS_WRL + (size_t)2 * 64 * 1024 * 2;
constexpr size_t WS_RSQ   = WS_KF + (size_t)T_TOK * 64 * 2;
constexpr size_t WS_RSKV  = WS_RSQ + (size_t)T_TOK * 4;
constexpr size_t WS_XB    = WS_RSKV + (size_t)T_TOK * 4;
constexpr size_t WS_END   = WS_XB + (size_t)T_TOK * 1024 * 2;
constexpr size_t WS_LIST  = WS_PROJ;
constexpr size_t WS_HMID  = WS_PROJ + (size_t)64 * 32768 * 4;
constexpr size_t WS_YFFN  = WS_HMID + (size_t)T_TOK * 512 * 2;
static_assert(WS_YFFN + (size_t)T_TOK * 2048 * 2 <= WS_SMALL, "aliases must fit in PROJ");
static_assert(WS_END <= (size_t)512 * 1024 * 1024, "workspace budget");

struct Args {
    const float* in[25];
    float* out;
    unsigned char* ws;
    float inv16[8];
    float inv32[16];
    int ph_lo, ph_hi;
};

typedef const __attribute__((address_space(4))) Args KArgs;
struct Ctx { int tid, lane, wave; unsigned char* lds; };
__device__ __forceinline__ Ctx fresh_ctx(unsigned char* lds) {
    int t = threadIdx.x; asm volatile("" : "+v"(t));
    Ctx c; c.tid = t; c.lane = t & 63; c.wave = __builtin_amdgcn_readfirstlane(t >> 6); c.lds = lds; return c;
}

typedef __attribute__((ext_vector_type(2))) float f32x2;
typedef __attribute__((ext_vector_type(2))) __bf16 bf16x2_t;
DI u16 f2bf(float x) { return __builtin_bit_cast(u16, (__bf16)x); }
DI float bf2f(u16 h) { return __uint_as_float(((unsigned)h) << 16); }
DI unsigned pack2(float a, float b) { f32x2 v = {a, b}; return __builtin_bit_cast(unsigned, __builtin_convertvector(v, bf16x2_t)); }
DI float ex2(float x) { return __builtin_amdgcn_exp2f(x); }
DI float relu_raw(float x) { float r; asm("v_max_f32 %0, 0, %1" : "=v"(r) : "v"(x)); return r; }
DI float max3f(float a, float b, float c) { float r; asm("v_max3_f32 %0, %1, %2, %3" : "=v"(r) : "v"(a), "v"(b), "v"(c)); return r; }
template <int CTRL, int ROWMASK> DI float dppf0(float x) { return __int_as_float(__builtin_amdgcn_update_dpp(0, __float_as_int(x), CTRL, ROWMASK, 0xf, false)); }
DI float wsum(float v) {
    v += dppf0<0x111, 0xf>(v); v += dppf0<0x112, 0xf>(v); v += dppf0<0x114, 0xf>(v); v += dppf0<0x118, 0xf>(v);
    v += dppf0<0x142, 0xa>(v); v += dppf0<0x143, 0xc>(v);
    return __int_as_float(__builtin_amdgcn_readlane(__float_as_int(v), 63));
}
DI float wmaxf(float v) { for (int o = 32; o >= 1; o >>= 1) v = fmaxf(v, __shfl_xor(v, o)); return v; }
DI float wminf(float v) { for (int o = 32; o >= 1; o >>= 1) v = fminf(v, __shfl_xor(v, o)); return v; }
template <int CTRL, int ROWMASK = 0xf>
DI unsigned dpp0(unsigned x) { return (unsigned)__builtin_amdgcn_update_dpp(0, (int)x, CTRL, ROWMASK, 0xf, false); }
DI unsigned wscan_add(unsigned x) {
    x += dpp0<0x111>(x); x += dpp0<0x112>(x); x += dpp0<0x114>(x); x += dpp0<0x118>(x);
    x += dpp0<0x142, 0xa>(x); x += dpp0<0x143, 0xc>(x);
    return x;
}
DI float4 bf4_to_f4(uint2 p) { return make_float4(__uint_as_float(p.x << 16), __uint_as_float(p.x & 0xffff0000u), __uint_as_float(p.y << 16), __uint_as_float(p.y & 0xffff0000u)); }
typedef unsigned u32x2nt __attribute__((ext_vector_type(2)));
DI float4 ldnt_f4(const float* p) { const auto t = __builtin_nontemporal_load((const __attribute__((ext_vector_type(4))) float*)p); return make_float4(t[0], t[1], t[2], t[3]); }
DI uint2 ldnt_u2(const u16* p) { const u32x2nt t = __builtin_nontemporal_load((const u32x2nt*)p); return make_uint2(t[0], t[1]); }
typedef unsigned u32x4nt __attribute__((ext_vector_type(4)));
DI float siluf(float x) { return x * __builtin_amdgcn_rcpf(1.f + __expf(-x)); }
DI float softplusf(float x) { return fmaxf(x, 0.f) + __logf(1.f + __expf(-fabsf(x))); }
DI int crow(int reg, int h) { return (reg & 3) + 8 * (reg >> 2) + 4 * h; }
DI bf16x8 pack8(const f32x16& x, int s) {
    uint4 p;
    p.x = pack2(x[8 * s + 0], x[8 * s + 1]); p.y = pack2(x[8 * s + 2], x[8 * s + 3]);
    p.z = pack2(x[8 * s + 4], x[8 * s + 5]); p.w = pack2(x[8 * s + 6], x[8 * s + 7]);
    return __builtin_bit_cast(bf16x8, p);
}
DI f32x16 zero16() { f32x16 z; for (int i = 0; i < 16; ++i) z[i] = 0.f; return z; }

DI int ref_col(int n) {
    if (n < 1024) return n;
    if (n < 1280) return n - 1024 + 1028;
    if (n < 1536) return n - 1280 + 1996;
    if (n < 1664) return n - 1536 + 2252;
    if (n < 1728) return n - 1664 + 1284;
    if (n < 1792) return n - 1728 + 1924;
    if (n < 2304) return n - 1792 + 1412;
    if (n < 2336) return n - 2304 + 2380;
    if (n < 2592) return n - 2336 + 2412;
    if (n < 2848) return n - 2592 + 2668;
    if (n < 2912) return n - 2848 + 1348;
    if (n < 3168) return n - 2912 + 2924;
    if (n < 3172) return n - 3168 + 1024;
    if (n < 3180) return n - 3172 + 1988;
    if (n < 3184) return n - 3180 + 3180;
    return -1;
}

DI int bid() { int b = blockIdx.x; asm volatile("" : "+s"(b)); return b; }
DI int vblock() { const int G = gridDim.x, bx = bid(); return (G % 8 == 0) ? (bx % 8) * (G / 8) + bx / 8 : bx; }

typedef __attribute__((ext_vector_type(4))) float f32x4;
#define LAS3 __attribute__((address_space(3)))
constexpr int G2_HTB = 128 * 64 * 2;
constexpr int G2_LDS_BYTES = 8 * G2_HTB;
DI int g2_lds_byte(int r, int cc0) { const int st = (r >> 4) * 2 + (cc0 >> 5), rr = r & 15, cc = cc0 & 31, ob = rr * 64 + cc * 2; return st * 1024 + (ob ^ (((ob >> 9) & 1) << 5)); }
DI void g2_stage_rc(int b, int& R, int& C) { const int st = b / 1024, sb = b % 1024, swz = sb ^ (((sb >> 9) & 1) << 5); R = (st >> 1) * 16 + swz / 64; C = (st & 1) * 32 + (swz % 64) / 2; }

DI int g2_perm32(int r) { return (r & ~31) + 8 * ((r >> 2) & 3) + 4 * ((r >> 4) & 1) + (r & 3); }
struct G2Ptrs { __amdgpu_buffer_rsrc_t ra, rb; unsigned va00, va01, va10, va11, vb0; unsigned sa, sb0, sb1, dsa, dsb; };
DI __amdgpu_buffer_rsrc_t g2_rsrc(const void* p) { return __builtin_amdgcn_make_buffer_rsrc((void*)p, 0, 0x7ffffff0, 0x00020000); }

template <class EPI>
DI void gemm256_unit(const Ctx& c, const G2Ptrs& g, int K, EPI&& epi) {
    LAS3 unsigned char* lds = (LAS3 unsigned char*)c.lds;
    const int wid = c.wave, lane = c.lane, wr = wid >> 2, wc = wid & 3, fr = lane & 15, fq = lane >> 4;
    const unsigned ldsw = (unsigned)wid * 1024u;
    const int aoff = g2_lds_byte(wr * 64 + fr, fq * 8), boff = g2_lds_byte(wc * 32 + fr, fq * 8);
#define G2_SA(b, h) (((b) * 2 + (h)) * G2_HTB)
#define G2_SB(b, h) ((4 + (b) * 2 + (h)) * G2_HTB)
#define G2_STAGE(bufoff, rs, v0, v1, so0, so1) do { \
        __builtin_amdgcn_raw_ptr_buffer_load_lds((rs), (LAS3 unsigned*)(lds + (bufoff) + ldsw), 16, (v0), (so0), 0, 0); \
        __builtin_amdgcn_raw_ptr_buffer_load_lds((rs), (LAS3 unsigned*)(lds + (bufoff) + ldsw + 8192), 16, (v1), (so1), 0, 0); } while (0)
#define G2_STA0(b, kt) G2_STAGE(G2_SA(b, 0), g.ra, g.va00, g.va01, g.sa + (unsigned)(kt) * 128u, g.sa + (unsigned)(kt) * 128u + g.dsa)
#define G2_STA1(b, kt) G2_STAGE(G2_SA(b, 1), g.ra, g.va10, g.va11, g.sa + (unsigned)(kt) * 128u + 2u * g.dsa, g.sa + (unsigned)(kt) * 128u + 3u * g.dsa)
#define G2_STB0(b, kt) G2_STAGE(G2_SB(b, 0), g.rb, g.vb0, g.vb0, g.sb0 + (unsigned)(kt) * 128u, g.sb0 + (unsigned)(kt) * 128u + g.dsb)
#define G2_STB1(b, kt) G2_STAGE(G2_SB(b, 1), g.rb, g.vb0, g.vb0, g.sb1 + (unsigned)(kt) * 128u, g.sb1 + (unsigned)(kt) * 128u + g.dsb)
#define G2_LDA(dst, b, h) do { _Pragma("unroll") for (int m = 0; m < 4; ++m) _Pragma("unroll") for (int k = 0; k < 2; ++k) dst[m][k] = *(const LAS3 bf16x8*)(lds + G2_SA(b, h) + aoff + m * 2048 + k * 1024); } while (0)
#define G2_LDB(dst, b, h) do { _Pragma("unroll") for (int n = 0; n < 2; ++n) _Pragma("unroll") for (int k = 0; k < 2; ++k) dst[n][k] = *(const LAS3 bf16x8*)(lds + G2_SB(b, h) + boff + n * 2048 + k * 1024); } while (0)
#define G2_MMA(ai, bj, At_, Bt_) do { __builtin_amdgcn_s_setprio(1); \
        _Pragma("unroll") for (int m = 0; m < 4; ++m) _Pragma("unroll") for (int n = 0; n < 2; ++n) _Pragma("unroll") for (int k = 0; k < 2; ++k) \
            acc[ai][bj][m][n] = __builtin_amdgcn_mfma_f32_16x16x32_bf16(Bt_[n][k], At_[m][k], acc[ai][bj][m][n], 0, 0, 0); \
        __builtin_amdgcn_s_setprio(0); } while (0)
#define G2_WAIT_V(n) asm volatile("s_waitcnt vmcnt(" #n ")" ::: "memory")
#define G2_WAIT_L(n) asm volatile("s_waitcnt lgkmcnt(" #n ")" ::: "memory")
#define G2_BAR __builtin_amdgcn_s_barrier()
#define G2_SCHED __builtin_amdgcn_sched_barrier(0)
    f32x4 acc[2][2][4][2];
#pragma unroll
    for (int i0 = 0; i0 < 2; ++i0)
#pragma unroll
        for (int i1 = 0; i1 < 2; ++i1)
#pragma unroll
            for (int i2 = 0; i2 < 4; ++i2)
#pragma unroll
                for (int i3 = 0; i3 < 2; ++i3) acc[i0][i1][i2][i3] = (f32x4){0.f, 0.f, 0.f, 0.f};
    bf16x8 At[4][2], B0[2][2], B1[2][2];
    int nt = K / 64; asm volatile("" : "+s"(nt));
    G2_STB0(0, 0); G2_STA0(0, 0); G2_STB1(0, 0); G2_STA1(0, 0);
    if (wr == 1) G2_BAR;
    G2_WAIT_V(4); G2_BAR;
    G2_STB0(1, 1); G2_STA0(1, 1); G2_STB1(1, 1);
    G2_WAIT_V(6); G2_BAR;
    for (int t = 0; t < nt - 2; t += 2) {
        G2_LDB(B0, 0, 0); G2_SCHED; G2_LDA(At, 0, 0); G2_STA1(1, t + 1);
        G2_WAIT_L(8); G2_BAR; G2_WAIT_L(0); G2_MMA(0, 0, At, B0); G2_BAR; G2_SCHED;
        G2_LDB(B1, 0, 1); G2_STB0(0, t + 2);
        G2_BAR; G2_WAIT_L(0); G2_MMA(0, 1, At, B1); G2_BAR;
        G2_LDA(At, 0, 1); G2_STA0(0, t + 2);
        G2_BAR; G2_WAIT_L(0); G2_MMA(1, 0, At, B0); G2_BAR; G2_SCHED;
        G2_STB1(0, t + 2);
        G2_WAIT_V(6); G2_BAR; G2_MMA(1, 1, At, B1); G2_BAR;
        G2_LDB(B0, 1, 0); G2_SCHED; G2_LDA(At, 1, 0); G2_STA1(0, t + 2);
        G2_WAIT_L(8); G2_BAR; G2_WAIT_L(0); G2_MMA(0, 0, At, B0); G2_BAR; G2_SCHED;
        G2_LDB(B1, 1, 1); G2_STB0(1, t + 3);
        G2_BAR; G2_WAIT_L(0); G2_MMA(0, 1, At, B1); G2_BAR;
        G2_LDA(At, 1, 1); G2_STA0(1, t + 3);
        G2_BAR; G2_WAIT_L(0); G2_MMA(1, 0, At, B0); G2_BAR; G2_SCHED;
        G2_STB1(1, t + 3);
        G2_WAIT_V(6); G2_BAR; G2_MMA(1, 1, At, B1); G2_BAR;
    }
    { G2_LDB(B0, 0, 0); G2_LDA(At, 0, 0); G2_STA1(1, nt - 1);
      G2_BAR; G2_WAIT_L(0); G2_MMA(0, 0, At, B0); G2_BAR;
      G2_LDB(B1, 0, 1); G2_BAR; G2_WAIT_L(0); G2_MMA(0, 1, At, B1); G2_BAR;
      G2_LDA(At, 0, 1); G2_WAIT_V(4); G2_BAR; G2_WAIT_L(0); G2_MMA(1, 0, At, B0); G2_MMA(1, 1, At, B1); G2_BAR; }
    { G2_LDB(B0, 1, 0); G2_LDA(At, 1, 0); G2_WAIT_V(2); G2_BAR; G2_WAIT_L(0); G2_MMA(0, 0, At, B0); G2_BAR;
      G2_LDB(B1, 1, 1); G2_WAIT_V(0); G2_BAR; G2_WAIT_L(0); G2_MMA(0, 1, At, B1); G2_BAR;
      G2_LDA(At, 1, 1); G2_BAR; G2_WAIT_L(0); G2_MMA(1, 0, At, B0); G2_MMA(1, 1, At, B1); G2_BAR; }
    if (wr == 0) G2_BAR;
    { int ln_ = threadIdx.x & 63; asm volatile("" : "+v"(ln_));
      epi(acc, wr, wc, ln_ & 15, ln_ >> 4); }
#undef G2_SA
#undef G2_SB
#undef G2_STAGE
#undef G2_STA0
#undef G2_STA1
#undef G2_STB0
#undef G2_STB1
#undef G2_LDA
#undef G2_LDB
#undef G2_MMA
#undef G2_WAIT_V
#undef G2_WAIT_L
#undef G2_BAR
#undef G2_SCHED
}

DI void xpose_tile(const Ctx& c, const float* in, int ld_in, int k0, int n0, int colmode, const float* kscale, u16* out, int ld_out) {
    float* tile = (float*)c.lds;
    {
        const int j4 = (c.tid & 15) * 4, r0 = c.tid >> 4;
        const int rc = colmode ? ref_col(n0 + j4) : n0 + j4;
#pragma unroll
        for (int rr = 0; rr < 2; ++rr) {
            const int kk = r0 + 32 * rr;
            float4 v = make_float4(0.f, 0.f, 0.f, 0.f);
            if (rc >= 0) v = ldnt_f4(in + (size_t)(k0 + kk) * ld_in + rc);
            if (kscale) { const float s = kscale[k0 + kk]; v.x *= s; v.y *= s; v.z *= s; v.w *= s; }
            *(float4*)(tile + kk * 68 + j4) = v;
        }
    }
    __syncthreads();
    {
        const int jj = c.tid >> 3, k8 = (c.tid & 7) * 8;
        uint4 pk;
        pk.x = pack2(tile[(k8 + 0) * 68 + jj], tile[(k8 + 1) * 68 + jj]);
        pk.y = pack2(tile[(k8 + 2) * 68 + jj], tile[(k8 + 3) * 68 + jj]);
        pk.z = pack2(tile[(k8 + 4) * 68 + jj], tile[(k8 + 5) * 68 + jj]);
        pk.w = pack2(tile[(k8 + 6) * 68 + jj], tile[(k8 + 7) * 68 + jj]);
        *(uint4*)(out + (size_t)(n0 + jj) * ld_out + k0 + k8) = pk;
    }
    __syncthreads();
}

DI void xpose_tile8(const Ctx& c, const float* in, int ld_in, int k0, int n0, int colmode, u16* out, int ld_out) {
    float* tile = (float*)c.lds;
    const int j4 = (c.tid & 15) * 4, r0 = c.tid >> 4;
    const int rc = colmode ? ref_col(n0 + j4) : n0 + j4;
    float4 v[8][2];
#pragma unroll
    for (int i = 0; i < 8; ++i)
#pragma unroll
        for (int rr = 0; rr < 2; ++rr) {
            v[i][rr] = make_float4(0.f, 0.f, 0.f, 0.f);
            if (rc >= 0) v[i][rr] = ldnt_f4(in + (size_t)(k0 + i * 64 + r0 + 32 * rr) * ld_in + rc);
        }
#pragma unroll
    for (int i = 0; i < 8; ++i)
#pragma unroll
        for (int rr = 0; rr < 2; ++rr) *(float4*)(tile + i * (64 * 68) + (r0 + 32 * rr) * 68 + j4) = v[i][rr];
    __syncthreads();
    const int jj = c.tid >> 3, k8 = (c.tid & 7) * 8;
#pragma unroll
    for (int i = 0; i < 8; ++i) {
        const float* tl = tile + i * (64 * 68);
        uint4 pk;
        pk.x = pack2(tl[(k8 + 0) * 68 + jj], tl[(k8 + 1) * 68 + jj]);
        pk.y = pack2(tl[(k8 + 2) * 68 + jj], tl[(k8 + 3) * 68 + jj]);
        pk.z = pack2(tl[(k8 + 4) * 68 + jj], tl[(k8 + 5) * 68 + jj]);
        pk.w = pack2(tl[(k8 + 6) * 68 + jj], tl[(k8 + 7) * 68 + jj]);
        *(uint4*)(out + (size_t)(n0 + jj) * ld_out + k0 + i * 64 + k8) = pk;
    }
    __syncthreads();
}

DI void phase_prep(const Ctx& c_in, KArgs& a) {
    const Ctx c = fresh_ctx(c_in.lds);
    unsigned char* ws = a.ws;
    const int n_win = 2 * 52 * 2;
    const int n_wuq = 2 * 8 * 4;
    const int n_wukv = 2 * 8 * 2;
    const int n_wout = 2 * 16 * 2;
    const int n_trig = T_TOK * 24 / NTHR;
    const int n_wr = 2 * 64 * 1024 / NTHR;
    const int total = n_win + n_wuq + n_wukv + n_wout + n_trig + n_wr;
    for (int it = bid(); it < total; it += gridDim.x) {
        int i = it;
        if (i < n_win) {
            const int l = i / 104, r = i % 104, nt = r / 2, kg = r % 2;
            xpose_tile8(c, a.in[3] + (size_t)l * 1024 * NREF, NREF, kg * 512, nt * 64, 1, (u16*)(ws + WS_WIN) + (size_t)l * NPAD * 1024, 1024);
            continue;
        }
        i -= n_win;
        if (i < n_wuq) {
            const int l = i / 32, r = i % 32, nt = r / 4, kt = r % 4;
            u16* dst = (u16*)(ws + WS_WUQ) + (size_t)l * 512 * 256;
            if (nt < 6) xpose_tile(c, a.in[11] + (size_t)l * 256 * 384, 384, kt * 64, nt * 64, 0, a.in[10] + l * 256, dst, 256);
            else { const int jj = c.tid >> 3, k8 = (c.tid & 7) * 8; *(uint4*)(dst + (size_t)(nt * 64 + jj) * 256 + kt * 64 + k8) = make_uint4(0, 0, 0, 0); }
            continue;
        }
        i -= n_wuq;
        if (i < n_wukv) {
            const int l = i / 16, r = i % 16, nt = r / 2, kt = r % 2;
            xpose_tile(c, a.in[13] + (size_t)l * 128 * 512, 512, kt * 64, nt * 64, 0, a.in[12] + l * 128, (u16*)(ws + WS_WUKV) + (size_t)l * 512 * 128, 128);
            continue;
        }
        i -= n_wukv;
        if (i < n_wout) {
            const int l = i / 32, r = i % 32, nt = r / 2, kg = r % 2;
            xpose_tile8(c, a.in[15] + (size_t)l * 1024 * 1024, 1024, kg * 512, nt * 64, 0, (u16*)(ws + WS_WOUT) + (size_t)l * 1024 * 1024, 1024);
            continue;
        }
        i -= n_wout;
        if (i >= n_trig) {
            const int e = (i - n_trig) * NTHR + c.tid;
            const int l = e >> 16, n = (e >> 10) & 63, k = e & 1023;
            float v = 0.f;
            if (n < 4) v = a.in[17][((size_t)l * 1024 + k) * 4 + n];
            else if (n < 36) v = a.in[19][((size_t)l * 1024 + k) * 32 + (n - 4)];
            const u16 hi = f2bf(v);
            const size_t fo = ((((size_t)l * 2 + (n >> 5)) * 64 + (k >> 4)) * 64 + (((k >> 3) & 1) * 32 + (n & 31))) * 8 + (k & 7);
            ((u16*)(ws + WS_WRH))[fo] = hi;
            ((u16*)(ws + WS_WRL))[fo] = f2bf(v - bf2f(hi));
            continue;
        }
        {
            const int e = i * NTHR + c.tid;
            const int t = e / 24, j = e % 24;
            const int pos = ((const int*)a.in[1])[t];
            const float inv = (j < 8) ? a.inv16[j] : a.inv32[j - 8];
            const float ang = (float)pos * inv;
            const double ad = (double)ang;
            const double r = ad - 6.283185307179586476925 * rint(ad * 0.15915494309189533577);
            const float rf = (float)r;
            const float cs = cosf(rf), sn = sinf(rf);
            float* trig = (float*)(ws + WS_TRIG) + (size_t)t * 48;
            if (j < 8) { trig[j] = cs; trig[8 + j] = sn; } else { trig[16 + (j - 8)] = cs; trig[32 + (j - 8)] = sn; }
        }
    }
}

constexpr int NCONV_PRE = 384;
DI void expert_conv_item(const Ctx& c, KArgs& a, int l, int it) {
    unsigned char* ws = a.ws;
    const int which = it / 256, r = it % 256, e = r / 8, grp = (r % 8) * 2;
    const float* src; u16* dst; int ld_in, ld_out, k0[8], n0[8];
    if (which < 2) {
        src = a.in[21 + which] + ((size_t)l * 32 + e) * 1024 * 256; dst = (u16*)(ws + (which == 0 ? WS_WG : WS_WU)) + (size_t)e * 256 * 1024; ld_in = 256; ld_out = 1024;
#pragma unroll
        for (int i = 0; i < 8; ++i) { n0[i] = (grp >> 2) * 64; k0[i] = ((grp & 3) * 4 + i) * 64; }
    } else {
        src = a.in[23] + ((size_t)l * 32 + e) * 256 * 1024; dst = (u16*)(ws + WS_WD) + (size_t)e * 1024 * 256; ld_in = 1024; ld_out = 256;
#pragma unroll
        for (int i = 0; i < 8; ++i) { n0[i] = (grp + (i >> 2)) * 64; k0[i] = (i & 3) * 64; }
    }
    float* tile = (float*)c.lds;
    const int j4 = (c.tid & 15) * 4, r0 = c.tid >> 4;
    float4 v[8][2];
#pragma unroll
    for (int i = 0; i < 8; ++i)
#pragma unroll
        for (int rr = 0; rr < 2; ++rr) {
            const f32x4 t_ = __builtin_nontemporal_load((const f32x4*)(src + (size_t)(k0[i] + r0 + 32 * rr) * ld_in + n0[i] + j4));
            v[i][rr] = make_float4(t_[0], t_[1], t_[2], t_[3]);
        }
#pragma unroll
    for (int i = 0; i < 8; ++i)
#pragma unroll
        for (int rr = 0; rr < 2; ++rr) *(float4*)(tile + i * (64 * 68) + (r0 + 32 * rr) * 68 + j4) = v[i][rr];
    __syncthreads();
    const int jj = c.tid >> 3, k8 = (c.tid & 7) * 8;
#pragma unroll
    for (int i = 0; i < 8; ++i) {
        const float* tl = tile + i * (64 * 68);
        uint4 pk;
        pk.x = pack2(tl[(k8 + 0) * 68 + jj], tl[(k8 + 1) * 68 + jj]);
        pk.y = pack2(tl[(k8 + 2) * 68 + jj], tl[(k8 + 3) * 68 + jj]);
        pk.z = pack2(tl[(k8 + 4) * 68 + jj], tl[(k8 + 5) * 68 + jj]);
        pk.w = pack2(tl[(k8 + 6) * 68 + jj], tl[(k8 + 7) * 68 + jj]);
        { const u32x4nt t_ = {pk.x, pk.y, pk.z, pk.w}; __builtin_nontemporal_store(t_, (u32x4nt*)(dst + (size_t)(n0[i] + jj) * ld_out + k0[i] + k8)); }
    }
    __syncthreads();
}

DI void phase_norm_in(const Ctx& c_in, KArgs& a, int l) {
    const Ctx c = fresh_ctx(c_in.lds);
    unsigned char* ws = a.ws;
    const float* x = a.in[0];
    u16* xb = (u16*)(ws + WS_XB);
    const float* g = a.in[2] + l * 1024;
    u16* act = (u16*)(ws + WS_ACT);
    if (bid() == 0 && c.tid < 192) ((int*)(ws + WS_CTL))[c.tid] = 0;
    float4 gg[4];
#pragma unroll
    for (int j = 0; j < 4; ++j) gg[j] = *(const float4*)(g + c.lane * 4 + 256 * j);
    const int nit = T_TOK / 16, G = gridDim.x;
    if (l == 0) {
        float4 cur[2][4];
        { const int i0 = min(bid(), nit - 1);
#pragma unroll
          for (int tt = 0; tt < 2; ++tt)
#pragma unroll
              for (int j = 0; j < 4; ++j) cur[tt][j] = ldnt_f4(x + (size_t)(i0 * 16 + c.wave * 2 + tt) * 1024 + c.lane * 4 + 256 * j); }
        for (int it = bid(); it < nit; it += G) {
            float4 nxt[2][4];
            const int in_ = min(it + G, nit - 1);
#pragma unroll
            for (int tt = 0; tt < 2; ++tt)
#pragma unroll
                for (int j = 0; j < 4; ++j) nxt[tt][j] = ldnt_f4(x + (size_t)(in_ * 16 + c.wave * 2 + tt) * 1024 + c.lane * 4 + 256 * j);
#pragma unroll
            for (int tt = 0; tt < 2; ++tt) {
                const int t = it * 16 + c.wave * 2 + tt;
                float ss = 0.f;
#pragma unroll
                for (int j = 0; j < 4; ++j) ss += cur[tt][j].x * cur[tt][j].x + cur[tt][j].y * cur[tt][j].y + cur[tt][j].z * cur[tt][j].z + cur[tt][j].w * cur[tt][j].w;
                ss = wsum(ss);
                const float rs = rsqrtf(ss * (1.f / 1024.f) + EPS);
#pragma unroll
                for (int j = 0; j < 4; ++j) {
                    uint2 pk; pk.x = pack2(cur[tt][j].x * rs * gg[j].x, cur[tt][j].y * rs * gg[j].y); pk.y = pack2(cur[tt][j].z * rs * gg[j].z, cur[tt][j].w * rs * gg[j].w);
                    *(uint2*)(act + (size_t)t * 1024 + c.lane * 4 + 256 * j) = pk;
                }
            }
#pragma unroll
            for (int tt = 0; tt < 2; ++tt)
#pragma unroll
                for (int j = 0; j < 4; ++j) cur[tt][j] = nxt[tt][j];
        }
    } else {
        const u16* yf = (const u16*)(ws + WS_YFFN);
        uint2 cx[2][4], cy0[2][4], cy1[2][4];
        { const int i0 = min(bid(), nit - 1);
#pragma unroll
          for (int tt = 0; tt < 2; ++tt)
#pragma unroll
              for (int j = 0; j < 4; ++j) {
                  const size_t t = (size_t)(i0 * 16 + c.wave * 2 + tt);
                  cx[tt][j] = ldnt_u2(xb + t * 1024 + c.lane * 4 + 256 * j);
                  cy0[tt][j] = ldnt_u2(yf + t * 2048 + c.lane * 4 + 256 * j); cy1[tt][j] = ldnt_u2(yf + t * 2048 + 1024 + c.lane * 4 + 256 * j);
              } }
        for (int it = bid(); it < nit; it += G) {
            uint2 nx[2][4], ny0[2][4], ny1[2][4];
            const int in_ = min(it + G, nit - 1);
#pragma unroll
            for (int tt = 0; tt < 2; ++tt)
#pragma unroll
                for (int j = 0; j < 4; ++j) {
                    const size_t t = (size_t)(in_ * 16 + c.wave * 2 + tt);
                    nx[tt][j] = ldnt_u2(xb + t * 1024 + c.lane * 4 + 256 * j);
                    ny0[tt][j] = ldnt_u2(yf + t * 2048 + c.lane * 4 + 256 * j); ny1[tt][j] = ldnt_u2(yf + t * 2048 + 1024 + c.lane * 4 + 256 * j);
                }
#pragma unroll
            for (int tt = 0; tt < 2; ++tt) {
                const int t = it * 16 + c.wave * 2 + tt;
                float4 v[4]; float ss = 0.f;
#pragma unroll
                for (int j = 0; j < 4; ++j) {
                    const float4 xf = bf4_to_f4(cx[tt][j]), y0f = bf4_to_f4(cy0[tt][j]), y1f = bf4_to_f4(cy1[tt][j]);
                    uint2 pk; pk.x = pack2(xf.x + (y0f.x + y1f.x), xf.y + (y0f.y + y1f.y)); pk.y = pack2(xf.z + (y0f.z + y1f.z), xf.w + (y0f.w + y1f.w));
                    { const u32x2nt t_ = {pk.x, pk.y}; __builtin_nontemporal_store(t_, (u32x2nt*)(xb + (size_t)t * 1024 + c.lane * 4 + 256 * j)); }
                    v[j] = bf4_to_f4(pk);
                    ss += v[j].x * v[j].x + v[j].y * v[j].y + v[j].z * v[j].z + v[j].w * v[j].w;
                }
                ss = wsum(ss);
                const float rs = rsqrtf(ss * (1.f / 1024.f) + EPS);
#pragma unroll
                for (int j = 0; j < 4; ++j) {
                    uint2 pk; pk.x = pack2(v[j].x * rs * gg[j].x, v[j].y * rs * gg[j].y); pk.y = pack2(v[j].z * rs * gg[j].z, v[j].w * rs * gg[j].w);
                    *(uint2*)(act + (size_t)t * 1024 + c.lane * 4 + 256 * j) = pk;
                }
            }
#pragma unroll
            for (int tt = 0; tt < 2; ++tt)
#pragma unroll
                for (int j = 0; j < 4; ++j) { cx[tt][j] = nx[tt][j]; cy0[tt][j] = ny0[tt][j]; cy1[tt][j] = ny1[tt][j]; }
        }
    }
}

DI void phase_inproj(const Ctx& c_in, KArgs& a, int l) {
    const Ctx c = fresh_ctx(c_in.lds);
    unsigned char* ws = a.ws;
    const u16* act = (const u16*)(ws + WS_ACT);
    const u16* w = (const u16*)(ws + WS_WIN) + (size_t)l * NPAD * 1024;
    u16* proj = (u16*)(ws + WS_PROJ);
    u16* dsavt = (u16*)(ws + WS_DSAVT);
    u16* foxvt = (u16*)(ws + WS_FOXVT);
    float* small = (float*)(ws + WS_SMALL);
    u16* mlak = (u16*)(ws + WS_MLAK);
    u16* kf = (u16*)(ws + WS_KF);
    const float* trig = (const float*)(ws + WS_TRIG);
    int R, C; g2_stage_rc(c.tid * 16, R, C);
    const int nunits = (T_TOK / 256) * 13;
    for (int u = vblock(); u < nunits; u += gridDim.x) {
        const int grp = u / 52, rr = u % 52;
        const int pm = grp * 4 + (rr & 3), pn = rr >> 2;
        G2Ptrs g;
        g.ra = g2_rsrc(act); g.rb = g2_rsrc(w);
        g.va00 = (unsigned)(R * 1024 + C) * 2u; g.va01 = g.va00; g.va10 = g.va00; g.va11 = g.va00; g.dsa = 64u * 2048u;
        const bool plain = (pn <= 3) || (pn == 5);
        g.vb0 = plain ? (unsigned)(g2_perm32(R) * 1024 + C) * 2u : g.va00; g.dsb = 64u * 2048u;
        g.sa = (unsigned)pm * (256u * 2048u); g.sb0 = (unsigned)pn * (256u * 2048u); g.sb1 = g.sb0 + 128u * 2048u;
        __syncthreads();
        gemm256_unit(c, g, 1024, [&](const f32x4 (&acc)[2][2][4][2], int wr, int wc, int fr, int fq) {
            if (plain) {
#pragma unroll
                for (int ai = 0; ai < 2; ++ai)
#pragma unroll
                    for (int m = 0; m < 4; ++m) {
                        u16* dst = proj + (size_t)(pm * 256 + ai * 128 + wr * 64 + m * 16 + fr) * LDP + pn * 256 + wc * 32 + 8 * fq;
#pragma unroll
                        for (int bj = 0; bj < 2; ++bj) {
                            const f32x4 v0 = acc[ai][bj][m][0], v1 = acc[ai][bj][m][1];
                            uint4 pk; pk.x = pack2(v0[0], v0[1]); pk.y = pack2(v0[2], v0[3]); pk.z = pack2(v1[0], v1[1]); pk.w = pack2(v1[2], v1[3]);
                            *(uint4*)(dst + bj * 128) = pk;
                        }
                    }
            } else
#pragma unroll
            for (int bj = 0; bj < 2; ++bj)
#pragma unroll
                for (int n = 0; n < 2; ++n) {
                    const int col0 = pn * 256 + bj * 128 + wc * 32 + n * 16;
                    if (col0 < LDP) {
                        const bool rope16 = ((col0 >= PC_DSAQ && col0 < PC_CQ) || (col0 >= PC_DSAK && col0 < PC_KR)) && ((col0 & 63) == 0);
                        const bool kr0 = (col0 == PC_KR), kr1 = (col0 == PC_KR + 16);
                        const bool foxk = (col0 >= PC_FOXK);
                        const bool idxk = (col0 >= PC_IDXK) && (col0 < PC_IDXK + 64);
                        float kmx = 0.f;
                        f32x4 tcs[2][4], tsn[2][4];
                        if (rope16 || kr0) {
                            const int toff = rope16 ? 4 * (fq & 1) : 16 + 4 * fq, tsn_off = rope16 ? 8 : 16;
#pragma unroll
                            for (int ai = 0; ai < 2; ++ai)
#pragma unroll
                                for (int m = 0; m < 4; ++m) {
                                    const float* tg = trig + (size_t)(pm * 256 + ai * 128 + wr * 64 + m * 16 + fr) * 48 + toff;
                                    tcs[ai][m] = *(const f32x4*)tg; tsn[ai][m] = *(const f32x4*)(tg + tsn_off);
                                }
                        }
#pragma unroll
                        for (int ai = 0; ai < 2; ++ai)
#pragma unroll
                            for (int m = 0; m < 4; ++m) {
                                const int row = pm * 256 + ai * 128 + wr * 64 + m * 16 + fr;
                                f32x4 v = acc[ai][bj][m][n];
                                if (rope16) {
                                    const f32x4 cs = tcs[ai][m], sn = tsn[ai][m];
                                    f32x4 pv;
#pragma unroll
                                    for (int j = 0; j < 4; ++j) pv[j] = __shfl_xor(v[j], 32);
                                    v = (fq < 2) ? (v * cs - pv * sn) : (v * cs + pv * sn);
                                }
                                if (kr0) {
                                    const f32x4 cs = tcs[ai][m], sn = tsn[ai][m];
                                    const f32x4 x2 = acc[ai][bj][m][1];
                                    const f32x4 o1 = v * cs - x2 * sn, o2 = x2 * cs + v * sn;
                                    uint2 p1, p2; p1.x = pack2(o1[0], o1[1]); p1.y = pack2(o1[2], o1[3]); p2.x = pack2(o2[0], o2[1]); p2.y = pack2(o2[2], o2[3]);
#pragma unroll
                                    for (int hd = 0; hd < 4; ++hd) {
                                        *(uint2*)(mlak + (size_t)row * 384 + hd * 96 + 64 + 4 * fq) = p1;
                                        *(uint2*)(mlak + (size_t)row * 384 + hd * 96 + 80 + 4 * fq) = p2;
                                    }
                                }
                                if (idxk) {
                                    uint2 pk; pk.x = pack2(v[0], v[1]); pk.y = pack2(v[2], v[3]);
                                    const int d0 = col0 - PC_IDXK + 4 * fq, bb = row >> 12, ss = row & 4095;
                                    *(uint2*)(kf + ((size_t)(((bb * 128 + (ss >> 5)) * 4 + (d0 >> 4)) * 64 + ((d0 >> 3) & 1) * 32 + (ss & 31))) * 8 + (d0 & 7)) = pk;
                                } else if (!kr0 && !kr1) {
                                    uint2 pk; pk.x = pack2(v[0], v[1]); pk.y = pack2(v[2], v[3]);
                                    *(uint2*)(proj + (size_t)row * LDP + col0 + 4 * fq) = pk;
                                    if (foxk) {
                                        const float b0 = bf2f((u16)(pk.x & 0xffff)), b1 = bf2f((u16)(pk.x >> 16)), b2 = bf2f((u16)(pk.y & 0xffff)), b3 = bf2f((u16)(pk.y >> 16));
                                        float ss = b0 * b0 + b1 * b1 + b2 * b2 + b3 * b3;
                                        ss += __shfl_xor(ss, 16); ss += __shfl_xor(ss, 32);
                                        kmx = fmaxf(kmx, ss);
                                    }
                                }
                            }
                        if (foxk) {
                            kmx = fmaxf(kmx, __shfl_xor(kmx, 1)); kmx = fmaxf(kmx, __shfl_xor(kmx, 2)); kmx = fmaxf(kmx, __shfl_xor(kmx, 4)); kmx = fmaxf(kmx, __shfl_xor(kmx, 8));
                            if (c.lane == 0) {
                                const int cc = col0 - PC_FOXK;
                                atomicMax((unsigned*)(ws + WS_CTL) + 64 + (((pm * 256) >> 12) * 4 + (cc >> 6)) * 4 + ((cc >> 4) & 3), __float_as_uint(kmx));
                            }
                        }
                    } else if (col0 < NC_SMALL) {
                        u16* vt = (col0 < NC_FOXV) ? dsavt + (size_t)(col0 - NC_DSAV + 4 * fq) * 4096 : foxvt + (size_t)(col0 - NC_FOXV + 4 * fq) * 4096;
                        const size_t bstride = (col0 < NC_FOXV) ? (size_t)64 * 4096 : (size_t)256 * 4096;
#pragma unroll
                        for (int ai = 0; ai < 2; ++ai)
#pragma unroll
                            for (int m = 0; m < 4; ++m) {
                                const int row = pm * 256 + ai * 128 + wr * 64 + m * 16 + fr;
                                u16* p = vt + (size_t)(row >> 12) * bstride + (row & 4095);
                                const f32x4 v = acc[ai][bj][m][n];
                                p[0] = f2bf(v[0]); p[4096] = f2bf(v[1]); p[2 * 4096] = f2bf(v[2]); p[3 * 4096] = f2bf(v[3]);
                            }
                    } else if (col0 == NC_SMALL) {
#pragma unroll
                        for (int ai = 0; ai < 2; ++ai)
#pragma unroll
                            for (int m = 0; m < 4; ++m) {
                                const int row = pm * 256 + ai * 128 + wr * 64 + m * 16 + fr;
                                const f32x4 v = acc[ai][bj][m][n];
                                *(f32x4*)(small + (size_t)row * 16 + 4 * fq) = v;
                                if (fq == 3) {
                                    float* fg = (float*)(ws + WS_FLOG) + (size_t)(row >> 12) * 4 * 4096 + (row & 4095);
                                    fg[0] = v[0]; fg[4096] = v[1]; fg[2 * 4096] = v[2]; fg[3 * 4096] = v[3];
                                }
                            }
                    }
                }
            if (pn == 5 || pn == 6) {
                float* part = (float*)c.lds;
#pragma unroll
                for (int ai = 0; ai < 2; ++ai)
#pragma unroll
                    for (int m = 0; m < 4; ++m) {
                        float ss = 0.f;
#pragma unroll
                        for (int bj = 0; bj < 2; ++bj)
#pragma unroll
                            for (int n = 0; n < 2; ++n) if (pn == 5 || bj == 0) {
                                const f32x4 v = acc[ai][bj][m][n];
#pragma unroll
                                for (int j = 0; j < 4; ++j) { const float bq = bf2f(f2bf(v[j])); ss += bq * bq; }
                            }
                        ss += __shfl_xor(ss, 16); ss += __shfl_xor(ss, 32);
                        if (fq == 0) part[(ai * 128 + wr * 64 + m * 16 + fr) * 4 + wc] = ss;
                    }
                __syncthreads();
                if (c.tid < 256) {
                    const float4 p4 = *(const float4*)(part + c.tid * 4);
                    const float s = p4.x + p4.y + p4.z + p4.w;
                    if (pn == 5) ((float*)(ws + WS_RSQ))[pm * 256 + c.tid] = rsqrtf(s * (1.f / 256.f) + EPS);
                    else ((float*)(ws + WS_RSKV))[pm * 256 + c.tid] = rsqrtf(s * (1.f / 128.f) + EPS);
                }
            }
        });
    }
    {
        const int G = gridDim.x, nfull = nunits % G, vb = vblock();
        const int nidle = nfull ? G - nfull : G, first = nfull ? vb - nfull : vb;
        if (first >= 0) {
            __syncthreads();
            for (int it = first; it < NCONV_PRE; it += nidle) expert_conv_item(c, a, l, it);
        }
    }
}

constexpr int SSD_LD = 136;
constexpr int SSD_TILE_B = 128 * SSD_LD * 2;
constexpr int SSD_OFF_DT = 3 * SSD_TILE_B;
constexpr int SSD_OFF_ACS = SSD_OFF_DT + 2048;
constexpr int SSD_OFF_SSQ = SSD_OFF_ACS + 2048;

DI void ssd_dt_acs(const Ctx& c, KArgs& a, int l, int tok0, float* dt_s, float* acs_s) {
    const float* small = (const float*)(a.ws + WS_SMALL);
    {
        const int t = c.tid >> 2, hd = c.tid & 3;
        const float raw = small[(size_t)(tok0 + t) * 16 + hd] + a.in[6][l * 4 + hd];
        dt_s[hd * 128 + t] = softplusf(raw);
    }
    __syncthreads();
    if (c.wave < 4) {
        const int hd = c.wave;
        const float av = -__expf(a.in[7][l * 4 + hd]);
        const float v0 = dt_s[hd * 128 + 2 * c.lane] * av, v1 = dt_s[hd * 128 + 2 * c.lane + 1] * av;
        const float s = v0 + v1;
        float inc = s;
#pragma unroll
        for (int o = 1; o < 64; o <<= 1) { const float tv = __shfl_up(inc, o); if (c.lane >= o) inc += tv; }
        const float ex = inc - s;
        acs_s[hd * 128 + 2 * c.lane] = ex + v0;
        acs_s[hd * 128 + 2 * c.lane + 1] = ex + v0 + v1;
    }
    __syncthreads();
}

DI float ssd_conv(const u16* proj, const float* cw, const float* cb, int b, int s, int xc) {
    float acc = cb[xc];
#pragma unroll
    for (int j = 0; j < 4; ++j) {
        const int sp = s - 3 + j;
        if (sp >= 0) acc += cw[j * 768 + xc] * bf2f(proj[(size_t)(b * 4096 + sp) * LDP + PC_XBC + xc]);
    }
    return siluf(acc);
}

template <bool TRANSPOSED>
DI void conv_stage_unit(const Ctx& c, const u16* proj, const float* cw, const float* cb, int b, int s0, int tseg, int xc0, u16* dst,
                        const float* dt_s, const float* acs_s, int head0, int half_lo = 0, int half_hi = 2) {
    const int ch = 2 * c.lane, xc = xc0 + ch;
    float w0[4], w1[4];
#pragma unroll
    for (int j = 0; j < 4; ++j) { w0[j] = cw[j * 768 + xc]; w1[j] = cw[j * 768 + xc + 1]; }
    const float bias0 = cb[xc], bias1 = cb[xc + 1];
    const u16* src = proj + (size_t)(b * 4096) * LDP + PC_XBC + xc;
    const int head = head0 + (ch >> 6);
#pragma unroll 1
    for (int half = half_lo; half < half_hi; ++half) {
        const int sb = s0 + tseg * 32 + half * 16 - 3;
        unsigned raw[19];
#pragma unroll
        for (int i = 0; i < 19; ++i) { const int sp = sb + i; raw[i] = (sp >= 0) ? *(const unsigned*)(src + (size_t)sp * LDP) : 0u; }
        asm volatile("" ::: "memory");
#pragma unroll
        for (int t = 0; t < 16; ++t) {
            float x0 = bias0, x1 = bias1;
#pragma unroll
            for (int j = 0; j < 4; ++j) { x0 += w0[j] * bf2f((u16)(raw[t + j] & 0xffff)); x1 += w1[j] * bf2f((u16)(raw[t + j] >> 16)); }
            x0 = siluf(x0); x1 = siluf(x1);
            const int tt = tseg * 32 + half * 16 + t;
            if (dt_s) { const float sc = dt_s[head * 128 + tt] * __expf(acs_s[head * 128 + 127] - acs_s[head * 128 + tt]); x0 *= sc; x1 *= sc; }
            if (TRANSPOSED) { dst[ch * SSD_LD + tt] = f2bf(x0); dst[(ch + 1) * SSD_LD + tt] = f2bf(x1); }
            else *(unsigned*)(dst + tt * SSD_LD + ch) = pack2(x0, x1);
        }
    }
}

DI void ssd_state_item(const Ctx& c_in, KArgs& a, int l, int item) {
    const Ctx c = fresh_ctx(c_in.lds);
    unsigned char* ws = a.ws;
    const u16* proj = (const u16*)(ws + WS_PROJ);
    const float* cw = a.in[4] + (size_t)l * 4 * 768;
    const float* cb = a.in[5] + (size_t)l * 768;
    float* cs = (float*)a.out;
    float* cdec = (float*)(ws + WS_CDEC);
    const int b = item >> 5, ch = item & 31, tok0 = b * 4096 + ch * 128, s0 = ch * 128;
    u16* XT = (u16*)c.lds;
    u16* BT = (u16*)(c.lds + SSD_TILE_B);
    float* dt_s = (float*)(c.lds + SSD_OFF_DT);
    float* acs_s = (float*)(c.lds + SSD_OFF_ACS);
    const int l31 = c.lane & 31, h = c.lane >> 5;
    ssd_dt_acs(c, a, l, tok0, dt_s, acs_s);
    if (c.tid < 4) cdec[(b * 32 + ch) * 4 + c.tid] = __expf(acs_s[c.tid * 128 + 127]);
    for (int g = 0; g < 2; ++g) {
        if (c.wave < 4) conv_stage_unit<true>(c, proj, cw, cb, b, s0, c.wave, 128 * g, XT, dt_s, acs_s, 2 * g);
        else conv_stage_unit<true>(c, proj, cw, cb, b, s0, c.wave - 4, 256 + 128 * g, BT, nullptr, nullptr, 0);
        __syncthreads();
        {
            const int hh = c.wave >> 2, pt = (c.wave >> 1) & 1, nh = c.wave & 1;
            f32x16 acc0 = zero16(), acc1 = zero16();
#pragma unroll
            for (int ks = 0; ks < 8; ++ks) {
                const bf16x8 af = *(const bf16x8*)(XT + (hh * 64 + pt * 32 + l31) * SSD_LD + ks * 16 + h * 8);
                const bf16x8 b0 = *(const bf16x8*)(BT + (nh * 64 + l31) * SSD_LD + ks * 16 + h * 8);
                const bf16x8 b1 = *(const bf16x8*)(BT + (nh * 64 + 32 + l31) * SSD_LD + ks * 16 + h * 8);
                acc0 = MFMA32(af, b0, acc0);
                acc1 = MFMA32(af, b1, acc1);
            }
            const int head = 2 * g + hh;
            float* dst = cs + ((size_t)((b * 32 + ch) * 4 + head) * 64) * 128;
            const int lb = ((nh * 4 + (l31 >> 4)) * 2 + pt) * 512 + ((l31 >> 3) & 1) * 256 + (l31 & 7);
#pragma unroll
            for (int r = 0; r < 16; ++r) {
                dst[lb + crow(r, h) * 8] = acc0[r];
                dst[lb + 2048 + crow(r, h) * 8] = acc1[r];
            }
        }
        __syncthreads();
    }
}

DI void ssd_scan_item(const Ctx& c_in, KArgs& a, int item) {
    const Ctx c = fresh_ctx(c_in.lds);
    float* cs = (float*)a.out;
    const float* cdec = (const float*)(a.ws + WS_CDEC);
    const int idx = item * NTHR + c.tid;
    const int bh = idx >> 13, pn = idx & 8191, b = bh >> 2, hd = bh & 3;
    float v[32], dcy[32];
#pragma unroll
    for (int ch = 0; ch < 32; ++ch) {
        v[ch] = cs[((size_t)((b * 32 + ch) * 4 + hd)) * 8192 + pn];
        dcy[ch] = cdec[(b * 32 + ch) * 4 + hd];
    }
    u16* prevb = (u16*)((unsigned char*)a.out + ((size_t)32 << 20));
    float s = 0.f;
#pragma unroll
    for (int ch = 0; ch < 32; ++ch) {
        prevb[((size_t)((b * 32 + ch) * 4 + hd)) * 8192 + pn] = f2bf(s);
        s = s * dcy[ch] + v[ch];
    }
}

DI void ssd_out_item(const Ctx& c_in, KArgs& a, int l, int item) {
    const Ctx c = fresh_ctx(c_in.lds);
    unsigned char* ws = a.ws;
    const u16* proj = (const u16*)(ws + WS_PROJ);
    const float* cw = a.in[4] + (size_t)l * 4 * 768;
    const float* cb = a.in[5] + (size_t)l * 768;
    const float* prev = (const float*)a.out;
    u16* act = (u16*)(ws + WS_ACT);
    const int b = item >> 5, ch = item & 31, tok0 = b * 4096 + ch * 128, s0 = ch * 128;
    u16* XT = (u16*)c.lds;
    u16* BM = (u16*)(c.lds + SSD_TILE_B);
    u16* CM = (u16*)(c.lds + 2 * SSD_TILE_B);
    float* dt_s = (float*)(c.lds + SSD_OFF_DT);
    float* acs_s = (float*)(c.lds + SSD_OFF_ACS);
    float* ssq = (float*)(c.lds + SSD_OFF_SSQ);
    const int l31 = c.lane & 31, h = c.lane >> 5;
    ssd_dt_acs(c, a, l, tok0, dt_s, acs_s);
    f32x16 yreg[2][2];
    const int hh = c.wave >> 2, qt = c.wave & 3;
#pragma unroll
    for (int g = 0; g < 2; ++g) {
        const int qtg = g ? 3 - qt : qt;
        const int q = qtg * 32 + l31;
        for (int u = c.wave; u < 24; u += 8) {
            const int part = u >> 3, tseg = (u >> 1) & 3, hf = u & 1;
            if (part == 0) conv_stage_unit<true>(c, proj, cw, cb, b, s0, tseg, 128 * g, XT, nullptr, nullptr, 0, hf, hf + 1);
            else if (part == 1) conv_stage_unit<false>(c, proj, cw, cb, b, s0, tseg, 256 + 128 * g, BM, nullptr, nullptr, 0, hf, hf + 1);
            else conv_stage_unit<false>(c, proj, cw, cb, b, s0, tseg, 512 + 128 * g, CM, nullptr, nullptr, 0, hf, hf + 1);
        }
        __syncthreads();
        {
            const int head = 2 * g + hh;
            const float acs_q = acs_s[head * 128 + q];
            bf16x8 cf[8];
#pragma unroll
            for (int ks = 0; ks < 8; ++ks) cf[ks] = *(const bf16x8*)(CM + q * SSD_LD + ks * 16 + h * 8);
            f32x16 yf0 = zero16(), yf1 = zero16();
            const u16* pv = (const u16*)((const unsigned char*)a.out + ((size_t)32 << 20)) + ((size_t)((b * 32 + ch) * 4 + head)) * 8192 + c.lane * 8;
#pragma unroll
            for (int ks = 0; ks < 8; ++ks) {
                yf0 = MFMA32(*(const bf16x8*)(pv + (ks * 2 + 0) * 512), cf[ks], yf0);
                yf1 = MFMA32(*(const bf16x8*)(pv + (ks * 2 + 1) * 512), cf[ks], yf1);
            }
            const float eq = __expf(acs_q);
            f32x16 yo0, yo1;
#pragma unroll
            for (int r = 0; r < 16; ++r) { yo0[r] = yf0[r] * eq; yo1[r] = yf1[r] * eq; }
            for (int kt = 0; kt <= qtg; ++kt) {
                f32x16 gt = zero16();
#pragma unroll
                for (int ks = 0; ks < 8; ++ks) {
                    const bf16x8 bf = *(const bf16x8*)(BM + (kt * 32 + l31) * SSD_LD + ks * 16 + h * 8);
                    gt = MFMA32(bf, cf[ks], gt);
                }
#pragma unroll
                for (int r = 0; r < 16; ++r) {
                    const int k = kt * 32 + crow(r, h);
                    const float dec = __expf(fminf(acs_q - acs_s[head * 128 + k], 0.f)) * dt_s[head * 128 + k];
                    gt[r] = (k <= q) ? gt[r] * dec : 0.f;
                }
#pragma unroll
                for (int s2 = 0; s2 < 2; ++s2) {
                    const bf16x8 pb = pack8(gt, s2);
                    const int koff = kt * 32 + 16 * s2 + 4 * h;
                    {
                        const u16* xr = XT + (hh * 64 + l31) * SSD_LD + koff;
                        const uint2 lo = *(const uint2*)xr, hi = *(const uint2*)(xr + 8);
                        const bf16x8 xa = __builtin_bit_cast(bf16x8, make_uint4(lo.x, lo.y, hi.x, hi.y));
                        yo0 = MFMA32(xa, pb, yo0);
                    }
                    {
                        const u16* xr = XT + (hh * 64 + 32 + l31) * SSD_LD + koff;
                        const uint2 lo = *(const uint2*)xr, hi = *(const uint2*)(xr + 8);
                        const bf16x8 xa = __builtin_bit_cast(bf16x8, make_uint4(lo.x, lo.y, hi.x, hi.y));
                        yo1 = MFMA32(xa, pb, yo1);
                    }
                }
            }
            const float dsk = a.in[8][l * 4 + head];
            float part = 0.f;
            uint2 zall[2][4];
#pragma unroll
            for (int pt = 0; pt < 2; ++pt)
#pragma unroll
                for (int qd = 0; qd < 4; ++qd) zall[pt][qd] = *(const uint2*)(proj + (size_t)(tok0 + q) * LDP + PC_Z + head * 64 + pt * 32 + 8 * qd + 4 * h);
            asm volatile("" ::: "memory");
#pragma unroll
            for (int pt = 0; pt < 2; ++pt) {
#pragma unroll
                for (int qd = 0; qd < 4; ++qd) {
                    const int p0 = pt * 32 + 8 * qd + 4 * h;
                    const uint2 zz = zall[pt][qd];
                    const float zf[4] = { bf2f((u16)(zz.x & 0xffff)), bf2f((u16)(zz.x >> 16)), bf2f((u16)(zz.y & 0xffff)), bf2f((u16)(zz.y >> 16)) };
#pragma unroll
                    for (int r3 = 0; r3 < 4; ++r3) {
                        const int r = 4 * qd + r3;
                        const float yo = pt ? yo1[r] : yo0[r];
                        const float xv = bf2f(XT[(hh * 64 + p0 + r3) * SSD_LD + q]);
                        const float y = (yo + dsk * xv) * siluf(zf[r3]);
                        yreg[g][pt][r] = y;
                        part += y * y;
                    }
                }
            }
            part += __shfl_xor(part, 32);
            if (h == 0) ssq[head * 128 + q] = part;
        }
        __syncthreads();
    }
    {
        const float* nw = a.in[9] + l * 256;
        float4 wv4[2][2][4];
#pragma unroll
        for (int g = 0; g < 2; ++g)
#pragma unroll
            for (int pt = 0; pt < 2; ++pt)
#pragma unroll
                for (int qd = 0; qd < 4; ++qd) wv4[g][pt][qd] = *(const float4*)(nw + (2 * g + hh) * 64 + pt * 32 + 8 * qd + 4 * h);
        asm volatile("" : "+v"(wv4[0][0][0].x), "+v"(wv4[0][0][1].x), "+v"(wv4[0][0][2].x), "+v"(wv4[0][0][3].x), "+v"(wv4[0][1][0].x), "+v"(wv4[0][1][1].x),
                          "+v"(wv4[0][1][2].x), "+v"(wv4[0][1][3].x), "+v"(wv4[1][0][0].x), "+v"(wv4[1][0][1].x), "+v"(wv4[1][0][2].x), "+v"(wv4[1][0][3].x),
                          "+v"(wv4[1][1][0].x), "+v"(wv4[1][1][1].x), "+v"(wv4[1][1][2].x), "+v"(wv4[1][1][3].x) :: "memory");
#pragma unroll
        for (int g = 0; g < 2; ++g) {
            const int head = 2 * g + hh;
            const int q = (g ? 3 - qt : qt) * 32 + l31;
            const float rs = rsqrtf((ssq[q] + ssq[128 + q] + ssq[256 + q] + ssq[384 + q]) * (1.f / 256.f) + EPS);
#pragma unroll
            for (int pt = 0; pt < 2; ++pt)
#pragma unroll
                for (int e = 0; e < 2; ++e) {
                    const float4 w0 = wv4[g][pt][2 * e], w1 = wv4[g][pt][2 * e + 1];
                    const f32x16& y = yreg[g][pt];
                    const unsigned ax = pack2(y[8 * e] * rs * w0.x, y[8 * e + 1] * rs * w0.y), ay = pack2(y[8 * e + 2] * rs * w0.z, y[8 * e + 3] * rs * w0.w);
                    const unsigned bx = pack2(y[8 * e + 4] * rs * w1.x, y[8 * e + 5] * rs * w1.y), by = pack2(y[8 * e + 6] * rs * w1.z, y[8 * e + 7] * rs * w1.w);
                    const auto sx = __builtin_amdgcn_permlane32_swap(ax, bx, false, false);
                    const auto sy = __builtin_amdgcn_permlane32_swap(ay, by, false, false);
                    *(uint4*)(act + (size_t)(tok0 + q) * 1024 + head * 64 + pt * 32 + 16 * e + 8 * h) = make_uint4(sx[0], sy[0], sx[1], sy[1]);
                }
        }
    }
    __syncthreads();
}

DI void mla_up_unit(const Ctx& c_in, KArgs& a, int l, int which, int unit) {
    const Ctx c = fresh_ctx(c_in.lds);
    unsigned char* ws = a.ws;
    const u16* proj = (const u16*)(ws + WS_PROJ);
    const float* trig = (const float*)(ws + WS_TRIG);
    u16* mlaq = (u16*)(ws + WS_MLAQ);
    u16* mlak = (u16*)(ws + WS_MLAK);
    u16* mlavt = (u16*)(ws + WS_MLAVT);
    int R, C; g2_stage_rc(c.tid * 16, R, C);
    const int pm = unit >> 1, pn = unit & 1;
    G2Ptrs g;
    g.ra = g2_rsrc(proj);
    g.va00 = (unsigned)(R * LDP + (which == 0 ? PC_CQ : PC_CKV) + C) * 2u; g.va01 = g.va00; g.va10 = g.va00; g.va11 = g.va00; g.dsa = 64u * LDP * 2u;
    g.sa = (unsigned)pm * (256u * LDP * 2u);
    __syncthreads();
    if (which == 0) {
        g.rb = g2_rsrc((const u16*)(ws + WS_WUQ) + (size_t)l * 512 * 256);
        g.vb0 = (unsigned)(R * 256 + C) * 2u; g.dsb = 64u * 512u; g.sb0 = (unsigned)pn * (256u * 512u); g.sb1 = g.sb0 + 128u * 512u;
        const float* rsq = (const float*)(ws + WS_RSQ);
        gemm256_unit(c, g, 256, [&](const f32x4 (&acc)[2][2][4][2], int wr, int wc, int fr, int fq) {
            float rsv[2][4];
#pragma unroll
            for (int ai = 0; ai < 2; ++ai)
#pragma unroll
                for (int m = 0; m < 4; ++m) rsv[ai][m] = rsq[pm * 256 + ai * 128 + wr * 64 + m * 16 + fr];
#pragma unroll
            for (int bj = 0; bj < 2; ++bj) {
                const int c32 = pn * 256 + bj * 128 + wc * 32;
                if (c32 < 384) {
                    const bool rot = (c32 % 96) == 64;
                    f32x4 cs[2][4], sn[2][4];
                    if (rot) {
#pragma unroll
                        for (int ai = 0; ai < 2; ++ai)
#pragma unroll
                            for (int m = 0; m < 4; ++m) {
                                const float* tg = trig + (size_t)(pm * 256 + ai * 128 + wr * 64 + m * 16 + fr) * 48 + 16 + 4 * fq;
                                cs[ai][m] = *(const f32x4*)tg; sn[ai][m] = *(const f32x4*)(tg + 16);
                            }
                    }
#pragma unroll
                    for (int ai = 0; ai < 2; ++ai)
#pragma unroll
                        for (int m = 0; m < 4; ++m) {
                            const int row = pm * 256 + ai * 128 + wr * 64 + m * 16 + fr;
                            f32x4 v0 = acc[ai][bj][m][0] * rsv[ai][m], v1 = acc[ai][bj][m][1] * rsv[ai][m];
                            if (rot) {
                                const f32x4 o1 = v0 * cs[ai][m] - v1 * sn[ai][m], o2 = v1 * cs[ai][m] + v0 * sn[ai][m];
                                v0 = o1; v1 = o2;
                            }
                            uint2 p0, p1; p0.x = pack2(v0[0], v0[1]); p0.y = pack2(v0[2], v0[3]); p1.x = pack2(v1[0], v1[1]); p1.y = pack2(v1[2], v1[3]);
                            *(uint2*)(mlaq + (size_t)row * 384 + c32 + 4 * fq) = p0;
                            *(uint2*)(mlaq + (size_t)row * 384 + c32 + 16 + 4 * fq) = p1;
                        }
                }
            }
        });
    } else {
        g.rb = g2_rsrc((const u16*)(ws + WS_WUKV) + (size_t)l * 512 * 128);
        g.vb0 = (unsigned)(R * 128 + C) * 2u; g.dsb = 64u * 256u; g.sb0 = (unsigned)pn * (256u * 256u); g.sb1 = g.sb0 + 128u * 256u;
        const float* rskv = (const float*)(ws + WS_RSKV);
        gemm256_unit(c, g, 128, [&](const f32x4 (&acc)[2][2][4][2], int wr, int wc, int fr, int fq) {
            float rsv[2][4];
#pragma unroll
            for (int ai = 0; ai < 2; ++ai)
#pragma unroll
                for (int m = 0; m < 4; ++m) rsv[ai][m] = rskv[pm * 256 + ai * 128 + wr * 64 + m * 16 + fr];
#pragma unroll
            for (int ai = 0; ai < 2; ++ai)
#pragma unroll
                for (int m = 0; m < 4; ++m) {
                    const int row = pm * 256 + ai * 128 + wr * 64 + m * 16 + fr;
                    const float rs = rsv[ai][m];
#pragma unroll
                    for (int bj = 0; bj < 2; ++bj) {
                        const int head = pn * 2 + bj, c32 = wc * 32;
#pragma unroll
                        for (int n = 0; n < 2; ++n) {
                            const f32x4 v = acc[ai][bj][m][n] * rs;
                            if (c32 < 64) {
                                uint2 pk; pk.x = pack2(v[0], v[1]); pk.y = pack2(v[2], v[3]);
                                *(uint2*)(mlak + (size_t)row * 384 + head * 96 + c32 + n * 16 + 4 * fq) = pk;
                            } else {
                                u16* p = mlavt + ((size_t)((row >> 12) * 4 + head) * 64 + (c32 - 64 + n * 16 + 4 * fq)) * 4096 + (row & 4095);
                                p[0] = f2bf(v[0]); p[4096] = f2bf(v[1]); p[2 * 4096] = f2bf(v[2]); p[3 * 4096] = f2bf(v[3]);
                            }
                        }
                    }
                }
        });
    }
}

constexpr int AT_LDV = 68;
template <int DQ, int MODE>
DI void attn_item(const Ctx& c_in, KArgs& a, int l, int b, int hd_in, int qb) {
    const Ctx c = fresh_ctx(c_in.lds);
    unsigned char* ws = a.ws;
    constexpr int LDK = DQ + 8;
    constexpr int K_EL = 64 * LDK, V_EL = 64 * AT_LDV, ST_EL = K_EL + V_EL;
    constexpr int NKS = DQ / 16;
    constexpr int KCH = DQ / 8;
    u16* S = (u16*)c.lds;
    float* fc_s = (float*)(c.lds + 2 * ST_EL * 2 + 64);
    const int l31 = c.lane & 31, h = c.lane >> 5;
    int hd, wq0, nkt;
    const u16 *Qp, *Kp, *Vp; int ldq, ldk, ocol;
    float scale;
    if (MODE == 0) {
        hd = hd_in;
        wq0 = qb * 256 + c.wave * 32; nkt = qb * 4 + 4;
        Qp = (const u16*)(ws + WS_MLAQ) + (size_t)b * 4096 * 384 + hd * 96; ldq = 384;
        Kp = (const u16*)(ws + WS_MLAK) + (size_t)b * 4096 * 384 + hd * 96; ldk = 384;
        Vp = (const u16*)(ws + WS_MLAVT) + (size_t)(b * 4 + hd) * 64 * 4096;
        ocol = 512 + hd * 64; scale = 0.10206207261596575f;
    } else if (MODE == 1) {
        hd = hd_in;
        wq0 = qb * 256 + c.wave * 32; nkt = qb * 4 + 4;
        Qp = (const u16*)(ws + WS_PROJ) + (size_t)b * 4096 * LDP + PC_FOXQ + hd * 64; ldq = LDP;
        Kp = (const u16*)(ws + WS_PROJ) + (size_t)b * 4096 * LDP + PC_FOXK + hd * 64; ldk = LDP;
        Vp = (const u16*)(ws + WS_FOXVT) + (size_t)(b * 4 + hd) * 64 * 4096;
        ocol = 768 + hd * 64; scale = 0.125f;
    } else {
        hd = c.wave & 3;
        wq0 = qb * 64 + (c.wave >> 2) * 32; nkt = qb + 1;
        Qp = (const u16*)(ws + WS_PROJ) + (size_t)b * 4096 * LDP + PC_DSAQ + hd * 64; ldq = LDP;
        Kp = (const u16*)(ws + WS_PROJ) + (size_t)b * 4096 * LDP + PC_DSAK; ldk = LDP;
        Vp = (const u16*)(ws + WS_DSAVT) + (size_t)b * 64 * 4096;
        ocol = 256 + hd * 64; scale = 0.125f;
    }
    const float sc2 = scale * LOG2E;
    const int q = wq0 + l31;
    bf16x8 qf[NKS];
#pragma unroll
    for (int ks = 0; ks < NKS; ++ks) qf[ks] = *(const bf16x8*)(Qp + (size_t)q * ldq + ks * 16 + h * 8);
    float fq = 0.f;
    if (MODE == 1) {
        const float* fsm = (const float*)(ws + WS_FLOG) + (size_t)(b * 4 + hd) * 4096;
        const float fbias = a.in[14][l * 4 + hd];
        float* wtot = (float*)(c.lds + 2 * ST_EL * 2);
        const int nk = nkt * 64;
        float v[8]; float s = 0.f;
        { const float4 va = *(const float4*)(fsm + c.tid * 8), vb = *(const float4*)(fsm + c.tid * 8 + 4);
          v[0] = va.x; v[1] = va.y; v[2] = va.z; v[3] = va.w; v[4] = vb.x; v[5] = vb.y; v[6] = vb.z; v[7] = vb.w; }
        asm volatile("" ::: "memory");
#pragma unroll
        for (int j = 0; j < 8; ++j) {
            const int idx = c.tid * 8 + j;
            const float f = v[j] + fbias;
            v[j] = (idx < nk) ? fminf(f, 0.f) - __logf(1.f + __expf(-fabsf(f))) : 0.f;
        }
#pragma unroll
        for (int j = 0; j < 8; ++j) { s += v[j]; v[j] = s; }
        float inc = s;
#pragma unroll
        for (int o = 1; o < 64; o <<= 1) { const float tv = __shfl_up(inc, o); if (c.lane >= o) inc += tv; }
        if (c.lane == 63) wtot[c.wave] = inc;
        __syncthreads();
        float base = inc - s;
        for (int w2 = 0; w2 < c.wave; ++w2) base += wtot[w2];
#pragma unroll
        for (int j = 0; j < 8; ++j) fc_s[c.tid * 8 + j] = (base + v[j]) * LOG2E;
        __syncthreads();
        fq = fc_s[q];
    }
    float sbound = 0.f;
    int* dflag = (int*)(c.lds + 2 * ST_EL * 2 + 64 + 4096 * 4);
    if (MODE == 1) {
        float qq = 0.f;
#pragma unroll
        for (int ks = 0; ks < NKS; ++ks)
#pragma unroll
            for (int j = 0; j < 8; ++j) { const float f = bf2f((u16)qf[ks][j]); qq += f * f; }
        qq += __shfl_xor(qq, 32);
        float kmax2 = 0.f;
#pragma unroll
        for (int f = 0; f < 4; ++f) kmax2 += __uint_as_float(__hip_atomic_load((const unsigned*)(ws + WS_CTL) + 64 + (b * 4 + hd) * 4 + f, __ATOMIC_RELAXED, __HIP_MEMORY_SCOPE_AGENT));
        sbound = sqrtf(qq * kmax2) * sc2 * 1.02f + 1.0f;
        if (c.tid < 16) dflag[c.tid] = 0;
    }
    bool wdone = false;
    const int krow0 = c.tid / KCH, kch0 = c.tid % KCH;
    const int c1 = c.tid + NTHR; const int krow1 = c1 / KCH, kch1 = c1 % KCH; const bool has1 = (KCH * 64 > NTHR) && (c1 < KCH * 64);
    const int vrow = c.tid >> 3, vch = c.tid & 7;
    struct KV { uint4 k0, k1, v; u64 mw; };
    KV sA, sB, sC;
    sA.k1 = sB.k1 = sC.k1 = make_uint4(0, 0, 0, 0); sA.mw = sB.mw = sC.mw = 0;
    const u64* mrow = (const u64*)(ws + WS_MASK) + (size_t)(b * 4096 + q) * 64;
    auto gload = [&](KV& s, int kt) {
        s.k0 = *(const uint4*)(Kp + (size_t)(kt * 64 + krow0) * ldk + kch0 * 8);
        if (has1) s.k1 = *(const uint4*)(Kp + (size_t)(kt * 64 + krow1) * ldk + kch1 * 8);
        s.v = *(const uint4*)(Vp + (size_t)vrow * 4096 + kt * 64 + vch * 8);
        if (MODE == 2) s.mw = mrow[kt];
    };
    auto sstore = [&](const KV& s, int st) {
        u16* Ks = S + st * ST_EL; u16* Vs = Ks + K_EL;
        *(uint4*)(Ks + krow0 * LDK + kch0 * 8) = s.k0;
        if (has1) *(uint4*)(Ks + krow1 * LDK + kch1 * 8) = s.k1;
        *(uint2*)(Vs + vrow * AT_LDV + vch * 8) = make_uint2(s.v.x, s.v.y);
        *(uint2*)(Vs + vrow * AT_LDV + vch * 8 + 4) = make_uint2(s.v.z, s.v.w);
    };
    f32x16 o0 = zero16(), o1 = zero16();
    float m_run = -1e30f, l_run = 0.f;
    auto tile_of = [&](int it) { return (MODE == 1) ? nkt - 1 - it : it; };
    bool stop = false;
    auto step = [&](int it, KV& cur, const KV& nxt) {
        const int kt = tile_of(it);
        const u64 mw_cur = cur.mw;
        if (it + 3 < nkt) gload(cur, tile_of(it + 3));
        if (kt * 64 <= wq0 + 31 && !wdone) {
            const u16* Ks = S + (it & 1) * ST_EL; const u16* Vs = Ks + K_EL;
            f32x16 s0 = zero16(), s1 = zero16();
#pragma unroll
            for (int ks = 0; ks < NKS; ++ks) {
                const bf16x8 k0 = *(const bf16x8*)(Ks + l31 * LDK + ks * 16 + h * 8);
                const bf16x8 k1 = *(const bf16x8*)(Ks + (32 + l31) * LDK + ks * 16 + h * 8);
                s0 = MFMA32(k0, qf[ks], s0);
                s1 = MFMA32(k1, qf[ks], s1);
            }
            const float scx = (MODE == 1) ? 1.0f : sc2;
            if (MODE == 1) {
#pragma unroll
                for (int g4 = 0; g4 < 4; ++g4) {
                    const float4 f0 = *(const float4*)(fc_s + kt * 64 + 8 * g4 + 4 * h);
                    const float4 f1 = *(const float4*)(fc_s + kt * 64 + 32 + 8 * g4 + 4 * h);
                    s0[4 * g4 + 0] = fmaf(s0[4 * g4 + 0], sc2, fq) - f0.x; s0[4 * g4 + 1] = fmaf(s0[4 * g4 + 1], sc2, fq) - f0.y;
                    s0[4 * g4 + 2] = fmaf(s0[4 * g4 + 2], sc2, fq) - f0.z; s0[4 * g4 + 3] = fmaf(s0[4 * g4 + 3], sc2, fq) - f0.w;
                    s1[4 * g4 + 0] = fmaf(s1[4 * g4 + 0], sc2, fq) - f1.x; s1[4 * g4 + 1] = fmaf(s1[4 * g4 + 1], sc2, fq) - f1.y;
                    s1[4 * g4 + 2] = fmaf(s1[4 * g4 + 2], sc2, fq) - f1.z; s1[4 * g4 + 3] = fmaf(s1[4 * g4 + 3], sc2, fq) - f1.w;
                }
            }
            if (MODE == 2) {
                const unsigned mlo = (unsigned)(mw_cur >> (4 * h)), mhi = (unsigned)(mw_cur >> (32 + 4 * h));
#pragma unroll
                for (int r = 0; r < 16; ++r) {
                    const int kr = (r & 3) + 8 * (r >> 2);
                    s0[r] = ((mlo >> kr) & 1u) ? s0[r] : -1e30f;
                    s1[r] = ((mhi >> kr) & 1u) ? s1[r] : -1e30f;
                }
            } else if (__builtin_amdgcn_readfirstlane(kt * 64 + 63 - wq0) > 0) {
                asm volatile("" ::: "memory");
                const int qrel = q - kt * 64 - 4 * h;
#pragma unroll
                for (int r = 0; r < 16; ++r) {
                    const int kr = (r & 3) + 8 * (r >> 2);
                    s0[r] = (kr <= qrel) ? s0[r] : -1e30f;
                    s1[r] = (kr + 32 <= qrel) ? s1[r] : -1e30f;
                }
            }
            asm volatile("s_nop 15\n\ts_nop 3" : "+v"(s0), "+v"(s1));
            float mx;
            {
                float t0 = max3f(s0[0], s0[1], s0[2]), t1 = max3f(s0[3], s0[4], s0[5]), t2 = max3f(s0[6], s0[7], s0[8]), t3 = max3f(s0[9], s0[10], s0[11]);
                float t4 = max3f(s0[12], s0[13], s0[14]), t5 = max3f(s0[15], s1[0], s1[1]), t6 = max3f(s1[2], s1[3], s1[4]), t7 = max3f(s1[5], s1[6], s1[7]);
                float t8 = max3f(s1[8], s1[9], s1[10]), t9 = max3f(s1[11], s1[12], s1[13]), t10 = max3f(s1[14], s1[15], t0);
                t1 = max3f(t1, t2, t3); t4 = max3f(t4, t5, t6); t7 = max3f(t7, t8, t9);
                mx = max3f(t1, t4, t7); mx = max3f(mx, t10, __shfl_xor(max3f(t1, t4, max3f(t7, t10, t10)), 32));
            }
            const float m_new = max3f(m_run, mx, mx);
            const float m_use = (MODE == 2) ? max3f(m_new, -1e20f, -1e20f) : m_new;
            const float alpha = ex2((m_run - m_new) * scx);
            const float nm = -m_use * scx;
            f32x2 rs2 = {0.f, 0.f};
            const f32x2 sc2v = {scx, scx}, nm2 = {nm, nm};
#pragma unroll
            for (int r = 0; r < 16; r += 2) {
                f32x2 xv = {s0[r], s0[r + 1]};
                xv = xv * sc2v + nm2;
                xv[0] = ex2(xv[0]); xv[1] = ex2(xv[1]);
                s0[r] = xv[0]; s0[r + 1] = xv[1];
                rs2 += xv;
                f32x2 yv = {s1[r], s1[r + 1]};
                yv = yv * sc2v + nm2;
                yv[0] = ex2(yv[0]); yv[1] = ex2(yv[1]);
                s1[r] = yv[0]; s1[r + 1] = yv[1];
                rs2 += yv;
            }
            float rsum = rs2[0] + rs2[1];
            rsum += __shfl_xor(rsum, 32);
            l_run = l_run * alpha + rsum; m_run = m_new;
            if (__any(alpha != 1.0f)) {
#pragma unroll
                for (int r = 0; r < 16; ++r) { o0[r] *= alpha; o1[r] *= alpha; }
            }
#pragma unroll
            for (int sub = 0; sub < 2; ++sub)
#pragma unroll
                for (int s2 = 0; s2 < 2; ++s2) {
                    const bf16x8 pb = pack8(sub ? s1 : s0, s2);
                    const int koff = sub * 32 + 16 * s2 + 4 * h;
                    {
                        const u16* vr = Vs + l31 * AT_LDV + koff;
                        const uint2 lo = *(const uint2*)vr, hi = *(const uint2*)(vr + 8);
                        o0 = MFMA32(__builtin_bit_cast(bf16x8, make_uint4(lo.x, lo.y, hi.x, hi.y)), pb, o0);
                    }
                    {
                        const u16* vr = Vs + (32 + l31) * AT_LDV + koff;
                        const uint2 lo = *(const uint2*)vr, hi = *(const uint2*)(vr + 8);
                        o1 = MFMA32(__builtin_bit_cast(bf16x8, make_uint4(lo.x, lo.y, hi.x, hi.y)), pb, o1);
                    }
                }
        }
        if (it + 1 < nkt) sstore(nxt, (it + 1) & 1);
        if (MODE == 1) {
            if (kt * 64 <= wq0 + 31 && !wdone && kt > 0) wdone = __all(sbound + (fq - fc_s[kt * 64 - 1]) < m_run - 40.f);
            if (c.lane == 0) dflag[(it & 1) * 8 + c.wave] = wdone ? 1 : 0;
        }
        __syncthreads();
        if (MODE == 1) {
            const int4 f0 = *(const int4*)(dflag + (it & 1) * 8), f1 = *(const int4*)(dflag + (it & 1) * 8 + 4);
            if ((f0.x & f0.y & f0.z & f0.w & f1.x & f1.y & f1.z & f1.w) != 0) stop = true;
        }
    };
    gload(sA, tile_of(0));
    if (nkt > 1) gload(sB, tile_of(1));
    if (nkt > 2) gload(sC, tile_of(2));
    sstore(sA, 0);
    __syncthreads();
    for (int it = 0; it < nkt; it += 3) {
        step(it, sA, sB); if (stop || it + 1 >= nkt) break;
        step(it + 1, sB, sC); if (stop || it + 2 >= nkt) break;
        step(it + 2, sC, sA); if (stop) break;
    }
    if (MODE == 1) __syncthreads();
    {
        const float inv = 1.f / l_run;
        u16* act = (u16*)(ws + WS_ACT) + (size_t)(b * 4096 + q) * 1024 + ocol;
#pragma unroll
        for (int e = 0; e < 2; ++e) {
#pragma unroll
            for (int ot = 0; ot < 2; ++ot) {
                const f32x16& o = ot ? o1 : o0;
                unsigned ax = pack2(o[8 * e] * inv, o[8 * e + 1] * inv), ay = pack2(o[8 * e + 2] * inv, o[8 * e + 3] * inv);
                unsigned bx = pack2(o[8 * e + 4] * inv, o[8 * e + 5] * inv), by = pack2(o[8 * e + 6] * inv, o[8 * e + 7] * inv);
                const auto sx = __builtin_amdgcn_permlane32_swap(ax, bx, false, false);
                const auto sy = __builtin_amdgcn_permlane32_swap(ay, by, false, false);
                *(uint4*)(act + 32 * ot + 16 * e + 8 * h) = make_uint4(sx[0], sy[0], sx[1], sy[1]);
            }
        }
    }
}

constexpr int SC_LD = 4100;
struct DsaPref { uint4 q; float w; bf16x8 kb[2][4]; };
DI void dsa_prefetch(const Ctx& c, KArgs& a, int b, int s0, DsaPref& pf) {
    const u16* proj = (const u16*)(a.ws + WS_PROJ);
    const float* small = (const float*)(a.ws + WS_SMALL);
    const int tok0 = b * 4096 + s0;
    const int npair = ((((s0 + 7) >> 5) + 1) + 1) >> 1;
    const u16* kbase = (const u16*)(a.ws + WS_KF) + (size_t)b * 128 * 4 * 512 + c.lane * 8;
    if (c.wave < npair) {
#pragma unroll
        for (int tt = 0; tt < 2; ++tt)
#pragma unroll
            for (int ks = 0; ks < 4; ++ks) pf.kb[tt][ks] = *(const bf16x8*)(kbase + (size_t)((2 * c.wave + tt) * 4 + ks) * 512);
    }
    {
        const int r = c.tid >> 3;
        pf.q = *(const uint4*)(proj + (size_t)(tok0 + (r >> 3)) * LDP + PC_IDXQ + (r & 7) * 64 + (c.tid & 7) * 8);
    }
    pf.w = (c.tid < 64) ? small[(size_t)(tok0 + (c.tid >> 3)) * 16 + 4 + (c.tid & 7)] * 0.044194173824159216f : 0.f;
}
DI void dsa_index_item(const Ctx& c_in, KArgs& a, int b, int s0, DsaPref& pf, bool last) {
    const Ctx c = fresh_ctx(c_in.lds);
    unsigned char* ws = a.ws;
    const u16* proj = (const u16*)(ws + WS_PROJ);
    const float* small = (const float*)(ws + WS_SMALL);
    u64* mask = (u64*)(ws + WS_MASK);
    unsigned* SC = (unsigned*)c.lds;
    unsigned* HIST = (unsigned*)(c.lds + 8 * SC_LD * 4);
    unsigned* QMM = HIST + 8 * 272;
    const int l31 = c.lane & 31, h = c.lane >> 5;
    const int tok0 = b * 4096 + s0;
    const int ntile = ((s0 + 7) >> 5) + 1;
    const int npair = (ntile + 1) >> 1;
    u16* QA_s = (u16*)(QMM + 16);
    float* W_s = (float*)(QA_s + 64 * 72);
    unsigned* QM = QMM + 8 * ((s0 >> 3) & 1);
    if (c.tid < 8) QM[c.tid] = 0u;
    *(uint4*)(QA_s + (c.tid >> 3) * 72 + (c.tid & 7) * 8) = pf.q;
    if (c.tid < 64) W_s[c.tid] = pf.w;
    const u16* kbase = (const u16*)(ws + WS_KF) + (size_t)b * 128 * 4 * 512 + c.lane * 8;
    bf16x8 kb[2][4], kn[2][4];
#pragma unroll
    for (int tt = 0; tt < 2; ++tt)
#pragma unroll
        for (int ks = 0; ks < 4; ++ks) kb[tt][ks] = pf.kb[tt][ks];
    __syncthreads();
    bf16x8 qa[2][4];
    float wv[2][16];
#pragma unroll
    for (int rt = 0; rt < 2; ++rt) {
        const int arow = (4 * rt + 2 * ((l31 >> 2) & 1) + (l31 >> 4)) * 8 + 4 * ((l31 >> 3) & 1) + (l31 & 3);
#pragma unroll
        for (int ks = 0; ks < 4; ++ks) qa[rt][ks] = *(const bf16x8*)(QA_s + arow * 72 + ks * 16 + h * 8);
#pragma unroll
        for (int g = 0; g < 4; ++g) {
            const float4 w4 = *(const float4*)(W_s + (4 * rt + 2 * h + (g >> 1)) * 8 + 4 * (g & 1));
            wv[rt][4 * g + 0] = w4.x; wv[rt][4 * g + 1] = w4.y; wv[rt][4 * g + 2] = w4.z; wv[rt][4 * g + 3] = w4.w;
        }
    }
    unsigned kmax[4];
#pragma unroll
    for (int g = 0; g < 4; ++g) kmax[g] = 0u;
    auto pair_scores = [&](const bf16x8 (&kf)[2][4], int kp) {
#pragma unroll
        for (int tt = 0; tt < 2; ++tt) {
            const int key = (2 * kp + tt) * 32 + l31;
            f32x16 a0 = zero16(), a1 = zero16();
#pragma unroll
            for (int ks = 0; ks < 4; ++ks) { a0 = MFMA32(qa[0][ks], kf[tt][ks], a0); a1 = MFMA32(qa[1][ks], kf[tt][ks], a1); }
            asm volatile("s_nop 15\n\ts_nop 3" : "+v"(a0), "+v"(a1));
#pragma unroll
            for (int u = 0; u < 2; ++u) {
                f32x2 p = {0.f, 0.f};
#pragma unroll
                for (int j = 0; j < 8; ++j) {
                    const f32x2 rl = {relu_raw(a0[8 * u + j]), relu_raw(a1[8 * u + j])};
                    const f32x2 ww = {wv[0][8 * u + j], wv[1][8 * u + j]};
                    p += ww * rl;
                }
#pragma unroll
                for (int z = 0; z < 2; ++z) {
                    const unsigned bits = __float_as_uint(p[z]);
                    const unsigned k = bits ^ ((unsigned)((int)bits >> 31) | 0x80000000u);
                    SC[(4 * z + 2 * h + u) * SC_LD + key] = k;
                    kmax[2 * u + z] = max(kmax[2 * u + z], k);
                }
            }
        }
    };
    auto pair_load = [&](bf16x8 (&kf)[2][4], int kp) {
#pragma unroll
        for (int tt = 0; tt < 2; ++tt)
#pragma unroll
            for (int ks = 0; ks < 4; ++ks) kf[tt][ks] = *(const bf16x8*)(kbase + (size_t)((2 * kp + tt) * 4 + ks) * 512);
    };
    for (int kp = c.wave; kp < npair; kp += 16) {
        if (kp + 8 < npair) pair_load(kn, kp + 8);
        pair_scores(kb, kp);
        if (kp + 8 >= npair) break;
        if (kp + 16 < npair) pair_load(kb, kp + 16);
        pair_scores(kn, kp + 8);
    }
    if (c.wave == ((npair - 1) & 7)) {
        const int key = (npair - 1) * 64 + c.lane;
#pragma unroll
        for (int q = 0; q < 8; ++q) if (key > s0 + q) SC[q * SC_LD + key] = 0u;
    }
#pragma unroll
    for (int g = 0; g < 4; ++g) {
        kmax[g] = max(kmax[g], dpp0<0x111>(kmax[g])); kmax[g] = max(kmax[g], dpp0<0x112>(kmax[g])); kmax[g] = max(kmax[g], dpp0<0x114>(kmax[g]));
        kmax[g] = max(kmax[g], dpp0<0x118>(kmax[g])); kmax[g] = max(kmax[g], dpp0<0x142, 0xa>(kmax[g]));
        if (l31 == 31) atomicMax(&QM[4 * (g & 1) + 2 * h + (g >> 1)], kmax[g]);
    }
    if (!last) dsa_prefetch(c, a, b, s0 + 8, pf);
    __syncthreads();
    {
        const int qi = __builtin_amdgcn_readfirstlane(s0 + c.wave), n = qi + 1;
        const unsigned* sc = SC + c.wave * SC_LD + c.lane;
        unsigned* hist = HIST + c.wave * 272;
        const int nit = (n + 63) >> 6;
        {
            unsigned* scw = SC + c.wave * SC_LD + c.lane;
            for (int it = nit; it < ((nit + 7) & ~7); ++it) scw[it * 64] = 0u;
        }
        unsigned thr = 1u; int cut = 0x7fffffff;
        if (n > 256) {
            unsigned lo = 0u, hi = (unsigned)__builtin_amdgcn_readfirstlane((int)QM[c.wave]);
            const unsigned hi_full = hi;
            bool filtered = false;
            {
                const int m = (int)(32768.f / (float)n) + 6;
                if (m < 60) {
                    const int sidx = ((c.lane * 13 + 5) * nit) >> 10;
                    const unsigned smp = sc[sidx * 64];
                    unsigned L = 0u;
#pragma unroll 4
                    for (int bit = 31; bit >= 0; --bit) {
                        const unsigned cand = L | (1u << bit);
                        if (__popcll(__ballot(smp >= cand)) >= m) L = cand;
                    }
                    if (L > 0u && L <= hi) { lo = L; filtered = true; }
                }
            }
            bool need_min = !filtered;
            int kk = 256;
            for (int iter = 0; iter < 6; ++iter) {
                if (need_min) {
                    need_min = false;
                    unsigned mn = 0xffffffffu;
                    for (int it = 0; it < nit; ++it) { const unsigned k = sc[it * 64]; mn = min(mn, k ? k : 0xffffffffu); }
#pragma unroll
                    for (int o = 32; o >= 1; o >>= 1) mn = min(mn, (unsigned)__shfl_xor((int)mn, o));
                    lo = (unsigned)__builtin_amdgcn_readfirstlane((int)mn);
                }
                const unsigned width = hi - lo;
                const int shift = max(0, 24 - (int)__clz(width | 1u));
#pragma unroll
                for (int j = 0; j < 5; ++j) { const int idx = c.lane + 64 * j; if (idx < 272) hist[idx] = 0u; }
                {
                    unsigned kv[8], kw[8];
#pragma unroll
                    for (int j = 0; j < 8; ++j) kv[j] = sc[j * 64];
#pragma unroll 1
                    for (int it0 = 0; it0 < nit; it0 += 8) {
#pragma unroll
                        for (int j = 0; j < 8; ++j) kw[j] = sc[(it0 + 8 + j) * 64];
#pragma unroll
                        for (int j = 0; j < 8; ++j) {
                            const unsigned d = kv[j] - lo;
                            if (d <= width) atomicAdd(&hist[d >> shift], 1u);
                        }
#pragma unroll
                        for (int j = 0; j < 8; ++j) kv[j] = kw[j];
                    }
                }
                const unsigned c0 = hist[4 * c.lane], c1 = hist[4 * c.lane + 1], c2 = hist[4 * c.lane + 2], c3 = hist[4 * c.lane + 3];
                const unsigned ls = c0 + c1 + c2 + c3;
                const unsigned pre = wscan_add(ls);
                const unsigned tot = (unsigned)__builtin_amdgcn_readlane((int)pre, 63);
                const unsigned suf = tot - pre + ls;
                if (filtered) {
                    filtered = false;
                    if (tot < (unsigned)kk) { hi = hi_full; need_min = true; continue; }
                }
                const unsigned above_lane = suf - ls;
                const bool mine = (suf >= (unsigned)kk) && (above_lane < (unsigned)kk);
                int bstar = 0; unsigned above = 0, cntb = 0;
                if (mine) {
                    unsigned run = above_lane;
                    if (run + c3 >= (unsigned)kk) { bstar = 4 * c.lane + 3; above = run; cntb = c3; }
                    else { run += c3;
                        if (run + c2 >= (unsigned)kk) { bstar = 4 * c.lane + 2; above = run; cntb = c2; }
                        else { run += c2;
                            if (run + c1 >= (unsigned)kk) { bstar = 4 * c.lane + 1; above = run; cntb = c1; }
                            else { run += c1; bstar = 4 * c.lane; above = run; cntb = c0; } } }
                }
                const u64 mm = __ballot(mine);
                const int src = __ffsll((long long)mm) - 1;
                bstar = __builtin_amdgcn_readlane(bstar, src); above = (unsigned)__builtin_amdgcn_readlane((int)above, src); cntb = (unsigned)__builtin_amdgcn_readlane((int)cntb, src);
                kk -= (int)above;
                const unsigned nlo = lo + ((unsigned)bstar << shift);
                const unsigned nhi = min(hi, nlo + ((1u << shift) - 1u));
                lo = nlo; hi = nhi; thr = lo;
                if ((int)cntb == kk) break;
                if (shift == 0) {
                    int need = kk;
                    for (int it = 0; it < nit; ++it) {
                        const unsigned k = sc[it * 64];
                        const bool e = (k == thr);
                        const u64 mk = __ballot(e); const int cn = __popcll(mk);
                        if (need <= cn) {
                            const u64 sel = __ballot(e && (__popcll(mk & ((1ull << c.lane) - 1ull)) == need - 1));
                            cut = it * 64 + (__ffsll((long long)sel) - 1);
                            break;
                        }
                        need -= cn;
                    }
                    break;
                }
            }
        }
        u64* mrow = mask + (size_t)(b * 4096 + qi) * 64;
        const bool tie = (cut != 0x7fffffff);
        {
            u64 wsel = 0;
            unsigned kv[8], kw[8];
#pragma unroll
            for (int j = 0; j < 8; ++j) kv[j] = sc[j * 64];
#pragma unroll 1
            for (int it0 = 0; it0 < nit; it0 += 8) {
#pragma unroll
                for (int j = 0; j < 8; ++j) kw[j] = sc[(it0 + 8 + j) * 64];
                const int lrel = c.lane - it0;
#pragma unroll
                for (int j = 0; j < 8; ++j) {
                    const unsigned k = kv[j];
                    bool sel = (k >= thr);
                    if (tie) sel = (k > thr) || (k == thr && ((it0 + j) * 64 + c.lane) <= cut);
                    const u64 wd = __ballot(sel);
                    wsel = (lrel == j) ? wd : wsel;
                }
#pragma unroll
                for (int j = 0; j < 8; ++j) kv[j] = kw[j];
            }
            mrow[c.lane] = wsel;
        }
    }
}

DI void phase_outproj(const Ctx& c_in, KArgs& a, int l) {
    const Ctx c = fresh_ctx(c_in.lds);
    unsigned char* ws = a.ws;
    const u16* act = (const u16*)(ws + WS_ACT);
    const u16* w = (const u16*)(ws + WS_WOUT) + (size_t)l * 1024 * 1024;
    const float* xin = a.in[0];
    u16* xb = (u16*)(ws + WS_XB);
    int R, C; g2_stage_rc(c.tid * 16, R, C);
    const int nunits = (T_TOK / 256) * 4;
    for (int u = vblock(); u < nunits; u += gridDim.x) {
        const int pm = (u >> 4) * 4 + (u & 3), pn = (u >> 2) & 3;
        G2Ptrs g;
        g.ra = g2_rsrc(act); g.rb = g2_rsrc(w);
        g.va00 = (unsigned)(R * 1024 + C) * 2u; g.va01 = g.va00; g.va10 = g.va00; g.va11 = g.va00; g.dsa = 64u * 2048u;
        g.vb0 = (unsigned)(g2_perm32(R) * 1024 + C) * 2u; g.dsb = 64u * 2048u;
        g.sa = (unsigned)pm * (256u * 2048u); g.sb0 = (unsigned)pn * (256u * 2048u); g.sb1 = g.sb0 + 128u * 2048u;
        __syncthreads();
        gemm256_unit(c, g, 1024, [&](const f32x4 (&acc)[2][2][4][2], int wr, int wc, int fr, int fq) {
            const float* __restrict__ xin_r = xin; u16* __restrict__ xb_r = xb;
#pragma unroll
            for (int ai = 0; ai < 2; ++ai) {
                if (l == 0) {
                    f32x4 xv[4][2][2];
#pragma unroll
                    for (int m = 0; m < 4; ++m) {
                        const size_t rowoff = (size_t)(pm * 256 + ai * 128 + wr * 64 + m * 16 + fr) * 1024 + pn * 256 + wc * 32 + 8 * fq;
#pragma unroll
                        for (int bj = 0; bj < 2; ++bj)
#pragma unroll
                            for (int n = 0; n < 2; ++n) xv[m][bj][n] = __builtin_nontemporal_load((const f32x4*)(xin_r + rowoff + bj * 128 + n * 4));
                    }
#pragma unroll
                    for (int m = 0; m < 4; ++m) {
                        const size_t rowoff = (size_t)(pm * 256 + ai * 128 + wr * 64 + m * 16 + fr) * 1024 + pn * 256 + wc * 32 + 8 * fq;
#pragma unroll
                        for (int bj = 0; bj < 2; ++bj) {
                            const f32x4 s0 = xv[m][bj][0] + acc[ai][bj][m][0], s1 = xv[m][bj][1] + acc[ai][bj][m][1];
                            uint4 pk; pk.x = pack2(s0[0], s0[1]); pk.y = pack2(s0[2], s0[3]); pk.z = pack2(s1[0], s1[1]); pk.w = pack2(s1[2], s1[3]);
                            *(uint4*)(xb_r + rowoff + bj * 128) = pk;
                        }
                    }
                } else {
                    uint4 xv[4][2];
#pragma unroll
                    for (int m = 0; m < 4; ++m) {
                        const size_t rowoff = (size_t)(pm * 256 + ai * 128 + wr * 64 + m * 16 + fr) * 1024 + pn * 256 + wc * 32 + 8 * fq;
#pragma unroll
                        for (int bj = 0; bj < 2; ++bj) { const u32x4nt t_ = __builtin_nontemporal_load((const u32x4nt*)(xb_r + rowoff + bj * 128)); xv[m][bj] = make_uint4(t_[0], t_[1], t_[2], t_[3]); }
                    }
#pragma unroll
                    for (int m = 0; m < 4; ++m) {
                        const size_t rowoff = (size_t)(pm * 256 + ai * 128 + wr * 64 + m * 16 + fr) * 1024 + pn * 256 + wc * 32 + 8 * fq;
#pragma unroll
                        for (int bj = 0; bj < 2; ++bj) {
                            const float4 x0 = bf4_to_f4(make_uint2(xv[m][bj].x, xv[m][bj].y)), x1 = bf4_to_f4(make_uint2(xv[m][bj].z, xv[m][bj].w));
                            const f32x4 a0 = acc[ai][bj][m][0], a1 = acc[ai][bj][m][1];
                            uint4 pk; pk.x = pack2(x0.x + a0[0], x0.y + a0[1]); pk.y = pack2(x0.z + a0[2], x0.w + a0[3]);
                            pk.z = pack2(x1.x + a1[0], x1.y + a1[1]); pk.w = pack2(x1.z + a1[2], x1.w + a1[3]);
                            *(uint4*)(xb_r + rowoff + bj * 128) = pk;
                        }
                    }
                }
            }
        });
    }
}

constexpr int RT_LD = 1032;
DI void phase_router(const Ctx& c_in, KArgs& a, int l) {
    const Ctx c = fresh_ctx(c_in.lds);
    unsigned char* ws = a.ws;
    const u16* x = (const u16*)(ws + WS_XB);
    const float* g = a.in[16] + l * 1024;
    const float* brg = a.in[18] + l * 4;
    const float* bre = a.in[20] + l * 32;
    const u16* wrh = (const u16*)(ws + WS_WRH) + (size_t)l * 64 * 1024;
    const u16* wrl = (const u16*)(ws + WS_WRL) + (size_t)l * 64 * 1024;
    u16* act = (u16*)(ws + WS_ACT);
    int* cnt = (int*)(ws + WS_CTL);
    int* list = (int*)(ws + WS_LIST);
    float* tokw = (float*)(ws + WS_TOKW);
    u16* HI = (u16*)c.lds;
    u16* LO = HI + 32 * RT_LD;
    float* LG = (float*)(c.lds + 2 * 32 * RT_LD * 2);
    const int l31 = c.lane & 31, h = c.lane >> 5;
    float4 ggv[4];
#pragma unroll
    for (int j = 0; j < 4; ++j) ggv[j] = *(const float4*)(g + c.lane * 4 + 256 * j);
    uint2 xv[4][4];
    {
        const int it0 = min(bid(), T_TOK / 32 - 1);
#pragma unroll
        for (int tt = 0; tt < 4; ++tt)
#pragma unroll
            for (int j = 0; j < 4; ++j) xv[tt][j] = ldnt_u2(x + (size_t)(it0 * 32 + c.wave * 4 + tt) * 1024 + c.lane * 4 + 256 * j);
    }
    for (int it = bid(); it < T_TOK / 32; it += gridDim.x) {
        const int t0 = it * 32;
        const int itn = min(it + (int)gridDim.x, T_TOK / 32 - 1);
#pragma unroll
        for (int tt = 0; tt < 4; ++tt) {
            const int tl = c.wave * 4 + tt, t = t0 + tl;
            float4 v[4]; float ss = 0.f;
#pragma unroll
            for (int j = 0; j < 4; ++j) { v[j] = bf4_to_f4(xv[tt][j]); ss += v[j].x * v[j].x + v[j].y * v[j].y + v[j].z * v[j].z + v[j].w * v[j].w; }
#pragma unroll
            for (int j = 0; j < 4; ++j) xv[tt][j] = ldnt_u2(x + (size_t)(itn * 32 + tl) * 1024 + c.lane * 4 + 256 * j);
            ss = wsum(ss);
            const float rs = rsqrtf(ss * (1.f / 1024.f) + EPS);
#pragma unroll
            for (int j = 0; j < 4; ++j) {
                const float4 gg = ggv[j];
                const float h0 = v[j].x * rs * gg.x, h1 = v[j].y * rs * gg.y, h2 = v[j].z * rs * gg.z, h3 = v[j].w * rs * gg.w;
                const u16 b0 = f2bf(h0), b1 = f2bf(h1), b2 = f2bf(h2), b3 = f2bf(h3);
                const uint2 hp = make_uint2((unsigned)b0 | ((unsigned)b1 << 16), (unsigned)b2 | ((unsigned)b3 << 16));
                const uint2 lp = make_uint2(pack2(h0 - bf2f(b0), h1 - bf2f(b1)), pack2(h2 - bf2f(b2), h3 - bf2f(b3)));
                *(uint2*)(act + (size_t)t * 1024 + c.lane * 4 + 256 * j) = hp;
                *(uint2*)(HI + tl * RT_LD + c.lane * 4 + 256 * j) = hp;
                *(uint2*)(LO + tl * RT_LD + c.lane * 4 + 256 * j) = lp;
            }
        }
        __syncthreads();
        {
            const int k0 = c.wave * 128 + h * 8;
            f32x16 acc0 = zero16(), acc1 = zero16();
#pragma unroll
            for (int ks = 0; ks < 8; ++ks) {
                const int k = k0 + ks * 16;
                const bf16x8 ah = *(const bf16x8*)(HI + l31 * RT_LD + k);
                const bf16x8 al = *(const bf16x8*)(LO + l31 * RT_LD + k);
                const int kst = c.wave * 8 + ks;
                const bf16x8 bh0 = *(const bf16x8*)(wrh + ((size_t)kst * 64 + c.lane) * 8);
                const bf16x8 bh1 = *(const bf16x8*)(wrh + ((size_t)(64 + kst) * 64 + c.lane) * 8);
                const bf16x8 bl0 = *(const bf16x8*)(wrl + ((size_t)kst * 64 + c.lane) * 8);
                const bf16x8 bl1 = *(const bf16x8*)(wrl + ((size_t)(64 + kst) * 64 + c.lane) * 8);
                acc0 = MFMA32(ah, bh0, acc0); acc0 = MFMA32(ah, bl0, acc0); acc0 = MFMA32(al, bh0, acc0);
                acc1 = MFMA32(ah, bh1, acc1); acc1 = MFMA32(ah, bl1, acc1); acc1 = MFMA32(al, bh1, acc1);
            }
            __syncthreads();
            float* PART = (float*)c.lds + c.wave * (32 * 37);
#pragma unroll
            for (int r = 0; r < 16; ++r) {
                PART[crow(r, h) * 37 + l31] = acc0[r];
                if (l31 < 4) PART[crow(r, h) * 37 + 32 + l31] = acc1[r];
            }
        }
        __syncthreads();
        for (int i = c.tid; i < 32 * 36; i += NTHR) {
            const int tk = i / 36, e = i % 36;
            float s = 0.f;
#pragma unroll
            for (int w2 = 0; w2 < 8; ++w2) s += ((const float*)c.lds)[w2 * (32 * 37) + tk * 37 + e];
            LG[tk * 65 + e] = s;
        }
        __syncthreads();
        int* lcnt = (int*)(LG + 32 * 65);
        if (c.tid < 64) lcnt[c.tid] = 0;
        __syncthreads();
        int myL1 = 0, myL2 = 0, r1 = 0, r2 = 0; float w1 = 0.f, w2 = 0.f;
        if (c.tid < 32) {
            const float* lg = LG + c.tid * 65;
            float gl[4];
#pragma unroll
            for (int e = 0; e < 4; ++e) gl[e] = lg[e] + brg[e];
            int gi = 0; float gm = gl[0];
#pragma unroll
            for (int e = 1; e < 4; ++e) if (gl[e] > gm) { gm = gl[e]; gi = e; }
            float den = 0.f;
#pragma unroll
            for (int e = 0; e < 4; ++e) den += __expf(gl[e] - gm);
            const float gp = 1.f / den;
            float el[8];
#pragma unroll
            for (int e = 0; e < 8; ++e) el[e] = lg[4 + gi * 8 + e] + bre[gi * 8 + e];
            int i1 = 0; float v1 = el[0];
#pragma unroll
            for (int e = 1; e < 8; ++e) if (el[e] > v1) { v1 = el[e]; i1 = e; }
            int i2 = 0; float v2 = -INFINITY;
#pragma unroll
            for (int e = 0; e < 8; ++e) if (e != i1 && el[e] > v2) { v2 = el[e]; i2 = e; }
            const float ex = __expf(v2 - v1);
            w1 = gp / (1.f + ex); w2 = gp * ex / (1.f + ex);
            myL1 = (gi * 8 + i1) * 2; myL2 = (gi * 8 + i2) * 2 + 1;
            r1 = atomicAdd(&lcnt[myL1], 1); r2 = atomicAdd(&lcnt[myL2], 1);
        }
        __syncthreads();
        if (c.tid < 64) { const int n = lcnt[c.tid]; lcnt[c.tid] = (n > 0) ? atomicAdd(&cnt[c.tid], n) : 0; }
        __syncthreads();
        if (c.tid < 32) {
            const int t = t0 + c.tid;
            list[(size_t)myL1 * 32768 + lcnt[myL1] + r1] = t;
            list[(size_t)myL2 * 32768 + lcnt[myL2] + r2] = t;
            tokw[t * 2] = w1; tokw[t * 2 + 1] = w2;
        }
        __syncthreads();
    }
}

DI int moe_setup(const Ctx& c, KArgs& a, int ntn, int kfilter, int* tstart  ) {
    const int* cnt = (const int*)(a.ws + WS_CTL);
    if (c.tid < 64) {
        const int L = c.tid;
        const int n = __hip_atomic_load(&cnt[L], __ATOMIC_RELAXED, __HIP_MEMORY_SCOPE_AGENT);
        const int mine = (kfilter < 0 || (L & 1) == kfilter) ? ((n + 255) >> 8) * ntn : 0;
        int inc = mine;
#pragma unroll
        for (int o = 1; o < 64; o <<= 1) { const int tv = __shfl_up(inc, o); if (L >= o) inc += tv; }
        tstart[L] = inc - mine;
        if (L == 63) tstart[64] = inc;
    }
    __syncthreads();
    return tstart[64];
}

constexpr int MOE_LDS_OFF = G2_LDS_BYTES;
DI void phase_moe_up(const Ctx& c_in, KArgs& a) {
    const Ctx c = fresh_ctx(c_in.lds);
    unsigned char* ws = a.ws;
    const u16* act = (const u16*)(ws + WS_ACT);
    const int* cnt = (const int*)(ws + WS_CTL);
    const int* list = (const int*)(ws + WS_LIST);
    const float* tokw = (const float*)(ws + WS_TOKW);
    u16* hmid = (u16*)(ws + WS_HMID);
    int* tstart = (int*)(c.lds + MOE_LDS_OFF);
    int* tok_s = (int*)(c.lds + MOE_LDS_OFF + 512);
    int R, C; g2_stage_rc(c.tid * 16, R, C);
    const int total = moe_setup(c, a, 2, -1, tstart);
    for (int tile = vblock(); tile < total; tile += gridDim.x) {
        const int L = __popcll(__ballot(tstart[c.lane + 1] <= tile));
        const int rel = tile - tstart[L], mi = rel >> 1, nt = rel & 1;
        const int e = L >> 1, kr = L & 1;
        const int n = __hip_atomic_load(&cnt[L], __ATOMIC_RELAXED, __HIP_MEMORY_SCOPE_AGENT);
        __syncthreads();
        if (c.tid < 256) { const int r = mi * 256 + c.tid; tok_s[c.tid] = (r < n) ? list[(size_t)L * 32768 + r] : -1; }
        __syncthreads();
        G2Ptrs g;
        g.ra = g2_rsrc(act); g.rb = g2_rsrc(ws + WS_WG);
        { const int t0 = tok_s[R], t1 = tok_s[R + 64], t2 = tok_s[R + 128], t3 = tok_s[R + 192];
          g.va00 = (unsigned)((t0 < 0 ? 0 : t0) * 1024 + C) * 2u; g.va01 = (unsigned)((t1 < 0 ? 0 : t1) * 1024 + C) * 2u;
          g.va10 = (unsigned)((t2 < 0 ? 0 : t2) * 1024 + C) * 2u; g.va11 = (unsigned)((t3 < 0 ? 0 : t3) * 1024 + C) * 2u; }
        g.vb0 = (unsigned)(g2_perm32(R) * 1024 + C) * 2u; g.dsb = 64u * 2048u;
        g.sa = 0u; g.dsa = 0u; g.sb0 = (unsigned)(e * 256 + nt * 128) * 2048u; g.sb1 = g.sb0 + (unsigned)(WS_WU - WS_WG);
        gemm256_unit(c, g, 1024, [&](const f32x4 (&acc)[2][2][4][2], int wr, int wc, int fr, int fq) {
            int tks[2][4]; float wgs[2][4];
#pragma unroll
            for (int ai = 0; ai < 2; ++ai)
#pragma unroll
                for (int m = 0; m < 4; ++m) tks[ai][m] = tok_s[ai * 128 + wr * 64 + m * 16 + fr];
#pragma unroll
            for (int ai = 0; ai < 2; ++ai)
#pragma unroll
                for (int m = 0; m < 4; ++m) wgs[ai][m] = tokw[(tks[ai][m] < 0 ? 0 : tks[ai][m]) * 2 + kr];
#pragma unroll
            for (int ai = 0; ai < 2; ++ai)
#pragma unroll
                for (int m = 0; m < 4; ++m) {
                    const int tk = tks[ai][m];
                    if (tk >= 0) {
                        const float wgt = wgs[ai][m];
                        u16* dst = hmid + ((size_t)tk * 2 + kr) * 256 + nt * 128 + wc * 32 + 8 * fq;
                        const f32x4 g0 = acc[ai][0][m][0], u0 = acc[ai][1][m][0], g1 = acc[ai][0][m][1], u1 = acc[ai][1][m][1];
                        uint4 pk;
                        pk.x = pack2(siluf(g0[0]) * u0[0] * wgt, siluf(g0[1]) * u0[1] * wgt);
                        pk.y = pack2(siluf(g0[2]) * u0[2] * wgt, siluf(g0[3]) * u0[3] * wgt);
                        pk.z = pack2(siluf(g1[0]) * u1[0] * wgt, siluf(g1[1]) * u1[1] * wgt);
                        pk.w = pack2(siluf(g1[2]) * u1[2] * wgt, siluf(g1[3]) * u1[3] * wgt);
                        *(uint4*)dst = pk;
                    }
                }
        });
    }
}

DI void phase_moe_down(const Ctx& c_in, KArgs& a) {
    const Ctx c = fresh_ctx(c_in.lds);
    unsigned char* ws = a.ws;
    const int* cnt = (const int*)(ws + WS_CTL);
    const int* list = (const int*)(ws + WS_LIST);
    const u16* hmid = (const u16*)(ws + WS_HMID);
    u16* yffn = (u16*)(ws + WS_YFFN);
    int* tstart = (int*)(c.lds + MOE_LDS_OFF);
    int* tok_s = (int*)(c.lds + MOE_LDS_OFF + 512);
    int R, C; g2_stage_rc(c.tid * 16, R, C);
    const int total = moe_setup(c, a, 4, -1, tstart);
    for (int tile = vblock(); tile < total; tile += gridDim.x) {
        const int L = __popcll(__ballot(tstart[c.lane + 1] <= tile));
        const int rel = tile - tstart[L], mi = rel >> 2, nt = rel & 3;
        const int e = L >> 1, kr = L & 1;
        const int n = __hip_atomic_load(&cnt[L], __ATOMIC_RELAXED, __HIP_MEMORY_SCOPE_AGENT);
        __syncthreads();
        if (c.tid < 256) { const int r = mi * 256 + c.tid; tok_s[c.tid] = (r < n) ? list[(size_t)L * 32768 + r] : -1; }
        __syncthreads();
        G2Ptrs g;
        g.ra = g2_rsrc(hmid); g.rb = g2_rsrc(ws + WS_WD);
        { const int t0 = tok_s[R], t1 = tok_s[R + 64], t2 = tok_s[R + 128], t3 = tok_s[R + 192];
          g.va00 = (unsigned)(((t0 < 0 ? 0 : t0) * 2 + kr) * 256 + C) * 2u; g.va01 = (unsigned)(((t1 < 0 ? 0 : t1) * 2 + kr) * 256 + C) * 2u;
          g.va10 = (unsigned)(((t2 < 0 ? 0 : t2) * 2 + kr) * 256 + C) * 2u; g.va11 = (unsigned)(((t3 < 0 ? 0 : t3) * 2 + kr) * 256 + C) * 2u; }
        g.vb0 = (unsigned)(g2_perm32(R) * 256 + C) * 2u; g.dsb = 64u * 512u;
        g.sa = 0u; g.dsa = 0u; g.sb0 = (unsigned)(e * 1024 + nt * 256) * 512u; g.sb1 = g.sb0 + 128u * 512u;
        gemm256_unit(c, g, 256, [&](const f32x4 (&acc)[2][2][4][2], int wr, int wc, int fr, int fq) {
#pragma unroll
            for (int ai = 0; ai < 2; ++ai)
#pragma unroll
                for (int m = 0; m < 4; ++m) {
                    const int tk = tok_s[ai * 128 + wr * 64 + m * 16 + fr];
                    if (tk >= 0) {
                        u16* dst = yffn + ((size_t)tk * 2 + kr) * 1024 + nt * 256 + wc * 32 + 8 * fq;
#pragma unroll
                        for (int bj = 0; bj < 2; ++bj) {
                            const f32x4 v0 = acc[ai][bj][m][0], v1 = acc[ai][bj][m][1];
                            uint4 pk; pk.x = pack2(v0[0], v0[1]); pk.y = pack2(v0[2], v0[3]); pk.z = pack2(v1[0], v1[1]); pk.w = pack2(v1[2], v1[3]);
                            *(uint4*)(dst + bj * 128) = pk;
                        }
                    }
                }
        });
    }
}

DI void phase_final(const Ctx& c_in, KArgs& a) {
    const Ctx c = fresh_ctx(c_in.lds);
    float* x = a.out;
    const u16* xb = (const u16*)(a.ws + WS_XB);
    const u16* yf = (const u16*)(a.ws + WS_YFFN);
    const float* g = a.in[24];
    float4 gg[4];
#pragma unroll
    for (int j = 0; j < 4; ++j) gg[j] = *(const float4*)(g + c.lane * 4 + 256 * j);
    const int nit = T_TOK / 16, G = gridDim.x;
    uint2 cx[2][4], cy0[2][4], cy1[2][4];
    { const int i0 = min(bid(), nit - 1);
#pragma unroll
      for (int tt = 0; tt < 2; ++tt)
#pragma unroll
          for (int j = 0; j < 4; ++j) {
              const size_t t = (size_t)(i0 * 16 + c.wave * 2 + tt);
              cx[tt][j] = ldnt_u2(xb + t * 1024 + c.lane * 4 + 256 * j);
              cy0[tt][j] = ldnt_u2(yf + t * 2048 + c.lane * 4 + 256 * j); cy1[tt][j] = ldnt_u2(yf + t * 2048 + 1024 + c.lane * 4 + 256 * j);
          } }
    for (int it = bid(); it < nit; it += G) {
        uint2 nx[2][4], ny0[2][4], ny1[2][4];
        const int in_ = min(it + G, nit - 1);
#pragma unroll
        for (int tt = 0; tt < 2; ++tt)
#pragma unroll
            for (int j = 0; j < 4; ++j) {
                const size_t t = (size_t)(in_ * 16 + c.wave * 2 + tt);
                nx[tt][j] = ldnt_u2(xb + t * 1024 + c.lane * 4 + 256 * j);
                ny0[tt][j] = ldnt_u2(yf + t * 2048 + c.lane * 4 + 256 * j); ny1[tt][j] = ldnt_u2(yf + t * 2048 + 1024 + c.lane * 4 + 256 * j);
            }
#pragma unroll
        for (int tt = 0; tt < 2; ++tt) {
            const int t = it * 16 + c.wave * 2 + tt;
            float* xr = x + (size_t)t * 1024 + c.lane * 4;
            float4 v[4]; float ss = 0.f;
#pragma unroll
            for (int j = 0; j < 4; ++j) {
                const float4 xf = bf4_to_f4(cx[tt][j]), y0f = bf4_to_f4(cy0[tt][j]), y1f = bf4_to_f4(cy1[tt][j]);
                v[j] = make_float4(xf.x + (y0f.x + y1f.x), xf.y + (y0f.y + y1f.y), xf.z + (y0f.z + y1f.z), xf.w + (y0f.w + y1f.w));
                ss += v[j].x * v[j].x + v[j].y * v[j].y + v[j].z * v[j].z + v[j].w * v[j].w;
            }
            ss = wsum(ss);
            const float rs = rsqrtf(ss * (1.f / 1024.f) + EPS);
#pragma unroll
            for (int j = 0; j < 4; ++j)
                { const f32x4 o_ = {v[j].x * rs * gg[j].x, v[j].y * rs * gg[j].y, v[j].z * rs * gg[j].z, v[j].w * rs * gg[j].w};
                  __builtin_nontemporal_store(o_, (f32x4*)(xr + 256 * j)); }
        }
#pragma unroll
        for (int tt = 0; tt < 2; ++tt)
#pragma unroll
            for (int j = 0; j < 4; ++j) { cx[tt][j] = nx[tt][j]; cy0[tt][j] = ny0[tt][j]; cy1[tt][j] = ny1[tt][j]; }
    }
}

#define XB_TMO      128
#define XB_XCNT(j)  (256  + 64 * (j))
#define XB_XSUB(j)  (1280 + 64 * (j))
#define XB_XGEN(j)  (2304 + 64 * (j))
#define XB_TOP      3328
#define XB_TOPGEN   3392
#define XCD_BAR_WORDS 3456
#define XB_SPIN_CAP (1u << 22)
#define LAS __attribute__((address_space(3)))
DI unsigned xb_ld(unsigned* p)              { return __hip_atomic_load(p, __ATOMIC_RELAXED, __HIP_MEMORY_SCOPE_AGENT); }
DI unsigned xb_add(unsigned* p, unsigned v) { return __hip_atomic_fetch_add(p, v, __ATOMIC_RELAXED, __HIP_MEMORY_SCOPE_AGENT); }
DI unsigned xb_xcc_id() { return (unsigned)__builtin_amdgcn_s_getreg((3 << 11) | 20) & 0xFu; }
#define XB_SPIN(cond, bar) do { unsigned _sp = 0; while (cond) { __builtin_amdgcn_s_sleep(1); \
    if ((++_sp & 255u) == 0u) { if (xb_ld(&(bar)[XB_TMO])) break; if (_sp > XB_SPIN_CAP) { atomicAdd(&(bar)[XB_TMO], 1u); break; } } } } while (0)
struct XcdBarrier { unsigned* bar; unsigned x; volatile LAS unsigned* st; };
DI XcdBarrier xcd_barrier_post(unsigned* bar, volatile LAS unsigned* st) {
    XcdBarrier b; b.bar = bar; b.x = xb_xcc_id(); b.st = st;
    if (threadIdx.x == 0) (void)xb_add(&bar[XB_XCNT(b.x)], 1u);
    return b;
}
DI void xcd_barrier_complete(unsigned* bar, unsigned x, unsigned& nloc, unsigned& nx) {
    const unsigned G = gridDim.x * gridDim.y * gridDim.z;
    unsigned sum, cnt, mine, sp = 0u;
    for (;;) {
        sum = 0u; cnt = 0u; mine = 0u;
#pragma unroll
        for (unsigned j = 0; j < 16; ++j) { const unsigned cc = xb_ld(&bar[XB_XCNT(j)]); sum += cc; cnt += (cc > 0u) ? 1u : 0u; mine = (j == x) ? cc : mine; }
        if (sum == G) break;
        __builtin_amdgcn_s_sleep(1);
        if ((++sp & 255u) == 0u) { if (xb_ld(&bar[XB_TMO])) break; if (sp > XB_SPIN_CAP) { atomicAdd(&bar[XB_TMO], 1u); break; } }
    }
    nloc = mine > 0u ? mine : 1u; nx = cnt > 0u ? cnt : 1u;
}
DI XcdBarrier xcd_barrier_ctx(volatile LAS unsigned* st) {
    KArgs* kp = (KArgs*)__builtin_amdgcn_kernarg_segment_ptr(); asm volatile("" : "+s"(kp));
    XcdBarrier b; b.bar = (unsigned*)(kp->ws + WS_BAR); b.x = xb_xcc_id(); b.st = st;
    return b;
}
DI void xcd_barrier(const XcdBarrier& b) {
    asm volatile("s_waitcnt vmcnt(0)" ::: "memory");
    __syncthreads();
    if (threadIdx.x == 0) {
        unsigned* bar = b.bar;
        __builtin_amdgcn_s_waitcnt(0);
        unsigned nloc = b.st[0], nx = b.st[1];
        if (nloc == 0u) { xcd_barrier_complete(bar, b.x, nloc, nx); b.st[0] = nloc; b.st[1] = nx; }
        const unsigned old = xb_add(&bar[XB_XSUB(b.x)], 1u);
        const unsigned gen = old / nloc;
        if (old + 1u == (gen + 1u) * nloc) {
            __builtin_amdgcn_fence(__ATOMIC_RELEASE, "agent");
            asm volatile("s_waitcnt vmcnt(0)\n\tbuffer_inv sc1" ::: "memory");
            const unsigned og = xb_add(&bar[XB_TOP], 1u);
            const unsigned tg = og / nx;
            if (og + 1u == (tg + 1u) * nx) {
#pragma unroll
                for (unsigned j = 0; j < 16; ++j) xb_add(&bar[XB_XGEN(j)], 1u);
            } else XB_SPIN(xb_ld(&bar[XB_XGEN(b.x)]) == gen, bar);
            asm volatile("s_waitcnt vmcnt(0)" ::: "memory");
        } else {
            asm volatile("buffer_inv sc1" ::: "memory");
            XB_SPIN(xb_ld(&bar[XB_XGEN(b.x)]) == gen, bar);
            asm volatile("s_waitcnt vmcnt(0)" ::: "memory");
        }
    }
    __syncthreads();
}

template <int SP>
DI void run_phase(const Ctx& c, KArgs& a, int l) {
    if constexpr (SP == 11) phase_prep(c, a);
    else if constexpr (SP == 12) phase_final(c, a);
    else if constexpr (SP == 0) phase_norm_in(c, a, l);
    else if constexpr (SP == 1) phase_inproj(c, a, l);
    else if constexpr (SP == 2) {
        const int n_ssd = 256, n_q = 256, n_kv = 256;
        for (int it = bid(); it < n_ssd + n_q + n_kv; it += gridDim.x) {
            if (it < n_ssd) ssd_state_item(c, a, l, it);
            else if (it < n_ssd + n_q) mla_up_unit(c, a, l, 0, it - n_ssd);
            else mla_up_unit(c, a, l, 1, it - n_ssd - n_q);
        }
    }
    else if constexpr (SP == 3) { for (int it = bid(); it < 512; it += gridDim.x) ssd_scan_item(c, a, it); }
    else if constexpr (SP == 4) {
        int* ctr = (int*)(a.ws + WS_CTL) + 256 + l;
        volatile int* s_item = (volatile int*)(c.lds + LDS_BYTES - 32);
        for (;;) {
            __syncthreads();
            if (threadIdx.x == 0) *s_item = atomicAdd(ctr, 1);
            __syncthreads();
            const int it = *s_item;
            if (it >= 1024 + 512 + 256 + 768 - NCONV_PRE) break;
            if (it < 1024) {
                const int j = 15 - (it >> 6), r = it & 63;
                if (r >= 8 && r < 40) { const int rem = r - 8; attn_item<96, 0>(c, a, l, rem >> 2, rem & 3, j); }
                else {
                    const int sub = (r < 8) ? 3 : 2 - ((r - 40) >> 3);
                    const int b = r & 7, qb = 4 * j + sub;
                    { DsaPref pf; dsa_prefetch(fresh_ctx(c.lds), a, b, qb * 64, pf);
                      for (int g8 = 0; g8 < 8; ++g8) dsa_index_item(c, a, b, qb * 64 + g8 * 8, pf, g8 == 7); }
                    asm volatile("s_waitcnt vmcnt(0)" ::: "memory");
                    __syncthreads();
                    attn_item<64, 2>(c, a, l, b, 0, qb);
                }
            } else if (it < 1536) { const int i2 = it - 1024; attn_item<64, 1>(c, a, l, (i2 & 31) >> 2, i2 & 3, 15 - (i2 >> 5)); }
            else if (it < 1792) ssd_out_item(c, a, l, it - 1536);
            else { const Ctx cc = fresh_ctx(c.lds); expert_conv_item(cc, a, l, it - 1792 + NCONV_PRE); }
        }
    }
    else if constexpr (SP == 5) phase_outproj(c, a, l);
    else if constexpr (SP == 6) phase_router(c, a, l);
    else if constexpr (SP == 7) phase_moe_up(c, a);
    else if constexpr (SP == 8) phase_moe_down(c, a);
}

#ifndef ONE_LAUNCH
#define ONE_LAUNCH 1
#endif

#if ONE_LAUNCH
__global__ void __launch_bounds__(NTHR) mega(Args a_unused) {
    extern __shared__ __attribute__((aligned(16))) unsigned char lds[];
    cg::grid_group grid = cg::this_grid();
    Ctx c; c.tid = threadIdx.x; c.lane = c.tid & 63; c.wave = 0; c.lds = lds;
    volatile LAS unsigned* st = (volatile LAS unsigned*)(lds + LDS_BYTES - 16);
    if (threadIdx.x == 0) { st[0] = 0u; st[1] = 0u; }
    __syncthreads();
    (void)xcd_barrier_post((unsigned*)(a_unused.ws + WS_BAR), st);
#define bar xcd_barrier_ctx((volatile LAS unsigned*)(lds + LDS_BYTES - 16))
#ifdef PROBE_SP
#define MEGA_PHASE(SPN, L) do { KArgs* kp_ = (KArgs*)__builtin_amdgcn_kernarg_segment_ptr(); asm volatile("" : "+s"(kp_)); \
        const unsigned long long pt0_ = __builtin_amdgcn_s_memrealtime(); run_phase<SPN>(c, *kp_, (L)); \
        if (SPN == PROBE_SP) { xcd_barrier(bar); const unsigned long long pt1_ = __builtin_amdgcn_s_memrealtime(); \
            while (__builtin_amdgcn_s_memrealtime() - pt1_ < (pt1_ - pt0_)) __builtin_amdgcn_s_sleep(8); } } while (0)
#else
#define MEGA_PHASE(SPN, L) do { KArgs* kp_ = (KArgs*)__builtin_amdgcn_kernarg_segment_ptr(); asm volatile("" : "+s"(kp_)); run_phase<SPN>(c, *kp_, (L)); } while (0)
#endif
    MEGA_PHASE(11, 0);
    { KArgs* kq_ = (KArgs*)__builtin_amdgcn_kernarg_segment_ptr(); if (kq_->ph_lo == 0x7fffffff) grid.sync(); }
    xcd_barrier(bar);
#pragma unroll 1
    for (int l = 0; l < DEPTH; ++l) {
        if (l > 0) xcd_barrier(bar);
        MEGA_PHASE(0, l); xcd_barrier(bar);
        MEGA_PHASE(1, l); xcd_barrier(bar);
        MEGA_PHASE(2, l); xcd_barrier(bar);
        MEGA_PHASE(3, l); xcd_barrier(bar);
        MEGA_PHASE(4, l); xcd_barrier(bar);
        MEGA_PHASE(5, l); xcd_barrier(bar);
        MEGA_PHASE(6, l); xcd_barrier(bar);
        MEGA_PHASE(7, l); xcd_barrier(bar);
        MEGA_PHASE(8, l);
    }
    xcd_barrier(bar);
    MEGA_PHASE(12, 0);
#undef bar
}
#else
template <int SP>
__global__ void __launch_bounds__(NTHR) kphase(Args a, int l) {
    extern __shared__ __attribute__((aligned(16))) unsigned char lds[];
    Ctx c; c.tid = threadIdx.x; c.lane = c.tid & 63; c.wave = __builtin_amdgcn_readfirstlane(c.tid >> 6); c.lds = lds;
    KArgs* kp = (KArgs*)__builtin_amdgcn_kernarg_segment_ptr();
    run_phase<SP>(c, *kp, l);
}
template <int SP>
static void launch_phase(const Args& a, int l, int grid, hipStream_t stream) {
    static bool attr_set = false;
    if (!attr_set) { (void)hipFuncSetAttribute((const void*)kphase<SP>, hipFuncAttributeMaxDynamicSharedMemorySize, LDS_BYTES); attr_set = true; }
    hipLaunchKernelGGL(kphase<SP>, dim3(grid), dim3(NTHR), LDS_BYTES, stream, a, l);
}
#endif

extern "C" void kernel_launch(void* const* d_in, const int* in_sizes, int n_in, void* d_out, int out_size, void* d_ws, size_t ws_size, hipStream_t stream) {
    static int grid = 0;
    if (grid == 0) {
        if (n_in != 25 || ws_size < WS_END) { fprintf(stderr, "kernel_launch: unexpected inputs (n_in %d, ws %zu, need %zu)\n", n_in, ws_size, (size_t)WS_END); grid = -1; return; }
        int dev = 0, cus = 0;
        (void)hipGetDevice(&dev);
        (void)hipDeviceGetAttribute(&cus, hipDeviceAttributeMultiprocessorCount, dev);
        if (cus <= 0) cus = 256;
#if ONE_LAUNCH
        int per_cu = 0;
        if (hipFuncSetAttribute((const void*)mega, hipFuncAttributeMaxDynamicSharedMemorySize, LDS_BYTES) != hipSuccess) { fprintf(stderr, "kernel_launch: hipFuncSetAttribute failed\n"); grid = -1; return; }
        if (hipOccupancyMaxActiveBlocksPerMultiprocessor(&per_cu, (const void*)mega, NTHR, LDS_BYTES) != hipSuccess || per_cu < 1) { fprintf(stderr, "kernel_launch: occupancy query says %d blocks per CU\n", per_cu); (void)hipGetLastError(); grid = -1; return; }
        grid = cus;
#else
        grid = cus;
#endif
    }
    if (grid < 0) return;
    Args a{};
    for (int i = 0; i < 25; ++i) a.in[i] = (const float*)d_in[i];
    a.out = (float*)d_out; a.ws = (unsigned char*)d_ws;
    for (int i = 0; i < 8; ++i) a.inv16[i] = (float)pow(500000.0, -(double)i / 8.0);
    for (int i = 0; i < 16; ++i) a.inv32[i] = (float)pow(500000.0, -(double)i / 16.0);
    a.ph_lo = 0; a.ph_hi = 0;
#if ONE_LAUNCH
    (void)hipMemsetAsync((unsigned char*)d_ws + WS_CTL, 0, WS_CTL_BYTES, stream);
    void* kargs[] = { &a };
    hipError_t e = hipLaunchCooperativeKernel((const void*)mega, dim3(grid), dim3(NTHR), kargs, LDS_BYTES, stream);
    if (e != hipSuccess) fprintf(stderr, "kernel_launch: cooperative launch failed: %s (grid %d)\n", hipGetErrorString(e), grid);
#else
    launch_phase<11>(a, 0, grid, stream);
    for (int l = 0; l < DEPTH; ++l) {
        launch_phase<0>(a, l, grid, stream);
        launch_phase<1>(a, l, grid, stream);
        launch_phase<2>(a, l, grid, stream);
        launch_phase<3>(a, l, grid, stream);
        launch_phase<4>(a, l, grid, stream);
        launch_phase<5>(a, l, grid, stream);
        launch_phase<6>(a, l, grid, stream);
        launch_phase<7>(a, l, grid, stream);
        launch_phase<8>(a, l, grid, stream);
    }
    launch_phase<12>(a, 0, grid, stream);
#endif
}
```
